# Optimizing an MI355X kernel written in HIP

```python
import math
import jax
import jax.numpy as jnp
from jax import lax
import numpy as np

D_MODEL = 1024
BATCH = 16
SEQ = 4096
DEPTH = 1
DEC_BATCH = 16
DEC_SEQ = 2048
PAST_LEN = 128

N_META = 16
D_FF = 2816
EPS = 1e-6
H_A = 8
DH_A = 64
DV_A = 2 * DH_A
Q_BLOCK = 128
N_BUCKETS = 32
MAX_DISTANCE = 128
H_R = 16
N_R = 64
C_R = H_R * N_R
R_W = 64
R_A = 64
R_G = 128
LNX_EPS = 64e-5
ATT_QK = H_A * 2 * DH_A
ATT_V = H_A * DV_A
ATT_COLS = 2 * ATT_QK + ATT_V
RW_SIZES = (C_R, C_R, C_R, R_W, R_W, R_A, R_A, R_G)
RW_COLS = sum(RW_SIZES)
GATE_COLS = 2 * D_MODEL
N_IN = ATT_COLS + RW_COLS + GATE_COLS

kernel_name = 'hybrid_diffattn_rwkv7_encoder'


def _split(x, sizes):
    cuts, acc = [], 0
    for s in sizes[:-1]:
        acc += s
        cuts.append(acc)
    return jnp.split(x, cuts, axis=-1)


def _rmsnorm(x, g):
    xf = x.astype(jnp.float32)
    y = xf * lax.rsqrt(jnp.mean(xf * xf, axis=-1, keepdims=True) + EPS)
    return (y * g.astype(jnp.float32)).astype(x.dtype)


def _swiglu(x, w_gate, w_up, w_down):
    return (jax.nn.silu(x @ w_gate) * (x @ w_up)) @ w_down


def _rel_bucket(rel):
    nb = N_BUCKETS // 2
    max_exact = nb // 2
    n = jnp.abs(rel)
    nf = jnp.maximum(n, 1).astype(jnp.float32)
    large = max_exact + (jnp.log(nf / max_exact) / math.log(MAX_DISTANCE / max_exact) * (nb - max_exact)).astype(jnp.int32)
    large = jnp.minimum(large, nb - 1)
    return (rel > 0).astype(jnp.int32) * nb + jnp.where(n < max_exact, n, large)


def _diff_attention(q, k, v, lam, rel_bias):
    B, L = q.shape[0], q.shape[1]
    n_blk = -(-L // Q_BLOCK)
    Lp = n_blk * Q_BLOCK
    qb = jnp.pad(q, ((0, 0), (0, Lp - L), (0, 0), (0, 0), (0, 0)))
    qb = jnp.moveaxis(qb.reshape(B, n_blk, Q_BLOCK, H_A, 2, DH_A), 1, 0)
    k1, k2 = k[..., 0, :], k[..., 1, :]
    k_pos = jnp.arange(L, dtype=jnp.int32)
    scale = DH_A ** -0.5
    table = rel_bias.astype(jnp.float32)

    def block(args):
        q_blk, start = args
        q_pos = start + jnp.arange(Q_BLOCK, dtype=jnp.int32)
        bias = jnp.transpose(table[_rel_bucket(k_pos[None, :] - q_pos[:, None])], (2, 0, 1))
        s1 = jnp.einsum('bqhd,bkhd->bhqk', q_blk[..., 0, :], k1) * scale + bias
        s2 = jnp.einsum('bqhd,bkhd->bhqk', q_blk[..., 1, :], k2) * scale + bias
        p = jax.nn.softmax(s1, axis=-1) - lam * jax.nn.softmax(s2, axis=-1)
        return jnp.einsum('bhqk,bkhd->bqhd', p, v)

    starts = jnp.arange(n_blk, dtype=jnp.int32) * Q_BLOCK
    out = lax.map(block, (qb, starts))
    return jnp.moveaxis(out, 0, 1).reshape(B, Lp, H_A, DV_A)[:, :L]


def _diff_attn_branch(p, l, P):
    B, L = p.shape[0], p.shape[1]
    q, k, v = _split(p.astype(jnp.float32), (ATT_QK, ATT_QK, ATT_V))
    q = q.reshape(B, L, H_A, 2, DH_A)
    k = k.reshape(B, L, H_A, 2, DH_A)
    v = v.reshape(B, L, H_A, DV_A)
    lam_init = 0.8 - 0.6 * math.exp(-0.3 * l)
    lam = (jnp.exp(jnp.sum(P['attn_lambda_q1'][l].astype(jnp.float32) * P['attn_lambda_k1'][l]))
           - jnp.exp(jnp.sum(P['attn_lambda_q2'][l].astype(jnp.float32) * P['attn_lambda_k2'][l])) + lam_init)
    o = _diff_attention(q, k, v, lam, P['rel_bias'])
    o = _rmsnorm(o, P['attn_subln'][l]) * (1.0 - lam_init)
    return o.reshape(B, L, ATT_V) @ P['w_attn_branch'][l]


def _centred_shift_mix(p, mu_prev, mu_next):
    prev = jnp.pad(p, ((0, 0), (1, 0), (0, 0)))[:, :-1]
    nxt = jnp.pad(p, ((0, 0), (0, 1), (0, 0)))[:, 1:]
    return p + mu_prev * (prev - p) + mu_next * (nxt - p)


def _wkv7_scan(r, w, k, v, a, b, reverse):
    def step(S, inp):
        r_t, w_t, k_t, v_t, a_t, b_t = inp
        sa = jnp.einsum('bhvk,bhk->bhv', S, a_t)
        S = S * w_t[:, :, None, :] + sa[..., None] * b_t[:, :, None, :] + v_t[..., None] * k_t[:, :, None, :]
        return S, jnp.einsum('bhvk,bhk->bhv', S, r_t)

    xs = tuple(jnp.moveaxis(t, 1, 0) for t in (r, w, k, v, a, b))
    S0 = jnp.zeros((r.shape[0], H_R, N_R, N_R), jnp.float32)
    _, ys = lax.scan(step, S0, xs, reverse=reverse)
    return jnp.moveaxis(ys, 0, 1)


def _rwkv7_direction(rh, vh, k, kk, wd, ad, w0, w2, a0, a2, k_a, r_k, reverse):
    B, L = k.shape[0], k.shape[1]
    logw = -jax.nn.softplus(-(w0 + jnp.tanh(wd) @ w2)) - 0.5
    decay = jnp.exp(-jnp.exp(logw)).reshape(B, L, H_R, N_R)
    a = jax.nn.sigmoid(a0 + ad @ a2)
    kd = (k * (1.0 + (a - 1.0) * k_a)).reshape(B, L, H_R, N_R)
    ah = a.reshape(B, L, H_R, N_R)
    y = _wkv7_scan(rh, decay, kd, vh, -kk, kk * ah, reverse)
    bonus = jnp.sum(rh * kd * r_k, axis=-1, keepdims=True) * vh
    return y, bonus


def _rwkv7_branch(p, l, P):
    B, L = p.shape[0], p.shape[1]
    p = _centred_shift_mix(p.astype(jnp.float32), P['rw_mu_prev'][l], P['rw_mu_next'][l])
    r, k, v, wd_f, wd_b, ad_f, ad_b, gd = _split(p, RW_SIZES)
    g = jax.nn.sigmoid(gd) @ P['rw_g2'][l]
    kk = (k * P['rw_k_k'][l]).reshape(B, L, H_R, N_R)
    kk = kk / jnp.maximum(jnp.sqrt(jnp.sum(kk * kk, axis=-1, keepdims=True)), 1e-12)
    rh = r.reshape(B, L, H_R, N_R)
    vh = v.reshape(B, L, H_R, N_R)
    y_f, bonus_f = _rwkv7_direction(rh, vh, k, kk, wd_f, ad_f, P['rw_w0'][l, 0], P['rw_w2'][l, 0],
                                    P['rw_a0'][l, 0], P['rw_a2'][l, 0], P['rw_k_a'][l], P['rw_r_k'][l], False)
    y_b, bonus_b = _rwkv7_direction(rh, vh, k, kk, wd_b, ad_b, P['rw_w0'][l, 1], P['rw_w2'][l, 1],
                                    P['rw_a0'][l, 1], P['rw_a2'][l, 1], P['rw_k_a'][l], P['rw_r_k'][l], True)
    y = y_f + y_b
    mu = jnp.mean(y, axis=-1, keepdims=True)
    var = jnp.mean(jnp.square(y - mu), axis=-1, keepdims=True)
    y = ((y - mu) * lax.rsqrt(var + LNX_EPS)).reshape(B, L, C_R) * P['rw_lnx_w'][l] + P['rw_lnx_b'][l]
    y = y + (bonus_f + bonus_b).reshape(B, L, C_R)
    return (y * g) @ P['w_rw_branch'][l]


def _layer(x, l, P):
    dt = x.dtype
    h = x + (0.5 * _swiglu(_rmsnorm(x, P['ffn1_norm'][l]), P['ffn1_w_gate'][l], P['ffn1_w_up'][l], P['ffn1_w_down'][l])).astype(dt)
    u = _rmsnorm(h, P['mix_norm'][l])
    p_att, p_rw, p_gate = _split(u @ P['w_in'][l], (ATT_COLS, RW_COLS, GATE_COLS))
    y_att = _diff_attn_branch(p_att, l, P)
    y_rw = _rwkv7_branch(p_rw, l, P)
    g_att, g_rw = jnp.split(jax.nn.sigmoid(p_gate.astype(jnp.float32)), 2, axis=-1)
    merged = g_att * y_att + g_rw * y_rw
    h = h + (merged @ P['w_out'][l]).astype(dt)
    h = h + (0.5 * _swiglu(_rmsnorm(h, P['ffn2_norm'][l]), P['ffn2_w_gate'][l], P['ffn2_w_up'][l], P['ffn2_w_down'][l])).astype(dt)
    return h


def _encode(x, P):
    B = x.shape[0]
    meta = jnp.broadcast_to(P['meta_tokens'].astype(x.dtype)[None], (B, N_META, D_MODEL))
    h = jnp.concatenate([meta, x], axis=1)
    for l in range(DEPTH):
        h = _layer(h, l, P)
    return _rmsnorm(h, P['final_norm'])[:, N_META:]


def setup_inputs(seed: int = 0) -> dict:
    key = jax.random.key(seed)
    ks = iter(jax.random.split(key, 48))
    f32 = jnp.float32

    def nrm(shape, scale):
        return jax.random.normal(next(ks), shape, f32) * scale

    def gain(shape):
        return 1.0 + nrm(shape, 0.02)

    def unif(shape, lo, hi):
        return jax.random.uniform(next(ks), shape, f32, lo, hi)

    return {
        'x_prompt': nrm((BATCH, SEQ, D_MODEL), 1.0),
        'x_sample': nrm((DEC_BATCH, DEC_SEQ, D_MODEL), 1.0),
        'meta_tokens': nrm((N_META, D_MODEL), 1.0),
        'rel_bias': nrm((N_BUCKETS, H_A), 0.5),
        'ffn1_norm': gain((DEPTH, D_MODEL)),
        'ffn1_w_gate': nrm((DEPTH, D_MODEL, D_FF), D_MODEL ** -0.5),
        'ffn1_w_up': nrm((DEPTH, D_MODEL, D_FF), D_MODEL ** -0.5),
        'ffn1_w_down': nrm((DEPTH, D_FF, D_MODEL), D_FF ** -0.5),
        'mix_norm': gain((DEPTH, D_MODEL)),
        'w_in': nrm((DEPTH, D_MODEL, N_IN), D_MODEL ** -0.5),
        'attn_lambda_q1': nrm((DEPTH, DH_A), 0.1),
        'attn_lambda_k1': nrm((DEPTH, DH_A), 0.1),
        'attn_lambda_q2': nrm((DEPTH, DH_A), 0.1),
        'attn_lambda_k2': nrm((DEPTH, DH_A), 0.1),
        'attn_subln': gain((DEPTH, DV_A)),
        'w_attn_branch': nrm((DEPTH, ATT_V, D_MODEL), ATT_V ** -0.5),
        'rw_mu_prev': unif((DEPTH, RW_COLS), 0.0, 0.5),
        'rw_mu_next': unif((DEPTH, RW_COLS), 0.0, 0.5),
        'rw_w0': unif((DEPTH, 2, C_R), -6.0, -1.0),
        'rw_w2': nrm((DEPTH, 2, R_W, C_R), 0.5 * R_W ** -0.5),
        'rw_a0': nrm((DEPTH, 2, C_R), 0.5),
        'rw_a2': nrm((DEPTH, 2, R_A, C_R), 0.5 * R_A ** -0.5),
        'rw_g2': nrm((DEPTH, R_G, C_R), R_G ** -0.5),
        'rw_k_k': 0.85 + nrm((DEPTH, C_R), 0.02),
        'rw_k_a': gain((DEPTH, C_R)),
        'rw_r_k': nrm((DEPTH, H_R, N_R), 0.1),
        'rw_lnx_w': gain((DEPTH, C_R)),
        'rw_lnx_b': nrm((DEPTH, C_R), 0.02),
        'w_rw_branch': nrm((DEPTH, C_R, D_MODEL), C_R ** -0.5),
        'w_out': nrm((DEPTH, D_MODEL, D_MODEL), D_MODEL ** -0.5),
        'ffn2_norm': gain((DEPTH, D_MODEL)),
        'ffn2_w_gate': nrm((DEPTH, D_MODEL, D_FF), D_MODEL ** -0.5),
        'ffn2_w_up': nrm((DEPTH, D_MODEL, D_FF), D_MODEL ** -0.5),
        'ffn2_w_down': nrm((DEPTH, D_FF, D_MODEL), D_FF ** -0.5),
        'final_norm': gain((D_MODEL,)),
    }


def reference(x_prompt, x_sample, meta_tokens, rel_bias, ffn1_norm, ffn1_w_gate, ffn1_w_up, ffn1_w_down,
              mix_norm, w_in, attn_lambda_q1, attn_lambda_k1, attn_lambda_q2, attn_lambda_k2, attn_subln,
              w_attn_branch, rw_mu_prev, rw_mu_next, rw_w0, rw_w2, rw_a0, rw_a2, rw_g2, rw_k_k, rw_k_a,
              rw_r_k, rw_lnx_w, rw_lnx_b, w_rw_branch, w_out, ffn2_norm, ffn2_w_gate, ffn2_w_up,
              ffn2_w_down, final_norm):
    P = dict(meta_tokens=meta_tokens, rel_bias=rel_bias, ffn1_norm=ffn1_norm, ffn1_w_gate=ffn1_w_gate,
             ffn1_w_up=ffn1_w_up, ffn1_w_down=ffn1_w_down, mix_norm=mix_norm, w_in=w_in,
             attn_lambda_q1=attn_lambda_q1, attn_lambda_k1=attn_lambda_k1, attn_lambda_q2=attn_lambda_q2,
             attn_lambda_k2=attn_lambda_k2, attn_subln=attn_subln, w_attn_branch=w_attn_branch,
             rw_mu_prev=rw_mu_prev, rw_mu_next=rw_mu_next, rw_w0=rw_w0, rw_w2=rw_w2, rw_a0=rw_a0,
             rw_a2=rw_a2, rw_g2=rw_g2, rw_k_k=rw_k_k, rw_k_a=rw_k_a, rw_r_k=rw_r_k, rw_lnx_w=rw_lnx_w,
             rw_lnx_b=rw_lnx_b, w_rw_branch=w_rw_branch, w_out=w_out, ffn2_norm=ffn2_norm,
             ffn2_w_gate=ffn2_w_gate, ffn2_w_up=ffn2_w_up, ffn2_w_down=ffn2_w_down, final_norm=final_norm)
    y_prompt = _encode(x_prompt, P)
    y_sample = _encode(x_sample, P)
    return (y_prompt, y_sample)
```

```cpp
#include <hip/hip_runtime.h>
#include <hip/hip_cooperative_groups.h>
#include <stdint.h>
#include <string.h>
#include <stdio.h>
namespace cg = cooperative_groups;

typedef unsigned short u16;
typedef short bf16x8 __attribute__((ext_vector_type(8)));
typedef float f32x16 __attribute__((ext_vector_type(16)));
typedef float f32x4 __attribute__((ext_vector_type(4)));
typedef float f32x2 __attribute__((ext_vector_type(2)));
typedef unsigned u32x4 __attribute__((ext_vector_type(4)));
typedef unsigned u32x2 __attribute__((ext_vector_type(2)));
typedef __bf16 bf16x2_t __attribute__((ext_vector_type(2)));
typedef _Float16 f16x2_t __attribute__((ext_vector_type(2)));

#define NIN 8576
#define FFD 2816
#define EPSN 1e-6f
#define LOG2E 1.4426950408889634f
#define NGROUPS 6
#define PH_PER_G 13
#define NPHASES (1 + NGROUPS * PH_PER_G)
#define MAXROWS 16512

struct Params {
  const float *x_prompt, *x_sample, *meta, *rel_bias, *ffn1_norm, *ffn1_wg, *ffn1_wu, *ffn1_wd, *mix_norm, *w_in;
  const float *lq1, *lk1, *lq2, *lk2, *subln, *w_attn, *mu_prev, *mu_next, *rw_w0, *rw_w2, *rw_a0, *rw_a2, *rw_g2;
  const float *k_k, *k_a, *r_k, *lnx_w, *lnx_b, *w_rw, *w_out, *ffn2_norm, *ffn2_wg, *ffn2_wu, *ffn2_wd, *final_norm;
  float* out;
  u16 *W1A, *WD1, *WIN, *WATT, *WRW, *WOUT, *W2A, *WD2, *W2F, *W2B, *A2F, *A2B, *G2T;
  float* lut; int* cnt; float* lam;
  float* H; u16 *HB, *ACT, *P, *RKV, *DIR0, *DIR1, *G, *O, *MERGED, *Y0, *Y1, *F;
  float *ss0, *ss1, *ss2, *ss3;
};

typedef const Params __attribute__((address_space(4))) CP;
struct Grp { int nseq, L, S, M; const float* x; float* out; };

__device__ __forceinline__ Grp get_grp(CP& p, int g) {
  Grp r;
  if (g < 4) { r.nseq = 4; r.L = 4112; r.S = 4096; r.x = p.x_prompt + (size_t)g * 4 * 4096 * 1024; r.out = p.out + (size_t)g * 4 * 4096 * 1024; }
  else { r.nseq = 8; r.L = 2064; r.S = 2048; r.x = p.x_sample + (size_t)(g - 4) * 8 * 2048 * 1024; r.out = p.out + (size_t)16 * 4096 * 1024 + (size_t)(g - 4) * 8 * 2048 * 1024; }
  r.M = r.nseq * r.L;
  return r;
}

__device__ __forceinline__ unsigned pk_bf16(float a, float b) {
  f32x2 v = {a, b};
  bf16x2_t r = __builtin_convertvector(v, bf16x2_t);
  return __builtin_bit_cast(unsigned, r);
}
__device__ __forceinline__ float bf_lo(unsigned u) { return __uint_as_float(u << 16); }
__device__ __forceinline__ float bf_hi(unsigned u) { return __uint_as_float(u & 0xffff0000u); }
__device__ __forceinline__ unsigned pk_f16(float a, float b) {
  f32x2 v = {a, b};
  f16x2_t r = __builtin_convertvector(v, f16x2_t);
  return __builtin_bit_cast(unsigned, r);
}
__device__ __forceinline__ float h_lo(unsigned u) { f16x2_t r = __builtin_bit_cast(f16x2_t, u); return (float)r.x; }
__device__ __forceinline__ float h_hi(unsigned u) { f16x2_t r = __builtin_bit_cast(f16x2_t, u); return (float)r.y; }
__device__ __forceinline__ u16 bf16_1(float a) { return (u16)(pk_bf16(a, 0.f) & 0xffffu); }
__device__ __forceinline__ float sigm(float x) { return 1.f / (1.f + __expf(-x)); }
__device__ __forceinline__ float wave_sum(float v) {
#pragma unroll
  for (int o = 32; o > 0; o >>= 1) v += __shfl_xor(v, o);
  return v;
}
template <int CTRL> __device__ __forceinline__ float dppf(float x) {
  return __int_as_float(__builtin_amdgcn_update_dpp(0, __float_as_int(x), CTRL, 0xf, 0xf, true));
}
__device__ __forceinline__ float reduce8(float x) {
  x += dppf<0xB1>(x);
  x += dppf<0x4E>(x);
  x += dppf<0x141>(x);
  return x;
}
__device__ __forceinline__ float reduce4(float x) {
  x += dppf<0xB1>(x);
  x += dppf<0x4E>(x);
  return x;
}

__device__ void prep_transpose(const float* __restrict__ src, int K, int N, u16* __restrict__ dst,
                               const float* __restrict__ gain, int mode, char* lds) {
  float* tile = (float*)lds;
  const int tn = N / 64, nt = (K / 64) * tn;
  const int tid = threadIdx.x;
  for (int t = blockIdx.x; t < nt; t += gridDim.x) {
    const int k0 = (t / tn) * 64, n0 = (t % tn) * 64;
    const int nl = tid & 63, kq = tid >> 6;
#pragma unroll
    for (int i = 0; i < 16; ++i) {
      const int k = i * 4 + kq;
      float v = src[(size_t)(k0 + k) * N + n0 + nl];
      if (gain) v *= gain[k0 + k];
      tile[k * 65 + nl] = v;
    }
    __syncthreads();
    const int n = tid >> 2, kk = (tid & 3) * 16;
    unsigned w[8];
#pragma unroll
    for (int i = 0; i < 8; ++i) w[i] = pk_bf16(tile[(kk + 2 * i) * 65 + n], tile[(kk + 2 * i + 1) * 65 + n]);
    const int ng = n0 + n;
    const int row = mode == 0 ? ng : ((ng >> 5) * 64 + (ng & 31) + (mode == 2 ? 32 : 0));
    u32x4* d = (u32x4*)(dst + (size_t)row * K + k0 + kk);
    d[0] = (u32x4){w[0], w[1], w[2], w[3]};
    d[1] = (u32x4){w[4], w[5], w[6], w[7]};
    __syncthreads();
  }
}

__device__ void phase_prep(CP& p, char* lds) {
  if (blockIdx.x == 0) {
    const int tid = threadIdx.x;
    if (tid < 16) p.cnt[tid] = 0;
    for (int idx = tid; idx < 8 * 511; idx += 256) {
      const int hd = idx / 511, di = idx - hd * 511, d = di - 255;
      const int n = d < 0 ? -d : d;
      int bk;
      if (n < 8) bk = n;
      else {
        const float nf = (float)n;
        int large = 8 + (int)(logf(nf / 8.0f) / 2.772588722239781f * 8.0f);
        bk = large < 15 ? large : 15;
      }
      const int bucket = (d > 0 ? 16 : 0) + bk;
      p.lut[hd * 512 + di] = p.rel_bias[bucket * 8 + hd] * LOG2E;
    }
    if (tid == 0) {
      float s1 = 0.f, s2 = 0.f;
      for (int i = 0; i < 64; ++i) { s1 += p.lq1[i] * p.lk1[i]; s2 += p.lq2[i] * p.lk2[i]; }
      p.lam[0] = expf(s1) - expf(s2) + 0.2f;
    }
  }
  prep_transpose(p.ffn1_wg, 1024, FFD, p.W1A, p.ffn1_norm, 1, lds);
  prep_transpose(p.ffn1_wu, 1024, FFD, p.W1A, p.ffn1_norm, 2, lds);
  prep_transpose(p.ffn1_wd, FFD, 1024, p.WD1, nullptr, 0, lds);
  prep_transpose(p.w_in, 1024, NIN, p.WIN, p.mix_norm, 0, lds);
  prep_transpose(p.w_attn, 1024, 1024, p.WATT, nullptr, 0, lds);
  prep_transpose(p.w_rw, 1024, 1024, p.WRW, nullptr, 0, lds);
  prep_transpose(p.w_out, 1024, 1024, p.WOUT, nullptr, 0, lds);
  prep_transpose(p.ffn2_wg, 1024, FFD, p.W2A, p.ffn2_norm, 1, lds);
  prep_transpose(p.ffn2_wu, 1024, FFD, p.W2A, p.ffn2_norm, 2, lds);
  prep_transpose(p.ffn2_wd, FFD, 1024, p.WD2, nullptr, 0, lds);
  prep_transpose(p.rw_w2, 64, 1024, p.W2F, nullptr, 0, lds);
  prep_transpose(p.rw_w2 + 64 * 1024, 64, 1024, p.W2B, nullptr, 0, lds);
  prep_transpose(p.rw_a2, 64, 1024, p.A2F, nullptr, 0, lds);
  prep_transpose(p.rw_a2 + 64 * 1024, 64, 1024, p.A2B, nullptr, 0, lds);
  prep_transpose(p.rw_g2, 128, 1024, p.G2T, nullptr, 0, lds);
}

__device__ void phase_rows(CP& p, const Grp& G) {
  const int lane = threadIdx.x & 63;
  const int nw = gridDim.x * 4;
  for (int row = blockIdx.x * 4 + (threadIdx.x >> 6); row < G.M; row += nw) {
    const int s = row / G.L, t = row - s * G.L;
    const float* src = t < 16 ? p.meta + t * 1024 : G.x + ((size_t)s * G.S + (t - 16)) * 1024;
    float ss = 0.f;
#pragma unroll
    for (int i = 0; i < 4; ++i) {
      const f32x4 v = *(const f32x4*)(src + i * 256 + lane * 4);
      ss += v.x * v.x + v.y * v.y + v.z * v.z + v.w * v.w;
      u32x2 o = {pk_bf16(v.x, v.y), pk_bf16(v.z, v.w)};
      *(u32x2*)(p.HB + (size_t)row * 1024 + i * 256 + lane * 4) = o;
    }
    ss = wave_sum(ss);
    if (lane == 0) { p.ss0[row] = ss; p.ss1[row] = 0.f; p.ss2[row] = 0.f; p.ss3[row] = 0.f; }
  }
}

__device__ __forceinline__ void gemm_kloop(f32x16 (&acc)[2][2], const u16* __restrict__ A, int lda, int M, int m0,
                                           const u16* __restrict__ W, int ldw, int n0, int K, char* lds) {
  const int tid = threadIdx.x, lane = tid & 63, wave = tid >> 6;
  const int wn = wave & 1, wt = wave >> 1, l32 = lane & 31, h = lane >> 5;
  u32x4 ra[4], rw[4];
  const u16* ap[4];
  const u16* wp[4];
  int ldso[4];
#pragma unroll
  for (int i = 0; i < 4; ++i) {
    const int c = tid + 256 * i, row = c >> 3, ch = c & 7;
    int ar = m0 + row; ar = ar < M ? ar : M - 1;
    ap[i] = A + (size_t)ar * lda + ch * 8;
    wp[i] = W + (size_t)(n0 + row) * ldw + ch * 8;
    ldso[i] = row * 128 + ((ch ^ ((row >> 1) & 7)) << 4);
  }
  int wro[2], wsw[2], aro[2], asw[2];
#pragma unroll
  for (int b = 0; b < 2; ++b) {
    const int wr = wn * 64 + b * 32 + l32, ar = wt * 64 + b * 32 + l32;
    wro[b] = wr * 128; wsw[b] = (wr >> 1) & 7;
    aro[b] = 16384 + ar * 128; asw[b] = (ar >> 1) & 7;
  }
  const int nk = K >> 6;
#pragma unroll
  for (int i = 0; i < 4; ++i) { ra[i] = *(const u32x4*)(ap[i]); rw[i] = *(const u32x4*)(wp[i]); }
#pragma unroll
  for (int i = 0; i < 4; ++i) { *(u32x4*)(lds + ldso[i]) = rw[i]; *(u32x4*)(lds + 16384 + ldso[i]) = ra[i]; }
  __syncthreads();
  for (int kt = 0; kt < nk; ++kt) {
    const bool more = kt + 1 < nk;
    if (more) {
#pragma unroll
      for (int i = 0; i < 4; ++i) { ra[i] = *(const u32x4*)(ap[i] + (kt + 1) * 64); rw[i] = *(const u32x4*)(wp[i] + (kt + 1) * 64); }
    }
    const char* st = lds + (kt & 1) * 32768;
#pragma unroll
    for (int ks = 0; ks < 4; ++ks) {
      bf16x8 wf[2], af[2];
#pragma unroll
      for (int b = 0; b < 2; ++b) {
        wf[b] = *(const bf16x8*)(st + wro[b] + (((ks * 2 + h) ^ wsw[b]) << 4));
        af[b] = *(const bf16x8*)(st + aro[b] + (((ks * 2 + h) ^ asw[b]) << 4));
      }
#pragma unroll
      for (int nb = 0; nb < 2; ++nb)
#pragma unroll
        for (int tb = 0; tb < 2; ++tb)
          acc[nb][tb] = __builtin_amdgcn_mfma_f32_32x32x16_bf16(wf[nb], af[tb], acc[nb][tb], 0, 0, 0);
    }
    if (more) {
      char* sn = lds + ((kt + 1) & 1) * 32768;
#pragma unroll
      for (int i = 0; i < 4; ++i) { *(u32x4*)(sn + ldso[i]) = rw[i]; *(u32x4*)(sn + 16384 + ldso[i]) = ra[i]; }
    }
    __syncthreads();
  }
}

__device__ __forceinline__ void zero_acc(f32x16 (&acc)[2][2]) {
#pragma unroll
  for (int a = 0; a < 2; ++a)
#pragma unroll
    for (int b = 0; b < 2; ++b)
#pragma unroll
      for (int r = 0; r < 16; ++r) acc[a][b][r] = 0.f;
}

template <class F>
__device__ __forceinline__ void gemm_phase(const u16* A, int lda, int M, const u16* W, int K, int N, char* lds, F&& epi) {
  const int nN = N >> 7, nM = (M + 127) >> 7, nt = nN * nM;
  const int wave = threadIdx.x >> 6;
  for (int t = blockIdx.x; t < nt; t += gridDim.x) {
    const int tm = t / nN, tn = t - tm * nN;
    f32x16 acc[2][2];
    zero_acc(acc);
    gemm_kloop(acc, A, lda, M, tm * 128, W, K, tn * 128, K, lds);
    epi(acc, tn * 128 + (wave & 1) * 64, tm * 128 + (wave >> 1) * 64);
  }
}

__device__ __forceinline__ void epi_swiglu(const f32x16 (&acc)[2][2], int nbase, int tbase, int M, const float* ss, u16* ACT) {
  const int lane = threadIdx.x & 63, l32 = lane & 31, h = lane >> 5;
  const int cb = (nbase >> 6) * 32;
#pragma unroll
  for (int tb = 0; tb < 2; ++tb) {
    const int tok = tbase + tb * 32 + l32;
    if (tok < M) {
      const float rs = rsqrtf(ss[tok] * (1.f / 1024.f) + EPSN);
      u16* dst = ACT + (size_t)tok * FFD + cb + 4 * h;
#pragma unroll
      for (int i = 0; i < 4; ++i) {
        float o[4];
#pragma unroll
        for (int j = 0; j < 4; ++j) {
          const float g = acc[0][tb][4 * i + j] * rs, u = acc[1][tb][4 * i + j] * rs;
          o[j] = g * sigm(g) * u;
        }
        *(u32x2*)(dst + 8 * i) = (u32x2){pk_bf16(o[0], o[1]), pk_bf16(o[2], o[3])};
      }
    }
  }
}

template <int MODE>
__device__ __forceinline__ void epi_resid(const f32x16 (&acc)[2][2], int nbase, int tbase, CP& p, const Grp& G) {
  const int lane = threadIdx.x & 63, l32 = lane & 31, h = lane >> 5;
  const float scale = MODE == 1 ? 1.f : 0.5f;
  float* ssout = MODE == 0 ? p.ss1 : (MODE == 1 ? p.ss2 : p.ss3);
#pragma unroll
  for (int tb = 0; tb < 2; ++tb) {
    const int tok = tbase + tb * 32 + l32;
    const bool valid = tok < G.M;
    float sq = 0.f;
    if (valid) {
      float* hp = p.H + (size_t)tok * 1024;
      const float* rp = hp;
      if (MODE == 0) {
        const int s = tok / G.L, t = tok - s * G.L;
        rp = t < 16 ? p.meta + t * 1024 : G.x + ((size_t)s * G.S + (t - 16)) * 1024;
      }
#pragma unroll
      for (int nb = 0; nb < 2; ++nb)
#pragma unroll
        for (int i = 0; i < 4; ++i) {
          const int n = nbase + nb * 32 + 8 * i + 4 * h;
          const f32x4 r = *(const f32x4*)(rp + n);
          f32x4 v;
          v.x = r.x + scale * acc[nb][tb][4 * i + 0];
          v.y = r.y + scale * acc[nb][tb][4 * i + 1];
          v.z = r.z + scale * acc[nb][tb][4 * i + 2];
          v.w = r.w + scale * acc[nb][tb][4 * i + 3];
          *(f32x4*)(hp + n) = v;
          sq += v.x * v.x + v.y * v.y + v.z * v.z + v.w * v.w;
          if (MODE != 2) *(u32x2*)(p.HB + (size_t)tok * 1024 + n) = (u32x2){pk_bf16(v.x, v.y), pk_bf16(v.z, v.w)};
        }
    }
    sq += __shfl_xor(sq, 32);
    if (valid && h == 0) atomicAdd(ssout + tok, sq);
  }
}

__device__ void phase_mix(CP& p, const Grp& G) {
  const int total = G.M * 432;
  for (int idx = blockIdx.x * 256 + threadIdx.x; idx < total; idx += gridDim.x * 256) {
    const int row = idx / 432, ch = idx - row * 432;
    const int t = row % G.L;
    const int col = ch * 8;
    const u16* pc = p.P + (size_t)row * NIN + 3072 + col;
    const u32x4 c = *(const u32x4*)pc;
    u32x4 pv = {0, 0, 0, 0}, nx = {0, 0, 0, 0};
    if (t > 0) pv = *(const u32x4*)(pc - NIN);
    if (t < G.L - 1) nx = *(const u32x4*)(pc + NIN);
    const f32x4 mp0 = *(const f32x4*)(p.mu_prev + col), mp1 = *(const f32x4*)(p.mu_prev + col + 4);
    const f32x4 mn0 = *(const f32x4*)(p.mu_next + col), mn1 = *(const f32x4*)(p.mu_next + col + 4);
    float o[8];
#pragma unroll
    for (int e = 0; e < 4; ++e) {
      const float c0 = bf_lo(c[e]), c1 = bf_hi(c[e]);
      const float mpa = e < 2 ? mp0[2 * e] : mp1[2 * e - 4], mpb = e < 2 ? mp0[2 * e + 1] : mp1[2 * e - 3];
      const float mna = e < 2 ? mn0[2 * e] : mn1[2 * e - 4], mnb = e < 2 ? mn0[2 * e + 1] : mn1[2 * e - 3];
      o[2 * e] = c0 + mpa * (bf_lo(pv[e]) - c0) + mna * (bf_lo(nx[e]) - c0);
      o[2 * e + 1] = c1 + mpb * (bf_hi(pv[e]) - c1) + mnb * (bf_hi(nx[e]) - c1);
    }
    if (col < 3072) {
      const int sec = col >> 10, ci = col & 1023, head = ci >> 6, c0 = ci & 63;
      const size_t ro = ((size_t)row * 16 + head) * 192 + sec * 64 + c0;
      const u32x4 pk = (u32x4){pk_f16(o[0], o[1]), pk_f16(o[2], o[3]), pk_f16(o[4], o[5]), pk_f16(o[6], o[7])};
      *(u32x4*)(p.RKV + ro) = pk;
      if (sec == 1) { *(u32x4*)(p.DIR0 + ro) = pk; *(u32x4*)(p.DIR1 + ro) = pk; }
    } else {
      const int fc = col - 3072;
      if (fc < 128) {
#pragma unroll
        for (int e = 0; e < 8; ++e) o[e] = 1.f - 2.f / (1.f + __expf(2.f * o[e]));
      } else if (fc >= 256) {
#pragma unroll
        for (int e = 0; e < 8; ++e) o[e] = sigm(o[e]);
      }
      *(u32x4*)(p.F + (size_t)row * 384 + fc) = (u32x4){pk_bf16(o[0], o[1]), pk_bf16(o[2], o[3]), pk_bf16(o[4], o[5]), pk_bf16(o[6], o[7])};
    }
  }
}

__device__ __forceinline__ void epi_decay(const f32x16 (&acc)[2][2], int nbase, int tbase, int M, const float* w0, u16* DIR) {
  const int lane = threadIdx.x & 63, l32 = lane & 31, h = lane >> 5;
  const int head = nbase >> 6;
#pragma unroll
  for (int tb = 0; tb < 2; ++tb) {
    const int tok = tbase + tb * 32 + l32;
    if (tok < M) {
      u16* dst = DIR + ((size_t)tok * 16 + head) * 192;
#pragma unroll
      for (int nb = 0; nb < 2; ++nb)
#pragma unroll
        for (int i = 0; i < 4; ++i) {
          const int c = nb * 32 + 8 * i + 4 * h;
          const f32x4 w = *(const f32x4*)(w0 + nbase + c);
          float o[4];
#pragma unroll
          for (int j = 0; j < 4; ++j) o[j] = 0.6065306597126334f * sigm(w[j] + acc[nb][tb][4 * i + j]);
          *(u32x2*)(dst + c) = (u32x2){pk_f16(o[0], o[1]), pk_f16(o[2], o[3])};
        }
    }
  }
}

__device__ __forceinline__ void epi_adir(const f32x16 (&acc)[2][2], int nbase, int tbase, int M, CP& p, int dir) {
  const int lane = threadIdx.x & 63, l32 = lane & 31, h = lane >> 5;
  const int head = nbase >> 6;
  u16* DIR = dir ? p.DIR1 : p.DIR0;
  const float* a0 = p.rw_a0 + dir * 1024;
#pragma unroll
  for (int tb = 0; tb < 2; ++tb) {
    const int tok = tbase + tb * 32 + l32;
    const bool valid = tok < M;
    const int tk = valid ? tok : M - 1;
    const size_t rec = ((size_t)tk * 16 + head) * 192;
    float nsq = 0.f;
#pragma unroll
    for (int nb = 0; nb < 2; ++nb)
#pragma unroll
      for (int i = 0; i < 4; ++i) {
        const int c = nb * 32 + 8 * i + 4 * h;
        const u32x2 kr = *(const u32x2*)(DIR + rec + 64 + c);
        const f32x4 kkw = *(const f32x4*)(p.k_k + nbase + c);
        const float q0 = h_lo(kr.x) * kkw[0], q1 = h_hi(kr.x) * kkw[1], q2 = h_lo(kr.y) * kkw[2], q3 = h_hi(kr.y) * kkw[3];
        nsq += q0 * q0 + q1 * q1 + q2 * q2 + q3 * q3;
      }
    nsq += __shfl_xor(nsq, 32);
    const float inv = 1.f / fmaxf(sqrtf(nsq), 1e-12f);
    if (valid) {
#pragma unroll
      for (int nb = 0; nb < 2; ++nb)
#pragma unroll
        for (int i = 0; i < 4; ++i) {
          const int c = nb * 32 + 8 * i + 4 * h;
          const u32x2 kr = *(const u32x2*)(DIR + rec + 64 + c);
          const float kv[4] = {h_lo(kr.x), h_hi(kr.x), h_lo(kr.y), h_hi(kr.y)};
          const f32x4 kkw = *(const f32x4*)(p.k_k + nbase + c);
          const f32x4 kaw = *(const f32x4*)(p.k_a + nbase + c);
          const f32x4 a0v = *(const f32x4*)(a0 + nbase + c);
          float kk[4], kd[4], bp[4];
#pragma unroll
          for (int j = 0; j < 4; ++j) {
            const float k = kv[j];
            kk[j] = k * kkw[j] * inv;
            const float aa = sigm(a0v[j] + acc[nb][tb][4 * i + j]);
            kd[j] = k * (1.f + (aa - 1.f) * kaw[j]);
            bp[j] = -kk[j] * aa;
          }
          if (dir == 0) *(u32x2*)(p.RKV + rec + 64 + c) = (u32x2){pk_f16(kk[0], kk[1]), pk_f16(kk[2], kk[3])};
          *(u32x2*)(DIR + rec + 64 + c) = (u32x2){pk_f16(kd[0], kd[1]), pk_f16(kd[2], kd[3])};
          *(u32x2*)(DIR + rec + 128 + c) = (u32x2){pk_f16(bp[0], bp[1]), pk_f16(bp[2], bp[3])};
        }
    }
  }
}

__device__ void scan_task(CP& p, const Grp& G, int task, char* lds) {
  const int half = task & 1, dir = (task >> 1) & 1, head = (task >> 2) & 15, s = task >> 6;
  float* buf = (float*)lds;
  const u16* rkv = p.RKV;
  const u16* dr = dir ? p.DIR1 : p.DIR0;
  u16* Y = dir ? p.Y1 : p.Y0;
  const int tid = threadIdx.x;
  const int row = half * 32 + (tid >> 3), kc = tid & 7;
  const int L = G.L, nch = L >> 4;
  u32x4 pre[3];
  auto issue = [&](int c) {
#pragma unroll
    for (int i = 0; i < 3; ++i) {
      const int id = tid + 256 * i, st = id / 48, ci = id - st * 48;
      const int n = c * 16 + st, t = dir ? L - 1 - n : n;
      const size_t rec = ((size_t)(s * L + t) * 16 + head) * 192;
      const u16* src = ci < 24 ? rkv + rec + ci * 8 : dr + rec + (ci - 24) * 8;
      pre[i] = *(const u32x4*)src;
    }
  };
  auto commit = [&](int b) {
#pragma unroll
    for (int i = 0; i < 3; ++i) {
      const int id = tid + 256 * i, st = id / 48, ci = id - st * 48;
      const int sec = ci >> 3;
      const int base = sec >= 3 ? (sec - 1) * 64 : (sec == 0 ? 64 : (sec == 1 ? 0 : 320));
      float f[8];
#pragma unroll
      for (int e = 0; e < 4; ++e) { f[2 * e] = h_lo(pre[i][e]); f[2 * e + 1] = h_hi(pre[i][e]); }
      if (sec == 3) {
#pragma unroll
        for (int e = 0; e < 8; ++e) f[e] = __expf(-f[e]);
      }
      float* d = buf + b * 6144 + st * 384 + base + (ci & 7) * 8;
      *(f32x4*)d = (f32x4){f[0], f[1], f[2], f[3]};
      *(f32x4*)(d + 4) = (f32x4){f[4], f[5], f[6], f[7]};
    }
  };
  float S[8];
#pragma unroll
  for (int i = 0; i < 8; ++i) S[i] = 0.f;
  __syncthreads();
  issue(0);
  commit(0);
  __syncthreads();
  for (int c = 0; c < nch; ++c) {
    if (c + 1 < nch) issue(c + 1);
    const float* b = buf + (c & 1) * 6144;
#pragma unroll 4
    for (int st = 0; st < 16; ++st) {
      const float* q = b + st * 384 + kc * 8;
      const f32x4 kk0 = *(const f32x4*)(q), kk1 = *(const f32x4*)(q + 4);
      const f32x4 r0 = *(const f32x4*)(q + 64), r1 = *(const f32x4*)(q + 68);
      const f32x4 w0 = *(const f32x4*)(q + 128), w1 = *(const f32x4*)(q + 132);
      const f32x4 d0 = *(const f32x4*)(q + 192), d1 = *(const f32x4*)(q + 196);
      const f32x4 b0 = *(const f32x4*)(q + 256), b1 = *(const f32x4*)(q + 260);
      const float vv = b[st * 384 + 320 + row];
      float sa = 0.f;
#pragma unroll
      for (int i = 0; i < 4; ++i) { sa += S[i] * kk0[i]; sa += S[4 + i] * kk1[i]; }
      sa = reduce8(sa);
      float y = 0.f;
#pragma unroll
      for (int i = 0; i < 4; ++i) {
        S[i] = S[i] * w0[i] + (sa * b0[i] + vv * d0[i]);
        S[4 + i] = S[4 + i] * w1[i] + (sa * b1[i] + vv * d1[i]);
        y += S[i] * r0[i];
        y += S[4 + i] * r1[i];
      }
      y = reduce8(y);
      if (kc == 0) {
        const int n = c * 16 + st, t = dir ? L - 1 - n : n;
        Y[(size_t)(s * L + t) * 1024 + head * 64 + row] = bf16_1(y);
      }
    }
    if (c + 1 < nch) commit((c + 1) & 1);
    __syncthreads();
  }
}

__device__ void attn_tile(CP& p, const Grp& G, int s, int hd, int qb, char* lds, float lam) {
  const int tid = threadIdx.x, lane = tid & 63, wave = tid >> 6, l32 = lane & 31, h = lane >> 5;
  const int L = G.L;
  const u16* Pb = p.P + (size_t)s * L * NIN;
  float* lutl = (float*)(lds + 24576);
  char* qfl = lds + 26624 + tid * 16;
  __syncthreads();
  for (int i = tid; i < 511; i += 256) lutl[i] = p.lut[hd * 512 + i];
  const int q = qb * 128 + wave * 32 + l32;
  const int qc = q < L ? q : L - 1;
  const int qw0 = qb * 128 + wave * 32;
  u16* odst = p.O + (size_t)(s * L + qc) * 1024 + hd * 128;
  const int kkey = tid >> 3, kch = tid & 7;
  const int kldo = kkey * 128 + ((kch ^ ((kkey >> 1) & 7)) << 4);
  int vkey[2], vdvc[2], vwo0[2], vwo1[2];
#pragma unroll
  for (int i = 0; i < 2; ++i) {
    const int c = tid + 256 * i;
    vkey[i] = (c & 15) + 16 * ((c >> 6) & 1);
    vdvc[i] = ((c >> 4) & 3) + 4 * (c >> 7);
    const int key = vkey[i];
    const int pos = (key & 16) | ((key & 4) << 1) | ((key & 8) >> 1) | (key & 3);
    const int chunk = pos >> 3, inb = (pos & 7) * 2;
    vwo0[i] = vdvc[i] * 512 + ((chunk ^ ((2 * vdvc[i]) & 3)) << 4) + inb;
    vwo1[i] = vdvc[i] * 512 + ((chunk ^ ((2 * vdvc[i] + 1) & 3)) << 4) + inb;
  }
  const int ntile = (L + 31) >> 5;
#pragma unroll 1
  for (int br = 0; br < 2; ++br) {
#pragma unroll
    for (int ks = 0; ks < 4; ++ks) {
      const u32x4 raw = *(const u32x4*)(Pb + (size_t)qc * NIN + hd * 128 + br * 64 + ks * 16 + h * 8);
      u32x4 sc;
#pragma unroll
      for (int e = 0; e < 4; ++e) sc[e] = pk_bf16(bf_lo(raw[e]) * 0.125f, bf_hi(raw[e]) * 0.125f);
      *(u32x4*)(qfl + ks * 4096) = sc;
    }
    const u16* kp = Pb + 1024 + hd * 128 + br * 64 + kch * 8;
    u32x4 rk, rv[2];
    auto issue = [&](int kt0) {
      int kr = kt0 + kkey; kr = kr < L ? kr : L - 1;
      rk = *(const u32x4*)(kp + (size_t)kr * NIN);
#pragma unroll
      for (int i = 0; i < 2; ++i) {
        int vr = kt0 + vkey[i]; vr = vr < L ? vr : L - 1;
        rv[i] = *(const u32x4*)(Pb + (size_t)vr * NIN + 2048 + hd * 128 + vdvc[i] * 8);
      }
    };
    auto commit = [&](int b) {
      char* st = lds + b * 12288;
      *(u32x4*)(st + kldo) = rk;
#pragma unroll
      for (int i = 0; i < 2; ++i) {
        char* vb = st + 4096;
#pragma unroll
        for (int e = 0; e < 8; ++e) {
          const unsigned wv = rv[i][e >> 1];
          const u16 val = (e & 1) ? (u16)(wv >> 16) : (u16)(wv & 0xffffu);
          *(u16*)(vb + (e < 4 ? vwo0[i] : vwo1[i]) + e * 64) = val;
        }
      }
    };
    f32x16 O[4];
#pragma unroll
    for (int mb = 0; mb < 4; ++mb)
#pragma unroll
      for (int r = 0; r < 16; ++r) O[mb][r] = 0.f;
    float mrun = -1e30f, lrun = 0.f;
    issue(0);
    commit(0);
    __syncthreads();
    const float cneg = lutl[0], cpos = lutl[510];
    for (int kt = 0; kt < ntile; ++kt) {
      const int kt0 = kt * 32;
      if (kt + 1 < ntile) issue(kt0 + 32);
      const char* st = lds + (kt & 1) * 12288;
      f32x16 sacc;
#pragma unroll
      for (int r = 0; r < 16; ++r) sacc[r] = 0.f;
#pragma unroll
      for (int ks = 0; ks < 4; ++ks) {
        const bf16x8 kf = *(const bf16x8*)(st + l32 * 128 + (((ks * 2 + h) ^ ((l32 >> 1) & 7)) << 4));
        const bf16x8 qv = *(const bf16x8*)(qfl + ks * 4096);
        sacc = __builtin_amdgcn_mfma_f32_32x32x16_bf16(kf, qv, sacc, 0, 0, 0);
      }
      const bool farneg = (kt0 + 31) <= (qw0 - 128);
      const bool farpos = kt0 >= (qw0 + 31 + 128);
      float mx = -1e30f;
      if (farneg || farpos) {
        const float cv = farneg ? cneg : cpos;
#pragma unroll
        for (int r = 0; r < 16; ++r) { sacc[r] = sacc[r] * LOG2E + cv; }
      } else {
#pragma unroll
        for (int r = 0; r < 16; ++r) {
          const int key = kt0 + 8 * (r >> 2) + 4 * h + (r & 3);
          int d = key - q + 255;
          d = d < 0 ? 0 : (d > 510 ? 510 : d);
          sacc[r] = sacc[r] * LOG2E + lutl[d];
        }
      }
      if (kt0 + 32 > L) {
#pragma unroll
        for (int r = 0; r < 16; ++r) {
          const int key = kt0 + 8 * (r >> 2) + 4 * h + (r & 3);
          if (key >= L) sacc[r] = -INFINITY;
        }
      }
#pragma unroll
      for (int r = 0; r < 16; ++r) mx = fmaxf(mx, sacc[r]);
      mx = fmaxf(mx, __shfl_xor(mx, 32));
      const float mnew = fmaxf(mrun, mx);
      const float alpha = __builtin_amdgcn_exp2f(mrun - mnew);
      mrun = mnew;
      float ps = 0.f;
#pragma unroll
      for (int r = 0; r < 16; ++r) { sacc[r] = __builtin_amdgcn_exp2f(sacc[r] - mnew); ps += sacc[r]; }
      lrun = lrun * alpha + ps;
      if (__any(alpha != 1.f)) {
#pragma unroll
        for (int mb = 0; mb < 4; ++mb)
#pragma unroll
          for (int r = 0; r < 16; ++r) O[mb][r] *= alpha;
      }
      bf16x8 pf[2];
#pragma unroll
      for (int s2 = 0; s2 < 2; ++s2) {
        u32x4 w;
#pragma unroll
        for (int e = 0; e < 4; ++e) w[e] = pk_bf16(sacc[8 * s2 + 2 * e], sacc[8 * s2 + 2 * e + 1]);
        pf[s2] = __builtin_bit_cast(bf16x8, w);
      }
#pragma unroll
      for (int mb = 0; mb < 4; ++mb)
#pragma unroll
        for (int s2 = 0; s2 < 2; ++s2) {
          const int vr = mb * 32 + l32;
          const bf16x8 vf = *(const bf16x8*)(st + 4096 + vr * 64 + (((2 * s2 + h) ^ ((vr >> 2) & 3)) << 4));
          O[mb] = __builtin_amdgcn_mfma_f32_32x32x16_bf16(vf, pf[s2], O[mb], 0, 0, 0);
          if (s2 == 1 && (mb & 1)) __builtin_amdgcn_sched_barrier(0);
        }
      if (kt + 1 < ntile) commit((kt + 1) & 1);
      __syncthreads();
    }
    const float lt = lrun + __shfl_xor(lrun, 32);
    if (br == 0) {
      const float i1 = 1.f / lt;
#pragma unroll
      for (int mb = 0; mb < 4; ++mb)
#pragma unroll
        for (int i = 0; i < 4; ++i)
          if (q < L) *(u32x2*)(odst + mb * 32 + 8 * i + 4 * h) = (u32x2){pk_bf16(O[mb][4 * i] * i1, O[mb][4 * i + 1] * i1), pk_bf16(O[mb][4 * i + 2] * i1, O[mb][4 * i + 3] * i1)};
    } else {
      const float i2 = lam / lt;
      float ssq = 0.f;
#pragma unroll
      for (int mb = 0; mb < 4; ++mb)
#pragma unroll
        for (int i = 0; i < 4; ++i) {
          u32x2 w = {0, 0};
          if (q < L) w = *(const u32x2*)(odst + mb * 32 + 8 * i + 4 * h);
          const float o0 = bf_lo(w.x) - O[mb][4 * i] * i2, o1v = bf_hi(w.x) - O[mb][4 * i + 1] * i2, o2 = bf_lo(w.y) - O[mb][4 * i + 2] * i2, o3 = bf_hi(w.y) - O[mb][4 * i + 3] * i2;
          O[mb][4 * i] = o0; O[mb][4 * i + 1] = o1v; O[mb][4 * i + 2] = o2; O[mb][4 * i + 3] = o3;
          ssq += o0 * o0 + o1v * o1v + o2 * o2 + o3 * o3;
        }
      ssq += __shfl_xor(ssq, 32);
      const float rn = rsqrtf(ssq * (1.f / 128.f) + EPSN) * 0.8f;
      if (q < L) {
        u16* dst = p.O + (size_t)(s * L + q) * 1024 + hd * 128;
#pragma unroll
        for (int mb = 0; mb < 4; ++mb)
#pragma unroll
          for (int i = 0; i < 4; ++i) {
            const int dv = mb * 32 + 8 * i + 4 * h;
            const f32x4 g = *(const f32x4*)(p.subln + dv);
            *(u32x2*)(dst + dv) = (u32x2){pk_bf16(O[mb][4 * i] * rn * g.x, O[mb][4 * i + 1] * rn * g.y),
                                          pk_bf16(O[mb][4 * i + 2] * rn * g.z, O[mb][4 * i + 3] * rn * g.w)};
          }
      }
    }
  }
}

__device__ void phase_mixer(CP& p, const Grp& G, int g, char* lds) {
  const int nscan = G.nseq * 64;
  for (int t = blockIdx.x; t < nscan; t += gridDim.x) scan_task(p, G, t, lds);
  const int nqb = (G.L + 127) >> 7;
  const int natt = G.nseq * 8 * nqb;
  const float lam = p.lam[0];
  int* shw = (int*)(lds + 65536 - 16);
  while (true) {
    __syncthreads();
    if (threadIdx.x == 0) *shw = atomicAdd(p.cnt + g, 1);
    __syncthreads();
    const int t = *shw;
    if (t >= natt) break;
    const int qb = t % nqb, r = t / nqb, hd = r & 7, s = r >> 3;
    attn_tile(p, G, s, hd, qb, lds, lam);
  }
}

__device__ void phase_post(CP& p, const Grp& G) {
  const int lane = threadIdx.x & 63;
  const int nw = gridDim.x * 4;
  const int c0 = lane * 16, head = lane >> 2, hc = (lane & 3) * 16;
  for (int row = blockIdx.x * 4 + (threadIdx.x >> 6); row < G.M; row += nw) {
    float y[16];
    {
      const u32x4 a0 = *(const u32x4*)(p.Y0 + (size_t)row * 1024 + c0), a1 = *(const u32x4*)(p.Y0 + (size_t)row * 1024 + c0 + 8);
      const u32x4 b0 = *(const u32x4*)(p.Y1 + (size_t)row * 1024 + c0), b1 = *(const u32x4*)(p.Y1 + (size_t)row * 1024 + c0 + 8);
#pragma unroll
      for (int e = 0; e < 4; ++e) {
        y[2 * e] = bf_lo(a0[e]) + bf_lo(b0[e]); y[2 * e + 1] = bf_hi(a0[e]) + bf_hi(b0[e]);
        y[8 + 2 * e] = bf_lo(a1[e]) + bf_lo(b1[e]); y[8 + 2 * e + 1] = bf_hi(a1[e]) + bf_hi(b1[e]);
      }
    }
    float s1 = 0.f;
#pragma unroll
    for (int e = 0; e < 16; ++e) s1 += y[e];
    s1 = reduce4(s1);
    const float mu = s1 * (1.f / 64.f);
    float s2 = 0.f;
#pragma unroll
    for (int e = 0; e < 16; ++e) { const float d = y[e] - mu; s2 += d * d; }
    s2 = reduce4(s2);
    const float rstd = rsqrtf(s2 * (1.f / 64.f) + 64e-5f);
    const size_t rec = ((size_t)row * 16 + head) * 192 + hc;
    float rr[16], vv[16], kd[16];
    {
      const u32x4 r0 = *(const u32x4*)(p.RKV + rec), r1 = *(const u32x4*)(p.RKV + rec + 8);
      const u32x4 v0 = *(const u32x4*)(p.RKV + rec + 128), v1 = *(const u32x4*)(p.RKV + rec + 136);
      const u32x4 f0 = *(const u32x4*)(p.DIR0 + rec + 64), f1 = *(const u32x4*)(p.DIR0 + rec + 72);
      const u32x4 g0 = *(const u32x4*)(p.DIR1 + rec + 64), g1 = *(const u32x4*)(p.DIR1 + rec + 72);
#pragma unroll
      for (int e = 0; e < 4; ++e) {
        rr[2 * e] = h_lo(r0[e]); rr[2 * e + 1] = h_hi(r0[e]); rr[8 + 2 * e] = h_lo(r1[e]); rr[8 + 2 * e + 1] = h_hi(r1[e]);
        vv[2 * e] = h_lo(v0[e]); vv[2 * e + 1] = h_hi(v0[e]); vv[8 + 2 * e] = h_lo(v1[e]); vv[8 + 2 * e + 1] = h_hi(v1[e]);
        kd[2 * e] = h_lo(f0[e]) + h_lo(g0[e]); kd[2 * e + 1] = h_hi(f0[e]) + h_hi(g0[e]);
        kd[8 + 2 * e] = h_lo(f1[e]) + h_lo(g1[e]); kd[8 + 2 * e + 1] = h_hi(f1[e]) + h_hi(g1[e]);
      }
    }
    float bs = 0.f;
#pragma unroll
    for (int e = 0; e < 16; ++e) bs += rr[e] * kd[e] * p.r_k[c0 + e];
    bs = reduce4(bs);
    const u32x4 g0 = *(const u32x4*)(p.G + (size_t)row * 1024 + c0), g1 = *(const u32x4*)(p.G + (size_t)row * 1024 + c0 + 8);
    float o[16];
#pragma unroll
    for (int e = 0; e < 16; ++e) {
      const unsigned gw = e < 8 ? g0[e >> 1] : g1[(e - 8) >> 1];
      const float gg = (e & 1) ? bf_hi(gw) : bf_lo(gw);
      o[e] = ((y[e] - mu) * rstd * p.lnx_w[c0 + e] + p.lnx_b[c0 + e] + bs * vv[e]) * gg;
    }
    u16* dst = p.HB + (size_t)row * 1024 + c0;
    *(u32x4*)dst = (u32x4){pk_bf16(o[0], o[1]), pk_bf16(o[2], o[3]), pk_bf16(o[4], o[5]), pk_bf16(o[6], o[7])};
    *(u32x4*)(dst + 8) = (u32x4){pk_bf16(o[8], o[9]), pk_bf16(o[10], o[11]), pk_bf16(o[12], o[13]), pk_bf16(o[14], o[15])};
  }
}

__device__ void phase_final(CP& p, const Grp& G) {
  const int lane = threadIdx.x & 63;
  const int nw = gridDim.x * 4;
  for (int row = blockIdx.x * 4 + (threadIdx.x >> 6); row < G.M; row += nw) {
    const int s = row / G.L, t = row - s * G.L;
    if (t < 16) continue;
    const float rs = rsqrtf(p.ss3[row] * (1.f / 1024.f) + EPSN);
    const float* hp = p.H + (size_t)row * 1024;
    float* op = G.out + ((size_t)s * G.S + (t - 16)) * 1024;
#pragma unroll
    for (int i = 0; i < 4; ++i) {
      const f32x4 v = *(const f32x4*)(hp + i * 256 + lane * 4);
      const f32x4 g = *(const f32x4*)(p.final_norm + i * 256 + lane * 4);
      *(f32x4*)(op + i * 256 + lane * 4) = (f32x4){v.x * rs * g.x, v.y * rs * g.y, v.z * rs * g.z, v.w * rs * g.w};
    }
  }
}

__device__ void run_phase(CP& p, int ph, char* lds) {
  if (ph == 0) { phase_prep(p, lds); return; }
  const int g = (ph - 1) / PH_PER_G, k = (ph - 1) - g * PH_PER_G;
  const Grp G = get_grp(p, g);
  const int M = G.M;
  switch (k) {
    case 0: phase_rows(p, G); break;
    case 1:
      gemm_phase(p.HB, 1024, M, p.W1A, 1024, 2 * FFD, lds, [&](const f32x16 (&acc)[2][2], int nb, int tb) { epi_swiglu(acc, nb, tb, M, p.ss0, p.ACT); });
      break;
    case 2:
      gemm_phase(p.ACT, FFD, M, p.WD1, FFD, 1024, lds, [&](const f32x16 (&acc)[2][2], int nb, int tb) { epi_resid<0>(acc, nb, tb, p, G); });
      break;
    case 3:
      gemm_phase(p.HB, 1024, M, p.WIN, 1024, NIN, lds, [&](const f32x16 (&acc)[2][2], int nbase, int tbase) {
        const int lane = threadIdx.x & 63, l32 = lane & 31, h = lane >> 5;
#pragma unroll
        for (int tb = 0; tb < 2; ++tb) {
          const int tok = tbase + tb * 32 + l32;
          if (tok < M) {
            const float rs = rsqrtf(p.ss1[tok] * (1.f / 1024.f) + EPSN);
            u16* dst = p.P + (size_t)tok * NIN + nbase + 4 * h;
#pragma unroll
            for (int nb = 0; nb < 2; ++nb)
#pragma unroll
              for (int i = 0; i < 4; ++i)
                *(u32x2*)(dst + nb * 32 + 8 * i) = (u32x2){pk_bf16(acc[nb][tb][4 * i] * rs, acc[nb][tb][4 * i + 1] * rs),
                                                           pk_bf16(acc[nb][tb][4 * i + 2] * rs, acc[nb][tb][4 * i + 3] * rs)};
          }
        }
      });
      break;
    case 4: phase_mix(p, G); break;
    case 5:
      gemm_phase(p.F, 384, M, p.W2F, 64, 1024, lds, [&](const f32x16 (&acc)[2][2], int nb, int tb) { epi_decay(acc, nb, tb, M, p.rw_w0, p.DIR0); });
      gemm_phase(p.F + 64, 384, M, p.W2B, 64, 1024, lds, [&](const f32x16 (&acc)[2][2], int nb, int tb) { epi_decay(acc, nb, tb, M, p.rw_w0 + 1024, p.DIR1); });
      gemm_phase(p.F + 128, 384, M, p.A2F, 64, 1024, lds, [&](const f32x16 (&acc)[2][2], int nb, int tb) { epi_adir(acc, nb, tb, M, p, 0); });
      gemm_phase(p.F + 192, 384, M, p.A2B, 64, 1024, lds, [&](const f32x16 (&acc)[2][2], int nb, int tb) { epi_adir(acc, nb, tb, M, p, 1); });
      gemm_phase(p.F + 256, 384, M, p.G2T, 128, 1024, lds, [&](const f32x16 (&acc)[2][2], int nbase, int tbase) {
        const int lane = threadIdx.x & 63, l32 = lane & 31, h = lane >> 5;
#pragma unroll
        for (int tb = 0; tb < 2; ++tb) {
          const int tok = tbase + tb * 32 + l32;
          if (tok < M) {
            u16* dst = p.G + (size_t)tok * 1024 + nbase + 4 * h;
#pragma unroll
            for (int nb = 0; nb < 2; ++nb)
#pragma unroll
              for (int i = 0; i < 4; ++i)
                *(u32x2*)(dst + nb * 32 + 8 * i) = (u32x2){pk_bf16(acc[nb][tb][4 * i], acc[nb][tb][4 * i + 1]), pk_bf16(acc[nb][tb][4 * i + 2], acc[nb][tb][4 * i + 3])};
          }
        }
      });
      break;
    case 6: phase_mixer(p, G, g, lds); break;
    case 7: phase_post(p, G); break;
    case 8: {
      const int nN = 8, nM = (M + 127) >> 7, nt = nN * nM;
      const int wave = threadIdx.x >> 6;
      const int lane = threadIdx.x & 63, l32 = lane & 31, h = lane >> 5;
      for (int t = blockIdx.x; t < nt; t += gridDim.x) {
        const int tm = t / nN, tn = t - tm * nN;
        const int nbase = tn * 128 + (wave & 1) * 64, tbase = tm * 128 + (wave >> 1) * 64;
#pragma unroll 1
        for (int pass = 0; pass < 2; ++pass) {
          f32x16 acc[2][2];
          zero_acc(acc);
          gemm_kloop(acc, pass ? p.HB : p.O, 1024, M, tm * 128, pass ? p.WRW : p.WATT, 1024, tn * 128, 1024, lds);
#pragma unroll
          for (int tb = 0; tb < 2; ++tb) {
            const int tok = tbase + tb * 32 + l32;
            if (tok < M) {
              const u16* gp = p.P + (size_t)tok * NIN + 6528 + pass * 1024 + nbase + 4 * h;
              u16* dst = p.MERGED + (size_t)tok * 1024 + nbase + 4 * h;
#pragma unroll
              for (int nb = 0; nb < 2; ++nb)
#pragma unroll
                for (int i = 0; i < 4; ++i) {
                  const u32x2 ga = *(const u32x2*)(gp + nb * 32 + 8 * i);
                  float o0 = sigm(bf_lo(ga.x)) * acc[nb][tb][4 * i];
                  float o1 = sigm(bf_hi(ga.x)) * acc[nb][tb][4 * i + 1];
                  float o2 = sigm(bf_lo(ga.y)) * acc[nb][tb][4 * i + 2];
                  float o3 = sigm(bf_hi(ga.y)) * acc[nb][tb][4 * i + 3];
                  if (pass) {
                    const u32x2 pv = *(const u32x2*)(dst + nb * 32 + 8 * i);
                    o0 += bf_lo(pv.x); o1 += bf_hi(pv.x); o2 += bf_lo(pv.y); o3 += bf_hi(pv.y);
                  }
                  *(u32x2*)(dst + nb * 32 + 8 * i) = (u32x2){pk_bf16(o0, o1), pk_bf16(o2, o3)};
                }
            }
          }
        }
      }
    } break;
    case 9:
      gemm_phase(p.MERGED, 1024, M, p.WOUT, 1024, 1024, lds, [&](const f32x16 (&acc)[2][2], int nb, int tb) { epi_resid<1>(acc, nb, tb, p, G); });
      break;
    case 10:
      gemm_phase(p.HB, 1024, M, p.W2A, 1024, 2 * FFD, lds, [&](const f32x16 (&acc)[2][2], int nb, int tb) { epi_swiglu(acc, nb, tb, M, p.ss2, p.ACT); });
      break;
    case 11:
      gemm_phase(p.ACT, FFD, M, p.WD2, FFD, 1024, lds, [&](const f32x16 (&acc)[2][2], int nb, int tb) { epi_resid<2>(acc, nb, tb, p, G); });
      break;
    case 12: phase_final(p, G); break;
  }
}

__global__ void __launch_bounds__(256) mega(Params p, int ph_lo, int ph_hi, int coop) {
  __shared__ __attribute__((aligned(16))) char lds[65536];
  CP* pp = (CP*)__builtin_amdgcn_kernarg_segment_ptr();
  asm volatile("" : "+s"(pp));
  for (int ph = ph_lo; ph < ph_hi; ++ph) {
    run_phase(*pp, ph, lds);
    if (coop && ph + 1 < ph_hi) cg::this_grid().sync();
  }
}

extern "C" void kernel_launch(void* const* d_in, const int* in_sizes, int n_in, void* d_out, int out_size, void* d_ws,
                              size_t ws_size, hipStream_t stream) {
  Params p;
  memset(&p, 0, sizeof(p));
  const float** f = (const float**)&p;
  for (int i = 0; i < 35; ++i) f[i] = (const float*)d_in[i];
  p.out = (float*)d_out;
  char* w = (char*)d_ws;
  size_t off = 0;
  auto alloc = [&](size_t bytes) { char* r = w + off; off += (bytes + 255) & ~(size_t)255; return r; };
  p.W1A = (u16*)alloc((size_t)2 * FFD * 1024 * 2);
  p.WD1 = (u16*)alloc((size_t)1024 * FFD * 2);
  p.WIN = (u16*)alloc((size_t)NIN * 1024 * 2);
  p.WATT = (u16*)alloc((size_t)1024 * 1024 * 2);
  p.WRW = (u16*)alloc((size_t)1024 * 1024 * 2);
  p.WOUT = (u16*)alloc((size_t)1024 * 1024 * 2);
  p.W2A = (u16*)alloc((size_t)2 * FFD * 1024 * 2);
  p.WD2 = (u16*)alloc((size_t)1024 * FFD * 2);
  p.W2F = (u16*)alloc((size_t)1024 * 64 * 2);
  p.W2B = (u16*)alloc((size_t)1024 * 64 * 2);
  p.A2F = (u16*)alloc((size_t)1024 * 64 * 2);
  p.A2B = (u16*)alloc((size_t)1024 * 64 * 2);
  p.G2T = (u16*)alloc((size_t)1024 * 128 * 2);
  p.lut = (float*)alloc(8 * 512 * 4);
  p.cnt = (int*)alloc(256);
  p.lam = (float*)alloc(256);
  const size_t R = MAXROWS;
  p.H = (float*)alloc(R * 1024 * 4);
  p.HB = (u16*)alloc(R * 1024 * 2);
  p.ACT = (u16*)alloc(R * FFD * 2);
  p.Y0 = p.ACT;
  p.Y1 = p.ACT + R * 1024;
  p.F = p.ACT + R * 2048;
  p.P = (u16*)alloc(R * NIN * 2);
  p.RKV = (u16*)alloc(R * 16 * 192 * 2);
  p.DIR0 = (u16*)alloc(R * 16 * 192 * 2);
  p.DIR1 = (u16*)alloc(R * 16 * 192 * 2);
  p.G = (u16*)alloc(R * 1024 * 2);
  p.O = (u16*)alloc(R * 1024 * 2);
  p.MERGED = (u16*)alloc(R * 1024 * 2);
  p.ss0 = (float*)alloc(R * 4);
  p.ss1 = (float*)alloc(R * 4);
  p.ss2 = (float*)alloc(R * 4);
  p.ss3 = (float*)alloc(R * 4);
  if (off > ws_size) { fprintf(stderr, "workspace too small: need %zu have %zu\n", off, ws_size); return; }
  static int grid_blocks = 0;
  if (!grid_blocks) {
    int dev = 0, cus = 0, per_cu = 0;
    hipGetDevice(&dev);
    hipDeviceGetAttribute(&cus, hipDeviceAttributeMultiprocessorCount, dev);
    hipOccupancyMaxActiveBlocksPerMultiprocessor(&per_cu, mega, 256, 0);
    if (per_cu < 1) per_cu = 1;
    if (per_cu > 2) per_cu = 2;
    grid_blocks = cus * per_cu;
  }
  int ph_lo = 0, ph_hi = NPHASES, coop = 1;
  void* args[] = {&p, &ph_lo, &ph_hi, &coop};
  hipError_t e = hipLaunchCooperativeKernel((void*)mega, dim3(grid_blocks), dim3(256), args, 0, stream);
  if (e != hipSuccess) fprintf(stderr, "cooperative launch failed: %s (grid %d)\n", hipGetErrorString(e), grid_blocks);
}
```

```cpp
#include <hip/hip_runtime.h>
#include <hip/hip_cooperative_groups.h>
#include <stdint.h>
#include <string.h>
#include <stdio.h>
namespace cg = cooperative_groups;

typedef unsigned short u16;
typedef short bf16x8 __attribute__((ext_vector_type(8)));
typedef float f32x16 __attribute__((ext_vector_type(16)));
typedef float f32x4 __attribute__((ext_vector_type(4)));
typedef float f32x2 __attribute__((ext_vector_type(2)));
typedef unsigned u32x4 __attribute__((ext_vector_type(4)));
typedef unsigned u32x2 __attribute__((ext_vector_type(2)));
typedef __bf16 bf16x2_t __attribute__((ext_vector_type(2)));
typedef _Float16 f16x2_t __attribute__((ext_vector_type(2)));

#define NIN 8576
#define FFD 2816
#define EPSN 1e-6f
#define LOG2E 1.4426950408889634f
#define NGROUPS 6
#define PH_PER_G 13
#define NPHASES (1 + NGROUPS * PH_PER_G)
#define MAXROWS 16512

struct Params {
  const float *x_prompt, *x_sample, *meta, *rel_bias, *ffn1_norm, *ffn1_wg, *ffn1_wu, *ffn1_wd, *mix_norm, *w_in;
  const float *lq1, *lk1, *lq2, *lk2, *subln, *w_attn, *mu_prev, *mu_next, *rw_w0, *rw_w2, *rw_a0, *rw_a2, *rw_g2;
  const float *k_k, *k_a, *r_k, *lnx_w, *lnx_b, *w_rw, *w_out, *ffn2_norm, *ffn2_wg, *ffn2_wu, *ffn2_wd, *final_norm;
  float* out;
  u16 *W1A, *WD1, *WIN, *WATT, *WRW, *WOUT, *W2A, *WD2, *W2F, *W2B, *A2F, *A2B, *G2T;
  float* lut; int* cnt; float* lam;
  float* H; u16 *HB, *ACT, *P, *RKV, *DIR0, *DIR1, *G, *O, *MERGED, *Y0, *Y1, *F;
  float *ss0, *ss1, *ss2, *ss3;
};

typedef const Params __attribute__((address_space(4))) CP;
struct Grp { int nseq, L, S, M; const float* x; float* out; };

__device__ __forceinline__ Grp get_grp(CP& p, int g) {
  Grp r;
  if (g < 4) { r.nseq = 4; r.L = 4112; r.S = 4096; r.x = p.x_prompt + (size_t)g * 4 * 4096 * 1024; r.out = p.out + (size_t)g * 4 * 4096 * 1024; }
  else { r.nseq = 8; r.L = 2064; r.S = 2048; r.x = p.x_sample + (size_t)(g - 4) * 8 * 2048 * 1024; r.out = p.out + (size_t)16 * 4096 * 1024 + (size_t)(g - 4) * 8 * 2048 * 1024; }
  r.M = r.nseq * r.L;
  return r;
}

__device__ __forceinline__ int ltid() { int t = threadIdx.x; asm volatile("" : "+v"(t)); return t; }
__device__ __forceinline__ unsigned pk_bf16(float a, float b) {
  f32x2 v = {a, b};
  bf16x2_t r = __builtin_convertvector(v, bf16x2_t);
  return __builtin_bit_cast(unsigned, r);
}
__device__ __forceinline__ float bf_lo(unsigned u) { return __uint_as_float(u << 16); }
__device__ __forceinline__ float bf_hi(unsigned u) { return __uint_as_float(u & 0xffff0000u); }
__device__ __forceinline__ unsigned pk_f16(float a, float b) {
  f32x2 v = {a, b};
  f16x2_t r = __builtin_convertvector(v, f16x2_t);
  return __builtin_bit_cast(unsigned, r);
}
__device__ __forceinline__ float h_lo(unsigned u) { f16x2_t r = __builtin_bit_cast(f16x2_t, u); return (float)r.x; }
__device__ __forceinline__ float h_hi(unsigned u) { f16x2_t r = __builtin_bit_cast(f16x2_t, u); return (float)r.y; }
__device__ __forceinline__ u16 bf16_1(float a) { return (u16)(pk_bf16(a, 0.f) & 0xffffu); }
__device__ __forceinline__ float sigm(float x) { return 1.f / (1.f + __expf(-x)); }
__device__ __forceinline__ float wave_sum(float v) {
#pragma unroll
  for (int o = 32; o > 0; o >>= 1) v += __shfl_xor(v, o);
  return v;
}
template <int CTRL> __device__ __forceinline__ float dppf(float x) {
  return __int_as_float(__builtin_amdgcn_update_dpp(0, __float_as_int(x), CTRL, 0xf, 0xf, true));
}
__device__ __forceinline__ float reduce8(float x) {
  x += dppf<0xB1>(x);
  x += dppf<0x4E>(x);
  x += dppf<0x141>(x);
  return x;
}
__device__ __forceinline__ float reduce4(float x) {
  x += dppf<0xB1>(x);
  x += dppf<0x4E>(x);
  return x;
}

__device__ void prep_transpose(const float* __restrict__ src, int K, int N, u16* __restrict__ dst,
                               const float* __restrict__ gain, int mode, char* lds) {
  float* tile = (float*)lds;
  const int tn = N / 64, nt = (K / 64) * tn;
  const int tid = ltid();
  for (int t = blockIdx.x; t < nt; t += gridDim.x) {
    const int k0 = (t / tn) * 64, n0 = (t % tn) * 64;
    const int nl = tid & 63, kq = tid >> 6;
#pragma unroll
    for (int i = 0; i < 16; ++i) {
      const int k = i * 4 + kq;
      float v = src[(size_t)(k0 + k) * N + n0 + nl];
      if (gain) v *= gain[k0 + k];
      tile[k * 65 + nl] = v;
    }
    __syncthreads();
    const int n = tid >> 2, kk = (tid & 3) * 16;
    unsigned w[8];
#pragma unroll
    for (int i = 0; i < 8; ++i) w[i] = pk_bf16(tile[(kk + 2 * i) * 65 + n], tile[(kk + 2 * i + 1) * 65 + n]);
    const int ng = n0 + n;
    const int row = mode == 0 ? ng : ((ng >> 5) * 64 + (ng & 31) + (mode == 2 ? 32 : 0));
    u32x4* d = (u32x4*)(dst + (size_t)row * K + k0 + kk);
    d[0] = (u32x4){w[0], w[1], w[2], w[3]};
    d[1] = (u32x4){w[4], w[5], w[6], w[7]};
    __syncthreads();
  }
}

__device__ void phase_prep(CP& p, char* lds) {
  if (blockIdx.x == 0) {
    const int tid = ltid();
    if (tid < 16) p.cnt[tid] = 0;
    for (int idx = tid; idx < 8 * 511; idx += 256) {
      const int hd = idx / 511, di = idx - hd * 511, d = di - 255;
      const int n = d < 0 ? -d : d;
      int bk;
      if (n < 8) bk = n;
      else {
        const float nf = (float)n;
        int large = 8 + (int)(logf(nf / 8.0f) / 2.772588722239781f * 8.0f);
        bk = large < 15 ? large : 15;
      }
      const int bucket = (d > 0 ? 16 : 0) + bk;
      p.lut[hd * 512 + di] = p.rel_bias[bucket * 8 + hd] * LOG2E;
    }
    if (tid == 0) {
      float s1 = 0.f, s2 = 0.f;
      for (int i = 0; i < 64; ++i) { s1 += p.lq1[i] * p.lk1[i]; s2 += p.lq2[i] * p.lk2[i]; }
      p.lam[0] = expf(s1) - expf(s2) + 0.2f;
    }
  }
  prep_transpose(p.ffn1_wg, 1024, FFD, p.W1A, p.ffn1_norm, 1, lds);
  prep_transpose(p.ffn1_wu, 1024, FFD, p.W1A, p.ffn1_norm, 2, lds);
  prep_transpose(p.ffn1_wd, FFD, 1024, p.WD1, nullptr, 0, lds);
  prep_transpose(p.w_in, 1024, NIN, p.WIN, p.mix_norm, 0, lds);
  prep_transpose(p.w_attn, 1024, 1024, p.WATT, nullptr, 0, lds);
  prep_transpose(p.w_rw, 1024, 1024, p.WRW, nullptr, 0, lds);
  prep_transpose(p.w_out, 1024, 1024, p.WOUT, nullptr, 0, lds);
  prep_transpose(p.ffn2_wg, 1024, FFD, p.W2A, p.ffn2_norm, 1, lds);
  prep_transpose(p.ffn2_wu, 1024, FFD, p.W2A, p.ffn2_norm, 2, lds);
  prep_transpose(p.ffn2_wd, FFD, 1024, p.WD2, nullptr, 0, lds);
  prep_transpose(p.rw_w2, 64, 1024, p.W2F, nullptr, 0, lds);
  prep_transpose(p.rw_w2 + 64 * 1024, 64, 1024, p.W2B, nullptr, 0, lds);
  prep_transpose(p.rw_a2, 64, 1024, p.A2F, nullptr, 0, lds);
  prep_transpose(p.rw_a2 + 64 * 1024, 64, 1024, p.A2B, nullptr, 0, lds);
  prep_transpose(p.rw_g2, 128, 1024, p.G2T, nullptr, 0, lds);
}

__device__ void phase_rows(CP& p, const Grp& G) {
  const int lane = ltid() & 63;
  const int nw = gridDim.x * 4;
  for (int row = blockIdx.x * 4 + (ltid() >> 6); row < G.M; row += nw) {
    const int s = row / G.L, t = row - s * G.L;
    const float* src = t < 16 ? p.meta + t * 1024 : G.x + ((size_t)s * G.S + (t - 16)) * 1024;
    float ss = 0.f;
#pragma unroll
    for (int i = 0; i < 4; ++i) {
      const f32x4 v = *(const f32x4*)(src + i * 256 + lane * 4);
      ss += v.x * v.x + v.y * v.y + v.z * v.z + v.w * v.w;
      u32x2 o = {pk_bf16(v.x, v.y), pk_bf16(v.z, v.w)};
      *(u32x2*)(p.HB + (size_t)row * 1024 + i * 256 + lane * 4) = o;
    }
    ss = wave_sum(ss);
    if (lane == 0) { p.ss0[row] = ss; p.ss1[row] = 0.f; p.ss2[row] = 0.f; p.ss3[row] = 0.f; }
  }
}

__device__ __forceinline__ void gemm_kloop(f32x16 (&acc)[2][2], const u16* __restrict__ A, int lda, int M, int m0,
                                           const u16* __restrict__ W, int ldw, int n0, int K, char* lds) {
  const int tid = ltid(), lane = tid & 63, wave = tid >> 6;
  const int wn = wave & 1, wt = wave >> 1, l32 = lane & 31, h = lane >> 5;
  u32x4 ra[4], rw[4];
  const u16* ap[4];
  const u16* wp[4];
  int ldso[4];
#pragma unroll
  for (int i = 0; i < 4; ++i) {
    const int c = tid + 256 * i, row = c >> 3, ch = c & 7;
    int ar = m0 + row; ar = ar < M ? ar : M - 1;
    ap[i] = A + (size_t)ar * lda + ch * 8;
    wp[i] = W + (size_t)(n0 + row) * ldw + ch * 8;
    ldso[i] = row * 128 + ((ch ^ ((row >> 1) & 7)) << 4);
  }
  int wro[2], wsw[2], aro[2], asw[2];
#pragma unroll
  for (int b = 0; b < 2; ++b) {
    const int wr = wn * 64 + b * 32 + l32, ar = wt * 64 + b * 32 + l32;
    wro[b] = wr * 128; wsw[b] = (wr >> 1) & 7;
    aro[b] = 16384 + ar * 128; asw[b] = (ar >> 1) & 7;
  }
  const int nk = K >> 6;
#pragma unroll
  for (int i = 0; i < 4; ++i) { ra[i] = *(const u32x4*)(ap[i]); rw[i] = *(const u32x4*)(wp[i]); }
#pragma unroll
  for (int i = 0; i < 4; ++i) { *(u32x4*)(lds + ldso[i]) = rw[i]; *(u32x4*)(lds + 16384 + ldso[i]) = ra[i]; }
  __syncthreads();
  for (int kt = 0; kt < nk; ++kt) {
    const bool more = kt + 1 < nk;
    if (more) {
#pragma unroll
      for (int i = 0; i < 4; ++i) { ra[i] = *(const u32x4*)(ap[i] + (kt + 1) * 64); rw[i] = *(const u32x4*)(wp[i] + (kt + 1) * 64); }
    }
    const char* st = lds + (kt & 1) * 32768;
#pragma unroll
    for (int ks = 0; ks < 4; ++ks) {
      bf16x8 wf[2], af[2];
#pragma unroll
      for (int b = 0; b < 2; ++b) {
        wf[b] = *(const bf16x8*)(st + wro[b] + (((ks * 2 + h) ^ wsw[b]) << 4));
        af[b] = *(const bf16x8*)(st + aro[b] + (((ks * 2 + h) ^ asw[b]) << 4));
      }
#pragma unroll
      for (int nb = 0; nb < 2; ++nb)
#pragma unroll
        for (int tb = 0; tb < 2; ++tb)
          acc[nb][tb] = __builtin_amdgcn_mfma_f32_32x32x16_bf16(wf[nb], af[tb], acc[nb][tb], 0, 0, 0);
    }
    if (more) {
      char* sn = lds + ((kt + 1) & 1) * 32768;
#pragma unroll
      for (int i = 0; i < 4; ++i) { *(u32x4*)(sn + ldso[i]) = rw[i]; *(u32x4*)(sn + 16384 + ldso[i]) = ra[i]; }
    }
    __syncthreads();
  }
}

__device__ __forceinline__ void zero_acc(f32x16 (&acc)[2][2]) {
#pragma unroll
  for (int a = 0; a < 2; ++a)
#pragma unroll
    for (int b = 0; b < 2; ++b)
#pragma unroll
      for (int r = 0; r < 16; ++r) acc[a][b][r] = 0.f;
}

template <class F>
__device__ __forceinline__ void gemm_phase(const u16* A, int lda, int M, const u16* W, int K, int N, char* lds, F&& epi) {
  const int nN = N >> 7, nM = (M + 127) >> 7, nt = nN * nM;
  const int wave = ltid() >> 6;
  for (int t = blockIdx.x; t < nt; t += gridDim.x) {
    const int tm = t / nN, tn = t - tm * nN;
    f32x16 acc[2][2];
    zero_acc(acc);
    gemm_kloop(acc, A, lda, M, tm * 128, W, K, tn * 128, K, lds);
    epi(acc, tn * 128 + (wave & 1) * 64, tm * 128 + (wave >> 1) * 64);
  }
}

__device__ __forceinline__ void epi_swiglu(const f32x16 (&acc)[2][2], int nbase, int tbase, int M, const float* ss, u16* ACT) {
  const int lane = ltid() & 63, l32 = lane & 31, h = lane >> 5;
  const int cb = (nbase >> 6) * 32;
#pragma unroll
  for (int tb = 0; tb < 2; ++tb) {
    const int tok = tbase + tb * 32 + l32;
    if (tok < M) {
      const float rs = rsqrtf(ss[tok] * (1.f / 1024.f) + EPSN);
      u16* dst = ACT + (size_t)tok * FFD + cb + 4 * h;
#pragma unroll
      for (int i = 0; i < 4; ++i) {
        float o[4];
#pragma unroll
        for (int j = 0; j < 4; ++j) {
          const float g = acc[0][tb][4 * i + j] * rs, u = acc[1][tb][4 * i + j] * rs;
          o[j] = g * sigm(g) * u;
        }
        *(u32x2*)(dst + 8 * i) = (u32x2){pk_bf16(o[0], o[1]), pk_bf16(o[2], o[3])};
      }
    }
  }
}

template <int MODE>
__device__ __forceinline__ void epi_resid(const f32x16 (&acc)[2][2], int nbase, int tbase, CP& p, const Grp& G) {
  const int lane = ltid() & 63, l32 = lane & 31, h = lane >> 5;
  const float scale = MODE == 1 ? 1.f : 0.5f;
  float* ssout = MODE == 0 ? p.ss1 : (MODE == 1 ? p.ss2 : p.ss3);
#pragma unroll
  for (int tb = 0; tb < 2; ++tb) {
    const int tok = tbase + tb * 32 + l32;
    const bool valid = tok < G.M;
    float sq = 0.f;
    if (valid) {
      float* hp = p.H + (size_t)tok * 1024;
      const float* rp = hp;
      if (MODE == 0) {
        const int s = tok / G.L, t = tok - s * G.L;
        rp = t < 16 ? p.meta + t * 1024 : G.x + ((size_t)s * G.S + (t - 16)) * 1024;
      }
#pragma unroll
      for (int nb = 0; nb < 2; ++nb)
#pragma unroll
        for (int i = 0; i < 4; ++i) {
          const int n = nbase + nb * 32 + 8 * i + 4 * h;
          const f32x4 r = *(const f32x4*)(rp + n);
          f32x4 v;
          v.x = r.x + scale * acc[nb][tb][4 * i + 0];
          v.y = r.y + scale * acc[nb][tb][4 * i + 1];
          v.z = r.z + scale * acc[nb][tb][4 * i + 2];
          v.w = r.w + scale * acc[nb][tb][4 * i + 3];
          *(f32x4*)(hp + n) = v;
          sq += v.x * v.x + v.y * v.y + v.z * v.z + v.w * v.w;
          if (MODE != 2) *(u32x2*)(p.HB + (size_t)tok * 1024 + n) = (u32x2){pk_bf16(v.x, v.y), pk_bf16(v.z, v.w)};
        }
    }
    sq += __shfl_xor(sq, 32);
    if (valid && h == 0) atomicAdd(ssout + tok, sq);
  }
}

__device__ void phase_mix(CP& p, const Grp& G) {
  const int total = G.M * 432;
  for (int idx = blockIdx.x * 256 + ltid(); idx < total; idx += gridDim.x * 256) {
    const int row = idx / 432, ch = idx - row * 432;
    const int t = row % G.L;
    const int col = ch * 8;
    const u16* pc = p.P + (size_t)row * NIN + 3072 + col;
    const u32x4 c = *(const u32x4*)pc;
    u32x4 pv = {0, 0, 0, 0}, nx = {0, 0, 0, 0};
    if (t > 0) pv = *(const u32x4*)(pc - NIN);
    if (t < G.L - 1) nx = *(const u32x4*)(pc + NIN);
    const f32x4 mp0 = *(const f32x4*)(p.mu_prev + col), mp1 = *(const f32x4*)(p.mu_prev + col + 4);
    const f32x4 mn0 = *(const f32x4*)(p.mu_next + col), mn1 = *(const f32x4*)(p.mu_next + col + 4);
    float o[8];
#pragma unroll
    for (int e = 0; e < 4; ++e) {
      const float c0 = bf_lo(c[e]), c1 = bf_hi(c[e]);
      const float mpa = e < 2 ? mp0[2 * e] : mp1[2 * e - 4], mpb = e < 2 ? mp0[2 * e + 1] : mp1[2 * e - 3];
      const float mna = e < 2 ? mn0[2 * e] : mn1[2 * e - 4], mnb = e < 2 ? mn0[2 * e + 1] : mn1[2 * e - 3];
      o[2 * e] = c0 + mpa * (bf_lo(pv[e]) - c0) + mna * (bf_lo(nx[e]) - c0);
      o[2 * e + 1] = c1 + mpb * (bf_hi(pv[e]) - c1) + mnb * (bf_hi(nx[e]) - c1);
    }
    if (col < 3072) {
      const int sec = col >> 10, ci = col & 1023, head = ci >> 6, c0 = ci & 63;
      const size_t ro = ((size_t)row * 16 + head) * 192 + sec * 64 + c0;
      const u32x4 pk = (u32x4){pk_f16(o[0], o[1]), pk_f16(o[2], o[3]), pk_f16(o[4], o[5]), pk_f16(o[6], o[7])};
      *(u32x4*)(p.RKV + ro) = pk;
      if (sec == 1) { *(u32x4*)(p.DIR0 + ro) = pk; *(u32x4*)(p.DIR1 + ro) = pk; }
    } else {
      const int fc = col - 3072;
      if (fc < 128) {
#pragma unroll
        for (int e = 0; e < 8; ++e) o[e] = 1.f - 2.f / (1.f + __expf(2.f * o[e]));
      } else if (fc >= 256) {
#pragma unroll
        for (int e = 0; e < 8; ++e) o[e] = sigm(o[e]);
      }
      *(u32x4*)(p.F + (size_t)row * 384 + fc) = (u32x4){pk_bf16(o[0], o[1]), pk_bf16(o[2], o[3]), pk_bf16(o[4], o[5]), pk_bf16(o[6], o[7])};
    }
  }
}

__device__ __forceinline__ void epi_decay(const f32x16 (&acc)[2][2], int nbase, int tbase, int M, const float* w0, u16* DIR) {
  const int lane = ltid() & 63, l32 = lane & 31, h = lane >> 5;
  const int head = nbase >> 6;
#pragma unroll
  for (int tb = 0; tb < 2; ++tb) {
    const int tok = tbase + tb * 32 + l32;
    if (tok < M) {
      u16* dst = DIR + ((size_t)tok * 16 + head) * 192;
#pragma unroll
      for (int nb = 0; nb < 2; ++nb)
#pragma unroll
        for (int i = 0; i < 4; ++i) {
          const int c = nb * 32 + 8 * i + 4 * h;
          const f32x4 w = *(const f32x4*)(w0 + nbase + c);
          float o[4];
#pragma unroll
          for (int j = 0; j < 4; ++j) o[j] = 0.6065306597126334f * sigm(w[j] + acc[nb][tb][4 * i + j]);
          *(u32x2*)(dst + c) = (u32x2){pk_f16(o[0], o[1]), pk_f16(o[2], o[3])};
        }
    }
  }
}

__device__ __forceinline__ void epi_adir(const f32x16 (&acc)[2][2], int nbase, int tbase, int M, CP& p, int dir) {
  const int lane = ltid() & 63, l32 = lane & 31, h = lane >> 5;
  const int head = nbase >> 6;
  u16* DIR = dir ? p.DIR1 : p.DIR0;
  const float* a0 = p.rw_a0 + dir * 1024;
#pragma unroll
  for (int tb = 0; tb < 2; ++tb) {
    const int tok = tbase + tb * 32 + l32;
    const bool valid = tok < M;
    const int tk = valid ? tok : M - 1;
    const size_t rec = ((size_t)tk * 16 + head) * 192;
    float nsq = 0.f;
#pragma unroll
    for (int nb = 0; nb < 2; ++nb)
#pragma unroll
      for (int i = 0; i < 4; ++i) {
        const int c = nb * 32 + 8 * i + 4 * h;
        const u32x2 kr = *(const u32x2*)(DIR + rec + 64 + c);
        const f32x4 kkw = *(const f32x4*)(p.k_k + nbase + c);
        const float q0 = h_lo(kr.x) * kkw[0], q1 = h_hi(kr.x) * kkw[1], q2 = h_lo(kr.y) * kkw[2], q3 = h_hi(kr.y) * kkw[3];
        nsq += q0 * q0 + q1 * q1 + q2 * q2 + q3 * q3;
      }
    nsq += __shfl_xor(nsq, 32);
    const float inv = 1.f / fmaxf(sqrtf(nsq), 1e-12f);
    if (valid) {
#pragma unroll
      for (int nb = 0; nb < 2; ++nb)
#pragma unroll
        for (int i = 0; i < 4; ++i) {
          const int c = nb * 32 + 8 * i + 4 * h;
          const u32x2 kr = *(const u32x2*)(DIR + rec + 64 + c);
          const float kv[4] = {h_lo(kr.x), h_hi(kr.x), h_lo(kr.y), h_hi(kr.y)};
          const f32x4 kkw = *(const f32x4*)(p.k_k + nbase + c);
          const f32x4 kaw = *(const f32x4*)(p.k_a + nbase + c);
          const f32x4 a0v = *(const f32x4*)(a0 + nbase + c);
          float kk[4], kd[4], bp[4];
#pragma unroll
          for (int j = 0; j < 4; ++j) {
            const float k = kv[j];
            kk[j] = k * kkw[j] * inv;
            const float aa = sigm(a0v[j] + acc[nb][tb][4 * i + j]);
            kd[j] = k * (1.f + (aa - 1.f) * kaw[j]);
            bp[j] = -kk[j] * aa;
          }
          if (dir == 0) *(u32x2*)(p.RKV + rec + 64 + c) = (u32x2){pk_f16(kk[0], kk[1]), pk_f16(kk[2], kk[3])};
          *(u32x2*)(DIR + rec + 64 + c) = (u32x2){pk_f16(kd[0], kd[1]), pk_f16(kd[2], kd[3])};
          *(u32x2*)(DIR + rec + 128 + c) = (u32x2){pk_f16(bp[0], bp[1]), pk_f16(bp[2], bp[3])};
        }
    }
  }
}

__device__ void scan_task(CP& p, const Grp& G, int task, char* lds) {
  const int half = task & 1, dir = (task >> 1) & 1, head = (task >> 2) & 15, s = task >> 6;
  float* buf = (float*)lds;
  const u16* rkv = p.RKV;
  const u16* dr = dir ? p.DIR1 : p.DIR0;
  u16* Y = dir ? p.Y1 : p.Y0;
  const int tid = ltid();
  const int row = half * 32 + (tid >> 3), kc = tid & 7;
  const int L = G.L, nch = L >> 4;
  u32x4 pre[3];
  auto issue = [&](int c) {
#pragma unroll
    for (int i = 0; i < 3; ++i) {
      const int id = tid + 256 * i, st = id / 48, ci = id - st * 48;
      const int n = c * 16 + st, t = dir ? L - 1 - n : n;
      const size_t rec = ((size_t)(s * L + t) * 16 + head) * 192;
      const u16* src = ci < 24 ? rkv + rec + ci * 8 : dr + rec + (ci - 24) * 8;
      pre[i] = *(const u32x4*)src;
    }
  };
  auto commit = [&](int b) {
#pragma unroll
    for (int i = 0; i < 3; ++i) {
      const int id = tid + 256 * i, st = id / 48, ci = id - st * 48;
      const int sec = ci >> 3;
      const int base = sec >= 3 ? (sec - 1) * 64 : (sec == 0 ? 64 : (sec == 1 ? 0 : 320));
      float f[8];
#pragma unroll
      for (int e = 0; e < 4; ++e) { f[2 * e] = h_lo(pre[i][e]); f[2 * e + 1] = h_hi(pre[i][e]); }
      if (sec == 3) {
#pragma unroll
        for (int e = 0; e < 8; ++e) f[e] = __expf(-f[e]);
      }
      float* d = buf + b * 6144 + st * 384 + base + (ci & 7) * 8;
      *(f32x4*)d = (f32x4){f[0], f[1], f[2], f[3]};
      *(f32x4*)(d + 4) = (f32x4){f[4], f[5], f[6], f[7]};
    }
  };
  float S[8];
#pragma unroll
  for (int i = 0; i < 8; ++i) S[i] = 0.f;
  __syncthreads();
  issue(0);
  commit(0);
  __syncthreads();
  for (int c = 0; c < nch; ++c) {
    if (c + 1 < nch) issue(c + 1);
    const float* b = buf + (c & 1) * 6144;
#pragma unroll 4
    for (int st = 0; st < 16; ++st) {
      const float* q = b + st * 384 + kc * 8;
      const f32x4 kk0 = *(const f32x4*)(q), kk1 = *(const f32x4*)(q + 4);
      const f32x4 r0 = *(const f32x4*)(q + 64), r1 = *(const f32x4*)(q + 68);
      const f32x4 w0 = *(const f32x4*)(q + 128), w1 = *(const f32x4*)(q + 132);
      const f32x4 d0 = *(const f32x4*)(q + 192), d1 = *(const f32x4*)(q + 196);
      const f32x4 b0 = *(const f32x4*)(q + 256), b1 = *(const f32x4*)(q + 260);
      const float vv = b[st * 384 + 320 + row];
      float sa = 0.f;
#pragma unroll
      for (int i = 0; i < 4; ++i) { sa += S[i] * kk0[i]; sa += S[4 + i] * kk1[i]; }
      sa = reduce8(sa);
      float y = 0.f;
#pragma unroll
      for (int i = 0; i < 4; ++i) {
        S[i] = S[i] * w0[i] + (sa * b0[i] + vv * d0[i]);
        S[4 + i] = S[4 + i] * w1[i] + (sa * b1[i] + vv * d1[i]);
        y += S[i] * r0[i];
        y += S[4 + i] * r1[i];
      }
      y = reduce8(y);
      if (kc == 0) {
        const int n = c * 16 + st, t = dir ? L - 1 - n : n;
        Y[(size_t)(s * L + t) * 1024 + head * 64 + row] = bf16_1(y);
      }
    }
    if (c + 1 < nch) commit((c + 1) & 1);
    __syncthreads();
  }
}

__device__ void attn_tile(CP& p, const Grp& G, int s, int hd, int qb, char* lds, float lam) {
  const int tid = ltid(), lane = tid & 63, wave = tid >> 6, l32 = lane & 31, h = lane >> 5;
  const int L = G.L;
  const u16* Pb = p.P + (size_t)s * L * NIN;
  float* lutl = (float*)(lds + 24576);
  char* qfl = lds + 26624 + tid * 16;
  __syncthreads();
  for (int i = tid; i < 511; i += 256) lutl[i] = p.lut[hd * 512 + i];
  const int q = qb * 128 + wave * 32 + l32;
  const int qc = q < L ? q : L - 1;
  const int qw0 = qb * 128 + wave * 32;
  u16* odst = p.O + (size_t)(s * L + qc) * 1024 + hd * 128;
  const int kkey = tid >> 3, kch = tid & 7;
  const int kldo = kkey * 128 + ((kch ^ ((kkey >> 1) & 7)) << 4);
  int vkey[2], vdvc[2], vwo0[2], vwo1[2];
#pragma unroll
  for (int i = 0; i < 2; ++i) {
    const int c = tid + 256 * i;
    vkey[i] = (c & 15) + 16 * ((c >> 6) & 1);
    vdvc[i] = ((c >> 4) & 3) + 4 * (c >> 7);
    const int key = vkey[i];
    const int pos = (key & 16) | ((key & 4) << 1) | ((key & 8) >> 1) | (key & 3);
    const int chunk = pos >> 3, inb = (pos & 7) * 2;
    vwo0[i] = vdvc[i] * 512 + ((chunk ^ ((2 * vdvc[i]) & 3)) << 4) + inb;
    vwo1[i] = vdvc[i] * 512 + ((chunk ^ ((2 * vdvc[i] + 1) & 3)) << 4) + inb;
  }
  const int ntile = (L + 31) >> 5;
#pragma unroll 1
  for (int br = 0; br < 2; ++br) {
#pragma unroll
    for (int ks = 0; ks < 4; ++ks) {
      const u32x4 raw = *(const u32x4*)(Pb + (size_t)qc * NIN + hd * 128 + br * 64 + ks * 16 + h * 8);
      u32x4 sc;
#pragma unroll
      for (int e = 0; e < 4; ++e) sc[e] = pk_bf16(bf_lo(raw[e]) * 0.125f, bf_hi(raw[e]) * 0.125f);
      *(u32x4*)(qfl + ks * 4096) = sc;
    }
    const u16* kp = Pb + 1024 + hd * 128 + br * 64 + kch * 8;
    u32x4 rk, rv[2];
    auto issue = [&](int kt0) {
      int kr = kt0 + kkey; kr = kr < L ? kr : L - 1;
      rk = *(const u32x4*)(kp + (size_t)kr * NIN);
#pragma unroll
      for (int i = 0; i < 2; ++i) {
        int vr = kt0 + vkey[i]; vr = vr < L ? vr : L - 1;
        rv[i] = *(const u32x4*)(Pb + (size_t)vr * NIN + 2048 + hd * 128 + vdvc[i] * 8);
      }
    };
    auto commit = [&](int b) {
      char* st = lds + b * 12288;
      *(u32x4*)(st + kldo) = rk;
#pragma unroll
      for (int i = 0; i < 2; ++i) {
        char* vb = st + 4096;
#pragma unroll
        for (int e = 0; e < 8; ++e) {
          const unsigned wv = rv[i][e >> 1];
          const u16 val = (e & 1) ? (u16)(wv >> 16) : (u16)(wv & 0xffffu);
          *(u16*)(vb + (e < 4 ? vwo0[i] : vwo1[i]) + e * 64) = val;
        }
      }
    };
    f32x16 O[4];
#pragma unroll
    for (int mb = 0; mb < 4; ++mb)
#pragma unroll
      for (int r = 0; r < 16; ++r) O[mb][r] = 0.f;
    float mrun = -1e30f, lrun = 0.f;
    issue(0);
    commit(0);
    __syncthreads();
    const float cneg = lutl[0], cpos = lutl[510];
    for (int kt = 0; kt < ntile; ++kt) {
      const int kt0 = kt * 32;
      if (kt + 1 < ntile) issue(kt0 + 32);
      const char* st = lds + (kt & 1) * 12288;
      f32x16 sacc;
#pragma unroll
      for (int r = 0; r < 16; ++r) sacc[r] = 0.f;
#pragma unroll
      for (int ks = 0; ks < 4; ++ks) {
        const bf16x8 kf = *(const bf16x8*)(st + l32 * 128 + (((ks * 2 + h) ^ ((l32 >> 1) & 7)) << 4));
        const bf16x8 qv = *(const bf16x8*)(qfl + ks * 4096);
        sacc = __builtin_amdgcn_mfma_f32_32x32x16_bf16(kf, qv, sacc, 0, 0, 0);
      }
      const bool farneg = (kt0 + 31) <= (qw0 - 128);
      const bool farpos = kt0 >= (qw0 + 31 + 128);
      float mx = -1e30f;
      if (farneg || farpos) {
        const float cv = farneg ? cneg : cpos;
#pragma unroll
        for (int r = 0; r < 16; ++r) { sacc[r] = sacc[r] * LOG2E + cv; }
      } else {
#pragma unroll
        for (int r = 0; r < 16; ++r) {
          const int key = kt0 + 8 * (r >> 2) + 4 * h + (r & 3);
          int d = key - q + 255;
          d = d < 0 ? 0 : (d > 510 ? 510 : d);
          sacc[r] = sacc[r] * LOG2E + lutl[d];
        }
      }
      if (kt0 + 32 > L) {
#pragma unroll
        for (int r = 0; r < 16; ++r) {
          const int key = kt0 + 8 * (r >> 2) + 4 * h + (r & 3);
          if (key >= L) sacc[r] = -INFINITY;
        }
      }
#pragma unroll
      for (int r = 0; r < 16; ++r) mx = fmaxf(mx, sacc[r]);
      mx = fmaxf(mx, __shfl_xor(mx, 32));
      const float mnew = fmaxf(mrun, mx);
      const float alpha = __builtin_amdgcn_exp2f(mrun - mnew);
      mrun = mnew;
      float ps = 0.f;
#pragma unroll
      for (int r = 0; r < 16; ++r) { sacc[r] = __builtin_amdgcn_exp2f(sacc[r] - mnew); ps += sacc[r]; }
      lrun = lrun * alpha + ps;
      if (__any(alpha != 1.f)) {
#pragma unroll
        for (int mb = 0; mb < 4; ++mb)
#pragma unroll
          for (int r = 0; r < 16; ++r) O[mb][r] *= alpha;
      }
      bf16x8 pf[2];
#pragma unroll
      for (int s2 = 0; s2 < 2; ++s2) {
        u32x4 w;
#pragma unroll
        for (int e = 0; e < 4; ++e) w[e] = pk_bf16(sacc[8 * s2 + 2 * e], sacc[8 * s2 + 2 * e + 1]);
        pf[s2] = __builtin_bit_cast(bf16x8, w);
      }
#pragma unroll
      for (int mb = 0; mb < 4; ++mb)
#pragma unroll
        for (int s2 = 0; s2 < 2; ++s2) {
          const int vr = mb * 32 + l32;
          const bf16x8 vf = *(const bf16x8*)(st + 4096 + vr * 64 + (((2 * s2 + h) ^ ((vr >> 2) & 3)) << 4));
          O[mb] = __builtin_amdgcn_mfma_f32_32x32x16_bf16(vf, pf[s2], O[mb], 0, 0, 0);
          if (s2 == 1 && (mb & 1)) __builtin_amdgcn_sched_barrier(0);
        }
      if (kt + 1 < ntile) commit((kt + 1) & 1);
      __syncthreads();
    }
    const float lt = lrun + __shfl_xor(lrun, 32);
    if (br == 0) {
      const float i1 = 1.f / lt;
#pragma unroll
      for (int mb = 0; mb < 4; ++mb)
#pragma unroll
        for (int i = 0; i < 4; ++i)
          if (q < L) *(u32x2*)(odst + mb * 32 + 8 * i + 4 * h) = (u32x2){pk_bf16(O[mb][4 * i] * i1, O[mb][4 * i + 1] * i1), pk_bf16(O[mb][4 * i + 2] * i1, O[mb][4 * i + 3] * i1)};
    } else {
      const float i2 = lam / lt;
      float ssq = 0.f;
#pragma unroll
      for (int mb = 0; mb < 4; ++mb)
#pragma unroll
        for (int i = 0; i < 4; ++i) {
          u32x2 w = {0, 0};
          if (q < L) w = *(const u32x2*)(odst + mb * 32 + 8 * i + 4 * h);
          const float o0 = bf_lo(w.x) - O[mb][4 * i] * i2, o1v = bf_hi(w.x) - O[mb][4 * i + 1] * i2, o2 = bf_lo(w.y) - O[mb][4 * i + 2] * i2, o3 = bf_hi(w.y) - O[mb][4 * i + 3] * i2;
          O[mb][4 * i] = o0; O[mb][4 * i + 1] = o1v; O[mb][4 * i + 2] = o2; O[mb][4 * i + 3] = o3;
          ssq += o0 * o0 + o1v * o1v + o2 * o2 + o3 * o3;
        }
      ssq += __shfl_xor(ssq, 32);
      const float rn = rsqrtf(ssq * (1.f / 128.f) + EPSN) * 0.8f;
      if (q < L) {
        u16* dst = p.O + (size_t)(s * L + q) * 1024 + hd * 128;
#pragma unroll
        for (int mb = 0; mb < 4; ++mb)
#pragma unroll
          for (int i = 0; i < 4; ++i) {
            const int dv = mb * 32 + 8 * i + 4 * h;
            const f32x4 g = *(const f32x4*)(p.subln + dv);
            *(u32x2*)(dst + dv) = (u32x2){pk_bf16(O[mb][4 * i] * rn * g.x, O[mb][4 * i + 1] * rn * g.y),
                                          pk_bf16(O[mb][4 * i + 2] * rn * g.z, O[mb][4 * i + 3] * rn * g.w)};
          }
      }
    }
  }
}

__device__ void phase_mixer(CP& p, const Grp& G, int g, char* lds) {
  const int nscan = G.nseq * 64;
  for (int t = blockIdx.x; t < nscan; t += gridDim.x) scan_task(p, G, t, lds);
  const int nqb = (G.L + 127) >> 7;
  const int natt = G.nseq * 8 * nqb;
  const float lam = p.lam[0];
  int* shw = (int*)(lds + 65536 - 16);
  while (true) {
    __syncthreads();
    if (ltid() == 0) *shw = atomicAdd(p.cnt + g, 1);
    __syncthreads();
    const int t = *shw;
    if (t >= natt) break;
    const int qb = t % nqb, r = t / nqb, hd = r & 7, s = r >> 3;
    attn_tile(p, G, s, hd, qb, lds, lam);
  }
}

__device__ void phase_post(CP& p, const Grp& G) {
  const int lane = ltid() & 63;
  const int nw = gridDim.x * 4;
  const int c0 = lane * 16, head = lane >> 2, hc = (lane & 3) * 16;
  for (int row = blockIdx.x * 4 + (ltid() >> 6); row < G.M; row += nw) {
    float y[16];
    {
      const u32x4 a0 = *(const u32x4*)(p.Y0 + (size_t)row * 1024 + c0), a1 = *(const u32x4*)(p.Y0 + (size_t)row * 1024 + c0 + 8);
      const u32x4 b0 = *(const u32x4*)(p.Y1 + (size_t)row * 1024 + c0), b1 = *(const u32x4*)(p.Y1 + (size_t)row * 1024 + c0 + 8);
#pragma unroll
      for (int e = 0; e < 4; ++e) {
        y[2 * e] = bf_lo(a0[e]) + bf_lo(b0[e]); y[2 * e + 1] = bf_hi(a0[e]) + bf_hi(b0[e]);
        y[8 + 2 * e] = bf_lo(a1[e]) + bf_lo(b1[e]); y[8 + 2 * e + 1] = bf_hi(a1[e]) + bf_hi(b1[e]);
      }
    }
    float s1 = 0.f;
#pragma unroll
    for (int e = 0; e < 16; ++e) s1 += y[e];
    s1 = reduce4(s1);
    const float mu = s1 * (1.f / 64.f);
    float s2 = 0.f;
#pragma unroll
    for (int e = 0; e < 16; ++e) { const float d = y[e] - mu; s2 += d * d; }
    s2 = reduce4(s2);
    const float rstd = rsqrtf(s2 * (1.f / 64.f) + 64e-5f);
    const size_t rec = ((size_t)row * 16 + head) * 192 + hc;
    float rr[16], vv[16], kd[16];
    {
      const u32x4 r0 = *(const u32x4*)(p.RKV + rec), r1 = *(const u32x4*)(p.RKV + rec + 8);
      const u32x4 v0 = *(const u32x4*)(p.RKV + rec + 128), v1 = *(const u32x4*)(p.RKV + rec + 136);
      const u32x4 f0 = *(const u32x4*)(p.DIR0 + rec + 64), f1 = *(const u32x4*)(p.DIR0 + rec + 72);
      const u32x4 g0 = *(const u32x4*)(p.DIR1 + rec + 64), g1 = *(const u32x4*)(p.DIR1 + rec + 72);
#pragma unroll
      for (int e = 0; e < 4; ++e) {
        rr[2 * e] = h_lo(r0[e]); rr[2 * e + 1] = h_hi(r0[e]); rr[8 + 2 * e] = h_lo(r1[e]); rr[8 + 2 * e + 1] = h_hi(r1[e]);
        vv[2 * e] = h_lo(v0[e]); vv[2 * e + 1] = h_hi(v0[e]); vv[8 + 2 * e] = h_lo(v1[e]); vv[8 + 2 * e + 1] = h_hi(v1[e]);
        kd[2 * e] = h_lo(f0[e]) + h_lo(g0[e]); kd[2 * e + 1] = h_hi(f0[e]) + h_hi(g0[e]);
        kd[8 + 2 * e] = h_lo(f1[e]) + h_lo(g1[e]); kd[8 + 2 * e + 1] = h_hi(f1[e]) + h_hi(g1[e]);
      }
    }
    float bs = 0.f;
#pragma unroll
    for (int e = 0; e < 16; ++e) bs += rr[e] * kd[e] * p.r_k[c0 + e];
    bs = reduce4(bs);
    const u32x4 g0 = *(const u32x4*)(p.G + (size_t)row * 1024 + c0), g1 = *(const u32x4*)(p.G + (size_t)row * 1024 + c0 + 8);
    float o[16];
#pragma unroll
    for (int e = 0; e < 16; ++e) {
      const unsigned gw = e < 8 ? g0[e >> 1] : g1[(e - 8) >> 1];
      const float gg = (e & 1) ? bf_hi(gw) : bf_lo(gw);
      o[e] = ((y[e] - mu) * rstd * p.lnx_w[c0 + e] + p.lnx_b[c0 + e] + bs * vv[e]) * gg;
    }
    u16* dst = p.HB + (size_t)row * 1024 + c0;
    *(u32x4*)dst = (u32x4){pk_bf16(o[0], o[1]), pk_bf16(o[2], o[3]), pk_bf16(o[4], o[5]), pk_bf16(o[6], o[7])};
    *(u32x4*)(dst + 8) = (u32x4){pk_bf16(o[8], o[9]), pk_bf16(o[10], o[11]), pk_bf16(o[12], o[13]), pk_bf16(o[14], o[15])};
  }
}

__device__ void phase_final(CP& p, const Grp& G) {
  const int lane = ltid() & 63;
  const int nw = gridDim.x * 4;
  for (int row = blockIdx.x * 4 + (ltid() >> 6); row < G.M; row += nw) {
    const int s = row / G.L, t = row - s * G.L;
    if (t < 16) continue;
    const float rs = rsqrtf(p.ss3[row] * (1.f / 1024.f) + EPSN);
    const float* hp = p.H + (size_t)row * 1024;
    float* op = G.out + ((size_t)s * G.S + (t - 16)) * 1024;
#pragma unroll
    for (int i = 0; i < 4; ++i) {
      const f32x4 v = *(const f32x4*)(hp + i * 256 + lane * 4);
      const f32x4 g = *(const f32x4*)(p.final_norm + i * 256 + lane * 4);
      *(f32x4*)(op + i * 256 + lane * 4) = (f32x4){v.x * rs * g.x, v.y * rs * g.y, v.z * rs * g.z, v.w * rs * g.w};
    }
  }
}

__device__ void run_phase(CP& p, int ph, char* lds) {
  if (ph == 0) { phase_prep(p, lds); return; }
  const int g = (ph - 1) / PH_PER_G, k = (ph - 1) - g * PH_PER_G;
  const Grp G = get_grp(p, g);
  const int M = G.M;
  switch (k) {
    case 0: phase_rows(p, G); break;
    case 1:
      gemm_phase(p.HB, 1024, M, p.W1A, 1024, 2 * FFD, lds, [&](const f32x16 (&acc)[2][2], int nb, int tb) { epi_swiglu(acc, nb, tb, M, p.ss0, p.ACT); });
      break;
    case 2:
      gemm_phase(p.ACT, FFD, M, p.WD1, FFD, 1024, lds, [&](const f32x16 (&acc)[2][2], int nb, int tb) { epi_resid<0>(acc, nb, tb, p, G); });
      break;
    case 3:
      gemm_phase(p.HB, 1024, M, p.WIN, 1024, NIN, lds, [&](const f32x16 (&acc)[2][2], int nbase, int tbase) {
        const int lane = ltid() & 63, l32 = lane & 31, h = lane >> 5;
#pragma unroll
        for (int tb = 0; tb < 2; ++tb) {
          const int tok = tbase + tb * 32 + l32;
          if (tok < M) {
            const float rs = rsqrtf(p.ss1[tok] * (1.f / 1024.f) + EPSN);
            u16* dst = p.P + (size_t)tok * NIN + nbase + 4 * h;
#pragma unroll
            for (int nb = 0; nb < 2; ++nb)
#pragma unroll
              for (int i = 0; i < 4; ++i)
                *(u32x2*)(dst + nb * 32 + 8 * i) = (u32x2){pk_bf16(acc[nb][tb][4 * i] * rs, acc[nb][tb][4 * i + 1] * rs),
                                                           pk_bf16(acc[nb][tb][4 * i + 2] * rs, acc[nb][tb][4 * i + 3] * rs)};
          }
        }
      });
      break;
    case 4: phase_mix(p, G); break;
    case 5:
      gemm_phase(p.F, 384, M, p.W2F, 64, 1024, lds, [&](const f32x16 (&acc)[2][2], int nb, int tb) { epi_decay(acc, nb, tb, M, p.rw_w0, p.DIR0); });
      gemm_phase(p.F + 64, 384, M, p.W2B, 64, 1024, lds, [&](const f32x16 (&acc)[2][2], int nb, int tb) { epi_decay(acc, nb, tb, M, p.rw_w0 + 1024, p.DIR1); });
      gemm_phase(p.F + 128, 384, M, p.A2F, 64, 1024, lds, [&](const f32x16 (&acc)[2][2], int nb, int tb) { epi_adir(acc, nb, tb, M, p, 0); });
      gemm_phase(p.F + 192, 384, M, p.A2B, 64, 1024, lds, [&](const f32x16 (&acc)[2][2], int nb, int tb) { epi_adir(acc, nb, tb, M, p, 1); });
      gemm_phase(p.F + 256, 384, M, p.G2T, 128, 1024, lds, [&](const f32x16 (&acc)[2][2], int nbase, int tbase) {
        const int lane = ltid() & 63, l32 = lane & 31, h = lane >> 5;
#pragma unroll
        for (int tb = 0; tb < 2; ++tb) {
          const int tok = tbase + tb * 32 + l32;
          if (tok < M) {
            u16* dst = p.G + (size_t)tok * 1024 + nbase + 4 * h;
#pragma unroll
            for (int nb = 0; nb < 2; ++nb)
#pragma unroll
              for (int i = 0; i < 4; ++i)
                *(u32x2*)(dst + nb * 32 + 8 * i) = (u32x2){pk_bf16(acc[nb][tb][4 * i], acc[nb][tb][4 * i + 1]), pk_bf16(acc[nb][tb][4 * i + 2], acc[nb][tb][4 * i + 3])};
          }
        }
      });
      break;
    case 6: phase_mixer(p, G, g, lds); break;
    case 7: phase_post(p, G); break;
    case 8: {
      const int nN = 8, nM = (M + 127) >> 7, nt = nN * nM;
      const int wave = ltid() >> 6;
      const int lane = ltid() & 63, l32 = lane & 31, h = lane >> 5;
      for (int t = blockIdx.x; t < nt; t += gridDim.x) {
        const int tm = t / nN, tn = t - tm * nN;
        const int nbase = tn * 128 + (wave & 1) * 64, tbase = tm * 128 + (wave >> 1) * 64;
#pragma unroll 1
        for (int pass = 0; pass < 2; ++pass) {
          f32x16 acc[2][2];
          zero_acc(acc);
          gemm_kloop(acc, pass ? p.HB : p.O, 1024, M, tm * 128, pass ? p.WRW : p.WATT, 1024, tn * 128, 1024, lds);
#pragma unroll
          for (int tb = 0; tb < 2; ++tb) {
            const int tok = tbase + tb * 32 + l32;
            if (tok < M) {
              const u16* gp = p.P + (size_t)tok * NIN + 6528 + pass * 1024 + nbase + 4 * h;
              u16* dst = p.MERGED + (size_t)tok * 1024 + nbase + 4 * h;
#pragma unroll
              for (int nb = 0; nb < 2; ++nb)
#pragma unroll
                for (int i = 0; i < 4; ++i) {
                  const u32x2 ga = *(const u32x2*)(gp + nb * 32 + 8 * i);
                  float o0 = sigm(bf_lo(ga.x)) * acc[nb][tb][4 * i];
                  float o1 = sigm(bf_hi(ga.x)) * acc[nb][tb][4 * i + 1];
                  float o2 = sigm(bf_lo(ga.y)) * acc[nb][tb][4 * i + 2];
                  float o3 = sigm(bf_hi(ga.y)) * acc[nb][tb][4 * i + 3];
                  if (pass) {
                    const u32x2 pv = *(const u32x2*)(dst + nb * 32 + 8 * i);
                    o0 += bf_lo(pv.x); o1 += bf_hi(pv.x); o2 += bf_lo(pv.y); o3 += bf_hi(pv.y);
                  }
                  *(u32x2*)(dst + nb * 32 + 8 * i) = (u32x2){pk_bf16(o0, o1), pk_bf16(o2, o3)};
                }
            }
          }
        }
      }
    } break;
    case 9:
      gemm_phase(p.MERGED, 1024, M, p.WOUT, 1024, 1024, lds, [&](const f32x16 (&acc)[2][2], int nb, int tb) { epi_resid<1>(acc, nb, tb, p, G); });
      break;
    case 10:
      gemm_phase(p.HB, 1024, M, p.W2A, 1024, 2 * FFD, lds, [&](const f32x16 (&acc)[2][2], int nb, int tb) { epi_swiglu(acc, nb, tb, M, p.ss2, p.ACT); });
      break;
    case 11:
      gemm_phase(p.ACT, FFD, M, p.WD2, FFD, 1024, lds, [&](const f32x16 (&acc)[2][2], int nb, int tb) { epi_resid<2>(acc, nb, tb, p, G); });
      break;
    case 12: phase_final(p, G); break;
  }
}

__global__ void __launch_bounds__(256, 2) mega(Params p, int ph_lo, int ph_hi, int coop) {
  __shared__ __attribute__((aligned(16))) char lds[65536];
  CP* pp = (CP*)__builtin_amdgcn_kernarg_segment_ptr();
  asm volatile("" : "+s"(pp));
  for (int ph = ph_lo; ph < ph_hi; ++ph) {
    run_phase(*pp, ph, lds);
    if (coop && ph + 1 < ph_hi) cg::this_grid().sync();
  }
}

extern "C" void kernel_launch(void* const* d_in, const int* in_sizes, int n_in, void* d_out, int out_size, void* d_ws,
                              size_t ws_size, hipStream_t stream) {
  Params p;
  memset(&p, 0, sizeof(p));
  const float** f = (const float**)&p;
  for (int i = 0; i < 35; ++i) f[i] = (const float*)d_in[i];
  p.out = (float*)d_out;
  char* w = (char*)d_ws;
  size_t off = 0;
  auto alloc = [&](size_t bytes) { char* r = w + off; off += (bytes + 255) & ~(size_t)255; return r; };
  p.W1A = (u16*)alloc((size_t)2 * FFD * 1024 * 2);
  p.WD1 = (u16*)alloc((size_t)1024 * FFD * 2);
  p.WIN = (u16*)alloc((size_t)NIN * 1024 * 2);
  p.WATT = (u16*)alloc((size_t)1024 * 1024 * 2);
  p.WRW = (u16*)alloc((size_t)1024 * 1024 * 2);
  p.WOUT = (u16*)alloc((size_t)1024 * 1024 * 2);
  p.W2A = (u16*)alloc((size_t)2 * FFD * 1024 * 2);
  p.WD2 = (u16*)alloc((size_t)1024 * FFD * 2);
  p.W2F = (u16*)alloc((size_t)1024 * 64 * 2);
  p.W2B = (u16*)alloc((size_t)1024 * 64 * 2);
  p.A2F = (u16*)alloc((size_t)1024 * 64 * 2);
  p.A2B = (u16*)alloc((size_t)1024 * 64 * 2);
  p.G2T = (u16*)alloc((size_t)1024 * 128 * 2);
  p.lut = (float*)alloc(8 * 512 * 4);
  p.cnt = (int*)alloc(256);
  p.lam = (float*)alloc(256);
  const size_t R = MAXROWS;
  p.H = (float*)alloc(R * 1024 * 4);
  p.HB = (u16*)alloc(R * 1024 * 2);
  p.ACT = (u16*)alloc(R * FFD * 2);
  p.Y0 = p.ACT;
  p.Y1 = p.ACT + R * 1024;
  p.F = p.ACT + R * 2048;
  p.P = (u16*)alloc(R * NIN * 2);
  p.RKV = (u16*)alloc(R * 16 * 192 * 2);
  p.DIR0 = (u16*)alloc(R * 16 * 192 * 2);
  p.DIR1 = (u16*)alloc(R * 16 * 192 * 2);
  p.G = (u16*)alloc(R * 1024 * 2);
  p.O = (u16*)alloc(R * 1024 * 2);
  p.MERGED = (u16*)alloc(R * 1024 * 2);
  p.ss0 = (float*)alloc(R * 4);
  p.ss1 = (float*)alloc(R * 4);
  p.ss2 = (float*)alloc(R * 4);
  p.ss3 = (float*)alloc(R * 4);
  if (off > ws_size) { fprintf(stderr, "workspace too small: need %zu have %zu\n", off, ws_size); return; }
  static int grid_blocks = 0;
  if (!grid_blocks) {
    int dev = 0, cus = 0, per_cu = 0;
    hipGetDevice(&dev);
    hipDeviceGetAttribute(&cus, hipDeviceAttributeMultiprocessorCount, dev);
    hipOccupancyMaxActiveBlocksPerMultiprocessor(&per_cu, mega, 256, 0);
    if (per_cu < 1) per_cu = 1;
    if (per_cu > 2) per_cu = 2;
    grid_blocks = cus * per_cu;
  }
  int ph_lo = 0, ph_hi = NPHASES, coop = 1;
  void* args[] = {&p, &ph_lo, &ph_hi, &coop};
  hipError_t e = hipLaunchCooperativeKernel((void*)mega, dim3(grid_blocks), dim3(256), args, 0, stream);
  if (e != hipSuccess) fprintf(stderr, "cooperative launch failed: %s (grid %d)\n", hipGetErrorString(e), grid_blocks);
}
```

```cpp
#include <hip/hip_runtime.h>
#include <hip/hip_cooperative_groups.h>
#include <stdint.h>
#include <string.h>
#include <stdio.h>
namespace cg = cooperative_groups;

typedef unsigned short u16;
typedef short bf16x8 __attribute__((ext_vector_type(8)));
typedef float f32x16 __attribute__((ext_vector_type(16)));
typedef float f32x4 __attribute__((ext_vector_type(4)));
typedef float f32x2 __attribute__((ext_vector_type(2)));
typedef unsigned u32x4 __attribute__((ext_vector_type(4)));
typedef unsigned u32x2 __attribute__((ext_vector_type(2)));
typedef __bf16 bf16x2_t __attribute__((ext_vector_type(2)));
typedef _Float16 f16x2_t __attribute__((ext_vector_type(2)));

#define NIN 8576
#define FFD 2816
#define EPSN 1e-6f
#define LOG2E 1.4426950408889634f
#define NGROUPS 6
#define PH_PER_G 13
#define NPHASES (1 + NGROUPS * PH_PER_G)
#define MAXROWS 16512

struct Params {
  const float *x_prompt, *x_sample, *meta, *rel_bias, *ffn1_norm, *ffn1_wg, *ffn1_wu, *ffn1_wd, *mix_norm, *w_in;
  const float *lq1, *lk1, *lq2, *lk2, *subln, *w_attn, *mu_prev, *mu_next, *rw_w0, *rw_w2, *rw_a0, *rw_a2, *rw_g2;
  const float *k_k, *k_a, *r_k, *lnx_w, *lnx_b, *w_rw, *w_out, *ffn2_norm, *ffn2_wg, *ffn2_wu, *ffn2_wd, *final_norm;
  float* out;
  u16 *W1A, *WD1, *WIN, *WATT, *WRW, *WOUT, *W2A, *WD2, *W2F, *W2B, *A2F, *A2B, *G2T;
  float* lut; int* cnt; float* lam; unsigned* bar;
  float* H; u16 *HB, *ACT, *P, *RKV, *DIR0, *DIR1, *G, *O, *MERGED, *Y0, *Y1, *F;
  float *ss0, *ss1, *ss2, *ss3;
};

typedef const Params __attribute__((address_space(4))) CP;
struct Grp { int nseq, L, S, M; const float* x; float* out; };

__device__ __forceinline__ Grp get_grp(CP& p, int g) {
  Grp r;
  if (g < 4) { r.nseq = 4; r.L = 4112; r.S = 4096; r.x = p.x_prompt + (size_t)g * 4 * 4096 * 1024; r.out = p.out + (size_t)g * 4 * 4096 * 1024; }
  else { r.nseq = 8; r.L = 2064; r.S = 2048; r.x = p.x_sample + (size_t)(g - 4) * 8 * 2048 * 1024; r.out = p.out + (size_t)16 * 4096 * 1024 + (size_t)(g - 4) * 8 * 2048 * 1024; }
  r.M = r.nseq * r.L;
  return r;
}

__device__ __forceinline__ int ltid() { int t = threadIdx.x; asm volatile("" : "+v"(t)); return t; }
__device__ __forceinline__ unsigned pk_bf16(float a, float b) {
  f32x2 v = {a, b};
  bf16x2_t r = __builtin_convertvector(v, bf16x2_t);
  return __builtin_bit_cast(unsigned, r);
}
__device__ __forceinline__ float bf_lo(unsigned u) { return __uint_as_float(u << 16); }
__device__ __forceinline__ float bf_hi(unsigned u) { return __uint_as_float(u & 0xffff0000u); }
__device__ __forceinline__ unsigned pk_f16(float a, float b) {
  f32x2 v = {a, b};
  f16x2_t r = __builtin_convertvector(v, f16x2_t);
  return __builtin_bit_cast(unsigned, r);
}
__device__ __forceinline__ float h_lo(unsigned u) { f16x2_t r = __builtin_bit_cast(f16x2_t, u); return (float)r.x; }
__device__ __forceinline__ float h_hi(unsigned u) { f16x2_t r = __builtin_bit_cast(f16x2_t, u); return (float)r.y; }
__device__ __forceinline__ u16 bf16_1(float a) { return (u16)(pk_bf16(a, 0.f) & 0xffffu); }
__device__ __forceinline__ float sigm(float x) { return 1.f / (1.f + __expf(-x)); }
__device__ __forceinline__ float wave_sum(float v) {
#pragma unroll
  for (int o = 32; o > 0; o >>= 1) v += __shfl_xor(v, o);
  return v;
}
template <int CTRL> __device__ __forceinline__ float dppf(float x) {
  return __int_as_float(__builtin_amdgcn_update_dpp(0, __float_as_int(x), CTRL, 0xf, 0xf, true));
}
__device__ __forceinline__ float reduce8(float x) {
  x += dppf<0xB1>(x);
  x += dppf<0x4E>(x);
  x += dppf<0x141>(x);
  return x;
}
__device__ __forceinline__ float reduce4(float x) {
  x += dppf<0xB1>(x);
  x += dppf<0x4E>(x);
  return x;
}

__device__ void prep_transpose(const float* __restrict__ src, int K, int N, u16* __restrict__ dst,
                               const float* __restrict__ gain, int mode, char* lds) {
  float* tile = (float*)lds;
  const int tn = N / 64, nt = (K / 64) * tn;
  const int tid = ltid();
  for (int t = blockIdx.x; t < nt; t += gridDim.x) {
    const int k0 = (t / tn) * 64, n0 = (t % tn) * 64;
    const int nl = tid & 63, kq = tid >> 6;
#pragma unroll
    for (int i = 0; i < 16; ++i) {
      const int k = i * 4 + kq;
      float v = src[(size_t)(k0 + k) * N + n0 + nl];
      if (gain) v *= gain[k0 + k];
      tile[k * 65 + nl] = v;
    }
    __syncthreads();
    const int n = tid >> 2, kk = (tid & 3) * 16;
    unsigned w[8];
#pragma unroll
    for (int i = 0; i < 8; ++i) w[i] = pk_bf16(tile[(kk + 2 * i) * 65 + n], tile[(kk + 2 * i + 1) * 65 + n]);
    const int ng = n0 + n;
    const int row = mode == 0 ? ng : ((ng >> 5) * 64 + (ng & 31) + (mode == 2 ? 32 : 0));
    u32x4* d = (u32x4*)(dst + (size_t)row * K + k0 + kk);
    d[0] = (u32x4){w[0], w[1], w[2], w[3]};
    d[1] = (u32x4){w[4], w[5], w[6], w[7]};
    __syncthreads();
  }
}

__device__ void phase_prep(CP& p, char* lds) {
  if (blockIdx.x == 0) {
    const int tid = ltid();
    if (tid < 16) p.cnt[tid] = 0;
    for (int idx = tid; idx < 8 * 511; idx += 256) {
      const int hd = idx / 511, di = idx - hd * 511, d = di - 255;
      const int n = d < 0 ? -d : d;
      int bk;
      if (n < 8) bk = n;
      else {
        const float nf = (float)n;
        int large = 8 + (int)(logf(nf / 8.0f) / 2.772588722239781f * 8.0f);
        bk = large < 15 ? large : 15;
      }
      const int bucket = (d > 0 ? 16 : 0) + bk;
      p.lut[hd * 512 + di] = p.rel_bias[bucket * 8 + hd] * LOG2E;
    }
    if (tid == 0) {
      float s1 = 0.f, s2 = 0.f;
      for (int i = 0; i < 64; ++i) { s1 += p.lq1[i] * p.lk1[i]; s2 += p.lq2[i] * p.lk2[i]; }
      p.lam[0] = expf(s1) - expf(s2) + 0.2f;
    }
  }
  prep_transpose(p.ffn1_wg, 1024, FFD, p.W1A, p.ffn1_norm, 1, lds);
  prep_transpose(p.ffn1_wu, 1024, FFD, p.W1A, p.ffn1_norm, 2, lds);
  prep_transpose(p.ffn1_wd, FFD, 1024, p.WD1, nullptr, 0, lds);
  prep_transpose(p.w_in, 1024, NIN, p.WIN, p.mix_norm, 0, lds);
  prep_transpose(p.w_attn, 1024, 1024, p.WATT, nullptr, 0, lds);
  prep_transpose(p.w_rw, 1024, 1024, p.WRW, nullptr, 0, lds);
  prep_transpose(p.w_out, 1024, 1024, p.WOUT, nullptr, 0, lds);
  prep_transpose(p.ffn2_wg, 1024, FFD, p.W2A, p.ffn2_norm, 1, lds);
  prep_transpose(p.ffn2_wu, 1024, FFD, p.W2A, p.ffn2_norm, 2, lds);
  prep_transpose(p.ffn2_wd, FFD, 1024, p.WD2, nullptr, 0, lds);
  prep_transpose(p.rw_w2, 64, 1024, p.W2F, nullptr, 0, lds);
  prep_transpose(p.rw_w2 + 64 * 1024, 64, 1024, p.W2B, nullptr, 0, lds);
  prep_transpose(p.rw_a2, 64, 1024, p.A2F, nullptr, 0, lds);
  prep_transpose(p.rw_a2 + 64 * 1024, 64, 1024, p.A2B, nullptr, 0, lds);
  prep_transpose(p.rw_g2, 128, 1024, p.G2T, nullptr, 0, lds);
}

__device__ void phase_rows(CP& p, const Grp& G) {
  const int lane = ltid() & 63;
  const int nw = gridDim.x * 4;
  for (int row = blockIdx.x * 4 + (ltid() >> 6); row < G.M; row += nw) {
    const int s = row / G.L, t = row - s * G.L;
    const float* src = t < 16 ? p.meta + t * 1024 : G.x + ((size_t)s * G.S + (t - 16)) * 1024;
    float ss = 0.f;
#pragma unroll
    for (int i = 0; i < 4; ++i) {
      const f32x4 v = *(const f32x4*)(src + i * 256 + lane * 4);
      ss += v.x * v.x + v.y * v.y + v.z * v.z + v.w * v.w;
      u32x2 o = {pk_bf16(v.x, v.y), pk_bf16(v.z, v.w)};
      *(u32x2*)(p.HB + (size_t)row * 1024 + i * 256 + lane * 4) = o;
    }
    ss = wave_sum(ss);
    if (lane == 0) { p.ss0[row] = ss; p.ss1[row] = 0.f; p.ss2[row] = 0.f; p.ss3[row] = 0.f; }
  }
}

#define LAS __attribute__((address_space(3)))
#define LAS __attribute__((address_space(3)))
#define LAS __attribute__((address_space(3)))
__device__ __forceinline__ void glds16(const void* gsrc, unsigned lds_dst) {
  unsigned keep;
  asm volatile("s_mov_b32 %0, m0\n\ts_mov_b32 m0, %2\n\ts_nop 0\n\tglobal_load_lds_dwordx4 %1, off\n\ts_mov_b32 m0, %0" : "=&s"(keep) : "v"(gsrc), "s"(lds_dst) : "memory");
}
__device__ __forceinline__ void gemm_kloop(f32x16 (&acc)[2][2], const u16* __restrict__ A, int lda, int M, int m0,
                                           const u16* __restrict__ W, int ldw, int n0, int K, char* lds) {
  const int tid = ltid(), lane = tid & 63, wave = tid >> 6;
  const int wn = wave & 1, wt = wave >> 1, l32 = lane & 31, h = lane >> 5;
  const u16* ap[2];
  const u16* wp[2];
#pragma unroll
  for (int i = 0; i < 2; ++i) {
    const int c = tid + 256 * i, row = c >> 2, ch = (c & 3) ^ ((row >> 2) & 3);
    int ar = m0 + row; ar = ar < M ? ar : M - 1;
    ap[i] = A + (size_t)ar * lda + ch * 8;
    wp[i] = W + (size_t)(n0 + row) * ldw + ch * 8;
  }
  int wro[2], wsw[2], aro[2], asw[2];
#pragma unroll
  for (int b = 0; b < 2; ++b) {
    const int wr = wn * 64 + b * 32 + l32, ar = wt * 64 + b * 32 + l32;
    wro[b] = wr * 64; wsw[b] = (wr >> 2) & 3;
    aro[b] = 8192 + ar * 64; asw[b] = (ar >> 2) & 3;
  }
  const int nk = K >> 5;
  const unsigned lds0 = __builtin_amdgcn_readfirstlane((unsigned)(uintptr_t)(LAS char*)lds + wave * 1024);
  auto stage = [&](int kt) {
    const unsigned sb = lds0 + (kt & 3) * 16384;
#pragma unroll
    for (int i = 0; i < 2; ++i) {
      glds16(wp[i] + kt * 32, sb + i * 4096);
      glds16(ap[i] + kt * 32, sb + 8192 + i * 4096);
    }
  };
  asm volatile("s_waitcnt vmcnt(0)" ::: "memory");
  __builtin_amdgcn_s_barrier();
#pragma unroll
  for (int s = 0; s < 3; ++s)
    if (s < nk) stage(s);
  for (int kt = 0; kt < nk; ++kt) {
    const int rem = nk - 1 - kt;
    if (rem >= 2) asm volatile("s_waitcnt vmcnt(8)" ::: "memory");
    else if (rem == 1) asm volatile("s_waitcnt vmcnt(4)" ::: "memory");
    else asm volatile("s_waitcnt vmcnt(0)" ::: "memory");
    __builtin_amdgcn_s_barrier();
    if (kt + 3 < nk) stage(kt + 3);
    const char* st = lds + (kt & 3) * 16384;
#pragma unroll
    for (int ks = 0; ks < 2; ++ks) {
      bf16x8 wf[2], af[2];
#pragma unroll
      for (int b = 0; b < 2; ++b) {
        wf[b] = *(const bf16x8*)(st + wro[b] + (((ks * 2 + h) ^ wsw[b]) << 4));
        af[b] = *(const bf16x8*)(st + aro[b] + (((ks * 2 + h) ^ asw[b]) << 4));
      }
#pragma unroll
      for (int nb = 0; nb < 2; ++nb)
#pragma unroll
        for (int tb = 0; tb < 2; ++tb)
          acc[nb][tb] = __builtin_amdgcn_mfma_f32_32x32x16_bf16(wf[nb], af[tb], acc[nb][tb], 0, 0, 0);
    }
  }
}

__device__ __forceinline__ void zero_acc(f32x16 (&acc)[2][2]) {
#pragma unroll
  for (int a = 0; a < 2; ++a)
#pragma unroll
    for (int b = 0; b < 2; ++b)
#pragma unroll
      for (int r = 0; r < 16; ++r) acc[a][b][r] = 0.f;
}

template <class F>
__device__ __forceinline__ void gemm_phase(const u16* A, int lda, int M, const u16* W, int K, int N, char* lds, F&& epi) {
  const int nN = N >> 7, nM = (M + 127) >> 7, nt = nN * nM;
  const int wave = ltid() >> 6;
  const int xcd = blockIdx.x & 7, g8 = gridDim.x >> 3;
  const int tq = nt >> 3, trm = nt & 7;
  const int tstart = xcd < trm ? xcd * (tq + 1) : trm * (tq + 1) + (xcd - trm) * tq;
  const int tcnt = tq + (xcd < trm ? 1 : 0);
  for (int off = blockIdx.x >> 3; off < tcnt; off += g8) {
    const int id = tstart + off, nig = 8 * nN, grp = id / nig, fm = grp * 8;
    const int gsz = (nM - fm) < 8 ? (nM - fm) : 8, idl = id - grp * nig;
    const int tm = fm + idl % gsz, tn = idl / gsz;
    f32x16 acc[2][2];
    zero_acc(acc);
    gemm_kloop(acc, A, lda, M, tm * 128, W, K, tn * 128, K, lds);
    epi(acc, tn * 128 + (wave & 1) * 64, tm * 128 + (wave >> 1) * 64);
  }
}

__device__ __forceinline__ void epi_swiglu(const f32x16 (&acc)[2][2], int nbase, int tbase, int M, const float* ss, u16* ACT) {
  const int lane = ltid() & 63, l32 = lane & 31, h = lane >> 5;
  const int cb = (nbase >> 6) * 32;
#pragma unroll
  for (int tb = 0; tb < 2; ++tb) {
    const int tok = tbase + tb * 32 + l32;
    if (tok < M) {
      const float rs = rsqrtf(ss[tok] * (1.f / 1024.f) + EPSN);
      u16* dst = ACT + (size_t)tok * FFD + cb + 4 * h;
#pragma unroll
      for (int i = 0; i < 4; ++i) {
        float o[4];
#pragma unroll
        for (int j = 0; j < 4; ++j) {
          const float g = acc[0][tb][4 * i + j] * rs, u = acc[1][tb][4 * i + j] * rs;
          o[j] = g * sigm(g) * u;
        }
        *(u32x2*)(dst + 8 * i) = (u32x2){pk_bf16(o[0], o[1]), pk_bf16(o[2], o[3])};
      }
    }
  }
}

template <int MODE>
__device__ __forceinline__ void epi_resid(const f32x16 (&acc)[2][2], int nbase, int tbase, CP& p, const Grp& G) {
  const int lane = ltid() & 63, l32 = lane & 31, h = lane >> 5;
  const float scale = MODE == 1 ? 1.f : 0.5f;
  float* ssout = MODE == 0 ? p.ss1 : (MODE == 1 ? p.ss2 : p.ss3);
#pragma unroll
  for (int tb = 0; tb < 2; ++tb) {
    const int tok = tbase + tb * 32 + l32;
    const bool valid = tok < G.M;
    float sq = 0.f;
    if (valid) {
      float* hp = p.H + (size_t)tok * 1024;
      const float* rp = hp;
      if (MODE == 0) {
        const int s = tok / G.L, t = tok - s * G.L;
        rp = t < 16 ? p.meta + t * 1024 : G.x + ((size_t)s * G.S + (t - 16)) * 1024;
      }
#pragma unroll
      for (int nb = 0; nb < 2; ++nb)
#pragma unroll
        for (int i = 0; i < 4; ++i) {
          const int n = nbase + nb * 32 + 8 * i + 4 * h;
          const f32x4 r = *(const f32x4*)(rp + n);
          f32x4 v;
          v.x = r.x + scale * acc[nb][tb][4 * i + 0];
          v.y = r.y + scale * acc[nb][tb][4 * i + 1];
          v.z = r.z + scale * acc[nb][tb][4 * i + 2];
          v.w = r.w + scale * acc[nb][tb][4 * i + 3];
          *(f32x4*)(hp + n) = v;
          sq += v.x * v.x + v.y * v.y + v.z * v.z + v.w * v.w;
          if (MODE != 2) *(u32x2*)(p.HB + (size_t)tok * 1024 + n) = (u32x2){pk_bf16(v.x, v.y), pk_bf16(v.z, v.w)};
        }
    }
    sq += __shfl_xor(sq, 32);
    if (valid && h == 0) atomicAdd(ssout + tok, sq);
  }
}

__device__ void phase_mix(CP& p, const Grp& G) {
  const int total = G.M * 432;
  for (int idx = blockIdx.x * 256 + ltid(); idx < total; idx += gridDim.x * 256) {
    const int row = idx / 432, ch = idx - row * 432;
    const int t = row % G.L;
    const int col = ch * 8;
    const u16* pc = p.P + (size_t)row * NIN + 3072 + col;
    const u32x4 c = *(const u32x4*)pc;
    u32x4 pv = {0, 0, 0, 0}, nx = {0, 0, 0, 0};
    if (t > 0) pv = *(const u32x4*)(pc - NIN);
    if (t < G.L - 1) nx = *(const u32x4*)(pc + NIN);
    const f32x4 mp0 = *(const f32x4*)(p.mu_prev + col), mp1 = *(const f32x4*)(p.mu_prev + col + 4);
    const f32x4 mn0 = *(const f32x4*)(p.mu_next + col), mn1 = *(const f32x4*)(p.mu_next + col + 4);
    float o[8];
#pragma unroll
    for (int e = 0; e < 4; ++e) {
      const float c0 = bf_lo(c[e]), c1 = bf_hi(c[e]);
      const float mpa = e < 2 ? mp0[2 * e] : mp1[2 * e - 4], mpb = e < 2 ? mp0[2 * e + 1] : mp1[2 * e - 3];
      const float mna = e < 2 ? mn0[2 * e] : mn1[2 * e - 4], mnb = e < 2 ? mn0[2 * e + 1] : mn1[2 * e - 3];
      o[2 * e] = c0 + mpa * (bf_lo(pv[e]) - c0) + mna * (bf_lo(nx[e]) - c0);
      o[2 * e + 1] = c1 + mpb * (bf_hi(pv[e]) - c1) + mnb * (bf_hi(nx[e]) - c1);
    }
    if (col < 3072) {
      const int sec = col >> 10, ci = col & 1023, head = ci >> 6, c0 = ci & 63;
      const size_t ro = ((size_t)row * 16 + head) * 192 + sec * 64 + c0;
      const u32x4 pk = (u32x4){pk_f16(o[0], o[1]), pk_f16(o[2], o[3]), pk_f16(o[4], o[5]), pk_f16(o[6], o[7])};
      *(u32x4*)(p.RKV + ro) = pk;
      if (sec == 1) { *(u32x4*)(p.DIR0 + ro) = pk; *(u32x4*)(p.DIR1 + ro) = pk; }
    } else {
      const int fc = col - 3072;
      if (fc < 128) {
#pragma unroll
        for (int e = 0; e < 8; ++e) o[e] = 1.f - 2.f / (1.f + __expf(2.f * o[e]));
      } else if (fc >= 256) {
#pragma unroll
        for (int e = 0; e < 8; ++e) o[e] = sigm(o[e]);
      }
      *(u32x4*)(p.F + (size_t)row * 384 + fc) = (u32x4){pk_bf16(o[0], o[1]), pk_bf16(o[2], o[3]), pk_bf16(o[4], o[5]), pk_bf16(o[6], o[7])};
    }
  }
}

__device__ __forceinline__ void epi_decay(const f32x16 (&acc)[2][2], int nbase, int tbase, int M, const float* w0, u16* DIR) {
  const int lane = ltid() & 63, l32 = lane & 31, h = lane >> 5;
  const int head = nbase >> 6;
#pragma unroll
  for (int tb = 0; tb < 2; ++tb) {
    const int tok = tbase + tb * 32 + l32;
    if (tok < M) {
      u16* dst = DIR + ((size_t)tok * 16 + head) * 192;
#pragma unroll
      for (int nb = 0; nb < 2; ++nb)
#pragma unroll
        for (int i = 0; i < 4; ++i) {
          const int c = nb * 32 + 8 * i + 4 * h;
          const f32x4 w = *(const f32x4*)(w0 + nbase + c);
          float o[4];
#pragma unroll
          for (int j = 0; j < 4; ++j) o[j] = 0.6065306597126334f * sigm(w[j] + acc[nb][tb][4 * i + j]);
          *(u32x2*)(dst + c) = (u32x2){pk_f16(o[0], o[1]), pk_f16(o[2], o[3])};
        }
    }
  }
}

__device__ __forceinline__ void epi_adir(const f32x16 (&acc)[2][2], int nbase, int tbase, int M, CP& p, int dir) {
  const int lane = ltid() & 63, l32 = lane & 31, h = lane >> 5;
  const int head = nbase >> 6;
  u16* DIR = dir ? p.DIR1 : p.DIR0;
  const float* a0 = p.rw_a0 + dir * 1024;
#pragma unroll
  for (int tb = 0; tb < 2; ++tb) {
    const int tok = tbase + tb * 32 + l32;
    const bool valid = tok < M;
    const int tk = valid ? tok : M - 1;
    const size_t rec = ((size_t)tk * 16 + head) * 192;
    float nsq = 0.f;
#pragma unroll
    for (int nb = 0; nb < 2; ++nb)
#pragma unroll
      for (int i = 0; i < 4; ++i) {
        const int c = nb * 32 + 8 * i + 4 * h;
        const u32x2 kr = *(const u32x2*)(DIR + rec + 64 + c);
        const f32x4 kkw = *(const f32x4*)(p.k_k + nbase + c);
        const float q0 = h_lo(kr.x) * kkw[0], q1 = h_hi(kr.x) * kkw[1], q2 = h_lo(kr.y) * kkw[2], q3 = h_hi(kr.y) * kkw[3];
        nsq += q0 * q0 + q1 * q1 + q2 * q2 + q3 * q3;
      }
    nsq += __shfl_xor(nsq, 32);
    const float inv = 1.f / fmaxf(sqrtf(nsq), 1e-12f);
    if (valid) {
#pragma unroll
      for (int nb = 0; nb < 2; ++nb)
#pragma unroll
        for (int i = 0; i < 4; ++i) {
          const int c = nb * 32 + 8 * i + 4 * h;
          const u32x2 kr = *(const u32x2*)(DIR + rec + 64 + c);
          const float kv[4] = {h_lo(kr.x), h_hi(kr.x), h_lo(kr.y), h_hi(kr.y)};
          const f32x4 kkw = *(const f32x4*)(p.k_k + nbase + c);
          const f32x4 kaw = *(const f32x4*)(p.k_a + nbase + c);
          const f32x4 a0v = *(const f32x4*)(a0 + nbase + c);
          float kk[4], kd[4], bp[4];
#pragma unroll
          for (int j = 0; j < 4; ++j) {
            const float k = kv[j];
            kk[j] = k * kkw[j] * inv;
            const float aa = sigm(a0v[j] + acc[nb][tb][4 * i + j]);
            kd[j] = k * (1.f + (aa - 1.f) * kaw[j]);
            bp[j] = -kk[j] * aa;
          }
          if (dir == 0) *(u32x2*)(p.RKV + rec + 64 + c) = (u32x2){pk_f16(kk[0], kk[1]), pk_f16(kk[2], kk[3])};
          *(u32x2*)(DIR + rec + 64 + c) = (u32x2){pk_f16(kd[0], kd[1]), pk_f16(kd[2], kd[3])};
          *(u32x2*)(DIR + rec + 128 + c) = (u32x2){pk_f16(bp[0], bp[1]), pk_f16(bp[2], bp[3])};
        }
    }
  }
}

__device__ void scan_task(CP& p, const Grp& G, int task, char* lds) {
  const int half = task & 1, dir = (task >> 1) & 1, head = (task >> 2) & 15, s = task >> 6;
  float* buf = (float*)lds;
  const u16* rkv = p.RKV;
  const u16* dr = dir ? p.DIR1 : p.DIR0;
  u16* Y = dir ? p.Y1 : p.Y0;
  const int tid = ltid();
  const int row = half * 32 + (tid >> 3), kc = tid & 7;
  const int L = G.L, nch = L >> 4;
  u32x4 pre[3];
  auto issue = [&](int c) {
#pragma unroll
    for (int i = 0; i < 3; ++i) {
      const int id = tid + 256 * i, st = id / 48, ci = id - st * 48;
      const int n = c * 16 + st, t = dir ? L - 1 - n : n;
      const size_t rec = ((size_t)(s * L + t) * 16 + head) * 192;
      const u16* src = ci < 24 ? rkv + rec + ci * 8 : dr + rec + (ci - 24) * 8;
      pre[i] = *(const u32x4*)src;
    }
  };
  auto commit = [&](int b) {
#pragma unroll
    for (int i = 0; i < 3; ++i) {
      const int id = tid + 256 * i, st = id / 48, ci = id - st * 48;
      const int sec = ci >> 3;
      const int base = sec >= 3 ? (sec - 1) * 64 : (sec == 0 ? 64 : (sec == 1 ? 0 : 320));
      float f[8];
#pragma unroll
      for (int e = 0; e < 4; ++e) { f[2 * e] = h_lo(pre[i][e]); f[2 * e + 1] = h_hi(pre[i][e]); }
      if (sec == 3) {
#pragma unroll
        for (int e = 0; e < 8; ++e) f[e] = __expf(-f[e]);
      }
      float* d = buf + b * 6144 + st * 384 + base + (ci & 7) * 8;
      *(f32x4*)d = (f32x4){f[0], f[1], f[2], f[3]};
      *(f32x4*)(d + 4) = (f32x4){f[4], f[5], f[6], f[7]};
    }
  };
  float S[8];
#pragma unroll
  for (int i = 0; i < 8; ++i) S[i] = 0.f;
  __syncthreads();
  issue(0);
  commit(0);
  __syncthreads();
  for (int c = 0; c < nch; ++c) {
    if (c + 1 < nch) issue(c + 1);
    const float* b = buf + (c & 1) * 6144;
#pragma unroll 4
    for (int st = 0; st < 16; ++st) {
      const float* q = b + st * 384 + kc * 8;
      const f32x4 kk0 = *(const f32x4*)(q), kk1 = *(const f32x4*)(q + 4);
      const f32x4 r0 = *(const f32x4*)(q + 64), r1 = *(const f32x4*)(q + 68);
      const f32x4 w0 = *(const f32x4*)(q + 128), w1 = *(const f32x4*)(q + 132);
      const f32x4 d0 = *(const f32x4*)(q + 192), d1 = *(const f32x4*)(q + 196);
      const f32x4 b0 = *(const f32x4*)(q + 256), b1 = *(const f32x4*)(q + 260);
      const float vv = b[st * 384 + 320 + row];
      float sa = 0.f;
#pragma unroll
      for (int i = 0; i < 4; ++i) { sa += S[i] * kk0[i]; sa += S[4 + i] * kk1[i]; }
      sa = reduce8(sa);
      float y = 0.f;
#pragma unroll
      for (int i = 0; i < 4; ++i) {
        S[i] = S[i] * w0[i] + (sa * b0[i] + vv * d0[i]);
        S[4 + i] = S[4 + i] * w1[i] + (sa * b1[i] + vv * d1[i]);
        y += S[i] * r0[i];
        y += S[4 + i] * r1[i];
      }
      y = reduce8(y);
      if (kc == 0) {
        const int n = c * 16 + st, t = dir ? L - 1 - n : n;
        Y[(size_t)(s * L + t) * 1024 + head * 64 + row] = bf16_1(y);
      }
    }
    if (c + 1 < nch) commit((c + 1) & 1);
    __syncthreads();
  }
}

__device__ void attn_tile(CP& p, const Grp& G, int s, int hd, int qb, char* lds, float lam) {
  const int tid = ltid(), lane = tid & 63, wave = tid >> 6, l32 = lane & 31, h = lane >> 5;
  const int L = G.L;
  const u16* Pb = p.P + (size_t)s * L * NIN;
  float* lutl = (float*)(lds + 24576);
  char* qfl = lds + 26624 + tid * 16;
  __syncthreads();
  for (int i = tid; i < 511; i += 256) lutl[i] = p.lut[hd * 512 + i];
  const int q = qb * 128 + wave * 32 + l32;
  const int qc = q < L ? q : L - 1;
  const int qw0 = qb * 128 + wave * 32;
  u16* odst = p.O + (size_t)(s * L + qc) * 1024 + hd * 128;
  const int kkey = tid >> 3, kch = tid & 7;
  const int kldo = kkey * 128 + ((kch ^ ((kkey >> 1) & 7)) << 4);
  int vkey[2], vdvc[2], vwo0[2], vwo1[2];
#pragma unroll
  for (int i = 0; i < 2; ++i) {
    const int c = tid + 256 * i;
    vkey[i] = (c & 15) + 16 * ((c >> 6) & 1);
    vdvc[i] = ((c >> 4) & 3) + 4 * (c >> 7);
    const int key = vkey[i];
    const int pos = (key & 16) | ((key & 4) << 1) | ((key & 8) >> 1) | (key & 3);
    const int chunk = pos >> 3, inb = (pos & 7) * 2;
    vwo0[i] = vdvc[i] * 512 + ((chunk ^ ((2 * vdvc[i]) & 3)) << 4) + inb;
    vwo1[i] = vdvc[i] * 512 + ((chunk ^ ((2 * vdvc[i] + 1) & 3)) << 4) + inb;
  }
  const int ntile = (L + 31) >> 5;
#pragma unroll 1
  for (int br = 0; br < 2; ++br) {
#pragma unroll
    for (int ks = 0; ks < 4; ++ks) {
      const u32x4 raw = *(const u32x4*)(Pb + (size_t)qc * NIN + hd * 128 + br * 64 + ks * 16 + h * 8);
      u32x4 sc;
#pragma unroll
      for (int e = 0; e < 4; ++e) sc[e] = pk_bf16(bf_lo(raw[e]) * 0.125f, bf_hi(raw[e]) * 0.125f);
      *(u32x4*)(qfl + ks * 4096) = sc;
    }
    const u16* kp = Pb + 1024 + hd * 128 + br * 64 + kch * 8;
    u32x4 rk, rv[2];
    auto issue = [&](int kt0) {
      int kr = kt0 + kkey; kr = kr < L ? kr : L - 1;
      rk = *(const u32x4*)(kp + (size_t)kr * NIN);
#pragma unroll
      for (int i = 0; i < 2; ++i) {
        int vr = kt0 + vkey[i]; vr = vr < L ? vr : L - 1;
        rv[i] = *(const u32x4*)(Pb + (size_t)vr * NIN + 2048 + hd * 128 + vdvc[i] * 8);
      }
    };
    auto commit = [&](int b) {
      char* st = lds + b * 12288;
      *(u32x4*)(st + kldo) = rk;
#pragma unroll
      for (int i = 0; i < 2; ++i) {
        char* vb = st + 4096;
#pragma unroll
        for (int e = 0; e < 8; ++e) {
          const unsigned wv = rv[i][e >> 1];
          const u16 val = (e & 1) ? (u16)(wv >> 16) : (u16)(wv & 0xffffu);
          *(u16*)(vb + (e < 4 ? vwo0[i] : vwo1[i]) + e * 64) = val;
        }
      }
    };
    f32x16 O[4];
#pragma unroll
    for (int mb = 0; mb < 4; ++mb)
#pragma unroll
      for (int r = 0; r < 16; ++r) O[mb][r] = 0.f;
    float mrun = -1e30f, lrun = 0.f;
    issue(0);
    commit(0);
    __syncthreads();
    const float cneg = lutl[0], cpos = lutl[510];
    for (int kt = 0; kt < ntile; ++kt) {
      const int kt0 = kt * 32;
      if (kt + 1 < ntile) issue(kt0 + 32);
      const char* st = lds + (kt & 1) * 12288;
      f32x16 sacc;
#pragma unroll
      for (int r = 0; r < 16; ++r) sacc[r] = 0.f;
#pragma unroll
      for (int ks = 0; ks < 4; ++ks) {
        const bf16x8 kf = *(const bf16x8*)(st + l32 * 128 + (((ks * 2 + h) ^ ((l32 >> 1) & 7)) << 4));
        const bf16x8 qv = *(const bf16x8*)(qfl + ks * 4096);
        sacc = __builtin_amdgcn_mfma_f32_32x32x16_bf16(kf, qv, sacc, 0, 0, 0);
      }
      const bool farneg = (kt0 + 31) <= (qw0 - 128);
      const bool farpos = kt0 >= (qw0 + 31 + 128);
      float mx = -1e30f;
      if (farneg || farpos) {
        const float cv = farneg ? cneg : cpos;
#pragma unroll
        for (int r = 0; r < 16; ++r) { sacc[r] = sacc[r] * LOG2E + cv; }
      } else {
#pragma unroll
        for (int r = 0; r < 16; ++r) {
          const int key = kt0 + 8 * (r >> 2) + 4 * h + (r & 3);
          int d = key - q + 255;
          d = d < 0 ? 0 : (d > 510 ? 510 : d);
          sacc[r] = sacc[r] * LOG2E + lutl[d];
        }
      }
      if (kt0 + 32 > L) {
#pragma unroll
        for (int r = 0; r < 16; ++r) {
          const int key = kt0 + 8 * (r >> 2) + 4 * h + (r & 3);
          if (key >= L) sacc[r] = -INFINITY;
        }
      }
#pragma unroll
      for (int r = 0; r < 16; ++r) mx = fmaxf(mx, sacc[r]);
      mx = fmaxf(mx, __shfl_xor(mx, 32));
      const float mnew = fmaxf(mrun, mx);
      const float alpha = __builtin_amdgcn_exp2f(mrun - mnew);
      mrun = mnew;
      float ps = 0.f;
#pragma unroll
      for (int r = 0; r < 16; ++r) { sacc[r] = __builtin_amdgcn_exp2f(sacc[r] - mnew); ps += sacc[r]; }
      lrun = lrun * alpha + ps;
      if (__any(alpha != 1.f)) {
#pragma unroll
        for (int mb = 0; mb < 4; ++mb)
#pragma unroll
          for (int r = 0; r < 16; ++r) O[mb][r] *= alpha;
      }
      bf16x8 pf[2];
#pragma unroll
      for (int s2 = 0; s2 < 2; ++s2) {
        u32x4 w;
#pragma unroll
        for (int e = 0; e < 4; ++e) w[e] = pk_bf16(sacc[8 * s2 + 2 * e], sacc[8 * s2 + 2 * e + 1]);
        pf[s2] = __builtin_bit_cast(bf16x8, w);
      }
#pragma unroll
      for (int mb = 0; mb < 4; ++mb)
#pragma unroll
        for (int s2 = 0; s2 < 2; ++s2) {
          const int vr = mb * 32 + l32;
          const bf16x8 vf = *(const bf16x8*)(st + 4096 + vr * 64 + (((2 * s2 + h) ^ ((vr >> 2) & 3)) << 4));
          O[mb] = __builtin_amdgcn_mfma_f32_32x32x16_bf16(vf, pf[s2], O[mb], 0, 0, 0);
          if (s2 == 1 && (mb & 1)) __builtin_amdgcn_sched_barrier(0);
        }
      if (kt + 1 < ntile) commit((kt + 1) & 1);
      __syncthreads();
    }
    const float lt = lrun + __shfl_xor(lrun, 32);
    if (br == 0) {
      const float i1 = 1.f / lt;
#pragma unroll
      for (int mb = 0; mb < 4; ++mb)
#pragma unroll
        for (int i = 0; i < 4; ++i)
          if (q < L) *(u32x2*)(odst + mb * 32 + 8 * i + 4 * h) = (u32x2){pk_bf16(O[mb][4 * i] * i1, O[mb][4 * i + 1] * i1), pk_bf16(O[mb][4 * i + 2] * i1, O[mb][4 * i + 3] * i1)};
    } else {
      const float i2 = lam / lt;
      float ssq = 0.f;
#pragma unroll
      for (int mb = 0; mb < 4; ++mb)
#pragma unroll
        for (int i = 0; i < 4; ++i) {
          u32x2 w = {0, 0};
          if (q < L) w = *(const u32x2*)(odst + mb * 32 + 8 * i + 4 * h);
          const float o0 = bf_lo(w.x) - O[mb][4 * i] * i2, o1v = bf_hi(w.x) - O[mb][4 * i + 1] * i2, o2 = bf_lo(w.y) - O[mb][4 * i + 2] * i2, o3 = bf_hi(w.y) - O[mb][4 * i + 3] * i2;
          O[mb][4 * i] = o0; O[mb][4 * i + 1] = o1v; O[mb][4 * i + 2] = o2; O[mb][4 * i + 3] = o3;
          ssq += o0 * o0 + o1v * o1v + o2 * o2 + o3 * o3;
        }
      ssq += __shfl_xor(ssq, 32);
      const float rn = rsqrtf(ssq * (1.f / 128.f) + EPSN) * 0.8f;
      if (q < L) {
        u16* dst = p.O + (size_t)(s * L + q) * 1024 + hd * 128;
#pragma unroll
        for (int mb = 0; mb < 4; ++mb)
#pragma unroll
          for (int i = 0; i < 4; ++i) {
            const int dv = mb * 32 + 8 * i + 4 * h;
            const f32x4 g = *(const f32x4*)(p.subln + dv);
            *(u32x2*)(dst + dv) = (u32x2){pk_bf16(O[mb][4 * i] * rn * g.x, O[mb][4 * i + 1] * rn * g.y),
                                          pk_bf16(O[mb][4 * i + 2] * rn * g.z, O[mb][4 * i + 3] * rn * g.w)};
          }
      }
    }
  }
}

__device__ void phase_mixer(CP& p, const Grp& G, int g, char* lds) {
  const int nscan = G.nseq * 64;
  for (int t = blockIdx.x; t < nscan; t += gridDim.x) scan_task(p, G, t, lds);
  const int nqb = (G.L + 127) >> 7;
  const int natt = G.nseq * 8 * nqb;
  const float lam = p.lam[0];
  int* shw = (int*)(lds + 65536 - 16);
  while (true) {
    __syncthreads();
    if (ltid() == 0) *shw = atomicAdd(p.cnt + g, 1);
    __syncthreads();
    const int t = *shw;
    if (t >= natt) break;
    const int qb = t % nqb, r = t / nqb, hd = r & 7, s = r >> 3;
    attn_tile(p, G, s, hd, qb, lds, lam);
  }
}

__device__ void phase_post(CP& p, const Grp& G) {
  const int lane = ltid() & 63;
  const int nw = gridDim.x * 4;
  const int c0 = lane * 16, head = lane >> 2, hc = (lane & 3) * 16;
  for (int row = blockIdx.x * 4 + (ltid() >> 6); row < G.M; row += nw) {
    float y[16];
    {
      const u32x4 a0 = *(const u32x4*)(p.Y0 + (size_t)row * 1024 + c0), a1 = *(const u32x4*)(p.Y0 + (size_t)row * 1024 + c0 + 8);
      const u32x4 b0 = *(const u32x4*)(p.Y1 + (size_t)row * 1024 + c0), b1 = *(const u32x4*)(p.Y1 + (size_t)row * 1024 + c0 + 8);
#pragma unroll
      for (int e = 0; e < 4; ++e) {
        y[2 * e] = bf_lo(a0[e]) + bf_lo(b0[e]); y[2 * e + 1] = bf_hi(a0[e]) + bf_hi(b0[e]);
        y[8 + 2 * e] = bf_lo(a1[e]) + bf_lo(b1[e]); y[8 + 2 * e + 1] = bf_hi(a1[e]) + bf_hi(b1[e]);
      }
    }
    float s1 = 0.f;
#pragma unroll
    for (int e = 0; e < 16; ++e) s1 += y[e];
    s1 = reduce4(s1);
    const float mu = s1 * (1.f / 64.f);
    float s2 = 0.f;
#pragma unroll
    for (int e = 0; e < 16; ++e) { const float d = y[e] - mu; s2 += d * d; }
    s2 = reduce4(s2);
    const float rstd = rsqrtf(s2 * (1.f / 64.f) + 64e-5f);
    const size_t rec = ((size_t)row * 16 + head) * 192 + hc;
    float rr[16], vv[16], kd[16];
    {
      const u32x4 r0 = *(const u32x4*)(p.RKV + rec), r1 = *(const u32x4*)(p.RKV + rec + 8);
      const u32x4 v0 = *(const u32x4*)(p.RKV + rec + 128), v1 = *(const u32x4*)(p.RKV + rec + 136);
      const u32x4 f0 = *(const u32x4*)(p.DIR0 + rec + 64), f1 = *(const u32x4*)(p.DIR0 + rec + 72);
      const u32x4 g0 = *(const u32x4*)(p.DIR1 + rec + 64), g1 = *(const u32x4*)(p.DIR1 + rec + 72);
#pragma unroll
      for (int e = 0; e < 4; ++e) {
        rr[2 * e] = h_lo(r0[e]); rr[2 * e + 1] = h_hi(r0[e]); rr[8 + 2 * e] = h_lo(r1[e]); rr[8 + 2 * e + 1] = h_hi(r1[e]);
        vv[2 * e] = h_lo(v0[e]); vv[2 * e + 1] = h_hi(v0[e]); vv[8 + 2 * e] = h_lo(v1[e]); vv[8 + 2 * e + 1] = h_hi(v1[e]);
        kd[2 * e] = h_lo(f0[e]) + h_lo(g0[e]); kd[2 * e + 1] = h_hi(f0[e]) + h_hi(g0[e]);
        kd[8 + 2 * e] = h_lo(f1[e]) + h_lo(g1[e]); kd[8 + 2 * e + 1] = h_hi(f1[e]) + h_hi(g1[e]);
      }
    }
    float bs = 0.f;
#pragma unroll
    for (int e = 0; e < 16; ++e) bs += rr[e] * kd[e] * p.r_k[c0 + e];
    bs = reduce4(bs);
    const u32x4 g0 = *(const u32x4*)(p.G + (size_t)row * 1024 + c0), g1 = *(const u32x4*)(p.G + (size_t)row * 1024 + c0 + 8);
    float o[16];
#pragma unroll
    for (int e = 0; e < 16; ++e) {
      const unsigned gw = e < 8 ? g0[e >> 1] : g1[(e - 8) >> 1];
      const float gg = (e & 1) ? bf_hi(gw) : bf_lo(gw);
      o[e] = ((y[e] - mu) * rstd * p.lnx_w[c0 + e] + p.lnx_b[c0 + e] + bs * vv[e]) * gg;
    }
    u16* dst = p.HB + (size_t)row * 1024 + c0;
    *(u32x4*)dst = (u32x4){pk_bf16(o[0], o[1]), pk_bf16(o[2], o[3]), pk_bf16(o[4], o[5]), pk_bf16(o[6], o[7])};
    *(u32x4*)(dst + 8) = (u32x4){pk_bf16(o[8], o[9]), pk_bf16(o[10], o[11]), pk_bf16(o[12], o[13]), pk_bf16(o[14], o[15])};
  }
}

__device__ void phase_final(CP& p, const Grp& G) {
  const int lane = ltid() & 63;
  const int nw = gridDim.x * 4;
  for (int row = blockIdx.x * 4 + (ltid() >> 6); row < G.M; row += nw) {
    const int s = row / G.L, t = row - s * G.L;
    if (t < 16) continue;
    const float rs = rsqrtf(p.ss3[row] * (1.f / 1024.f) + EPSN);
    const float* hp = p.H + (size_t)row * 1024;
    float* op = G.out + ((size_t)s * G.S + (t - 16)) * 1024;
#pragma unroll
    for (int i = 0; i < 4; ++i) {
      const f32x4 v = *(const f32x4*)(hp + i * 256 + lane * 4);
      const f32x4 g = *(const f32x4*)(p.final_norm + i * 256 + lane * 4);
      *(f32x4*)(op + i * 256 + lane * 4) = (f32x4){v.x * rs * g.x, v.y * rs * g.y, v.z * rs * g.z, v.w * rs * g.w};
    }
  }
}


#define XB_TMO      128
#define XB_XCNT(j)  (256  + 64 * (j))
#define XB_XSUB(j)  (1280 + 64 * (j))
#define XB_XGEN(j)  (2304 + 64 * (j))
#define XB_TOP      3328
#define XB_TOPGEN   3392
#define XCD_BAR_WORDS 3456
#define XB_SPIN_CAP (1u << 18)
__device__ __forceinline__ unsigned xb_ld(unsigned* p) { return __hip_atomic_load(p, __ATOMIC_RELAXED, __HIP_MEMORY_SCOPE_AGENT); }
__device__ __forceinline__ unsigned xb_add(unsigned* p, unsigned v) { return __hip_atomic_fetch_add(p, v, __ATOMIC_RELAXED, __HIP_MEMORY_SCOPE_AGENT); }
__device__ __forceinline__ unsigned xb_xcc_id() { return (unsigned)__builtin_amdgcn_s_getreg((3 << 11) | 20) & 0xFu; }
#define XB_SPIN(cond, bar) do { unsigned _sp = 0; while (cond) { __builtin_amdgcn_s_sleep(1); \
    if ((++_sp & 255u) == 0u) { if (xb_ld(&(bar)[XB_TMO])) break; if (_sp > XB_SPIN_CAP) { atomicAdd(&(bar)[XB_TMO], 1u); break; } } } } while (0)
struct XcdBarrier { unsigned* bar; unsigned x; volatile LAS unsigned* st; };
__device__ __forceinline__ XcdBarrier xcd_barrier_post(unsigned* bar, volatile LAS unsigned* st) {
  XcdBarrier b; b.bar = bar; b.x = xb_xcc_id(); b.st = st;
  if (threadIdx.x == 0) (void)xb_add(&bar[XB_XCNT(b.x)], 1u);
  return b;
}
__device__ __forceinline__ void xcd_barrier_complete(unsigned* bar, unsigned x, unsigned& nloc, unsigned& nx) {
  const unsigned G = gridDim.x * gridDim.y * gridDim.z;
  unsigned sum, cnt, mine, sp = 0u;
  for (;;) {
    sum = 0u; cnt = 0u; mine = 0u;
#pragma unroll
    for (unsigned j = 0; j < 16; ++j) { const unsigned c = xb_ld(&bar[XB_XCNT(j)]); sum += c; cnt += (c > 0u) ? 1u : 0u; mine = (j == x) ? c : mine; }
    if (sum == G) break;
    __builtin_amdgcn_s_sleep(1);
    if ((++sp & 255u) == 0u) { if (xb_ld(&bar[XB_TMO])) break; if (sp > XB_SPIN_CAP) { atomicAdd(&bar[XB_TMO], 1u); break; } }
  }
  nloc = mine > 0u ? mine : 1u; nx = cnt > 0u ? cnt : 1u;
}
__device__ __forceinline__ void xcd_barrier(const XcdBarrier& b) {
  asm volatile("s_waitcnt vmcnt(0)" ::: "memory");
  __syncthreads();
  if (threadIdx.x == 0) {
    unsigned* bar = b.bar;
    __builtin_amdgcn_s_waitcnt(0);
    unsigned nloc = b.st[0], nx = b.st[1];
    if (nloc == 0u) { xcd_barrier_complete(bar, b.x, nloc, nx); b.st[0] = nloc; b.st[1] = nx; }
    const unsigned old = xb_add(&bar[XB_XSUB(b.x)], 1u);
    const unsigned gen = old / nloc;
    if (old + 1u == (gen + 1u) * nloc) {
      __builtin_amdgcn_fence(__ATOMIC_RELEASE, "agent");
      asm volatile("s_waitcnt vmcnt(0)" ::: "memory");
      const unsigned og = xb_add(&bar[XB_TOP], 1u);
      const unsigned tg = og / nx;
      if (og + 1u == (tg + 1u) * nx) xb_add(&bar[XB_TOPGEN], 1u);
      else XB_SPIN(xb_ld(&bar[XB_TOPGEN]) == tg, bar);
      __builtin_amdgcn_fence(__ATOMIC_ACQUIRE, "agent");
      xb_add(&bar[XB_XGEN(b.x)], 1u);
      asm volatile("s_waitcnt vmcnt(0)" ::: "memory");
    } else {
      XB_SPIN(xb_ld(&bar[XB_XGEN(b.x)]) == gen, bar);
      __builtin_amdgcn_fence(__ATOMIC_ACQUIRE, "agent");
      asm volatile("s_waitcnt vmcnt(0)" ::: "memory");
    }
  }
  __syncthreads();
}

__device__ void run_phase(CP& p, int ph, char* lds) {
  if (ph == 0) { phase_prep(p, lds); return; }
  const int g = (ph - 1) / PH_PER_G, k = (ph - 1) - g * PH_PER_G;
  const Grp G = get_grp(p, g);
  const int M = G.M;
  switch (k) {
    case 0: phase_rows(p, G); break;
    case 1:
      gemm_phase(p.HB, 1024, M, p.W1A, 1024, 2 * FFD, lds, [&](const f32x16 (&acc)[2][2], int nb, int tb) { epi_swiglu(acc, nb, tb, M, p.ss0, p.ACT); });
      break;
    case 2:
      gemm_phase(p.ACT, FFD, M, p.WD1, FFD, 1024, lds, [&](const f32x16 (&acc)[2][2], int nb, int tb) { epi_resid<0>(acc, nb, tb, p, G); });
      break;
    case 3:
      gemm_phase(p.HB, 1024, M, p.WIN, 1024, NIN, lds, [&](const f32x16 (&acc)[2][2], int nbase, int tbase) {
        const int lane = ltid() & 63, l32 = lane & 31, h = lane >> 5;
#pragma unroll
        for (int tb = 0; tb < 2; ++tb) {
          const int tok = tbase + tb * 32 + l32;
          if (tok < M) {
            const float rs = rsqrtf(p.ss1[tok] * (1.f / 1024.f) + EPSN);
            u16* dst = p.P + (size_t)tok * NIN + nbase + 4 * h;
#pragma unroll
            for (int nb = 0; nb < 2; ++nb)
#pragma unroll
              for (int i = 0; i < 4; ++i)
                *(u32x2*)(dst + nb * 32 + 8 * i) = (u32x2){pk_bf16(acc[nb][tb][4 * i] * rs, acc[nb][tb][4 * i + 1] * rs),
                                                           pk_bf16(acc[nb][tb][4 * i + 2] * rs, acc[nb][tb][4 * i + 3] * rs)};
          }
        }
      });
      break;
    case 4: phase_mix(p, G); break;
    case 5:
      gemm_phase(p.F, 384, M, p.W2F, 64, 1024, lds, [&](const f32x16 (&acc)[2][2], int nb, int tb) { epi_decay(acc, nb, tb, M, p.rw_w0, p.DIR0); });
      gemm_phase(p.F + 64, 384, M, p.W2B, 64, 1024, lds, [&](const f32x16 (&acc)[2][2], int nb, int tb) { epi_decay(acc, nb, tb, M, p.rw_w0 + 1024, p.DIR1); });
      gemm_phase(p.F + 128, 384, M, p.A2F, 64, 1024, lds, [&](const f32x16 (&acc)[2][2], int nb, int tb) { epi_adir(acc, nb, tb, M, p, 0); });
      gemm_phase(p.F + 192, 384, M, p.A2B, 64, 1024, lds, [&](const f32x16 (&acc)[2][2], int nb, int tb) { epi_adir(acc, nb, tb, M, p, 1); });
      gemm_phase(p.F + 256, 384, M, p.G2T, 128, 1024, lds, [&](const f32x16 (&acc)[2][2], int nbase, int tbase) {
        const int lane = ltid() & 63, l32 = lane & 31, h = lane >> 5;
#pragma unroll
        for (int tb = 0; tb < 2; ++tb) {
          const int tok = tbase + tb * 32 + l32;
          if (tok < M) {
            u16* dst = p.G + (size_t)tok * 1024 + nbase + 4 * h;
#pragma unroll
            for (int nb = 0; nb < 2; ++nb)
#pragma unroll
              for (int i = 0; i < 4; ++i)
                *(u32x2*)(dst + nb * 32 + 8 * i) = (u32x2){pk_bf16(acc[nb][tb][4 * i], acc[nb][tb][4 * i + 1]), pk_bf16(acc[nb][tb][4 * i + 2], acc[nb][tb][4 * i + 3])};
          }
        }
      });
      break;
    case 6: phase_mixer(p, G, g, lds); break;
    case 7: phase_post(p, G); break;
    case 8: {
      const int nN = 8, nM = (M + 127) >> 7, nt = nN * nM;
      const int wave = ltid() >> 6;
      const int lane = ltid() & 63, l32 = lane & 31, h = lane >> 5;
      const int xcd = blockIdx.x & 7, g8 = gridDim.x >> 3;
      const int tq = nt >> 3, trm = nt & 7;
      const int tstart = xcd < trm ? xcd * (tq + 1) : trm * (tq + 1) + (xcd - trm) * tq;
      const int tcnt = tq + (xcd < trm ? 1 : 0);
      for (int off = blockIdx.x >> 3; off < tcnt; off += g8) {
        const int id = tstart + off, nig = 8 * nN, grp = id / nig, fm = grp * 8;
        const int gsz = (nM - fm) < 8 ? (nM - fm) : 8, idl = id - grp * nig;
        const int tm = fm + idl % gsz, tn = idl / gsz;
        const int nbase = tn * 128 + (wave & 1) * 64, tbase = tm * 128 + (wave >> 1) * 64;
#pragma unroll 1
        for (int pass = 0; pass < 2; ++pass) {
          f32x16 acc[2][2];
          zero_acc(acc);
          gemm_kloop(acc, pass ? p.HB : p.O, 1024, M, tm * 128, pass ? p.WRW : p.WATT, 1024, tn * 128, 1024, lds);
#pragma unroll
          for (int tb = 0; tb < 2; ++tb) {
            const int tok = tbase + tb * 32 + l32;
            if (tok < M) {
              const u16* gp = p.P + (size_t)tok * NIN + 6528 + pass * 1024 + nbase + 4 * h;
              u16* dst = p.MERGED + (size_t)tok * 1024 + nbase + 4 * h;
#pragma unroll
              for (int nb = 0; nb < 2; ++nb)
#pragma unroll
                for (int i = 0; i < 4; ++i) {
                  const u32x2 ga = *(const u32x2*)(gp + nb * 32 + 8 * i);
                  float o0 = sigm(bf_lo(ga.x)) * acc[nb][tb][4 * i];
                  float o1 = sigm(bf_hi(ga.x)) * acc[nb][tb][4 * i + 1];
                  float o2 = sigm(bf_lo(ga.y)) * acc[nb][tb][4 * i + 2];
                  float o3 = sigm(bf_hi(ga.y)) * acc[nb][tb][4 * i + 3];
                  if (pass) {
                    const u32x2 pv = *(const u32x2*)(dst + nb * 32 + 8 * i);
                    o0 += bf_lo(pv.x); o1 += bf_hi(pv.x); o2 += bf_lo(pv.y); o3 += bf_hi(pv.y);
                  }
                  *(u32x2*)(dst + nb * 32 + 8 * i) = (u32x2){pk_bf16(o0, o1), pk_bf16(o2, o3)};
                }
            }
          }
        }
      }
    } break;
    case 9:
      gemm_phase(p.MERGED, 1024, M, p.WOUT, 1024, 1024, lds, [&](const f32x16 (&acc)[2][2], int nb, int tb) { epi_resid<1>(acc, nb, tb, p, G); });
      break;
    case 10:
      gemm_phase(p.HB, 1024, M, p.W2A, 1024, 2 * FFD, lds, [&](const f32x16 (&acc)[2][2], int nb, int tb) { epi_swiglu(acc, nb, tb, M, p.ss2, p.ACT); });
      break;
    case 11:
      gemm_phase(p.ACT, FFD, M, p.WD2, FFD, 1024, lds, [&](const f32x16 (&acc)[2][2], int nb, int tb) { epi_resid<2>(acc, nb, tb, p, G); });
      break;
    case 12: phase_final(p, G); break;
  }
}

__global__ void __launch_bounds__(256, 2) mega(Params p, int ph_lo, int ph_hi, int coop) {
  __shared__ __attribute__((aligned(16))) char lds[65536];
  __shared__ uint4 xb_words;
  CP* pp = (CP*)__builtin_amdgcn_kernarg_segment_ptr();
  asm volatile("" : "+s"(pp));
  if (threadIdx.x == 0) xb_words = make_uint4(0u, 0u, 0u, 0u);
  __syncthreads();
  const XcdBarrier xb = xcd_barrier_post(pp->bar, (volatile LAS unsigned*)&xb_words);
  for (int ph = ph_lo; ph < ph_hi; ++ph) {
    run_phase(*pp, ph, lds);
    if (coop && ph + 1 < ph_hi) {
      if (ph == 0) cg::this_grid().sync();
      else xcd_barrier(xb);
    }
  }
}

extern "C" void kernel_launch(void* const* d_in, const int* in_sizes, int n_in, void* d_out, int out_size, void* d_ws,
                              size_t ws_size, hipStream_t stream) {
  Params p;
  memset(&p, 0, sizeof(p));
  const float** f = (const float**)&p;
  for (int i = 0; i < 35; ++i) f[i] = (const float*)d_in[i];
  p.out = (float*)d_out;
  char* w = (char*)d_ws;
  size_t off = 0;
  auto alloc = [&](size_t bytes) { char* r = w + off; off += (bytes + 255) & ~(size_t)255; return r; };
  p.W1A = (u16*)alloc((size_t)2 * FFD * 1024 * 2);
  p.WD1 = (u16*)alloc((size_t)1024 * FFD * 2);
  p.WIN = (u16*)alloc((size_t)NIN * 1024 * 2);
  p.WATT = (u16*)alloc((size_t)1024 * 1024 * 2);
  p.WRW = (u16*)alloc((size_t)1024 * 1024 * 2);
  p.WOUT = (u16*)alloc((size_t)1024 * 1024 * 2);
  p.W2A = (u16*)alloc((size_t)2 * FFD * 1024 * 2);
  p.WD2 = (u16*)alloc((size_t)1024 * FFD * 2);
  p.W2F = (u16*)alloc((size_t)1024 * 64 * 2);
  p.W2B = (u16*)alloc((size_t)1024 * 64 * 2);
  p.A2F = (u16*)alloc((size_t)1024 * 64 * 2);
  p.A2B = (u16*)alloc((size_t)1024 * 64 * 2);
  p.G2T = (u16*)alloc((size_t)1024 * 128 * 2);
  p.lut = (float*)alloc(8 * 512 * 4);
  p.cnt = (int*)alloc(256);
  p.lam = (float*)alloc(256);
  p.bar = (unsigned*)alloc(XCD_BAR_WORDS * 4);
  const size_t R = MAXROWS;
  p.H = (float*)alloc(R * 1024 * 4);
  p.HB = (u16*)alloc(R * 1024 * 2);
  p.ACT = (u16*)alloc(R * FFD * 2);
  p.Y0 = p.ACT;
  p.Y1 = p.ACT + R * 1024;
  p.F = p.ACT + R * 2048;
  p.P = (u16*)alloc(R * NIN * 2);
  p.RKV = (u16*)alloc(R * 16 * 192 * 2);
  p.DIR0 = (u16*)alloc(R * 16 * 192 * 2);
  p.DIR1 = (u16*)alloc(R * 16 * 192 * 2);
  p.G = (u16*)alloc(R * 1024 * 2);
  p.O = (u16*)alloc(R * 1024 * 2);
  p.MERGED = (u16*)alloc(R * 1024 * 2);
  p.ss0 = (float*)alloc(R * 4);
  p.ss1 = (float*)alloc(R * 4);
  p.ss2 = (float*)alloc(R * 4);
  p.ss3 = (float*)alloc(R * 4);
  if (off > ws_size) { fprintf(stderr, "workspace too small: need %zu have %zu\n", off, ws_size); return; }
  static int grid_blocks = 0;
  if (!grid_blocks) {
    int dev = 0, cus = 0, per_cu = 0;
    hipGetDevice(&dev);
    hipDeviceGetAttribute(&cus, hipDeviceAttributeMultiprocessorCount, dev);
    hipOccupancyMaxActiveBlocksPerMultiprocessor(&per_cu, mega, 256, 0);
    per_cu = 2;
    grid_blocks = cus * per_cu;
  }
  hipMemsetAsync(p.bar, 0, XCD_BAR_WORDS * 4, stream);
  int ph_lo = 0, ph_hi = NPHASES, coop = 1;
  void* args[] = {&p, &ph_lo, &ph_hi, &coop};
  hipError_t e = hipLaunchCooperativeKernel((void*)mega, dim3(grid_blocks), dim3(256), args, 0, stream);
  if (e != hipSuccess) fprintf(stderr, "cooperative launch failed: %s (grid %d)\n", hipGetErrorString(e), grid_blocks);
}
```

```cpp
#include <hip/hip_runtime.h>
#include <hip/hip_cooperative_groups.h>
#include <stdint.h>
#include <string.h>
#include <stdio.h>
namespace cg = cooperative_groups;

typedef unsigned short u16;
typedef short bf16x8 __attribute__((ext_vector_type(8)));
typedef float f32x16 __attribute__((ext_vector_type(16)));
typedef float f32x4 __attribute__((ext_vector_type(4)));
typedef float f32x2 __attribute__((ext_vector_type(2)));
typedef unsigned u32x4 __attribute__((ext_vector_type(4)));
typedef unsigned u32x2 __attribute__((ext_vector_type(2)));
typedef __bf16 bf16x2_t __attribute__((ext_vector_type(2)));
typedef _Float16 f16x2_t __attribute__((ext_vector_type(2)));

#define NIN 8576
#define FFD 2816
#define EPSN 1e-6f
#define LOG2E 1.4426950408889634f
#define NGROUPS 6
#define PH_PER_G 13
#define NPHASES (1 + NGROUPS * PH_PER_G)
#define MAXROWS 16512

struct Params {
  const float *x_prompt, *x_sample, *meta, *rel_bias, *ffn1_norm, *ffn1_wg, *ffn1_wu, *ffn1_wd, *mix_norm, *w_in;
  const float *lq1, *lk1, *lq2, *lk2, *subln, *w_attn, *mu_prev, *mu_next, *rw_w0, *rw_w2, *rw_a0, *rw_a2, *rw_g2;
  const float *k_k, *k_a, *r_k, *lnx_w, *lnx_b, *w_rw, *w_out, *ffn2_norm, *ffn2_wg, *ffn2_wu, *ffn2_wd, *final_norm;
  float* out;
  u16 *W1A, *WD1, *WIN, *WATT, *WRW, *WOUT, *W2A, *WD2, *W2F, *W2B, *A2F, *A2B, *G2T;
  float* lut; int* cnt; float* lam; unsigned* bar; u16* VT;
  float* H; u16 *HB, *ACT, *P, *RKV, *DIR0, *DIR1, *G, *O, *MERGED, *Y0, *Y1, *F;
  float *ss0, *ss1, *ss2, *ss3;
};

typedef const Params __attribute__((address_space(4))) CP;
struct Grp { int nseq, L, S, M; const float* x; float* out; };

__device__ __forceinline__ Grp get_grp(CP& p, int g) {
  Grp r;
  if (g < 4) { r.nseq = 4; r.L = 4112; r.S = 4096; r.x = p.x_prompt + (size_t)g * 4 * 4096 * 1024; r.out = p.out + (size_t)g * 4 * 4096 * 1024; }
  else { r.nseq = 8; r.L = 2064; r.S = 2048; r.x = p.x_sample + (size_t)(g - 4) * 8 * 2048 * 1024; r.out = p.out + (size_t)16 * 4096 * 1024 + (size_t)(g - 4) * 8 * 2048 * 1024; }
  r.M = r.nseq * r.L;
  return r;
}

__device__ __forceinline__ int ltid() { int t = threadIdx.x; asm volatile("" : "+v"(t)); return t; }
__device__ __forceinline__ unsigned pk_bf16(float a, float b) {
  f32x2 v = {a, b};
  bf16x2_t r = __builtin_convertvector(v, bf16x2_t);
  return __builtin_bit_cast(unsigned, r);
}
__device__ __forceinline__ float bf_lo(unsigned u) { return __uint_as_float(u << 16); }
__device__ __forceinline__ float bf_hi(unsigned u) { return __uint_as_float(u & 0xffff0000u); }
__device__ __forceinline__ unsigned pk_f16(float a, float b) {
  f32x2 v = {a, b};
  f16x2_t r = __builtin_convertvector(v, f16x2_t);
  return __builtin_bit_cast(unsigned, r);
}
__device__ __forceinline__ float h_lo(unsigned u) { f16x2_t r = __builtin_bit_cast(f16x2_t, u); return (float)r.x; }
__device__ __forceinline__ float h_hi(unsigned u) { f16x2_t r = __builtin_bit_cast(f16x2_t, u); return (float)r.y; }
__device__ __forceinline__ u16 bf16_1(float a) { return (u16)(pk_bf16(a, 0.f) & 0xffffu); }
__device__ __forceinline__ float sigm(float x) { return 1.f / (1.f + __expf(-x)); }
__device__ __forceinline__ float wave_sum(float v) {
#pragma unroll
  for (int o = 32; o > 0; o >>= 1) v += __shfl_xor(v, o);
  return v;
}
template <int CTRL> __device__ __forceinline__ float dppf(float x) {
  return __int_as_float(__builtin_amdgcn_update_dpp(0, __float_as_int(x), CTRL, 0xf, 0xf, true));
}
__device__ __forceinline__ float reduce8(float x) {
  x += dppf<0xB1>(x);
  x += dppf<0x4E>(x);
  x += dppf<0x141>(x);
  return x;
}
__device__ __forceinline__ float reduce4(float x) {
  x += dppf<0xB1>(x);
  x += dppf<0x4E>(x);
  return x;
}

__device__ void prep_transpose(const float* __restrict__ src, int K, int N, u16* __restrict__ dst,
                               const float* __restrict__ gain, int mode, char* lds) {
  float* tile = (float*)lds;
  const int tn = N / 64, nt = (K / 64) * tn;
  const int tid = ltid();
  for (int t = blockIdx.x; t < nt; t += gridDim.x) {
    const int k0 = (t / tn) * 64, n0 = (t % tn) * 64;
    const int nl = tid & 63, kq = tid >> 6;
#pragma unroll
    for (int i = 0; i < 16; ++i) {
      const int k = i * 4 + kq;
      float v = src[(size_t)(k0 + k) * N + n0 + nl];
      if (gain) v *= gain[k0 + k];
      tile[k * 65 + nl] = v;
    }
    __syncthreads();
    const int n = tid >> 2, kk = (tid & 3) * 16;
    unsigned w[8];
#pragma unroll
    for (int i = 0; i < 8; ++i) w[i] = pk_bf16(tile[(kk + 2 * i) * 65 + n], tile[(kk + 2 * i + 1) * 65 + n]);
    const int ng = n0 + n;
    const int row = mode == 0 ? ng : ((ng >> 5) * 64 + (ng & 31) + (mode == 2 ? 32 : 0));
    u32x4* d = (u32x4*)(dst + (size_t)row * K + k0 + kk);
    d[0] = (u32x4){w[0], w[1], w[2], w[3]};
    d[1] = (u32x4){w[4], w[5], w[6], w[7]};
    __syncthreads();
  }
}

__device__ void phase_prep(CP& p, char* lds) {
  if (blockIdx.x == 0) {
    const int tid = ltid();
    if (tid < 16) p.cnt[tid] = 0;
    for (int idx = tid; idx < 8 * 511; idx += 256) {
      const int hd = idx / 511, di = idx - hd * 511, d = di - 255;
      const int n = d < 0 ? -d : d;
      int bk;
      if (n < 8) bk = n;
      else {
        const float nf = (float)n;
        int large = 8 + (int)(logf(nf / 8.0f) / 2.772588722239781f * 8.0f);
        bk = large < 15 ? large : 15;
      }
      const int bucket = (d > 0 ? 16 : 0) + bk;
      p.lut[hd * 512 + di] = p.rel_bias[bucket * 8 + hd] * LOG2E;
    }
    if (tid == 0) {
      float s1 = 0.f, s2 = 0.f;
      for (int i = 0; i < 64; ++i) { s1 += p.lq1[i] * p.lk1[i]; s2 += p.lq2[i] * p.lk2[i]; }
      p.lam[0] = expf(s1) - expf(s2) + 0.2f;
    }
  }
  prep_transpose(p.ffn1_wg, 1024, FFD, p.W1A, p.ffn1_norm, 1, lds);
  prep_transpose(p.ffn1_wu, 1024, FFD, p.W1A, p.ffn1_norm, 2, lds);
  prep_transpose(p.ffn1_wd, FFD, 1024, p.WD1, nullptr, 0, lds);
  prep_transpose(p.w_in, 1024, NIN, p.WIN, p.mix_norm, 0, lds);
  prep_transpose(p.w_attn, 1024, 1024, p.WATT, nullptr, 0, lds);
  prep_transpose(p.w_rw, 1024, 1024, p.WRW, nullptr, 0, lds);
  prep_transpose(p.w_out, 1024, 1024, p.WOUT, nullptr, 0, lds);
  prep_transpose(p.ffn2_wg, 1024, FFD, p.W2A, p.ffn2_norm, 1, lds);
  prep_transpose(p.ffn2_wu, 1024, FFD, p.W2A, p.ffn2_norm, 2, lds);
  prep_transpose(p.ffn2_wd, FFD, 1024, p.WD2, nullptr, 0, lds);
  prep_transpose(p.rw_w2, 64, 1024, p.W2F, nullptr, 0, lds);
  prep_transpose(p.rw_w2 + 64 * 1024, 64, 1024, p.W2B, nullptr, 0, lds);
  prep_transpose(p.rw_a2, 64, 1024, p.A2F, nullptr, 0, lds);
  prep_transpose(p.rw_a2 + 64 * 1024, 64, 1024, p.A2B, nullptr, 0, lds);
  prep_transpose(p.rw_g2, 128, 1024, p.G2T, nullptr, 0, lds);
}

__device__ void phase_rows(CP& p, const Grp& G) {
  const int lane = ltid() & 63;
  const int nw = gridDim.x * 4;
  for (int row = blockIdx.x * 4 + (ltid() >> 6); row < G.M; row += nw) {
    const int s = row / G.L, t = row - s * G.L;
    const float* src = t < 16 ? p.meta + t * 1024 : G.x + ((size_t)s * G.S + (t - 16)) * 1024;
    float ss = 0.f;
#pragma unroll
    for (int i = 0; i < 4; ++i) {
      const f32x4 v = *(const f32x4*)(src + i * 256 + lane * 4);
      ss += v.x * v.x + v.y * v.y + v.z * v.z + v.w * v.w;
      u32x2 o = {pk_bf16(v.x, v.y), pk_bf16(v.z, v.w)};
      *(u32x2*)(p.HB + (size_t)row * 1024 + i * 256 + lane * 4) = o;
    }
    ss = wave_sum(ss);
    if (lane == 0) { p.ss0[row] = ss; p.ss1[row] = 0.f; p.ss2[row] = 0.f; p.ss3[row] = 0.f; }
  }
}

#define LAS __attribute__((address_space(3)))
#define LAS __attribute__((address_space(3)))
#define LAS __attribute__((address_space(3)))
__device__ __forceinline__ void glds16(const void* gsrc, unsigned lds_dst) {
  unsigned keep;
  asm volatile("s_mov_b32 %0, m0\n\ts_mov_b32 m0, %2\n\ts_nop 0\n\tglobal_load_lds_dwordx4 %1, off\n\ts_mov_b32 m0, %0" : "=&s"(keep) : "v"(gsrc), "s"(lds_dst) : "memory");
}
__device__ __forceinline__ void gemm_kloop(f32x16 (&acc)[2][2], const u16* __restrict__ A, int lda, int M, int m0,
                                           const u16* __restrict__ W, int ldw, int n0, int K, char* lds) {
  const int tid = ltid(), lane = tid & 63, wave = tid >> 6;
  const int wn = wave & 1, wt = wave >> 1, l32 = lane & 31, h = lane >> 5;
  const u16* ap[2];
  const u16* wp[2];
#pragma unroll
  for (int i = 0; i < 2; ++i) {
    const int c = tid + 256 * i, row = c >> 2, ch = (c & 3) ^ ((row >> 2) & 3);
    int ar = m0 + row; ar = ar < M ? ar : M - 1;
    ap[i] = A + (size_t)ar * lda + ch * 8;
    wp[i] = W + (size_t)(n0 + row) * ldw + ch * 8;
  }
  int wro[2], wsw[2], aro[2], asw[2];
#pragma unroll
  for (int b = 0; b < 2; ++b) {
    const int wr = wn * 64 + b * 32 + l32, ar = wt * 64 + b * 32 + l32;
    wro[b] = wr * 64; wsw[b] = (wr >> 2) & 3;
    aro[b] = 8192 + ar * 64; asw[b] = (ar >> 2) & 3;
  }
  const int nk = K >> 5;
  const unsigned lds0 = __builtin_amdgcn_readfirstlane((unsigned)(uintptr_t)(LAS char*)lds + wave * 1024);
  auto stage = [&](int kt) {
    const unsigned sb = lds0 + (kt & 3) * 16384;
#pragma unroll
    for (int i = 0; i < 2; ++i) {
      glds16(wp[i] + kt * 32, sb + i * 4096);
      glds16(ap[i] + kt * 32, sb + 8192 + i * 4096);
    }
  };
  asm volatile("s_waitcnt vmcnt(0)" ::: "memory");
  __builtin_amdgcn_s_barrier();
#pragma unroll
  for (int s = 0; s < 3; ++s)
    if (s < nk) stage(s);
  for (int kt = 0; kt < nk; ++kt) {
    const int rem = nk - 1 - kt;
    if (rem >= 2) asm volatile("s_waitcnt vmcnt(8)" ::: "memory");
    else if (rem == 1) asm volatile("s_waitcnt vmcnt(4)" ::: "memory");
    else asm volatile("s_waitcnt vmcnt(0)" ::: "memory");
    __builtin_amdgcn_s_barrier();
    if (kt + 3 < nk) stage(kt + 3);
    const char* st = lds + (kt & 3) * 16384;
#pragma unroll
    for (int ks = 0; ks < 2; ++ks) {
      bf16x8 wf[2], af[2];
#pragma unroll
      for (int b = 0; b < 2; ++b) {
        wf[b] = *(const bf16x8*)(st + wro[b] + (((ks * 2 + h) ^ wsw[b]) << 4));
        af[b] = *(const bf16x8*)(st + aro[b] + (((ks * 2 + h) ^ asw[b]) << 4));
      }
#pragma unroll
      for (int nb = 0; nb < 2; ++nb)
#pragma unroll
        for (int tb = 0; tb < 2; ++tb)
          acc[nb][tb] = __builtin_amdgcn_mfma_f32_32x32x16_bf16(wf[nb], af[tb], acc[nb][tb], 0, 0, 0);
    }
  }
}

__device__ __forceinline__ void zero_acc(f32x16 (&acc)[2][2]) {
#pragma unroll
  for (int a = 0; a < 2; ++a)
#pragma unroll
    for (int b = 0; b < 2; ++b)
#pragma unroll
      for (int r = 0; r < 16; ++r) acc[a][b][r] = 0.f;
}

template <class F>
__device__ __forceinline__ void gemm_phase(const u16* A, int lda, int M, const u16* W, int K, int N, char* lds, F&& epi) {
  const int nN = N >> 7, nM = (M + 127) >> 7, nt = nN * nM;
  const int wave = ltid() >> 6;
  const int xcd = blockIdx.x & 7, g8 = gridDim.x >> 3;
  const int tq = nt >> 3, trm = nt & 7;
  const int tstart = xcd < trm ? xcd * (tq + 1) : trm * (tq + 1) + (xcd - trm) * tq;
  const int tcnt = tq + (xcd < trm ? 1 : 0);
  for (int off = blockIdx.x >> 3; off < tcnt; off += g8) {
    const int id = tstart + off, nig = 8 * nN, grp = id / nig, fm = grp * 8;
    const int gsz = (nM - fm) < 8 ? (nM - fm) : 8, idl = id - grp * nig;
    const int tm = fm + idl % gsz, tn = idl / gsz;
    f32x16 acc[2][2];
    zero_acc(acc);
    gemm_kloop(acc, A, lda, M, tm * 128, W, K, tn * 128, K, lds);
    epi(acc, tn * 128 + (wave & 1) * 64, tm * 128 + (wave >> 1) * 64);
  }
}

__device__ __forceinline__ void epi_swiglu(const f32x16 (&acc)[2][2], int nbase, int tbase, int M, const float* ss, u16* ACT) {
  const int lane = ltid() & 63, l32 = lane & 31, h = lane >> 5;
  const int cb = (nbase >> 6) * 32;
#pragma unroll
  for (int tb = 0; tb < 2; ++tb) {
    const int tok = tbase + tb * 32 + l32;
    if (tok < M) {
      const float rs = rsqrtf(ss[tok] * (1.f / 1024.f) + EPSN);
      u16* dst = ACT + (size_t)tok * FFD + cb + 4 * h;
#pragma unroll
      for (int i = 0; i < 4; ++i) {
        float o[4];
#pragma unroll
        for (int j = 0; j < 4; ++j) {
          const float g = acc[0][tb][4 * i + j] * rs, u = acc[1][tb][4 * i + j] * rs;
          o[j] = g * sigm(g) * u;
        }
        *(u32x2*)(dst + 8 * i) = (u32x2){pk_bf16(o[0], o[1]), pk_bf16(o[2], o[3])};
      }
    }
  }
}

template <int MODE>
__device__ __forceinline__ void epi_resid(const f32x16 (&acc)[2][2], int nbase, int tbase, CP& p, const Grp& G) {
  const int lane = ltid() & 63, l32 = lane & 31, h = lane >> 5;
  const float scale = MODE == 1 ? 1.f : 0.5f;
  float* ssout = MODE == 0 ? p.ss1 : (MODE == 1 ? p.ss2 : p.ss3);
#pragma unroll
  for (int tb = 0; tb < 2; ++tb) {
    const int tok = tbase + tb * 32 + l32;
    const bool valid = tok < G.M;
    float sq = 0.f;
    if (valid) {
      float* hp = p.H + (size_t)tok * 1024;
      const float* rp = hp;
      if (MODE == 0) {
        const int s = tok / G.L, t = tok - s * G.L;
        rp = t < 16 ? p.meta + t * 1024 : G.x + ((size_t)s * G.S + (t - 16)) * 1024;
      }
#pragma unroll
      for (int nb = 0; nb < 2; ++nb)
#pragma unroll
        for (int i = 0; i < 4; ++i) {
          const int n = nbase + nb * 32 + 8 * i + 4 * h;
          const f32x4 r = *(const f32x4*)(rp + n);
          f32x4 v;
          v.x = r.x + scale * acc[nb][tb][4 * i + 0];
          v.y = r.y + scale * acc[nb][tb][4 * i + 1];
          v.z = r.z + scale * acc[nb][tb][4 * i + 2];
          v.w = r.w + scale * acc[nb][tb][4 * i + 3];
          *(f32x4*)(hp + n) = v;
          sq += v.x * v.x + v.y * v.y + v.z * v.z + v.w * v.w;
          if (MODE != 2) *(u32x2*)(p.HB + (size_t)tok * 1024 + n) = (u32x2){pk_bf16(v.x, v.y), pk_bf16(v.z, v.w)};
        }
    }
    sq += __shfl_xor(sq, 32);
    if (valid && h == 0) atomicAdd(ssout + tok, sq);
  }
}

__device__ void phase_mix(CP& p, const Grp& G) {
  const int total = G.M * 432;
  for (int idx = blockIdx.x * 256 + ltid(); idx < total; idx += gridDim.x * 256) {
    const int row = idx / 432, ch = idx - row * 432;
    const int t = row % G.L;
    const int col = ch * 8;
    const u16* pc = p.P + (size_t)row * NIN + 3072 + col;
    const u32x4 c = *(const u32x4*)pc;
    u32x4 pv = {0, 0, 0, 0}, nx = {0, 0, 0, 0};
    if (t > 0) pv = *(const u32x4*)(pc - NIN);
    if (t < G.L - 1) nx = *(const u32x4*)(pc + NIN);
    const f32x4 mp0 = *(const f32x4*)(p.mu_prev + col), mp1 = *(const f32x4*)(p.mu_prev + col + 4);
    const f32x4 mn0 = *(const f32x4*)(p.mu_next + col), mn1 = *(const f32x4*)(p.mu_next + col + 4);
    float o[8];
#pragma unroll
    for (int e = 0; e < 4; ++e) {
      const float c0 = bf_lo(c[e]), c1 = bf_hi(c[e]);
      const float mpa = e < 2 ? mp0[2 * e] : mp1[2 * e - 4], mpb = e < 2 ? mp0[2 * e + 1] : mp1[2 * e - 3];
      const float mna = e < 2 ? mn0[2 * e] : mn1[2 * e - 4], mnb = e < 2 ? mn0[2 * e + 1] : mn1[2 * e - 3];
      o[2 * e] = c0 + mpa * (bf_lo(pv[e]) - c0) + mna * (bf_lo(nx[e]) - c0);
      o[2 * e + 1] = c1 + mpb * (bf_hi(pv[e]) - c1) + mnb * (bf_hi(nx[e]) - c1);
    }
    if (col < 3072) {
      const int sec = col >> 10, ci = col & 1023, head = ci >> 6, c0 = ci & 63;
      const size_t ro = ((size_t)row * 16 + head) * 192 + sec * 64 + c0;
      const u32x4 pk = (u32x4){pk_f16(o[0], o[1]), pk_f16(o[2], o[3]), pk_f16(o[4], o[5]), pk_f16(o[6], o[7])};
      *(u32x4*)(p.RKV + ro) = pk;
      if (sec == 1) { *(u32x4*)(p.DIR0 + ro) = pk; *(u32x4*)(p.DIR1 + ro) = pk; }
    } else {
      const int fc = col - 3072;
      if (fc < 128) {
#pragma unroll
        for (int e = 0; e < 8; ++e) o[e] = 1.f - 2.f / (1.f + __expf(2.f * o[e]));
      } else if (fc >= 256) {
#pragma unroll
        for (int e = 0; e < 8; ++e) o[e] = sigm(o[e]);
      }
      *(u32x4*)(p.F + (size_t)row * 384 + fc) = (u32x4){pk_bf16(o[0], o[1]), pk_bf16(o[2], o[3]), pk_bf16(o[4], o[5]), pk_bf16(o[6], o[7])};
    }
  }
}

__device__ __forceinline__ void epi_decay(const f32x16 (&acc)[2][2], int nbase, int tbase, int M, const float* w0, u16* DIR) {
  const int lane = ltid() & 63, l32 = lane & 31, h = lane >> 5;
  const int head = nbase >> 6;
#pragma unroll
  for (int tb = 0; tb < 2; ++tb) {
    const int tok = tbase + tb * 32 + l32;
    if (tok < M) {
      u16* dst = DIR + ((size_t)tok * 16 + head) * 192;
#pragma unroll
      for (int nb = 0; nb < 2; ++nb)
#pragma unroll
        for (int i = 0; i < 4; ++i) {
          const int c = nb * 32 + 8 * i + 4 * h;
          const f32x4 w = *(const f32x4*)(w0 + nbase + c);
          float o[4];
#pragma unroll
          for (int j = 0; j < 4; ++j) o[j] = 0.6065306597126334f * sigm(w[j] + acc[nb][tb][4 * i + j]);
          *(u32x2*)(dst + c) = (u32x2){pk_f16(o[0], o[1]), pk_f16(o[2], o[3])};
        }
    }
  }
}

__device__ __forceinline__ void epi_adir(const f32x16 (&acc)[2][2], int nbase, int tbase, int M, CP& p, int dir) {
  const int lane = ltid() & 63, l32 = lane & 31, h = lane >> 5;
  const int head = nbase >> 6;
  u16* DIR = dir ? p.DIR1 : p.DIR0;
  const float* a0 = p.rw_a0 + dir * 1024;
#pragma unroll
  for (int tb = 0; tb < 2; ++tb) {
    const int tok = tbase + tb * 32 + l32;
    const bool valid = tok < M;
    const int tk = valid ? tok : M - 1;
    const size_t rec = ((size_t)tk * 16 + head) * 192;
    float nsq = 0.f;
#pragma unroll
    for (int nb = 0; nb < 2; ++nb)
#pragma unroll
      for (int i = 0; i < 4; ++i) {
        const int c = nb * 32 + 8 * i + 4 * h;
        const u32x2 kr = *(const u32x2*)(DIR + rec + 64 + c);
        const f32x4 kkw = *(const f32x4*)(p.k_k + nbase + c);
        const float q0 = h_lo(kr.x) * kkw[0], q1 = h_hi(kr.x) * kkw[1], q2 = h_lo(kr.y) * kkw[2], q3 = h_hi(kr.y) * kkw[3];
        nsq += q0 * q0 + q1 * q1 + q2 * q2 + q3 * q3;
      }
    nsq += __shfl_xor(nsq, 32);
    const float inv = 1.f / fmaxf(sqrtf(nsq), 1e-12f);
    if (valid) {
#pragma unroll
      for (int nb = 0; nb < 2; ++nb)
#pragma unroll
        for (int i = 0; i < 4; ++i) {
          const int c = nb * 32 + 8 * i + 4 * h;
          const u32x2 kr = *(const u32x2*)(DIR + rec + 64 + c);
          const float kv[4] = {h_lo(kr.x), h_hi(kr.x), h_lo(kr.y), h_hi(kr.y)};
          const f32x4 kkw = *(const f32x4*)(p.k_k + nbase + c);
          const f32x4 kaw = *(const f32x4*)(p.k_a + nbase + c);
          const f32x4 a0v = *(const f32x4*)(a0 + nbase + c);
          float kk[4], kd[4], bp[4];
#pragma unroll
          for (int j = 0; j < 4; ++j) {
            const float k = kv[j];
            kk[j] = k * kkw[j] * inv;
            const float aa = sigm(a0v[j] + acc[nb][tb][4 * i + j]);
            kd[j] = k * (1.f + (aa - 1.f) * kaw[j]);
            bp[j] = -kk[j] * aa;
          }
          if (dir == 0) *(u32x2*)(p.RKV + rec + 64 + c) = (u32x2){pk_f16(kk[0], kk[1]), pk_f16(kk[2], kk[3])};
          *(u32x2*)(DIR + rec + 64 + c) = (u32x2){pk_f16(kd[0], kd[1]), pk_f16(kd[2], kd[3])};
          *(u32x2*)(DIR + rec + 128 + c) = (u32x2){pk_f16(bp[0], bp[1]), pk_f16(bp[2], bp[3])};
        }
    }
  }
}

template <int LPR>
__device__ void scan_task(CP& p, const Grp& G, int task, char* lds) {
  constexpr int KPL = 64 / LPR, RPB = 256 / LPR, NSPLIT = 64 / RPB;
  const int part = task % NSPLIT, t1 = task / NSPLIT;
  const int dir = t1 & 1, head = (t1 >> 1) & 15, s = t1 >> 5;
  float* buf = (float*)lds;
  const u16* rkv = p.RKV;
  const u16* dr = dir ? p.DIR1 : p.DIR0;
  u16* Y = dir ? p.Y1 : p.Y0;
  const int tid = ltid();
  const int row = part * RPB + tid / LPR, kc = tid % LPR;
  const int L = G.L, nch = L >> 4;
  u32x4 pre[3];
  auto issue = [&](int c) {
#pragma unroll
    for (int i = 0; i < 3; ++i) {
      const int id = tid + 256 * i, st = id / 48, ci = id - st * 48;
      const int n = c * 16 + st, t = dir ? L - 1 - n : n;
      const size_t rec = ((size_t)(s * L + t) * 16 + head) * 192;
      const u16* src = ci < 24 ? rkv + rec + ci * 8 : dr + rec + (ci - 24) * 8;
      pre[i] = *(const u32x4*)src;
    }
  };
  auto commit = [&](int b) {
#pragma unroll
    for (int i = 0; i < 3; ++i) {
      const int id = tid + 256 * i, st = id / 48, ci = id - st * 48;
      const int sec = ci >> 3;
      const int base = sec >= 3 ? (sec - 1) * 64 : (sec == 0 ? 64 : (sec == 1 ? 0 : 320));
      float f[8];
#pragma unroll
      for (int e = 0; e < 4; ++e) { f[2 * e] = h_lo(pre[i][e]); f[2 * e + 1] = h_hi(pre[i][e]); }
      if (sec == 3) {
#pragma unroll
        for (int e = 0; e < 8; ++e) f[e] = __expf(-f[e]);
      }
      float* d = buf + b * 6144 + st * 384 + base + (ci & 7) * 8;
      *(f32x4*)d = (f32x4){f[0], f[1], f[2], f[3]};
      *(f32x4*)(d + 4) = (f32x4){f[4], f[5], f[6], f[7]};
    }
  };
  float S[KPL];
#pragma unroll
  for (int i = 0; i < KPL; ++i) S[i] = 0.f;
  __syncthreads();
  issue(0);
  commit(0);
  __syncthreads();
  __builtin_amdgcn_s_setprio(3);
  for (int c = 0; c < nch; ++c) {
    if (c + 1 < nch) issue(c + 1);
    const float* b = buf + (c & 1) * 6144;
#pragma unroll 4
    for (int st = 0; st < 16; ++st) {
      const float* q = b + st * 384 + kc * KPL;
      f32x4 kk[KPL / 4], rr[KPL / 4], ww[KPL / 4], dd[KPL / 4], bb[KPL / 4];
#pragma unroll
      for (int j = 0; j < KPL / 4; ++j) {
        kk[j] = *(const f32x4*)(q + 4 * j);
        rr[j] = *(const f32x4*)(q + 64 + 4 * j);
        ww[j] = *(const f32x4*)(q + 128 + 4 * j);
        dd[j] = *(const f32x4*)(q + 192 + 4 * j);
        bb[j] = *(const f32x4*)(q + 256 + 4 * j);
      }
      const float vv = b[st * 384 + 320 + row];
      float sa0 = 0.f, sa1 = 0.f;
#pragma unroll
      for (int j = 0; j < KPL / 4; ++j) {
        sa0 += S[4 * j] * kk[j][0]; sa1 += S[4 * j + 1] * kk[j][1];
        sa0 += S[4 * j + 2] * kk[j][2]; sa1 += S[4 * j + 3] * kk[j][3];
      }
      float sa = sa0 + sa1;
      sa = LPR == 8 ? reduce8(sa) : reduce4(sa);
      float y0 = 0.f, y1 = 0.f;
#pragma unroll
      for (int j = 0; j < KPL / 4; ++j)
#pragma unroll
        for (int e = 0; e < 4; ++e) {
          const float sn = S[4 * j + e] * ww[j][e] + (sa * bb[j][e] + vv * dd[j][e]);
          S[4 * j + e] = sn;
          if (e & 1) y1 += sn * rr[j][e]; else y0 += sn * rr[j][e];
        }
      float y = y0 + y1;
      y = LPR == 8 ? reduce8(y) : reduce4(y);
      if (kc == 0) {
        const int n = c * 16 + st, t = dir ? L - 1 - n : n;
        Y[(size_t)(s * L + t) * 1024 + head * 64 + row] = bf16_1(y);
      }
    }
    if (c + 1 < nch) commit((c + 1) & 1);
    __syncthreads();
  }
  __builtin_amdgcn_s_setprio(0);
}

__device__ void attn_tile(CP& p, const Grp& G, int s, int hd, int qb, char* lds, float lam) {
  const int tid = ltid(), lane = tid & 63, wave = tid >> 6, l32 = lane & 31, h = lane >> 5;
  const int L = G.L, Lp = (G.L + 31) & ~31;
  const u16* Pb = p.P + (size_t)s * L * NIN;
  float* lutl = (float*)(lds + 36864);
  char* qfl = lds + 38912 + tid * 16;
  __syncthreads();
  for (int i = tid; i < 511; i += 256) lutl[i] = p.lut[hd * 512 + i];
  const int q = qb * 128 + wave * 32 + l32;
  const int qc = q < L ? q : L - 1;
  const int qw0 = qb * 128 + wave * 32;
  u16* odst = p.O + (size_t)(s * L + qc) * 1024 + hd * 128;
  const int kkey = tid >> 3, kch = (tid & 7) ^ ((kkey >> 1) & 7);
  const u16* vsrc[2];
#pragma unroll
  for (int i = 0; i < 2; ++i) {
    const int c = tid + 256 * i, dv = c >> 2, c4 = (c & 3) ^ ((dv >> 2) & 3);
    vsrc[i] = p.VT + ((size_t)(s * 1024 + hd * 128 + dv) * Lp) + c4 * 8;
  }
  const unsigned lds0 = __builtin_amdgcn_readfirstlane((unsigned)(uintptr_t)(LAS char*)lds + wave * 1024);
  const int ntile = (L + 31) >> 5;
#pragma unroll 1
  for (int br = 0; br < 2; ++br) {
#pragma unroll
    for (int ks = 0; ks < 4; ++ks) {
      const u32x4 raw = *(const u32x4*)(Pb + (size_t)qc * NIN + hd * 128 + br * 64 + ks * 16 + h * 8);
      u32x4 sc;
#pragma unroll
      for (int e = 0; e < 4; ++e) sc[e] = pk_bf16(bf_lo(raw[e]) * 0.125f, bf_hi(raw[e]) * 0.125f);
      *(u32x4*)(qfl + ks * 4096) = sc;
    }
    const u16* kp = Pb + 1024 + hd * 128 + br * 64 + kch * 8;
    auto stage = [&](int kt) {
      const int kt0 = kt * 32;
      const unsigned sb = lds0 + (kt % 3) * 12288;
      int kr = kt0 + kkey; kr = kr < L ? kr : L - 1;
      glds16(kp + (size_t)kr * NIN, sb);
      glds16(vsrc[0] + kt0, sb + 4096);
      glds16(vsrc[1] + kt0, sb + 8192);
    };
    f32x16 O[4];
#pragma unroll
    for (int mb = 0; mb < 4; ++mb)
#pragma unroll
      for (int r = 0; r < 16; ++r) O[mb][r] = 0.f;
    float mrun = -1e30f, lrun = 0.f;
    asm volatile("s_waitcnt vmcnt(0) lgkmcnt(0)" ::: "memory");
    __builtin_amdgcn_s_barrier();
    stage(0);
    if (ntile > 1) stage(1);
    const float cneg = lutl[0], cpos = lutl[510];
    for (int kt = 0; kt < ntile; ++kt) {
      const int kt0 = kt * 32;
      if (kt + 1 < ntile) asm volatile("s_waitcnt vmcnt(3)" ::: "memory");
      else asm volatile("s_waitcnt vmcnt(0)" ::: "memory");
      __builtin_amdgcn_s_barrier();
      if (kt + 2 < ntile) stage(kt + 2);
      const char* st = lds + (kt % 3) * 12288;
      f32x16 sacc;
#pragma unroll
      for (int r = 0; r < 16; ++r) sacc[r] = 0.f;
#pragma unroll
      for (int ks = 0; ks < 4; ++ks) {
        const bf16x8 kf = *(const bf16x8*)(st + l32 * 128 + (((ks * 2 + h) ^ ((l32 >> 1) & 7)) << 4));
        const bf16x8 qv = *(const bf16x8*)(qfl + ks * 4096);
        sacc = __builtin_amdgcn_mfma_f32_32x32x16_bf16(kf, qv, sacc, 0, 0, 0);
      }
      const bool farneg = (kt0 + 31) <= (qw0 - 128);
      const bool farpos = kt0 >= (qw0 + 31 + 128);
      float mx = -1e30f;
      if (farneg || farpos) {
        const float cv = farneg ? cneg : cpos;
#pragma unroll
        for (int r = 0; r < 16; ++r) { sacc[r] = sacc[r] * LOG2E + cv; }
      } else {
#pragma unroll
        for (int r = 0; r < 16; ++r) {
          const int key = kt0 + 8 * (r >> 2) + 4 * h + (r & 3);
          int d = key - q + 255;
          d = d < 0 ? 0 : (d > 510 ? 510 : d);
          sacc[r] = sacc[r] * LOG2E + lutl[d];
        }
      }
      if (kt0 + 32 > L) {
#pragma unroll
        for (int r = 0; r < 16; ++r) {
          const int key = kt0 + 8 * (r >> 2) + 4 * h + (r & 3);
          if (key >= L) sacc[r] = -INFINITY;
        }
      }
#pragma unroll
      for (int r = 0; r < 16; ++r) mx = fmaxf(mx, sacc[r]);
      mx = fmaxf(mx, __shfl_xor(mx, 32));
      const float mnew = fmaxf(mrun, mx);
      const float alpha = __builtin_amdgcn_exp2f(mrun - mnew);
      mrun = mnew;
      float ps = 0.f;
#pragma unroll
      for (int r = 0; r < 16; ++r) { sacc[r] = __builtin_amdgcn_exp2f(sacc[r] - mnew); ps += sacc[r]; }
      lrun = lrun * alpha + ps;
      if (__any(alpha != 1.f)) {
#pragma unroll
        for (int mb = 0; mb < 4; ++mb)
#pragma unroll
          for (int r = 0; r < 16; ++r) O[mb][r] *= alpha;
      }
      bf16x8 pf[2];
#pragma unroll
      for (int s2 = 0; s2 < 2; ++s2) {
        u32x4 w;
#pragma unroll
        for (int e = 0; e < 4; ++e) w[e] = pk_bf16(sacc[8 * s2 + 2 * e], sacc[8 * s2 + 2 * e + 1]);
        pf[s2] = __builtin_bit_cast(bf16x8, w);
      }
#pragma unroll
      for (int mb = 0; mb < 4; ++mb)
#pragma unroll
        for (int s2 = 0; s2 < 2; ++s2) {
          const int vr = mb * 32 + l32;
          const bf16x8 vf = *(const bf16x8*)(st + 4096 + vr * 64 + (((2 * s2 + h) ^ ((vr >> 2) & 3)) << 4));
          O[mb] = __builtin_amdgcn_mfma_f32_32x32x16_bf16(vf, pf[s2], O[mb], 0, 0, 0);
        }
    }
    const float lt = lrun + __shfl_xor(lrun, 32);
    if (br == 0) {
      const float i1 = 1.f / lt;
#pragma unroll
      for (int mb = 0; mb < 4; ++mb)
#pragma unroll
        for (int i = 0; i < 4; ++i)
          if (q < L) *(u32x2*)(odst + mb * 32 + 8 * i + 4 * h) = (u32x2){pk_bf16(O[mb][4 * i] * i1, O[mb][4 * i + 1] * i1), pk_bf16(O[mb][4 * i + 2] * i1, O[mb][4 * i + 3] * i1)};
    } else {
      const float i2 = lam / lt;
      float ssq = 0.f;
#pragma unroll
      for (int mb = 0; mb < 4; ++mb)
#pragma unroll
        for (int i = 0; i < 4; ++i) {
          u32x2 w = {0, 0};
          if (q < L) w = *(const u32x2*)(odst + mb * 32 + 8 * i + 4 * h);
          const float o0 = bf_lo(w.x) - O[mb][4 * i] * i2, o1v = bf_hi(w.x) - O[mb][4 * i + 1] * i2, o2 = bf_lo(w.y) - O[mb][4 * i + 2] * i2, o3 = bf_hi(w.y) - O[mb][4 * i + 3] * i2;
          O[mb][4 * i] = o0; O[mb][4 * i + 1] = o1v; O[mb][4 * i + 2] = o2; O[mb][4 * i + 3] = o3;
          ssq += o0 * o0 + o1v * o1v + o2 * o2 + o3 * o3;
        }
      ssq += __shfl_xor(ssq, 32);
      const float rn = rsqrtf(ssq * (1.f / 128.f) + EPSN) * 0.8f;
      if (q < L) {
#pragma unroll
        for (int mb = 0; mb < 4; ++mb)
#pragma unroll
          for (int i = 0; i < 4; ++i) {
            const int dv = mb * 32 + 8 * i + 4 * h;
            const f32x4 g = *(const f32x4*)(p.subln + dv);
            *(u32x2*)(odst + dv) = (u32x2){pk_bf16(O[mb][4 * i] * rn * g.x, O[mb][4 * i + 1] * rn * g.y),
                                           pk_bf16(O[mb][4 * i + 2] * rn * g.z, O[mb][4 * i + 3] * rn * g.w)};
          }
      }
    }
  }
}

__device__ void phase_mixer(CP& p, const Grp& G, int g, char* lds) {
  if (G.nseq == 4) { for (int t = blockIdx.x; t < 256; t += gridDim.x) scan_task<8>(p, G, t, lds); }
  else { for (int t = blockIdx.x; t < 256; t += gridDim.x) scan_task<4>(p, G, t, lds); }
  const int nqb = (G.L + 127) >> 7;
  const int natt = G.nseq * 8 * nqb;
  const float lam = p.lam[0];
  int* shw = (int*)(lds + 65536 - 16);
  while (true) {
    __syncthreads();
    if (ltid() == 0) *shw = atomicAdd(p.cnt + g, 1);
    __syncthreads();
    const int t = *shw;
    if (t >= natt) break;
    const int qb = t % nqb, r = t / nqb, hd = r & 7, s = r >> 3;
    attn_tile(p, G, s, hd, qb, lds, lam);
  }
}

__device__ void phase_post(CP& p, const Grp& G) {
  const int lane = ltid() & 63;
  const int nw = gridDim.x * 4;
  const int c0 = lane * 16, head = lane >> 2, hc = (lane & 3) * 16;
  for (int row = blockIdx.x * 4 + (ltid() >> 6); row < G.M; row += nw) {
    float y[16];
    {
      const u32x4 a0 = *(const u32x4*)(p.Y0 + (size_t)row * 1024 + c0), a1 = *(const u32x4*)(p.Y0 + (size_t)row * 1024 + c0 + 8);
      const u32x4 b0 = *(const u32x4*)(p.Y1 + (size_t)row * 1024 + c0), b1 = *(const u32x4*)(p.Y1 + (size_t)row * 1024 + c0 + 8);
#pragma unroll
      for (int e = 0; e < 4; ++e) {
        y[2 * e] = bf_lo(a0[e]) + bf_lo(b0[e]); y[2 * e + 1] = bf_hi(a0[e]) + bf_hi(b0[e]);
        y[8 + 2 * e] = bf_lo(a1[e]) + bf_lo(b1[e]); y[8 + 2 * e + 1] = bf_hi(a1[e]) + bf_hi(b1[e]);
      }
    }
    float s1 = 0.f;
#pragma unroll
    for (int e = 0; e < 16; ++e) s1 += y[e];
    s1 = reduce4(s1);
    const float mu = s1 * (1.f / 64.f);
    float s2 = 0.f;
#pragma unroll
    for (int e = 0; e < 16; ++e) { const float d = y[e] - mu; s2 += d * d; }
    s2 = reduce4(s2);
    const float rstd = rsqrtf(s2 * (1.f / 64.f) + 64e-5f);
    const size_t rec = ((size_t)row * 16 + head) * 192 + hc;
    float rr[16], vv[16], kd[16];
    {
      const u32x4 r0 = *(const u32x4*)(p.RKV + rec), r1 = *(const u32x4*)(p.RKV + rec + 8);
      const u32x4 v0 = *(const u32x4*)(p.RKV + rec + 128), v1 = *(const u32x4*)(p.RKV + rec + 136);
      const u32x4 f0 = *(const u32x4*)(p.DIR0 + rec + 64), f1 = *(const u32x4*)(p.DIR0 + rec + 72);
      const u32x4 g0 = *(const u32x4*)(p.DIR1 + rec + 64), g1 = *(const u32x4*)(p.DIR1 + rec + 72);
#pragma unroll
      for (int e = 0; e < 4; ++e) {
        rr[2 * e] = h_lo(r0[e]); rr[2 * e + 1] = h_hi(r0[e]); rr[8 + 2 * e] = h_lo(r1[e]); rr[8 + 2 * e + 1] = h_hi(r1[e]);
        vv[2 * e] = h_lo(v0[e]); vv[2 * e + 1] = h_hi(v0[e]); vv[8 + 2 * e] = h_lo(v1[e]); vv[8 + 2 * e + 1] = h_hi(v1[e]);
        kd[2 * e] = h_lo(f0[e]) + h_lo(g0[e]); kd[2 * e + 1] = h_hi(f0[e]) + h_hi(g0[e]);
        kd[8 + 2 * e] = h_lo(f1[e]) + h_lo(g1[e]); kd[8 + 2 * e + 1] = h_hi(f1[e]) + h_hi(g1[e]);
      }
    }
    float bs = 0.f;
#pragma unroll
    for (int e = 0; e < 16; ++e) bs += rr[e] * kd[e] * p.r_k[c0 + e];
    bs = reduce4(bs);
    const u32x4 g0 = *(const u32x4*)(p.G + (size_t)row * 1024 + c0), g1 = *(const u32x4*)(p.G + (size_t)row * 1024 + c0 + 8);
    float o[16];
#pragma unroll
    for (int e = 0; e < 16; ++e) {
      const unsigned gw = e < 8 ? g0[e >> 1] : g1[(e - 8) >> 1];
      const float gg = (e & 1) ? bf_hi(gw) : bf_lo(gw);
      o[e] = ((y[e] - mu) * rstd * p.lnx_w[c0 + e] + p.lnx_b[c0 + e] + bs * vv[e]) * gg;
    }
    u16* dst = p.HB + (size_t)row * 1024 + c0;
    *(u32x4*)dst = (u32x4){pk_bf16(o[0], o[1]), pk_bf16(o[2], o[3]), pk_bf16(o[4], o[5]), pk_bf16(o[6], o[7])};
    *(u32x4*)(dst + 8) = (u32x4){pk_bf16(o[8], o[9]), pk_bf16(o[10], o[11]), pk_bf16(o[12], o[13]), pk_bf16(o[14], o[15])};
  }
}

__device__ void phase_final(CP& p, const Grp& G) {
  const int lane = ltid() & 63;
  const int nw = gridDim.x * 4;
  for (int row = blockIdx.x * 4 + (ltid() >> 6); row < G.M; row += nw) {
    const int s = row / G.L, t = row - s * G.L;
    if (t < 16) continue;
    const float rs = rsqrtf(p.ss3[row] * (1.f / 1024.f) + EPSN);
    const float* hp = p.H + (size_t)row * 1024;
    float* op = G.out + ((size_t)s * G.S + (t - 16)) * 1024;
#pragma unroll
    for (int i = 0; i < 4; ++i) {
      const f32x4 v = *(const f32x4*)(hp + i * 256 + lane * 4);
      const f32x4 g = *(const f32x4*)(p.final_norm + i * 256 + lane * 4);
      *(f32x4*)(op + i * 256 + lane * 4) = (f32x4){v.x * rs * g.x, v.y * rs * g.y, v.z * rs * g.z, v.w * rs * g.w};
    }
  }
}


#define XB_TMO      128
#define XB_XCNT(j)  (256  + 64 * (j))
#define XB_XSUB(j)  (1280 + 64 * (j))
#define XB_XGEN(j)  (2304 + 64 * (j))
#define XB_TOP      3328
#define XB_TOPGEN   3392
#define XCD_BAR_WORDS 3456
#define XB_SPIN_CAP (1u << 18)
__device__ __forceinline__ unsigned xb_ld(unsigned* p) { return __hip_atomic_load(p, __ATOMIC_RELAXED, __HIP_MEMORY_SCOPE_AGENT); }
__device__ __forceinline__ unsigned xb_add(unsigned* p, unsigned v) { return __hip_atomic_fetch_add(p, v, __ATOMIC_RELAXED, __HIP_MEMORY_SCOPE_AGENT); }
__device__ __forceinline__ unsigned xb_xcc_id() { return (unsigned)__builtin_amdgcn_s_getreg((3 << 11) | 20) & 0xFu; }
#define XB_SPIN(cond, bar) do { unsigned _sp = 0; while (cond) { __builtin_amdgcn_s_sleep(1); \
    if ((++_sp & 255u) == 0u) { if (xb_ld(&(bar)[XB_TMO])) break; if (_sp > XB_SPIN_CAP) { atomicAdd(&(bar)[XB_TMO], 1u); break; } } } } while (0)
struct XcdBarrier { unsigned* bar; unsigned x; volatile LAS unsigned* st; };
__device__ __forceinline__ XcdBarrier xcd_barrier_post(unsigned* bar, volatile LAS unsigned* st) {
  XcdBarrier b; b.bar = bar; b.x = xb_xcc_id(); b.st = st;
  if (threadIdx.x == 0) (void)xb_add(&bar[XB_XCNT(b.x)], 1u);
  return b;
}
__device__ __forceinline__ void xcd_barrier_complete(unsigned* bar, unsigned x, unsigned& nloc, unsigned& nx) {
  const unsigned G = gridDim.x * gridDim.y * gridDim.z;
  unsigned sum, cnt, mine, sp = 0u;
  for (;;) {
    sum = 0u; cnt = 0u; mine = 0u;
#pragma unroll
    for (unsigned j = 0; j < 16; ++j) { const unsigned c = xb_ld(&bar[XB_XCNT(j)]); sum += c; cnt += (c > 0u) ? 1u : 0u; mine = (j == x) ? c : mine; }
    if (sum == G) break;
    __builtin_amdgcn_s_sleep(1);
    if ((++sp & 255u) == 0u) { if (xb_ld(&bar[XB_TMO])) break; if (sp > XB_SPIN_CAP) { atomicAdd(&bar[XB_TMO], 1u); break; } }
  }
  nloc = mine > 0u ? mine : 1u; nx = cnt > 0u ? cnt : 1u;
}
__device__ __forceinline__ void xcd_barrier(const XcdBarrier& b) {
  asm volatile("s_waitcnt vmcnt(0)" ::: "memory");
  __syncthreads();
  if (threadIdx.x == 0) {
    unsigned* bar = b.bar;
    __builtin_amdgcn_s_waitcnt(0);
    unsigned nloc = b.st[0], nx = b.st[1];
    if (nloc == 0u) { xcd_barrier_complete(bar, b.x, nloc, nx); b.st[0] = nloc; b.st[1] = nx; }
    const unsigned old = xb_add(&bar[XB_XSUB(b.x)], 1u);
    const unsigned gen = old / nloc;
    if (old + 1u == (gen + 1u) * nloc) {
      __builtin_amdgcn_fence(__ATOMIC_RELEASE, "agent");
      asm volatile("s_waitcnt vmcnt(0)" ::: "memory");
      const unsigned og = xb_add(&bar[XB_TOP], 1u);
      const unsigned tg = og / nx;
      if (og + 1u == (tg + 1u) * nx) xb_add(&bar[XB_TOPGEN], 1u);
      else XB_SPIN(xb_ld(&bar[XB_TOPGEN]) == tg, bar);
      __builtin_amdgcn_fence(__ATOMIC_ACQUIRE, "agent");
      xb_add(&bar[XB_XGEN(b.x)], 1u);
      asm volatile("s_waitcnt vmcnt(0)" ::: "memory");
    } else {
      XB_SPIN(xb_ld(&bar[XB_XGEN(b.x)]) == gen, bar);
      __builtin_amdgcn_fence(__ATOMIC_ACQUIRE, "agent");
      asm volatile("s_waitcnt vmcnt(0)" ::: "memory");
    }
  }
  __syncthreads();
}

__device__ void run_phase(CP& p, int ph, char* lds) {
  if (ph == 0) { phase_prep(p, lds); return; }
  const int g = (ph - 1) / PH_PER_G, k = (ph - 1) - g * PH_PER_G;
  const Grp G = get_grp(p, g);
  const int M = G.M;
  switch (k) {
    case 0: phase_rows(p, G); break;
    case 1:
      gemm_phase(p.HB, 1024, M, p.W1A, 1024, 2 * FFD, lds, [&](const f32x16 (&acc)[2][2], int nb, int tb) { epi_swiglu(acc, nb, tb, M, p.ss0, p.ACT); });
      break;
    case 2:
      gemm_phase(p.ACT, FFD, M, p.WD1, FFD, 1024, lds, [&](const f32x16 (&acc)[2][2], int nb, int tb) { epi_resid<0>(acc, nb, tb, p, G); });
      break;
    case 3:
      gemm_phase(p.HB, 1024, M, p.WIN, 1024, NIN, lds, [&](const f32x16 (&acc)[2][2], int nbase, int tbase) {
        const int lane = ltid() & 63, l32 = lane & 31, h = lane >> 5;
#pragma unroll
        for (int tb = 0; tb < 2; ++tb) {
          const int tok = tbase + tb * 32 + l32;
          if (tok < M) {
            const float rs = rsqrtf(p.ss1[tok] * (1.f / 1024.f) + EPSN);
            if (nbase >= 2048 && nbase < 3072) {
              const int s = tok / G.L, t = tok - s * G.L;
              const int Lp = (G.L + 31) & ~31;
              const int pos = (t & ~12) | ((t & 4) << 1) | ((t & 8) >> 1);
              u16* vt = p.VT + ((size_t)(s * 1024 + (nbase - 2048)) * Lp) + pos;
#pragma unroll
              for (int nb = 0; nb < 2; ++nb)
#pragma unroll
                for (int r = 0; r < 16; ++r) {
                  const int dvl = nb * 32 + 8 * (r >> 2) + 4 * h + (r & 3);
                  vt[(size_t)dvl * Lp] = bf16_1(acc[nb][tb][r] * rs);
                }
            } else {
              u16* dst = p.P + (size_t)tok * NIN + nbase + 4 * h;
#pragma unroll
              for (int nb = 0; nb < 2; ++nb)
#pragma unroll
                for (int i = 0; i < 4; ++i)
                  *(u32x2*)(dst + nb * 32 + 8 * i) = (u32x2){pk_bf16(acc[nb][tb][4 * i] * rs, acc[nb][tb][4 * i + 1] * rs),
                                                             pk_bf16(acc[nb][tb][4 * i + 2] * rs, acc[nb][tb][4 * i + 3] * rs)};
            }
          }
        }
      });
      break;
    case 4: phase_mix(p, G); break;
    case 5:
      gemm_phase(p.F, 384, M, p.W2F, 64, 1024, lds, [&](const f32x16 (&acc)[2][2], int nb, int tb) { epi_decay(acc, nb, tb, M, p.rw_w0, p.DIR0); });
      gemm_phase(p.F + 64, 384, M, p.W2B, 64, 1024, lds, [&](const f32x16 (&acc)[2][2], int nb, int tb) { epi_decay(acc, nb, tb, M, p.rw_w0 + 1024, p.DIR1); });
      gemm_phase(p.F + 128, 384, M, p.A2F, 64, 1024, lds, [&](const f32x16 (&acc)[2][2], int nb, int tb) { epi_adir(acc, nb, tb, M, p, 0); });
      gemm_phase(p.F + 192, 384, M, p.A2B, 64, 1024, lds, [&](const f32x16 (&acc)[2][2], int nb, int tb) { epi_adir(acc, nb, tb, M, p, 1); });
      gemm_phase(p.F + 256, 384, M, p.G2T, 128, 1024, lds, [&](const f32x16 (&acc)[2][2], int nbase, int tbase) {
        const int lane = ltid() & 63, l32 = lane & 31, h = lane >> 5;
#pragma unroll
        for (int tb = 0; tb < 2; ++tb) {
          const int tok = tbase + tb * 32 + l32;
          if (tok < M) {
            u16* dst = p.G + (size_t)tok * 1024 + nbase + 4 * h;
#pragma unroll
            for (int nb = 0; nb < 2; ++nb)
#pragma unroll
              for (int i = 0; i < 4; ++i)
                *(u32x2*)(dst + nb * 32 + 8 * i) = (u32x2){pk_bf16(acc[nb][tb][4 * i], acc[nb][tb][4 * i + 1]), pk_bf16(acc[nb][tb][4 * i + 2], acc[nb][tb][4 * i + 3])};
          }
        }
      });
      break;
    case 6: phase_mixer(p, G, g, lds); break;
    case 7: phase_post(p, G); break;
    case 8: {
      const int nN = 8, nM = (M + 127) >> 7, nt = nN * nM;
      const int wave = ltid() >> 6;
      const int lane = ltid() & 63, l32 = lane & 31, h = lane >> 5;
      const int xcd = blockIdx.x & 7, g8 = gridDim.x >> 3;
      const int tq = nt >> 3, trm = nt & 7;
      const int tstart = xcd < trm ? xcd * (tq + 1) : trm * (tq + 1) + (xcd - trm) * tq;
      const int tcnt = tq + (xcd < trm ? 1 : 0);
      for (int off = blockIdx.x >> 3; off < tcnt; off += g8) {
        const int id = tstart + off, nig = 8 * nN, grp = id / nig, fm = grp * 8;
        const int gsz = (nM - fm) < 8 ? (nM - fm) : 8, idl = id - grp * nig;
        const int tm = fm + idl % gsz, tn = idl / gsz;
        const int nbase = tn * 128 + (wave & 1) * 64, tbase = tm * 128 + (wave >> 1) * 64;
#pragma unroll 1
        for (int pass = 0; pass < 2; ++pass) {
          f32x16 acc[2][2];
          zero_acc(acc);
          gemm_kloop(acc, pass ? p.HB : p.O, 1024, M, tm * 128, pass ? p.WRW : p.WATT, 1024, tn * 128, 1024, lds);
#pragma unroll
          for (int tb = 0; tb < 2; ++tb) {
            const int tok = tbase + tb * 32 + l32;
            if (tok < M) {
              const u16* gp = p.P + (size_t)tok * NIN + 6528 + pass * 1024 + nbase + 4 * h;
              u16* dst = p.MERGED + (size_t)tok * 1024 + nbase + 4 * h;
#pragma unroll
              for (int nb = 0; nb < 2; ++nb)
#pragma unroll
                for (int i = 0; i < 4; ++i) {
                  const u32x2 ga = *(const u32x2*)(gp + nb * 32 + 8 * i);
                  float o0 = sigm(bf_lo(ga.x)) * acc[nb][tb][4 * i];
                  float o1 = sigm(bf_hi(ga.x)) * acc[nb][tb][4 * i + 1];
                  float o2 = sigm(bf_lo(ga.y)) * acc[nb][tb][4 * i + 2];
                  float o3 = sigm(bf_hi(ga.y)) * acc[nb][tb][4 * i + 3];
                  if (pass) {
                    const u32x2 pv = *(const u32x2*)(dst + nb * 32 + 8 * i);
                    o0 += bf_lo(pv.x); o1 += bf_hi(pv.x); o2 += bf_lo(pv.y); o3 += bf_hi(pv.y);
                  }
                  *(u32x2*)(dst + nb * 32 + 8 * i) = (u32x2){pk_bf16(o0, o1), pk_bf16(o2, o3)};
                }
            }
          }
        }
      }
    } break;
    case 9:
      gemm_phase(p.MERGED, 1024, M, p.WOUT, 1024, 1024, lds, [&](const f32x16 (&acc)[2][2], int nb, int tb) { epi_resid<1>(acc, nb, tb, p, G); });
      break;
    case 10:
      gemm_phase(p.HB, 1024, M, p.W2A, 1024, 2 * FFD, lds, [&](const f32x16 (&acc)[2][2], int nb, int tb) { epi_swiglu(acc, nb, tb, M, p.ss2, p.ACT); });
      break;
    case 11:
      gemm_phase(p.ACT, FFD, M, p.WD2, FFD, 1024, lds, [&](const f32x16 (&acc)[2][2], int nb, int tb) { epi_resid<2>(acc, nb, tb, p, G); });
      break;
    case 12: phase_final(p, G); break;
  }
}

__global__ void __launch_bounds__(256, 2) mega(Params p, int ph_lo, int ph_hi, int coop) {
  __shared__ __attribute__((aligned(16))) char lds[65536];
  __shared__ uint4 xb_words;
  CP* pp = (CP*)__builtin_amdgcn_kernarg_segment_ptr();
  asm volatile("" : "+s"(pp));
  if (threadIdx.x == 0) xb_words = make_uint4(0u, 0u, 0u, 0u);
  __syncthreads();
  const XcdBarrier xb = xcd_barrier_post(pp->bar, (volatile LAS unsigned*)&xb_words);
  for (int ph = ph_lo; ph < ph_hi; ++ph) {
    run_phase(*pp, ph, lds);
    if (coop && ph + 1 < ph_hi) {
      if (ph == 0) cg::this_grid().sync();
      else xcd_barrier(xb);
    }
  }
}

extern "C" void kernel_launch(void* const* d_in, const int* in_sizes, int n_in, void* d_out, int out_size, void* d_ws,
                              size_t ws_size, hipStream_t stream) {
  Params p;
  memset(&p, 0, sizeof(p));
  const float** f = (const float**)&p;
  for (int i = 0; i < 35; ++i) f[i] = (const float*)d_in[i];
  p.out = (float*)d_out;
  char* w = (char*)d_ws;
  size_t off = 0;
  auto alloc = [&](size_t bytes) { char* r = w + off; off += (bytes + 255) & ~(size_t)255; return r; };
  p.W1A = (u16*)alloc((size_t)2 * FFD * 1024 * 2);
  p.WD1 = (u16*)alloc((size_t)1024 * FFD * 2);
  p.WIN = (u16*)alloc((size_t)NIN * 1024 * 2);
  p.WATT = (u16*)alloc((size_t)1024 * 1024 * 2);
  p.WRW = (u16*)alloc((size_t)1024 * 1024 * 2);
  p.WOUT = (u16*)alloc((size_t)1024 * 1024 * 2);
  p.W2A = (u16*)alloc((size_t)2 * FFD * 1024 * 2);
  p.WD2 = (u16*)alloc((size_t)1024 * FFD * 2);
  p.W2F = (u16*)alloc((size_t)1024 * 64 * 2);
  p.W2B = (u16*)alloc((size_t)1024 * 64 * 2);
  p.A2F = (u16*)alloc((size_t)1024 * 64 * 2);
  p.A2B = (u16*)alloc((size_t)1024 * 64 * 2);
  p.G2T = (u16*)alloc((size_t)1024 * 128 * 2);
  p.lut = (float*)alloc(8 * 512 * 4);
  p.cnt = (int*)alloc(256);
  p.lam = (float*)alloc(256);
  p.bar = (unsigned*)alloc(XCD_BAR_WORDS * 4);
  const size_t R = MAXROWS;
  p.H = (float*)alloc(R * 1024 * 4);
  p.HB = (u16*)alloc(R * 1024 * 2);
  p.ACT = (u16*)alloc(R * FFD * 2);
  p.Y0 = p.ACT;
  p.Y1 = p.ACT + R * 1024;
  p.F = p.ACT + R * 2048;
  p.P = (u16*)alloc(R * NIN * 2);
  p.RKV = (u16*)alloc(R * 16 * 192 * 2);
  p.DIR0 = (u16*)alloc(R * 16 * 192 * 2);
  p.DIR1 = (u16*)alloc(R * 16 * 192 * 2);
  p.G = (u16*)alloc(R * 1024 * 2);
  p.O = (u16*)alloc(R * 1024 * 2);
  p.MERGED = (u16*)alloc(R * 1024 * 2);
  p.VT = (u16*)alloc((size_t)8 * 8 * 128 * 2080 * 2);
  p.ss0 = (float*)alloc(R * 4);
  p.ss1 = (float*)alloc(R * 4);
  p.ss2 = (float*)alloc(R * 4);
  p.ss3 = (float*)alloc(R * 4);
  if (off > ws_size) { fprintf(stderr, "workspace too small: need %zu have %zu\n", off, ws_size); return; }
  static int grid_blocks = 0;
  if (!grid_blocks) {
    int dev = 0, cus = 0, per_cu = 0;
    hipGetDevice(&dev);
    hipDeviceGetAttribute(&cus, hipDeviceAttributeMultiprocessorCount, dev);
    hipOccupancyMaxActiveBlocksPerMultiprocessor(&per_cu, mega, 256, 0);
    per_cu = 2;
    grid_blocks = cus * per_cu;
  }
  hipMemsetAsync(p.bar, 0, XCD_BAR_WORDS * 4, stream);
  int ph_lo = 0, ph_hi = NPHASES, coop = 1;
  void* args[] = {&p, &ph_lo, &ph_hi, &coop};
  hipError_t e = hipLaunchCooperativeKernel((void*)mega, dim3(grid_blocks), dim3(256), args, 0, stream);
  if (e != hipSuccess) fprintf(stderr, "cooperative launch failed: %s (grid %d)\n", hipGetErrorString(e), grid_blocks);
}
```

```cpp
#include <hip/hip_runtime.h>
#include <hip/hip_cooperative_groups.h>
#include <stdint.h>
#include <string.h>
#include <stdio.h>
namespace cg = cooperative_groups;

typedef unsigned short u16;
typedef short bf16x8 __attribute__((ext_vector_type(8)));
typedef float f32x16 __attribute__((ext_vector_type(16)));
typedef float f32x4 __attribute__((ext_vector_type(4)));
typedef float f32x2 __attribute__((ext_vector_type(2)));
typedef unsigned u32x4 __attribute__((ext_vector_type(4)));
typedef unsigned u32x2 __attribute__((ext_vector_type(2)));
typedef __bf16 bf16x2_t __attribute__((ext_vector_type(2)));
typedef _Float16 f16x2_t __attribute__((ext_vector_type(2)));

#define NIN 8576
#define FFD 2816
#define EPSN 1e-6f
#define LOG2E 1.4426950408889634f
#define NGROUPS 6
#define PH_PER_G 13
#define NMETA_PH 4
#define NPHASES (1 + NMETA_PH + NGROUPS * PH_PER_G)
#define MAXROWS 16512

struct Params {
  const float *x_prompt, *x_sample, *meta, *rel_bias, *ffn1_norm, *ffn1_wg, *ffn1_wu, *ffn1_wd, *mix_norm, *w_in;
  const float *lq1, *lk1, *lq2, *lk2, *subln, *w_attn, *mu_prev, *mu_next, *rw_w0, *rw_w2, *rw_a0, *rw_a2, *rw_g2;
  const float *k_k, *k_a, *r_k, *lnx_w, *lnx_b, *w_rw, *w_out, *ffn2_norm, *ffn2_wg, *ffn2_wu, *ffn2_wd, *final_norm;
  float* out;
  u16 *W1A, *WD1, *WIN, *WATT, *WRW, *WOUT, *W2A, *WD2, *W2F, *W2B, *A2F, *A2B, *G2T;
  float* lut; int* cnt; float* lam; unsigned* bar; u16* VT; u16* PM;
  float* H; u16 *HB, *ACT, *P, *RKV, *DIR0, *DIR1, *G, *O, *MERGED, *Y0, *Y1, *F;
  float *ss0, *ss1, *ss2, *ss3;
};

typedef const Params __attribute__((address_space(4))) CP;
struct Grp { int nseq, L, S, lgS, M, Mx, meta; const float* x; float* out; };
__device__ __forceinline__ int rowof(const Grp& G, int s, int t) { return t < 16 ? G.Mx + s * 16 + t : s * G.S + (t - 16); }

__device__ __forceinline__ Grp get_grp(CP& p, int g) {
  Grp r;
  r.meta = 0;
  if (g < 0) {
    r.nseq = 1; r.L = 16; r.S = 16; r.lgS = 4; r.x = p.meta; r.out = nullptr; r.M = 16; r.Mx = 16; r.meta = 1;
    return r;
  }
  if (g < 4) { r.nseq = 4; r.L = 4112; r.S = 4096; r.lgS = 12; r.x = p.x_prompt + (size_t)g * 4 * 4096 * 1024; r.out = p.out + (size_t)g * 4 * 4096 * 1024; }
  else { r.nseq = 8; r.L = 2064; r.S = 2048; r.lgS = 11; r.x = p.x_sample + (size_t)(g - 4) * 8 * 2048 * 1024; r.out = p.out + (size_t)16 * 4096 * 1024 + (size_t)(g - 4) * 8 * 2048 * 1024; }
  r.M = r.nseq * r.L;
  r.Mx = r.nseq * r.S;
  return r;
}

__device__ __forceinline__ int ltid() { int t = threadIdx.x; asm volatile("" : "+v"(t)); return t; }
__device__ __forceinline__ unsigned pk_bf16(float a, float b) {
  f32x2 v = {a, b};
  bf16x2_t r = __builtin_convertvector(v, bf16x2_t);
  return __builtin_bit_cast(unsigned, r);
}
__device__ __forceinline__ float bf_lo(unsigned u) { return __uint_as_float(u << 16); }
__device__ __forceinline__ float bf_hi(unsigned u) { return __uint_as_float(u & 0xffff0000u); }
__device__ __forceinline__ unsigned pk_f16(float a, float b) {
  f32x2 v = {a, b};
  f16x2_t r = __builtin_convertvector(v, f16x2_t);
  return __builtin_bit_cast(unsigned, r);
}
__device__ __forceinline__ float h_lo(unsigned u) { f16x2_t r = __builtin_bit_cast(f16x2_t, u); return (float)r.x; }
__device__ __forceinline__ float h_hi(unsigned u) { f16x2_t r = __builtin_bit_cast(f16x2_t, u); return (float)r.y; }
__device__ __forceinline__ u16 bf16_1(float a) { return (u16)(pk_bf16(a, 0.f) & 0xffffu); }
__device__ __forceinline__ float sigm(float x) { return __builtin_amdgcn_rcpf(1.f + __builtin_amdgcn_exp2f(-LOG2E * x)); }
__device__ __forceinline__ float wave_sum(float v) {
#pragma unroll
  for (int o = 32; o > 0; o >>= 1) v += __shfl_xor(v, o);
  return v;
}
template <int CTRL> __device__ __forceinline__ float dppf(float x) {
  return __int_as_float(__builtin_amdgcn_update_dpp(0, __float_as_int(x), CTRL, 0xf, 0xf, true));
}
__device__ __forceinline__ float reduce8(float x) {
  x += dppf<0xB1>(x);
  x += dppf<0x4E>(x);
  x += dppf<0x141>(x);
  return x;
}
__device__ __forceinline__ float reduce4(float x) {
  x += dppf<0xB1>(x);
  x += dppf<0x4E>(x);
  return x;
}

__device__ void prep_transpose(const float* __restrict__ src, int K, int N, u16* __restrict__ dst,
                               const float* __restrict__ gain, int mode, char* lds) {
  float* tile = (float*)lds;
  const int tn = N / 64, nt = (K / 64) * tn;
  const int tid = ltid();
  for (int t = blockIdx.x; t < nt; t += gridDim.x) {
    const int k0 = (t / tn) * 64, n0 = (t % tn) * 64;
    const int nl = tid & 63, kq = tid >> 6;
#pragma unroll
    for (int i = 0; i < 16; ++i) {
      const int k = i * 4 + kq;
      float v = src[(size_t)(k0 + k) * N + n0 + nl];
      if (gain) v *= gain[k0 + k];
      tile[k * 65 + nl] = v;
    }
    __syncthreads();
    const int n = tid >> 2, kk = (tid & 3) * 16;
    unsigned w[8];
#pragma unroll
    for (int i = 0; i < 8; ++i) w[i] = pk_bf16(tile[(kk + 2 * i) * 65 + n], tile[(kk + 2 * i + 1) * 65 + n]);
    const int ng = n0 + n;
    const int row = mode == 0 ? ng : ((ng >> 5) * 64 + (ng & 31) + (mode == 2 ? 32 : 0));
    u32x4* d = (u32x4*)(dst + (size_t)row * K + k0 + kk);
    d[0] = (u32x4){w[0], w[1], w[2], w[3]};
    d[1] = (u32x4){w[4], w[5], w[6], w[7]};
    __syncthreads();
  }
}

__device__ void phase_prep(CP& p, char* lds) {
  if (blockIdx.x == 0) {
    const int tid = ltid();
    for (int idx = tid; idx < 8 * 511; idx += 256) {
      const int hd = idx / 511, di = idx - hd * 511, d = di - 255;
      const int n = d < 0 ? -d : d;
      int bk;
      if (n < 8) bk = n;
      else {
        const float nf = (float)n;
        int large = 8 + (int)(logf(nf / 8.0f) / 2.772588722239781f * 8.0f);
        bk = large < 15 ? large : 15;
      }
      const int bucket = (d > 0 ? 16 : 0) + bk;
      p.lut[hd * 512 + di] = p.rel_bias[bucket * 8 + hd] * LOG2E;
    }
    if (tid == 0) {
      float s1 = 0.f, s2 = 0.f;
      for (int i = 0; i < 64; ++i) { s1 += p.lq1[i] * p.lk1[i]; s2 += p.lq2[i] * p.lk2[i]; }
      p.lam[0] = expf(s1) - expf(s2) + 0.2f;
    }
  }
  prep_transpose(p.ffn1_wg, 1024, FFD, p.W1A, p.ffn1_norm, 1, lds);
  prep_transpose(p.ffn1_wu, 1024, FFD, p.W1A, p.ffn1_norm, 2, lds);
  prep_transpose(p.ffn1_wd, FFD, 1024, p.WD1, nullptr, 0, lds);
  prep_transpose(p.w_in, 1024, NIN, p.WIN, p.mix_norm, 0, lds);
  prep_transpose(p.w_attn, 1024, 1024, p.WATT, nullptr, 0, lds);
  prep_transpose(p.w_rw, 1024, 1024, p.WRW, nullptr, 0, lds);
  prep_transpose(p.w_out, 1024, 1024, p.WOUT, nullptr, 0, lds);
  prep_transpose(p.ffn2_wg, 1024, FFD, p.W2A, p.ffn2_norm, 1, lds);
  prep_transpose(p.ffn2_wu, 1024, FFD, p.W2A, p.ffn2_norm, 2, lds);
  prep_transpose(p.ffn2_wd, FFD, 1024, p.WD2, nullptr, 0, lds);
  prep_transpose(p.rw_w2, 64, 1024, p.W2F, nullptr, 0, lds);
  prep_transpose(p.rw_w2 + 64 * 1024, 64, 1024, p.W2B, nullptr, 0, lds);
  prep_transpose(p.rw_a2, 64, 1024, p.A2F, nullptr, 0, lds);
  prep_transpose(p.rw_a2 + 64 * 1024, 64, 1024, p.A2B, nullptr, 0, lds);
  prep_transpose(p.rw_g2, 128, 1024, p.G2T, nullptr, 0, lds);
}

__device__ void phase_rows(CP& p, const Grp& G) {
  const int lane = ltid() & 63;
  const int nw = gridDim.x * 4;
  const int gw = blockIdx.x * 4 + (ltid() >> 6);
  for (int row = gw; row < G.Mx; row += nw) {
    const float* src = G.x + (size_t)row * 1024;
    float ss = 0.f;
#pragma unroll
    for (int i = 0; i < 4; ++i) {
      const f32x4 v = *(const f32x4*)(src + i * 256 + lane * 4);
      ss += v.x * v.x + v.y * v.y + v.z * v.z + v.w * v.w;
      u32x2 o = {pk_bf16(v.x, v.y), pk_bf16(v.z, v.w)};
      *(u32x2*)(p.HB + (size_t)row * 1024 + i * 256 + lane * 4) = o;
    }
    ss = wave_sum(ss);
    if (lane == 0) { p.ss0[row] = ss; p.ss1[row] = 0.f; p.ss2[row] = 0.f; p.ss3[row] = 0.f; }
  }
  if (G.meta) return;
  const int Lp = (G.L + 31) & ~31;
  for (int r = gw; r < G.nseq * 16; r += nw) {
    const int s = r >> 4, t = r & 15;
    const u16* srcp = p.PM + (size_t)t * NIN;
    u16* dstp = p.P + (size_t)(G.Mx + r) * NIN;
    for (int c = lane * 8; c < NIN; c += 512)
      if (c < 2048 || c >= 3072) *(u32x4*)(dstp + c) = *(const u32x4*)(srcp + c);
    const int pos = (t & ~12) | ((t & 4) << 1) | ((t & 8) >> 1);
    for (int c = lane; c < 1024; c += 64) p.VT[(size_t)(s * 1024 + c) * Lp + pos] = srcp[2048 + c];
  }
}

#define LAS __attribute__((address_space(3)))
#define XB_TMO      128
#define XB_XCNT(j)  (256  + 64 * (j))
#define XB_XSUB(j)  (1280 + 64 * (j))
#define XB_XGEN(j)  (2304 + 64 * (j))
#define XB_TOP      3328
#define XB_TOPGEN   3392
#define XCD_BAR_WORDS 3456
#define XB_SPIN_CAP (1u << 18)
__device__ __forceinline__ unsigned xb_ld(unsigned* p) { return __hip_atomic_load(p, __ATOMIC_RELAXED, __HIP_MEMORY_SCOPE_AGENT); }
__device__ __forceinline__ unsigned xb_add(unsigned* p, unsigned v) { return __hip_atomic_fetch_add(p, v, __ATOMIC_RELAXED, __HIP_MEMORY_SCOPE_AGENT); }
__device__ __forceinline__ unsigned xb_xcc_id() { return (unsigned)__builtin_amdgcn_s_getreg((3 << 11) | 20) & 0xFu; }
#define XB_SPIN(cond, bar) do { unsigned _sp = 0; while (cond) { __builtin_amdgcn_s_sleep(1); \
    if ((++_sp & 255u) == 0u) { if (xb_ld(&(bar)[XB_TMO])) break; if (_sp > XB_SPIN_CAP) { atomicAdd(&(bar)[XB_TMO], 1u); break; } } } } while (0)
struct XcdBarrier { unsigned* bar; unsigned x; volatile LAS unsigned* st; };
__device__ __forceinline__ XcdBarrier xcd_barrier_post(unsigned* bar, volatile LAS unsigned* st) {
  XcdBarrier b; b.bar = bar; b.x = xb_xcc_id(); b.st = st;
  if (threadIdx.x == 0) (void)xb_add(&bar[XB_XCNT(b.x)], 1u);
  return b;
}
__device__ __forceinline__ void xcd_barrier_complete(unsigned* bar, unsigned x, unsigned& nloc, unsigned& nx) {
  const unsigned G = gridDim.x * gridDim.y * gridDim.z;
  unsigned sum, cnt, mine, sp = 0u;
  for (;;) {
    sum = 0u; cnt = 0u; mine = 0u;
#pragma unroll
    for (unsigned j = 0; j < 16; ++j) { const unsigned c = xb_ld(&bar[XB_XCNT(j)]); sum += c; cnt += (c > 0u) ? 1u : 0u; mine = (j == x) ? c : mine; }
    if (sum == G) break;
    __builtin_amdgcn_s_sleep(1);
    if ((++sp & 255u) == 0u) { if (xb_ld(&bar[XB_TMO])) break; if (sp > XB_SPIN_CAP) { atomicAdd(&bar[XB_TMO], 1u); break; } }
  }
  nloc = mine > 0u ? mine : 1u; nx = cnt > 0u ? cnt : 1u;
}
__device__ __forceinline__ void xcd_barrier(const XcdBarrier& b) {
  asm volatile("s_waitcnt vmcnt(0)" ::: "memory");
  __syncthreads();
  if (threadIdx.x == 0) {
    unsigned* bar = b.bar;
    __builtin_amdgcn_s_waitcnt(0);
    unsigned nloc = b.st[0], nx = b.st[1];
    if (nloc == 0u) { xcd_barrier_complete(bar, b.x, nloc, nx); b.st[0] = nloc; b.st[1] = nx; }
    const unsigned old = xb_add(&bar[XB_XSUB(b.x)], 1u);
    const unsigned gen = old / nloc;
    if (old + 1u == (gen + 1u) * nloc) {
      __builtin_amdgcn_fence(__ATOMIC_RELEASE, "agent");
      asm volatile("s_waitcnt vmcnt(0)" ::: "memory");
      const unsigned og = xb_add(&bar[XB_TOP], 1u);
      const unsigned tg = og / nx;
      if (og + 1u == (tg + 1u) * nx) xb_add(&bar[XB_TOPGEN], 1u);
      else XB_SPIN(xb_ld(&bar[XB_TOPGEN]) == tg, bar);
      __builtin_amdgcn_fence(__ATOMIC_ACQUIRE, "agent");
      xb_add(&bar[XB_XGEN(b.x)], 1u);
      asm volatile("s_waitcnt vmcnt(0)" ::: "memory");
    } else {
      XB_SPIN(xb_ld(&bar[XB_XGEN(b.x)]) == gen, bar);
      __builtin_amdgcn_fence(__ATOMIC_ACQUIRE, "agent");
      asm volatile("s_waitcnt vmcnt(0)" ::: "memory");
    }
  }
  __syncthreads();
}

#define LAS __attribute__((address_space(3)))
#define LAS __attribute__((address_space(3)))
#define LAS __attribute__((address_space(3)))
__device__ __forceinline__ void glds16(const void* gsrc, unsigned lds_dst) {
  unsigned keep;
  asm volatile("s_mov_b32 %0, m0\n\ts_mov_b32 m0, %2\n\ts_nop 0\n\tglobal_load_lds_dwordx4 %1, off\n\ts_mov_b32 m0, %0" : "=&s"(keep) : "v"(gsrc), "s"(lds_dst) : "memory");
}
struct GemmCtx {
  const u16* ap[2];
  const u16* wp[2];
  int wro[2], wsw[2], aro[2], asw[2];
  unsigned lds0;
  int tid, h;
};
__device__ __forceinline__ void g_init(GemmCtx& c, char* lds) {
  const int tid = ltid(), lane = tid & 63, wave = tid >> 6;
  const int wn = wave & 1, wt = wave >> 1, l32 = lane & 31;
  c.tid = tid; c.h = lane >> 5;
#pragma unroll
  for (int b = 0; b < 2; ++b) {
    const int wr = wn * 64 + b * 32 + l32, ar = wt * 64 + b * 32 + l32;
    c.wro[b] = wr * 64; c.wsw[b] = (wr >> 2) & 3;
    c.aro[b] = 8192 + ar * 64; c.asw[b] = (ar >> 2) & 3;
  }
  c.lds0 = __builtin_amdgcn_readfirstlane((unsigned)(uintptr_t)(LAS char*)lds + wave * 1024);
}
__device__ __forceinline__ void g_tile(GemmCtx& c, const u16* __restrict__ A, int lda, int M, int m0, const u16* __restrict__ W, int ldw, int n0) {
#pragma unroll
  for (int i = 0; i < 2; ++i) {
    const int q = c.tid + 256 * i, row = q >> 2, ch = (q & 3) ^ ((row >> 2) & 3);
    int ar = m0 + row; ar = ar < M ? ar : M - 1;
    c.ap[i] = A + (size_t)ar * lda + ch * 8;
    c.wp[i] = W + (size_t)(n0 + row) * ldw + ch * 8;
  }
}
__device__ __forceinline__ void g_stage(const GemmCtx& c, int kt) {
  const unsigned sb = c.lds0 + (kt & 3) * 16384;
#pragma unroll
  for (int i = 0; i < 2; ++i) {
    glds16(c.wp[i] + kt * 32, sb + i * 4096);
    glds16(c.ap[i] + kt * 32, sb + 8192 + i * 4096);
  }
}
__device__ __forceinline__ void g_prologue(const GemmCtx& c, int nk) {
#pragma unroll
  for (int s = 0; s < 3; ++s)
    if (s < nk) g_stage(c, s);
}
struct Frags { bf16x8 w[2][2], a[2][2]; };
__device__ __forceinline__ void g_read(Frags& f, const GemmCtx& c, int kt, const char* lds) {
  const char* st = lds + (kt & 3) * 16384;
#pragma unroll
  for (int ks = 0; ks < 2; ++ks)
#pragma unroll
    for (int b = 0; b < 2; ++b) {
      f.w[ks][b] = *(const bf16x8*)(st + c.wro[b] + (((ks * 2 + c.h) ^ c.wsw[b]) << 4));
      f.a[ks][b] = *(const bf16x8*)(st + c.aro[b] + (((ks * 2 + c.h) ^ c.asw[b]) << 4));
    }
}
__device__ __forceinline__ void g_mma(f32x16 (&acc)[2][2], const Frags& f) {
#pragma unroll
  for (int ks = 0; ks < 2; ++ks)
#pragma unroll
    for (int nb = 0; nb < 2; ++nb)
#pragma unroll
      for (int tb = 0; tb < 2; ++tb)
        acc[nb][tb] = __builtin_amdgcn_mfma_f32_32x32x16_bf16(f.w[ks][nb], f.a[ks][tb], acc[nb][tb], 0, 0, 0);
}
__device__ __forceinline__ void g_wait(int ks_needed, int issued_hi, bool drain_all) {
  const int allowed = issued_hi - ks_needed;
  if (drain_all || allowed <= 0) asm volatile("s_waitcnt vmcnt(0) lgkmcnt(0)" ::: "memory");
  else if (allowed == 1) asm volatile("s_waitcnt vmcnt(4) lgkmcnt(0)" ::: "memory");
  else asm volatile("s_waitcnt vmcnt(8) lgkmcnt(0)" ::: "memory");
  __builtin_amdgcn_s_barrier();
}
__device__ __forceinline__ void g_main(f32x16 (&acc)[2][2], const GemmCtx& c, int nk, char* lds) {
  Frags f0, f1;
  g_wait(0, nk - 1 < 2 ? nk - 1 : 2, true);
  if (3 < nk) g_stage(c, 3);
  g_read(f0, c, 0, lds);
  for (int kt = 0; kt < nk; kt += 2) {
    {
      const int hi = (kt + 3 < nk - 1) ? kt + 3 : nk - 1;
      g_wait(kt + 1, hi, false);
      if (kt + 4 < nk) g_stage(c, kt + 4);
      g_read(f1, c, kt + 1, lds);
      g_mma(acc, f0);
    }
    if (kt + 2 < nk) {
      const int hi = (kt + 4 < nk - 1) ? kt + 4 : nk - 1;
      g_wait(kt + 2, hi, false);
      if (kt + 5 < nk) g_stage(c, kt + 5);
      g_read(f0, c, kt + 2, lds);
    }
    g_mma(acc, f1);
  }
}
__device__ __forceinline__ void gemm_kloop(f32x16 (&acc)[2][2], const u16* __restrict__ A, int lda, int M, int m0,
                                           const u16* __restrict__ W, int ldw, int n0, int K, char* lds) {
  GemmCtx c;
  g_init(c, lds);
  g_tile(c, A, lda, M, m0, W, ldw, n0);
  asm volatile("s_waitcnt vmcnt(0)" ::: "memory");
  __builtin_amdgcn_s_barrier();
  g_prologue(c, K >> 5);
  g_main(acc, c, K >> 5, lds);
}

__device__ __forceinline__ void zero_acc(f32x16 (&acc)[2][2]) {
#pragma unroll
  for (int a = 0; a < 2; ++a)
#pragma unroll
    for (int b = 0; b < 2; ++b)
#pragma unroll
      for (int r = 0; r < 16; ++r) acc[a][b][r] = 0.f;
}

template <class F>
__device__ __forceinline__ void gemm_phase(const u16* A, int lda, int M, const u16* W, int K, int N, char* lds, int* ctr, F&& epi) {
  const int nN = N >> 7, nM = (M + 127) >> 7, nt = nN * nM, nk = K >> 5;
  const int xcd = (int)xb_xcc_id() & 7;
  const int tq = nt >> 3, trm = nt & 7;
  const int tstart = xcd < trm ? xcd * (tq + 1) : trm * (tq + 1) + (xcd - trm) * tq;
  const int tcnt = tq + (xcd < trm ? 1 : 0);
  auto decode = [&](int off, int& tm, int& tn) {
    const int id = tstart + off, nig = 8 * nN, grp = id / nig, fm = grp * 8;
    const int gsz = (nM - fm) < 8 ? (nM - fm) : 8, idl = id - grp * nig;
    tm = fm + idl % gsz; tn = idl / gsz;
  };
  GemmCtx c;
  g_init(c, lds);
  const int wave = c.tid >> 6;
  volatile int* bw = (volatile int*)(lds + 65536);
  int* myctr = ctr + xcd;
  int par = 0;
  if (c.tid == 0) bw[2] = atomicAdd(myctr, 1);
  asm volatile("s_waitcnt vmcnt(0) lgkmcnt(0)" ::: "memory");
  __builtin_amdgcn_s_barrier();
  int off = bw[2];
  int tm = 0, tn = 0;
  if (off < tcnt) { decode(off, tm, tn); g_tile(c, A, lda, M, tm * 128, W, K, tn * 128); g_prologue(c, nk); }
  while (off < tcnt) {
    f32x16 acc[2][2];
    zero_acc(acc);
    g_main(acc, c, nk, lds);
    const int ctm = tm, ctn = tn;
    par ^= 1;
    if (c.tid == 0) bw[2 + par] = atomicAdd(myctr, 1);
    asm volatile("s_waitcnt lgkmcnt(0)" ::: "memory");
    __builtin_amdgcn_s_barrier();
    off = bw[2 + par];
    if (off < tcnt) { decode(off, tm, tn); g_tile(c, A, lda, M, tm * 128, W, K, tn * 128); g_prologue(c, nk); }
    epi(acc, ctn * 128 + (wave & 1) * 64, ctm * 128 + (wave >> 1) * 64);
  }
}

__device__ __forceinline__ void epi_swiglu(const f32x16 (&acc)[2][2], int nbase, int tbase, int M, const float* ss, u16* ACT) {
  const int lane = ltid() & 63, l32 = lane & 31, h = lane >> 5;
  const int cb = (nbase >> 6) * 32;
#pragma unroll
  for (int tb = 0; tb < 2; ++tb) {
    const int tok = tbase + tb * 32 + l32;
    if (tok < M) {
      const float rs = rsqrtf(ss[tok] * (1.f / 1024.f) + EPSN);
      u16* dst = ACT + (size_t)tok * FFD + cb + 4 * h;
#pragma unroll
      for (int i = 0; i < 4; ++i) {
        float o[4];
#pragma unroll
        for (int j = 0; j < 4; ++j) {
          const float g = acc[0][tb][4 * i + j] * rs, u = acc[1][tb][4 * i + j] * rs;
          o[j] = g * sigm(g) * u;
        }
        *(u32x2*)(dst + 8 * i) = (u32x2){pk_bf16(o[0], o[1]), pk_bf16(o[2], o[3])};
      }
    }
  }
}

template <int MODE>
__device__ __forceinline__ void epi_resid(const f32x16 (&acc)[2][2], int nbase, int tbase, CP& p, const Grp& G) {
  const int lane = ltid() & 63, l32 = lane & 31, h = lane >> 5;
  const float scale = MODE == 1 ? 1.f : 0.5f;
  float* ssout = MODE == 0 ? p.ss1 : (MODE == 1 ? p.ss2 : p.ss3);
#pragma unroll
  for (int tb = 0; tb < 2; ++tb) {
    const int tok = tbase + tb * 32 + l32;
    const bool valid = tok < G.Mx;
    float sq = 0.f;
    if (valid) {
      float* hp = p.H + (size_t)tok * 1024;
      const float* rp = hp;
      if (MODE == 0) {
        rp = G.x + (size_t)tok * 1024;
      }
#pragma unroll
      for (int nb = 0; nb < 2; ++nb)
#pragma unroll
        for (int i = 0; i < 4; ++i) {
          const int n = nbase + nb * 32 + 8 * i + 4 * h;
          const f32x4 r = *(const f32x4*)(rp + n);
          f32x4 v;
          v.x = r.x + scale * acc[nb][tb][4 * i + 0];
          v.y = r.y + scale * acc[nb][tb][4 * i + 1];
          v.z = r.z + scale * acc[nb][tb][4 * i + 2];
          v.w = r.w + scale * acc[nb][tb][4 * i + 3];
          *(f32x4*)(hp + n) = v;
          sq += v.x * v.x + v.y * v.y + v.z * v.z + v.w * v.w;
          if (MODE != 2) *(u32x2*)(p.HB + (size_t)tok * 1024 + n) = (u32x2){pk_bf16(v.x, v.y), pk_bf16(v.z, v.w)};
        }
    }
    sq += __shfl_xor(sq, 32);
    if (valid && h == 0) atomicAdd(ssout + tok, sq);
  }
}

__device__ void phase_mix(CP& p, const Grp& G) {
  const int total = G.M * 432;
  for (int idx = blockIdx.x * 256 + ltid(); idx < total; idx += gridDim.x * 256) {
    const int row = idx / 432, ch = idx - row * 432;
    int s, t;
    if (row < G.Mx) { s = row >> G.lgS; t = 16 + (row & (G.S - 1)); } else { s = (row - G.Mx) >> 4; t = (row - G.Mx) & 15; }
    const int col = ch * 8;
    const u16* pc = p.P + (size_t)row * NIN + 3072 + col;
    const u32x4 c = *(const u32x4*)pc;
    u32x4 pv = {0, 0, 0, 0}, nx = {0, 0, 0, 0};
    if (t > 0) pv = *(const u32x4*)(p.P + (size_t)rowof(G, s, t - 1) * NIN + 3072 + col);
    if (t < G.L - 1) nx = *(const u32x4*)(p.P + (size_t)rowof(G, s, t + 1) * NIN + 3072 + col);
    const f32x4 mp0 = *(const f32x4*)(p.mu_prev + col), mp1 = *(const f32x4*)(p.mu_prev + col + 4);
    const f32x4 mn0 = *(const f32x4*)(p.mu_next + col), mn1 = *(const f32x4*)(p.mu_next + col + 4);
    float o[8];
#pragma unroll
    for (int e = 0; e < 4; ++e) {
      const float c0 = bf_lo(c[e]), c1 = bf_hi(c[e]);
      const float mpa = e < 2 ? mp0[2 * e] : mp1[2 * e - 4], mpb = e < 2 ? mp0[2 * e + 1] : mp1[2 * e - 3];
      const float mna = e < 2 ? mn0[2 * e] : mn1[2 * e - 4], mnb = e < 2 ? mn0[2 * e + 1] : mn1[2 * e - 3];
      o[2 * e] = c0 + mpa * (bf_lo(pv[e]) - c0) + mna * (bf_lo(nx[e]) - c0);
      o[2 * e + 1] = c1 + mpb * (bf_hi(pv[e]) - c1) + mnb * (bf_hi(nx[e]) - c1);
    }
    if (col < 3072) {
      const int sec = col >> 10, ci = col & 1023, head = ci >> 6, c0 = ci & 63;
      const size_t ro = ((size_t)row * 16 + head) * 192 + sec * 64 + c0;
      const u32x4 pk = (u32x4){pk_f16(o[0], o[1]), pk_f16(o[2], o[3]), pk_f16(o[4], o[5]), pk_f16(o[6], o[7])};
      *(u32x4*)(p.RKV + ro) = pk;
      if (sec == 1) { *(u32x4*)(p.DIR0 + ro) = pk; *(u32x4*)(p.DIR1 + ro) = pk; }
    } else {
      const int fc = col - 3072;
      if (fc < 128) {
#pragma unroll
        for (int e = 0; e < 8; ++e) o[e] = 1.f - 2.f / (1.f + __expf(2.f * o[e]));
      } else if (fc >= 256) {
#pragma unroll
        for (int e = 0; e < 8; ++e) o[e] = sigm(o[e]);
      }
      *(u32x4*)(p.F + (size_t)row * 384 + fc) = (u32x4){pk_bf16(o[0], o[1]), pk_bf16(o[2], o[3]), pk_bf16(o[4], o[5]), pk_bf16(o[6], o[7])};
    }
  }
}

__device__ __forceinline__ void epi_decay(const f32x16 (&acc)[2][2], int nbase, int tbase, int M, const float* w0, u16* DIR) {
  const int lane = ltid() & 63, l32 = lane & 31, h = lane >> 5;
  const int head = nbase >> 6;
#pragma unroll
  for (int tb = 0; tb < 2; ++tb) {
    const int tok = tbase + tb * 32 + l32;
    if (tok < M) {
      u16* dst = DIR + ((size_t)tok * 16 + head) * 192;
#pragma unroll
      for (int nb = 0; nb < 2; ++nb)
#pragma unroll
        for (int i = 0; i < 4; ++i) {
          const int c = nb * 32 + 8 * i + 4 * h;
          const f32x4 w = *(const f32x4*)(w0 + nbase + c);
          float o[4];
#pragma unroll
          for (int j = 0; j < 4; ++j) o[j] = 0.6065306597126334f * sigm(w[j] + acc[nb][tb][4 * i + j]);
          *(u32x2*)(dst + c) = (u32x2){pk_f16(o[0], o[1]), pk_f16(o[2], o[3])};
        }
    }
  }
}

__device__ __forceinline__ void epi_adir(const f32x16 (&acc)[2][2], int nbase, int tbase, int M, CP& p, int dir) {
  const int lane = ltid() & 63, l32 = lane & 31, h = lane >> 5;
  const int head = nbase >> 6;
  u16* DIR = dir ? p.DIR1 : p.DIR0;
  const float* a0 = p.rw_a0 + dir * 1024;
#pragma unroll
  for (int tb = 0; tb < 2; ++tb) {
    const int tok = tbase + tb * 32 + l32;
    const bool valid = tok < M;
    const int tk = valid ? tok : M - 1;
    const size_t rec = ((size_t)tk * 16 + head) * 192;
    float nsq = 0.f;
#pragma unroll
    for (int nb = 0; nb < 2; ++nb)
#pragma unroll
      for (int i = 0; i < 4; ++i) {
        const int c = nb * 32 + 8 * i + 4 * h;
        const u32x2 kr = *(const u32x2*)(DIR + rec + 64 + c);
        const f32x4 kkw = *(const f32x4*)(p.k_k + nbase + c);
        const float q0 = h_lo(kr.x) * kkw[0], q1 = h_hi(kr.x) * kkw[1], q2 = h_lo(kr.y) * kkw[2], q3 = h_hi(kr.y) * kkw[3];
        nsq += q0 * q0 + q1 * q1 + q2 * q2 + q3 * q3;
      }
    nsq += __shfl_xor(nsq, 32);
    const float inv = 1.f / fmaxf(sqrtf(nsq), 1e-12f);
    if (valid) {
#pragma unroll
      for (int nb = 0; nb < 2; ++nb)
#pragma unroll
        for (int i = 0; i < 4; ++i) {
          const int c = nb * 32 + 8 * i + 4 * h;
          const u32x2 kr = *(const u32x2*)(DIR + rec + 64 + c);
          const float kv[4] = {h_lo(kr.x), h_hi(kr.x), h_lo(kr.y), h_hi(kr.y)};
          const f32x4 kkw = *(const f32x4*)(p.k_k + nbase + c);
          const f32x4 kaw = *(const f32x4*)(p.k_a + nbase + c);
          const f32x4 a0v = *(const f32x4*)(a0 + nbase + c);
          float kk[4], kd[4], bp[4];
#pragma unroll
          for (int j = 0; j < 4; ++j) {
            const float k = kv[j];
            kk[j] = k * kkw[j] * inv;
            const float aa = sigm(a0v[j] + acc[nb][tb][4 * i + j]);
            kd[j] = k * (1.f + (aa - 1.f) * kaw[j]);
            bp[j] = -kk[j] * aa;
          }
          if (dir == 0) *(u32x2*)(p.RKV + rec + 64 + c) = (u32x2){pk_f16(kk[0], kk[1]), pk_f16(kk[2], kk[3])};
          *(u32x2*)(DIR + rec + 64 + c) = (u32x2){pk_f16(kd[0], kd[1]), pk_f16(kd[2], kd[3])};
          *(u32x2*)(DIR + rec + 128 + c) = (u32x2){pk_f16(bp[0], bp[1]), pk_f16(bp[2], bp[3])};
        }
    }
  }
}

template <int LPR>
__device__ void scan_task(CP& p, const Grp& G, int task, char* lds) {
  constexpr int KPL = 64 / LPR, RPB = 256 / LPR, NSPLIT = 64 / RPB;
  const int part = task % NSPLIT, t1 = task / NSPLIT;
  const int dir = t1 & 1, head = (t1 >> 1) & 15, s = t1 >> 5;
  float* buf = (float*)lds;
  const u16* rkv = p.RKV;
  const u16* dr = dir ? p.DIR1 : p.DIR0;
  u16* Y = dir ? p.Y1 : p.Y0;
  const int tid = ltid();
  const int row = part * RPB + tid / LPR, kc = tid % LPR;
  const int L = G.L, nch = L >> 4;
  u32x4 pre[3];
  auto issue = [&](int c) {
#pragma unroll
    for (int i = 0; i < 3; ++i) {
      const int id = tid + 256 * i, st = id / 48, ci = id - st * 48;
      const int n = c * 16 + st, t = dir ? L - 1 - n : n;
      const size_t rec = ((size_t)rowof(G, s, t) * 16 + head) * 192;
      const u16* src = ci < 24 ? rkv + rec + ci * 8 : dr + rec + (ci - 24) * 8;
      pre[i] = *(const u32x4*)src;
    }
  };
  auto commit = [&](int b) {
#pragma unroll
    for (int i = 0; i < 3; ++i) {
      const int id = tid + 256 * i, st = id / 48, ci = id - st * 48;
      const int sec = ci >> 3;
      const int base = sec >= 3 ? (sec - 1) * 64 : (sec == 0 ? 64 : (sec == 1 ? 0 : 320));
      float f[8];
#pragma unroll
      for (int e = 0; e < 4; ++e) { f[2 * e] = h_lo(pre[i][e]); f[2 * e + 1] = h_hi(pre[i][e]); }
      if (sec == 3) {
#pragma unroll
        for (int e = 0; e < 8; ++e) f[e] = __expf(-f[e]);
      }
      float* d = buf + b * 6144 + st * 384 + base + (ci & 7) * 8;
      *(f32x4*)d = (f32x4){f[0], f[1], f[2], f[3]};
      *(f32x4*)(d + 4) = (f32x4){f[4], f[5], f[6], f[7]};
    }
  };
  float S[KPL];
#pragma unroll
  for (int i = 0; i < KPL; ++i) S[i] = 0.f;
  __syncthreads();
  issue(0);
  commit(0);
  __syncthreads();
  __builtin_amdgcn_s_setprio(3);
  for (int c = 0; c < nch; ++c) {
    if (c + 1 < nch) issue(c + 1);
    const float* b = buf + (c & 1) * 6144;
#pragma unroll 4
    for (int st = 0; st < 16; ++st) {
      const float* q = b + st * 384 + kc * KPL;
      f32x4 kk[KPL / 4], rr[KPL / 4], ww[KPL / 4], dd[KPL / 4], bb[KPL / 4];
#pragma unroll
      for (int j = 0; j < KPL / 4; ++j) {
        kk[j] = *(const f32x4*)(q + 4 * j);
        rr[j] = *(const f32x4*)(q + 64 + 4 * j);
        ww[j] = *(const f32x4*)(q + 128 + 4 * j);
        dd[j] = *(const f32x4*)(q + 192 + 4 * j);
        bb[j] = *(const f32x4*)(q + 256 + 4 * j);
      }
      const float vv = b[st * 384 + 320 + row];
      float sa0 = 0.f, sa1 = 0.f;
#pragma unroll
      for (int j = 0; j < KPL / 4; ++j) {
        sa0 += S[4 * j] * kk[j][0]; sa1 += S[4 * j + 1] * kk[j][1];
        sa0 += S[4 * j + 2] * kk[j][2]; sa1 += S[4 * j + 3] * kk[j][3];
      }
      float sa = sa0 + sa1;
      sa = LPR == 8 ? reduce8(sa) : reduce4(sa);
      float y0 = 0.f, y1 = 0.f;
#pragma unroll
      for (int j = 0; j < KPL / 4; ++j)
#pragma unroll
        for (int e = 0; e < 4; ++e) {
          const float sn = S[4 * j + e] * ww[j][e] + (sa * bb[j][e] + vv * dd[j][e]);
          S[4 * j + e] = sn;
          if (e & 1) y1 += sn * rr[j][e]; else y0 += sn * rr[j][e];
        }
      float y = y0 + y1;
      y = LPR == 8 ? reduce8(y) : reduce4(y);
      if (kc == 0) {
        const int n = c * 16 + st, t = dir ? L - 1 - n : n;
        Y[(size_t)rowof(G, s, t) * 1024 + head * 64 + row] = bf16_1(y);
      }
    }
    if (c + 1 < nch) commit((c + 1) & 1);
    __syncthreads();
  }
  __builtin_amdgcn_s_setprio(0);
}

__device__ void attn_tile(CP& p, const Grp& G, int s, int hd, int qb, char* lds, float lam) {
  const int tid = ltid(), lane = tid & 63, wave = tid >> 6, l32 = lane & 31, h = lane >> 5;
  const int L = G.L, Lp = (G.L + 31) & ~31;
  const u16* Pb = p.P;
  float* lutl = (float*)(lds + 36864);
  char* qfl = lds + 38912 + tid * 16;
  __syncthreads();
  for (int i = tid; i < 511; i += 256) lutl[i] = p.lut[hd * 512 + i];
  const int q = 16 + qb * 128 + wave * 32 + l32;
  const int qc = s * G.S + (q - 16);
  const int qw0 = 16 + qb * 128 + wave * 32;
  u16* odst = p.O + (size_t)qc * 1024 + hd * 128;
  const int kkey = tid >> 3, kch = (tid & 7) ^ ((kkey >> 1) & 7);
  const u16* vsrc[2];
#pragma unroll
  for (int i = 0; i < 2; ++i) {
    const int c = tid + 256 * i, dv = c >> 2, c4 = (c & 3) ^ ((dv >> 2) & 3);
    vsrc[i] = p.VT + ((size_t)(s * 1024 + hd * 128 + dv) * Lp) + c4 * 8;
  }
  const unsigned lds0 = __builtin_amdgcn_readfirstlane((unsigned)(uintptr_t)(LAS char*)lds + wave * 1024);
  const int ntile = (L + 31) >> 5;
#pragma unroll 1
  for (int br = 0; br < 2; ++br) {
#pragma unroll
    for (int ks = 0; ks < 4; ++ks) {
      const u32x4 raw = *(const u32x4*)(Pb + (size_t)qc * NIN + hd * 128 + br * 64 + ks * 16 + h * 8);
      u32x4 sc;
#pragma unroll
      for (int e = 0; e < 4; ++e) sc[e] = pk_bf16(bf_lo(raw[e]) * 0.125f, bf_hi(raw[e]) * 0.125f);
      *(u32x4*)(qfl + ks * 4096) = sc;
    }
    const u16* kp = Pb + 1024 + hd * 128 + br * 64 + kch * 8;
    auto stage = [&](int kt) {
      const int kt0 = kt * 32;
      const unsigned sb = lds0 + (kt % 3) * 12288;
      int kr = kt0 + kkey; kr = kr < L ? kr : L - 1;
      glds16(kp + (size_t)rowof(G, s, kr) * NIN, sb);
      glds16(vsrc[0] + kt0, sb + 4096);
      glds16(vsrc[1] + kt0, sb + 8192);
    };
    f32x16 O[4];
#pragma unroll
    for (int mb = 0; mb < 4; ++mb)
#pragma unroll
      for (int r = 0; r < 16; ++r) O[mb][r] = 0.f;
    float mrun = -1e30f, lrun = 0.f;
    asm volatile("s_waitcnt vmcnt(0) lgkmcnt(0)" ::: "memory");
    __builtin_amdgcn_s_barrier();
    stage(0);
    if (ntile > 1) stage(1);
    const float cneg = lutl[0], cpos = lutl[510];
    for (int kt = 0; kt < ntile; ++kt) {
      const int kt0 = kt * 32;
      if (kt + 1 < ntile) asm volatile("s_waitcnt vmcnt(3)" ::: "memory");
      else asm volatile("s_waitcnt vmcnt(0)" ::: "memory");
      __builtin_amdgcn_s_barrier();
      if (kt + 2 < ntile) stage(kt + 2);
      const char* st = lds + (kt % 3) * 12288;
      f32x16 sacc;
#pragma unroll
      for (int r = 0; r < 16; ++r) sacc[r] = 0.f;
#pragma unroll
      for (int ks = 0; ks < 4; ++ks) {
        const bf16x8 kf = *(const bf16x8*)(st + l32 * 128 + (((ks * 2 + h) ^ ((l32 >> 1) & 7)) << 4));
        const bf16x8 qv = *(const bf16x8*)(qfl + ks * 4096);
        sacc = __builtin_amdgcn_mfma_f32_32x32x16_bf16(kf, qv, sacc, 0, 0, 0);
      }
      const bool farneg = (kt0 + 31) <= (qw0 - 128);
      const bool farpos = kt0 >= (qw0 + 31 + 128);
      float mx = -1e30f;
      if (farneg || farpos) {
        const float cv = farneg ? cneg : cpos;
#pragma unroll
        for (int r = 0; r < 16; ++r) { sacc[r] = sacc[r] * LOG2E + cv; }
      } else {
#pragma unroll
        for (int r = 0; r < 16; ++r) {
          const int key = kt0 + 8 * (r >> 2) + 4 * h + (r & 3);
          int d = key - q + 255;
          d = d < 0 ? 0 : (d > 510 ? 510 : d);
          sacc[r] = sacc[r] * LOG2E + lutl[d];
        }
      }
      if (kt0 + 32 > L) {
#pragma unroll
        for (int r = 0; r < 16; ++r) {
          const int key = kt0 + 8 * (r >> 2) + 4 * h + (r & 3);
          if (key >= L) sacc[r] = -INFINITY;
        }
      }
#pragma unroll
      for (int r = 0; r < 16; ++r) mx = fmaxf(mx, sacc[r]);
      mx = fmaxf(mx, __shfl_xor(mx, 32));
      const float mnew = fmaxf(mrun, mx);
      const float alpha = __builtin_amdgcn_exp2f(mrun - mnew);
      mrun = mnew;
      float ps = 0.f;
#pragma unroll
      for (int r = 0; r < 16; ++r) { sacc[r] = __builtin_amdgcn_exp2f(sacc[r] - mnew); ps += sacc[r]; }
      lrun = lrun * alpha + ps;
      if (__any(alpha != 1.f)) {
#pragma unroll
        for (int mb = 0; mb < 4; ++mb)
#pragma unroll
          for (int r = 0; r < 16; ++r) O[mb][r] *= alpha;
      }
      bf16x8 pf[2];
#pragma unroll
      for (int s2 = 0; s2 < 2; ++s2) {
        u32x4 w;
#pragma unroll
        for (int e = 0; e < 4; ++e) w[e] = pk_bf16(sacc[8 * s2 + 2 * e], sacc[8 * s2 + 2 * e + 1]);
        pf[s2] = __builtin_bit_cast(bf16x8, w);
      }
#pragma unroll
      for (int mb = 0; mb < 4; ++mb)
#pragma unroll
        for (int s2 = 0; s2 < 2; ++s2) {
          const int vr = mb * 32 + l32;
          const bf16x8 vf = *(const bf16x8*)(st + 4096 + vr * 64 + (((2 * s2 + h) ^ ((vr >> 2) & 3)) << 4));
          O[mb] = __builtin_amdgcn_mfma_f32_32x32x16_bf16(vf, pf[s2], O[mb], 0, 0, 0);
        }
    }
    const float lt = lrun + __shfl_xor(lrun, 32);
    if (br == 0) {
      const float i1 = 1.f / lt;
#pragma unroll
      for (int mb = 0; mb < 4; ++mb)
#pragma unroll
        for (int i = 0; i < 4; ++i)
          if (q < L) *(u32x2*)(odst + mb * 32 + 8 * i + 4 * h) = (u32x2){pk_bf16(O[mb][4 * i] * i1, O[mb][4 * i + 1] * i1), pk_bf16(O[mb][4 * i + 2] * i1, O[mb][4 * i + 3] * i1)};
    } else {
      const float i2 = lam / lt;
      float ssq = 0.f;
#pragma unroll
      for (int mb = 0; mb < 4; ++mb)
#pragma unroll
        for (int i = 0; i < 4; ++i) {
          u32x2 w = {0, 0};
          if (q < L) w = *(const u32x2*)(odst + mb * 32 + 8 * i + 4 * h);
          const float o0 = bf_lo(w.x) - O[mb][4 * i] * i2, o1v = bf_hi(w.x) - O[mb][4 * i + 1] * i2, o2 = bf_lo(w.y) - O[mb][4 * i + 2] * i2, o3 = bf_hi(w.y) - O[mb][4 * i + 3] * i2;
          O[mb][4 * i] = o0; O[mb][4 * i + 1] = o1v; O[mb][4 * i + 2] = o2; O[mb][4 * i + 3] = o3;
          ssq += o0 * o0 + o1v * o1v + o2 * o2 + o3 * o3;
        }
      ssq += __shfl_xor(ssq, 32);
      const float rn = rsqrtf(ssq * (1.f / 128.f) + EPSN) * 0.8f;
      if (q < L) {
#pragma unroll
        for (int mb = 0; mb < 4; ++mb)
#pragma unroll
          for (int i = 0; i < 4; ++i) {
            const int dv = mb * 32 + 8 * i + 4 * h;
            const f32x4 g = *(const f32x4*)(p.subln + dv);
            *(u32x2*)(odst + dv) = (u32x2){pk_bf16(O[mb][4 * i] * rn * g.x, O[mb][4 * i + 1] * rn * g.y),
                                           pk_bf16(O[mb][4 * i + 2] * rn * g.z, O[mb][4 * i + 3] * rn * g.w)};
          }
      }
    }
  }
}

__device__ void phase_mixer(CP& p, const Grp& G, int g, char* lds) {
  if (G.nseq == 4) { for (int t = blockIdx.x; t < 256; t += gridDim.x) scan_task<8>(p, G, t, lds); }
  else { for (int t = blockIdx.x; t < 256; t += gridDim.x) scan_task<4>(p, G, t, lds); }
  const int nqb = G.S >> 7;
  const int natt = G.nseq * 8 * nqb;
  const float lam = p.lam[0];
  int* shw = (int*)(lds + 65536 - 16);
  while (true) {
    __syncthreads();
    if (ltid() == 0) *shw = atomicAdd(p.cnt + g, 1);
    __syncthreads();
    const int t = *shw;
    if (t >= natt) break;
    const int qb = t % nqb, r = t / nqb, hd = r & 7, s = r >> 3;
    attn_tile(p, G, s, hd, qb, lds, lam);
  }
}

__device__ void phase_post(CP& p, const Grp& G) {
  const int lane = ltid() & 63;
  const int nw = gridDim.x * 4;
  const int c0 = lane * 16, head = lane >> 2, hc = (lane & 3) * 16;
  for (int row = blockIdx.x * 4 + (ltid() >> 6); row < G.Mx; row += nw) {
    float y[16];
    {
      const u32x4 a0 = *(const u32x4*)(p.Y0 + (size_t)row * 1024 + c0), a1 = *(const u32x4*)(p.Y0 + (size_t)row * 1024 + c0 + 8);
      const u32x4 b0 = *(const u32x4*)(p.Y1 + (size_t)row * 1024 + c0), b1 = *(const u32x4*)(p.Y1 + (size_t)row * 1024 + c0 + 8);
#pragma unroll
      for (int e = 0; e < 4; ++e) {
        y[2 * e] = bf_lo(a0[e]) + bf_lo(b0[e]); y[2 * e + 1] = bf_hi(a0[e]) + bf_hi(b0[e]);
        y[8 + 2 * e] = bf_lo(a1[e]) + bf_lo(b1[e]); y[8 + 2 * e + 1] = bf_hi(a1[e]) + bf_hi(b1[e]);
      }
    }
    float s1 = 0.f;
#pragma unroll
    for (int e = 0; e < 16; ++e) s1 += y[e];
    s1 = reduce4(s1);
    const float mu = s1 * (1.f / 64.f);
    float s2 = 0.f;
#pragma unroll
    for (int e = 0; e < 16; ++e) { const float d = y[e] - mu; s2 += d * d; }
    s2 = reduce4(s2);
    const float rstd = rsqrtf(s2 * (1.f / 64.f) + 64e-5f);
    const size_t rec = ((size_t)row * 16 + head) * 192 + hc;
    float rr[16], vv[16], kd[16];
    {
      const u32x4 r0 = *(const u32x4*)(p.RKV + rec), r1 = *(const u32x4*)(p.RKV + rec + 8);
      const u32x4 v0 = *(const u32x4*)(p.RKV + rec + 128), v1 = *(const u32x4*)(p.RKV + rec + 136);
      const u32x4 f0 = *(const u32x4*)(p.DIR0 + rec + 64), f1 = *(const u32x4*)(p.DIR0 + rec + 72);
      const u32x4 g0 = *(const u32x4*)(p.DIR1 + rec + 64), g1 = *(const u32x4*)(p.DIR1 + rec + 72);
#pragma unroll
      for (int e = 0; e < 4; ++e) {
        rr[2 * e] = h_lo(r0[e]); rr[2 * e + 1] = h_hi(r0[e]); rr[8 + 2 * e] = h_lo(r1[e]); rr[8 + 2 * e + 1] = h_hi(r1[e]);
        vv[2 * e] = h_lo(v0[e]); vv[2 * e + 1] = h_hi(v0[e]); vv[8 + 2 * e] = h_lo(v1[e]); vv[8 + 2 * e + 1] = h_hi(v1[e]);
        kd[2 * e] = h_lo(f0[e]) + h_lo(g0[e]); kd[2 * e + 1] = h_hi(f0[e]) + h_hi(g0[e]);
        kd[8 + 2 * e] = h_lo(f1[e]) + h_lo(g1[e]); kd[8 + 2 * e + 1] = h_hi(f1[e]) + h_hi(g1[e]);
      }
    }
    float bs = 0.f;
#pragma unroll
    for (int e = 0; e < 16; ++e) bs += rr[e] * kd[e] * p.r_k[c0 + e];
    bs = reduce4(bs);
    const u32x4 g0 = *(const u32x4*)(p.G + (size_t)row * 1024 + c0), g1 = *(const u32x4*)(p.G + (size_t)row * 1024 + c0 + 8);
    float o[16];
#pragma unroll
    for (int e = 0; e < 16; ++e) {
      const unsigned gw = e < 8 ? g0[e >> 1] : g1[(e - 8) >> 1];
      const float gg = (e & 1) ? bf_hi(gw) : bf_lo(gw);
      o[e] = ((y[e] - mu) * rstd * p.lnx_w[c0 + e] + p.lnx_b[c0 + e] + bs * vv[e]) * gg;
    }
    u16* dst = p.HB + (size_t)row * 1024 + c0;
    *(u32x4*)dst = (u32x4){pk_bf16(o[0], o[1]), pk_bf16(o[2], o[3]), pk_bf16(o[4], o[5]), pk_bf16(o[6], o[7])};
    *(u32x4*)(dst + 8) = (u32x4){pk_bf16(o[8], o[9]), pk_bf16(o[10], o[11]), pk_bf16(o[12], o[13]), pk_bf16(o[14], o[15])};
  }
}

__device__ void phase_final(CP& p, const Grp& G) {
  const int lane = ltid() & 63;
  const int nw = gridDim.x * 4;
  for (int row = blockIdx.x * 4 + (ltid() >> 6); row < G.Mx; row += nw) {
    const float rs = rsqrtf(p.ss3[row] * (1.f / 1024.f) + EPSN);
    const float* hp = p.H + (size_t)row * 1024;
    float* op = G.out + (size_t)row * 1024;
#pragma unroll
    for (int i = 0; i < 4; ++i) {
      const f32x4 v = *(const f32x4*)(hp + i * 256 + lane * 4);
      const f32x4 g = *(const f32x4*)(p.final_norm + i * 256 + lane * 4);
      *(f32x4*)(op + i * 256 + lane * 4) = (f32x4){v.x * rs * g.x, v.y * rs * g.y, v.z * rs * g.z, v.w * rs * g.w};
    }
  }
}

__device__ void run_phase(CP& p, int ph, char* lds) {
  int* gctr = p.cnt + 64 + ph * 64;
  if (ph == 0) { phase_prep(p, lds); return; }
  int g, k;
  if (ph <= NMETA_PH) { g = -1; k = ph - 1; }
  else { g = (ph - 1 - NMETA_PH) / PH_PER_G; k = (ph - 1 - NMETA_PH) - g * PH_PER_G; }
  const Grp G = get_grp(p, g);
  const int Mall = G.M;
  const int M = G.Mx;
  u16* Pout = G.meta ? p.PM : p.P;
  switch (k) {
    case 0: phase_rows(p, G); break;
    case 1:
      gemm_phase(p.HB, 1024, M, p.W1A, 1024, 2 * FFD, lds, gctr, [&](const f32x16 (&acc)[2][2], int nb, int tb) { epi_swiglu(acc, nb, tb, M, p.ss0, p.ACT); });
      break;
    case 2:
      gemm_phase(p.ACT, FFD, M, p.WD1, FFD, 1024, lds, gctr, [&](const f32x16 (&acc)[2][2], int nb, int tb) { epi_resid<0>(acc, nb, tb, p, G); });
      break;
    case 3:
      gemm_phase(p.HB, 1024, M, p.WIN, 1024, NIN, lds, gctr, [&](const f32x16 (&acc)[2][2], int nbase, int tbase) {
        const int lane = ltid() & 63, l32 = lane & 31, h = lane >> 5;
#pragma unroll
        for (int tb = 0; tb < 2; ++tb) {
          const int tok = tbase + tb * 32 + l32;
          if (tok < M) {
            const float rs = rsqrtf(p.ss1[tok] * (1.f / 1024.f) + EPSN);
            if (!G.meta && nbase >= 2048 && nbase < 3072) {
              const int s = tok >> G.lgS, t = 16 + (tok & (G.S - 1));
              const int Lp = (G.L + 31) & ~31;
              const int pos = (t & ~12) | ((t & 4) << 1) | ((t & 8) >> 1);
              u16* vt = p.VT + ((size_t)(s * 1024 + (nbase - 2048)) * Lp) + pos;
#pragma unroll
              for (int nb = 0; nb < 2; ++nb)
#pragma unroll
                for (int r = 0; r < 16; ++r) {
                  const int dvl = nb * 32 + 8 * (r >> 2) + 4 * h + (r & 3);
                  vt[(size_t)dvl * Lp] = bf16_1(acc[nb][tb][r] * rs);
                }
            } else {
              u16* dst = Pout + (size_t)tok * NIN + nbase + 4 * h;
#pragma unroll
              for (int nb = 0; nb < 2; ++nb)
#pragma unroll
                for (int i = 0; i < 4; ++i)
                  *(u32x2*)(dst + nb * 32 + 8 * i) = (u32x2){pk_bf16(acc[nb][tb][4 * i] * rs, acc[nb][tb][4 * i + 1] * rs),
                                                             pk_bf16(acc[nb][tb][4 * i + 2] * rs, acc[nb][tb][4 * i + 3] * rs)};
            }
          }
        }
      });
      break;
    case 4: phase_mix(p, G); break;
    case 5:
      gemm_phase(p.F, 384, Mall, p.W2F, 64, 1024, lds, gctr, [&](const f32x16 (&acc)[2][2], int nb, int tb) { epi_decay(acc, nb, tb, Mall, p.rw_w0, p.DIR0); });
      gemm_phase(p.F + 64, 384, Mall, p.W2B, 64, 1024, lds, gctr + 8, [&](const f32x16 (&acc)[2][2], int nb, int tb) { epi_decay(acc, nb, tb, Mall, p.rw_w0 + 1024, p.DIR1); });
      gemm_phase(p.F + 128, 384, Mall, p.A2F, 64, 1024, lds, gctr + 16, [&](const f32x16 (&acc)[2][2], int nb, int tb) { epi_adir(acc, nb, tb, Mall, p, 0); });
      gemm_phase(p.F + 192, 384, Mall, p.A2B, 64, 1024, lds, gctr + 24, [&](const f32x16 (&acc)[2][2], int nb, int tb) { epi_adir(acc, nb, tb, Mall, p, 1); });
      gemm_phase(p.F + 256, 384, Mall, p.G2T, 128, 1024, lds, gctr + 32, [&](const f32x16 (&acc)[2][2], int nbase, int tbase) {
        const int lane = ltid() & 63, l32 = lane & 31, h = lane >> 5;
#pragma unroll
        for (int tb = 0; tb < 2; ++tb) {
          const int tok = tbase + tb * 32 + l32;
          if (tok < Mall) {
            u16* dst = p.G + (size_t)tok * 1024 + nbase + 4 * h;
#pragma unroll
            for (int nb = 0; nb < 2; ++nb)
#pragma unroll
              for (int i = 0; i < 4; ++i)
                *(u32x2*)(dst + nb * 32 + 8 * i) = (u32x2){pk_bf16(acc[nb][tb][4 * i], acc[nb][tb][4 * i + 1]), pk_bf16(acc[nb][tb][4 * i + 2], acc[nb][tb][4 * i + 3])};
          }
        }
      });
      break;
    case 6: phase_mixer(p, G, g, lds); break;
    case 7: phase_post(p, G); break;
    case 8: {
      const int nN = 8, nM = (M + 127) >> 7, nt = nN * nM;
      const int wave = ltid() >> 6;
      const int lane = ltid() & 63, l32 = lane & 31, h = lane >> 5;
      const int xcd = blockIdx.x & 7, g8 = gridDim.x >> 3;
      const int tq = nt >> 3, trm = nt & 7;
      const int tstart = xcd < trm ? xcd * (tq + 1) : trm * (tq + 1) + (xcd - trm) * tq;
      const int tcnt = tq + (xcd < trm ? 1 : 0);
      for (int off = blockIdx.x >> 3; off < tcnt; off += g8) {
        const int id = tstart + off, nig = 8 * nN, grp = id / nig, fm = grp * 8;
        const int gsz = (nM - fm) < 8 ? (nM - fm) : 8, idl = id - grp * nig;
        const int tm = fm + idl % gsz, tn = idl / gsz;
        const int nbase = tn * 128 + (wave & 1) * 64, tbase = tm * 128 + (wave >> 1) * 64;
#pragma unroll 1
        for (int pass = 0; pass < 2; ++pass) {
          f32x16 acc[2][2];
          zero_acc(acc);
          gemm_kloop(acc, pass ? p.HB : p.O, 1024, M, tm * 128, pass ? p.WRW : p.WATT, 1024, tn * 128, 1024, lds);
#pragma unroll
          for (int tb = 0; tb < 2; ++tb) {
            const int tok = tbase + tb * 32 + l32;
            if (tok < M) {
              const u16* gp = p.P + (size_t)tok * NIN + 6528 + pass * 1024 + nbase + 4 * h;
              u16* dst = p.MERGED + (size_t)tok * 1024 + nbase + 4 * h;
#pragma unroll
              for (int nb = 0; nb < 2; ++nb)
#pragma unroll
                for (int i = 0; i < 4; ++i) {
                  const u32x2 ga = *(const u32x2*)(gp + nb * 32 + 8 * i);
                  float o0 = sigm(bf_lo(ga.x)) * acc[nb][tb][4 * i];
                  float o1 = sigm(bf_hi(ga.x)) * acc[nb][tb][4 * i + 1];
                  float o2 = sigm(bf_lo(ga.y)) * acc[nb][tb][4 * i + 2];
                  float o3 = sigm(bf_hi(ga.y)) * acc[nb][tb][4 * i + 3];
                  if (pass) {
                    const u32x2 pv = *(const u32x2*)(dst + nb * 32 + 8 * i);
                    o0 += bf_lo(pv.x); o1 += bf_hi(pv.x); o2 += bf_lo(pv.y); o3 += bf_hi(pv.y);
                  }
                  *(u32x2*)(dst + nb * 32 + 8 * i) = (u32x2){pk_bf16(o0, o1), pk_bf16(o2, o3)};
                }
            }
          }
        }
      }
    } break;
    case 9:
      gemm_phase(p.MERGED, 1024, M, p.WOUT, 1024, 1024, lds, gctr, [&](const f32x16 (&acc)[2][2], int nb, int tb) { epi_resid<1>(acc, nb, tb, p, G); });
      break;
    case 10:
      gemm_phase(p.HB, 1024, M, p.W2A, 1024, 2 * FFD, lds, gctr, [&](const f32x16 (&acc)[2][2], int nb, int tb) { epi_swiglu(acc, nb, tb, M, p.ss2, p.ACT); });
      break;
    case 11:
      gemm_phase(p.ACT, FFD, M, p.WD2, FFD, 1024, lds, gctr, [&](const f32x16 (&acc)[2][2], int nb, int tb) { epi_resid<2>(acc, nb, tb, p, G); });
      break;
    case 12: phase_final(p, G); break;
  }
}

__global__ void __launch_bounds__(256, 2) mega(Params p, int ph_lo, int ph_hi, int coop) {
  __shared__ __attribute__((aligned(16))) char lds[65536 + 16];
  uint4& xb_words = *(uint4*)(lds + 65536);
  CP* pp = (CP*)__builtin_amdgcn_kernarg_segment_ptr();
  asm volatile("" : "+s"(pp));
  if (threadIdx.x == 0) xb_words = make_uint4(0u, 0u, 0u, 0u);
  __syncthreads();
  const XcdBarrier xb = xcd_barrier_post(pp->bar, (volatile LAS unsigned*)&xb_words);
  for (int ph = ph_lo; ph < ph_hi; ++ph) {
    run_phase(*pp, ph, lds);
    if (coop && ph + 1 < ph_hi) {
      if (ph == 0) cg::this_grid().sync();
      else xcd_barrier(xb);
    }
  }
}

extern "C" void kernel_launch(void* const* d_in, const int* in_sizes, int n_in, void* d_out, int out_size, void* d_ws,
                              size_t ws_size, hipStream_t stream) {
  Params p;
  memset(&p, 0, sizeof(p));
  const float** f = (const float**)&p;
  for (int i = 0; i < 35; ++i) f[i] = (const float*)d_in[i];
  p.out = (float*)d_out;
  char* w = (char*)d_ws;
  size_t off = 0;
  auto alloc = [&](size_t bytes) { char* r = w + off; off += (bytes + 255) & ~(size_t)255; return r; };
  p.W1A = (u16*)alloc((size_t)2 * FFD * 1024 * 2);
  p.WD1 = (u16*)alloc((size_t)1024 * FFD * 2);
  p.WIN = (u16*)alloc((size_t)NIN * 1024 * 2);
  p.WATT = (u16*)alloc((size_t)1024 * 1024 * 2);
  p.WRW = (u16*)alloc((size_t)1024 * 1024 * 2);
  p.WOUT = (u16*)alloc((size_t)1024 * 1024 * 2);
  p.W2A = (u16*)alloc((size_t)2 * FFD * 1024 * 2);
  p.WD2 = (u16*)alloc((size_t)1024 * FFD * 2);
  p.W2F = (u16*)alloc((size_t)1024 * 64 * 2);
  p.W2B = (u16*)alloc((size_t)1024 * 64 * 2);
  p.A2F = (u16*)alloc((size_t)1024 * 64 * 2);
  p.A2B = (u16*)alloc((size_t)1024 * 64 * 2);
  p.G2T = (u16*)alloc((size_t)1024 * 128 * 2);
  p.lut = (float*)alloc(8 * 512 * 4);
  p.cnt = (int*)alloc((64 + NPHASES * 64) * 4);
  p.lam = (float*)alloc(256);
  p.bar = (unsigned*)alloc(XCD_BAR_WORDS * 4);
  const size_t R = MAXROWS;
  p.H = (float*)alloc(R * 1024 * 4);
  p.HB = (u16*)alloc(R * 1024 * 2);
  p.ACT = (u16*)alloc(R * FFD * 2);
  p.Y0 = p.ACT;
  p.Y1 = p.ACT + R * 1024;
  p.F = p.ACT + R * 2048;
  p.P = (u16*)alloc(R * NIN * 2);
  p.RKV = (u16*)alloc(R * 16 * 192 * 2);
  p.DIR0 = (u16*)alloc(R * 16 * 192 * 2);
  p.DIR1 = (u16*)alloc(R * 16 * 192 * 2);
  p.G = (u16*)alloc(R * 1024 * 2);
  p.O = (u16*)alloc(R * 1024 * 2);
  p.MERGED = (u16*)alloc(R * 1024 * 2);
  p.VT = (u16*)alloc((size_t)8 * 8 * 128 * 2080 * 2);
  p.PM = (u16*)alloc((size_t)16 * NIN * 2);
  p.ss0 = (float*)alloc(R * 4);
  p.ss1 = (float*)alloc(R * 4);
  p.ss2 = (float*)alloc(R * 4);
  p.ss3 = (float*)alloc(R * 4);
  if (off > ws_size) { fprintf(stderr, "workspace too small: need %zu have %zu\n", off, ws_size); return; }
  static int grid_blocks = 0;
  if (!grid_blocks) {
    int dev = 0, cus = 0, per_cu = 0;
    hipGetDevice(&dev);
    hipDeviceGetAttribute(&cus, hipDeviceAttributeMultiprocessorCount, dev);
    hipOccupancyMaxActiveBlocksPerMultiprocessor(&per_cu, mega, 256, 0);
    per_cu = 2;
    grid_blocks = cus * per_cu;
  }
  hipMemsetAsync(p.bar, 0, XCD_BAR_WORDS * 4, stream);
  hipMemsetAsync(p.cnt, 0, (64 + NPHASES * 64) * 4, stream);
  int ph_lo = 0, ph_hi = NPHASES, coop = 1;
  void* args[] = {&p, &ph_lo, &ph_hi, &coop};
  hipError_t e = hipLaunchCooperativeKernel((void*)mega, dim3(grid_blocks), dim3(256), args, 0, stream);
  if (e != hipSuccess) fprintf(stderr, "cooperative launch failed: %s (grid %d)\n", hipGetErrorString(e), grid_blocks);
}
```

```cpp
#include <hip/hip_runtime.h>
#include <hip/hip_cooperative_groups.h>
#include <stdint.h>
#include <string.h>
#include <stdio.h>
namespace cg = cooperative_groups;

typedef unsigned short u16;
typedef short bf16x8 __attribute__((ext_vector_type(8)));
typedef float f32x16 __attribute__((ext_vector_type(16)));
typedef float f32x4 __attribute__((ext_vector_type(4)));
typedef float f32x2 __attribute__((ext_vector_type(2)));
typedef unsigned u32x4 __attribute__((ext_vector_type(4)));
typedef unsigned u32x2 __attribute__((ext_vector_type(2)));
typedef __bf16 bf16x2_t __attribute__((ext_vector_type(2)));
typedef _Float16 f16x2_t __attribute__((ext_vector_type(2)));

#define NIN 8576
#define FFD 2816
#define EPSN 1e-6f
#define LOG2E 1.4426950408889634f
#define NGROUPS 6
#define PH_PER_G 13
#define NMETA_PH 4
#define NPHASES (1 + NMETA_PH + NGROUPS * PH_PER_G)
#define MAXROWS 16512

struct Params {
  const float *x_prompt, *x_sample, *meta, *rel_bias, *ffn1_norm, *ffn1_wg, *ffn1_wu, *ffn1_wd, *mix_norm, *w_in;
  const float *lq1, *lk1, *lq2, *lk2, *subln, *w_attn, *mu_prev, *mu_next, *rw_w0, *rw_w2, *rw_a0, *rw_a2, *rw_g2;
  const float *k_k, *k_a, *r_k, *lnx_w, *lnx_b, *w_rw, *w_out, *ffn2_norm, *ffn2_wg, *ffn2_wu, *ffn2_wd, *final_norm;
  float* out;
  u16 *W1A, *WD1, *WIN, *WATT, *WRW, *WOUT, *W2A, *WD2, *W2F, *W2B, *A2F, *A2B, *G2T;
  float* lut; int* cnt; float* lam; unsigned* bar; u16* VT; u16* PM;
  float* H; u16 *HB, *ACT, *P, *RKV, *DIR0, *DIR1, *G, *O, *MERGED, *Y0, *Y1, *F;
  float *ss0, *ss1, *ss2, *ss3;
};

typedef const Params __attribute__((address_space(4))) CP;
struct Grp { int nseq, L, S, lgS, M, Mx, meta; const float* x; float* out; };
__device__ __forceinline__ int rowof(const Grp& G, int s, int t) { return t < 16 ? G.Mx + s * 16 + t : s * G.S + (t - 16); }

__device__ __forceinline__ Grp get_grp(CP& p, int g) {
  Grp r;
  r.meta = 0;
  if (g < 0) {
    r.nseq = 1; r.L = 16; r.S = 16; r.lgS = 4; r.x = p.meta; r.out = nullptr; r.M = 16; r.Mx = 16; r.meta = 1;
    return r;
  }
  if (g < 4) { r.nseq = 4; r.L = 4112; r.S = 4096; r.lgS = 12; r.x = p.x_prompt + (size_t)g * 4 * 4096 * 1024; r.out = p.out + (size_t)g * 4 * 4096 * 1024; }
  else { r.nseq = 8; r.L = 2064; r.S = 2048; r.lgS = 11; r.x = p.x_sample + (size_t)(g - 4) * 8 * 2048 * 1024; r.out = p.out + (size_t)16 * 4096 * 1024 + (size_t)(g - 4) * 8 * 2048 * 1024; }
  r.M = r.nseq * r.L;
  r.Mx = r.nseq * r.S;
  return r;
}

__device__ __forceinline__ int ltid() { int t = threadIdx.x; asm volatile("" : "+v"(t)); return t; }
__device__ __forceinline__ unsigned pk_bf16(float a, float b) {
  f32x2 v = {a, b};
  bf16x2_t r = __builtin_convertvector(v, bf16x2_t);
  return __builtin_bit_cast(unsigned, r);
}
__device__ __forceinline__ float bf_lo(unsigned u) { return __uint_as_float(u << 16); }
__device__ __forceinline__ float bf_hi(unsigned u) { return __uint_as_float(u & 0xffff0000u); }
__device__ __forceinline__ unsigned pk_f16(float a, float b) {
  f32x2 v = {a, b};
  f16x2_t r = __builtin_convertvector(v, f16x2_t);
  return __builtin_bit_cast(unsigned, r);
}
__device__ __forceinline__ float h_lo(unsigned u) { f16x2_t r = __builtin_bit_cast(f16x2_t, u); return (float)r.x; }
__device__ __forceinline__ float h_hi(unsigned u) { f16x2_t r = __builtin_bit_cast(f16x2_t, u); return (float)r.y; }
__device__ __forceinline__ u16 bf16_1(float a) { return (u16)(pk_bf16(a, 0.f) & 0xffffu); }
__device__ __forceinline__ float sigm(float x) { return __builtin_amdgcn_rcpf(1.f + __builtin_amdgcn_exp2f(-LOG2E * x)); }
__device__ __forceinline__ float wave_sum(float v) {
#pragma unroll
  for (int o = 32; o > 0; o >>= 1) v += __shfl_xor(v, o);
  return v;
}
template <int CTRL> __device__ __forceinline__ float dppf(float x) {
  return __int_as_float(__builtin_amdgcn_update_dpp(0, __float_as_int(x), CTRL, 0xf, 0xf, true));
}
__device__ __forceinline__ float reduce8(float x) {
  x += dppf<0xB1>(x);
  x += dppf<0x4E>(x);
  x += dppf<0x141>(x);
  return x;
}
__device__ __forceinline__ float reduce4(float x) {
  x += dppf<0xB1>(x);
  x += dppf<0x4E>(x);
  return x;
}

__device__ void prep_transpose(const float* __restrict__ src, int K, int N, u16* __restrict__ dst,
                               const float* __restrict__ gain, int mode, char* lds) {
  float* tile = (float*)lds;
  const int tn = N / 64, nt = (K / 64) * tn;
  const int tid = ltid();
  for (int t = blockIdx.x; t < nt; t += gridDim.x) {
    const int k0 = (t / tn) * 64, n0 = (t % tn) * 64;
    const int nl = tid & 63, kq = tid >> 6;
#pragma unroll
    for (int i = 0; i < 16; ++i) {
      const int k = i * 4 + kq;
      float v = src[(size_t)(k0 + k) * N + n0 + nl];
      if (gain) v *= gain[k0 + k];
      tile[k * 65 + nl] = v;
    }
    __syncthreads();
    const int n = tid >> 2, kk = (tid & 3) * 16;
    unsigned w[8];
#pragma unroll
    for (int i = 0; i < 8; ++i) w[i] = pk_bf16(tile[(kk + 2 * i) * 65 + n], tile[(kk + 2 * i + 1) * 65 + n]);
    const int ng = n0 + n;
    const int row = mode == 0 ? ng : ((ng >> 5) * 64 + (ng & 31) + (mode == 2 ? 32 : 0));
    u32x4* d = (u32x4*)(dst + (size_t)row * K + k0 + kk);
    d[0] = (u32x4){w[0], w[1], w[2], w[3]};
    d[1] = (u32x4){w[4], w[5], w[6], w[7]};
    __syncthreads();
  }
}

__device__ void phase_prep(CP& p, char* lds) {
  if (blockIdx.x == 0) {
    const int tid = ltid();
    for (int idx = tid; idx < 8 * 511; idx += 256) {
      const int hd = idx / 511, di = idx - hd * 511, d = di - 255;
      const int n = d < 0 ? -d : d;
      int bk;
      if (n < 8) bk = n;
      else {
        const float nf = (float)n;
        int large = 8 + (int)(logf(nf / 8.0f) / 2.772588722239781f * 8.0f);
        bk = large < 15 ? large : 15;
      }
      const int bucket = (d > 0 ? 16 : 0) + bk;
      p.lut[hd * 512 + di] = p.rel_bias[bucket * 8 + hd] * LOG2E;
    }
    if (tid == 0) {
      float s1 = 0.f, s2 = 0.f;
      for (int i = 0; i < 64; ++i) { s1 += p.lq1[i] * p.lk1[i]; s2 += p.lq2[i] * p.lk2[i]; }
      p.lam[0] = expf(s1) - expf(s2) + 0.2f;
    }
  }
  prep_transpose(p.ffn1_wg, 1024, FFD, p.W1A, p.ffn1_norm, 1, lds);
  prep_transpose(p.ffn1_wu, 1024, FFD, p.W1A, p.ffn1_norm, 2, lds);
  prep_transpose(p.ffn1_wd, FFD, 1024, p.WD1, nullptr, 0, lds);
  prep_transpose(p.w_in, 1024, NIN, p.WIN, p.mix_norm, 0, lds);
  prep_transpose(p.w_attn, 1024, 1024, p.WATT, nullptr, 0, lds);
  prep_transpose(p.w_rw, 1024, 1024, p.WRW, nullptr, 0, lds);
  prep_transpose(p.w_out, 1024, 1024, p.WOUT, nullptr, 0, lds);
  prep_transpose(p.ffn2_wg, 1024, FFD, p.W2A, p.ffn2_norm, 1, lds);
  prep_transpose(p.ffn2_wu, 1024, FFD, p.W2A, p.ffn2_norm, 2, lds);
  prep_transpose(p.ffn2_wd, FFD, 1024, p.WD2, nullptr, 0, lds);
  prep_transpose(p.rw_w2, 64, 1024, p.W2F, nullptr, 0, lds);
  prep_transpose(p.rw_w2 + 64 * 1024, 64, 1024, p.W2B, nullptr, 0, lds);
  prep_transpose(p.rw_a2, 64, 1024, p.A2F, nullptr, 0, lds);
  prep_transpose(p.rw_a2 + 64 * 1024, 64, 1024, p.A2B, nullptr, 0, lds);
  prep_transpose(p.rw_g2, 128, 1024, p.G2T, nullptr, 0, lds);
}

__device__ void phase_rows(CP& p, const Grp& G) {
  const int lane = ltid() & 63;
  const int nw = gridDim.x * 4;
  const int gw = blockIdx.x * 4 + (ltid() >> 6);
  for (int row = gw; row < G.Mx; row += nw) {
    const float* src = G.x + (size_t)row * 1024;
    float ss = 0.f;
#pragma unroll
    for (int i = 0; i < 4; ++i) {
      const f32x4 v = *(const f32x4*)(src + i * 256 + lane * 4);
      ss += v.x * v.x + v.y * v.y + v.z * v.z + v.w * v.w;
      u32x2 o = {pk_bf16(v.x, v.y), pk_bf16(v.z, v.w)};
      *(u32x2*)(p.HB + (size_t)row * 1024 + i * 256 + lane * 4) = o;
    }
    ss = wave_sum(ss);
    if (lane == 0) { p.ss0[row] = ss; p.ss1[row] = 0.f; p.ss2[row] = 0.f; p.ss3[row] = 0.f; }
  }
  if (G.meta) return;
  const int Lp = (G.L + 31) & ~31;
  for (int r = gw; r < G.nseq * 16; r += nw) {
    const int s = r >> 4, t = r & 15;
    const u16* srcp = p.PM + (size_t)t * NIN;
    u16* dstp = p.P + (size_t)(G.Mx + r) * NIN;
    for (int c = lane * 8; c < NIN; c += 512)
      if (c < 2048 || c >= 3072) *(u32x4*)(dstp + c) = *(const u32x4*)(srcp + c);
    const int pos = (t & ~12) | ((t & 4) << 1) | ((t & 8) >> 1);
    for (int c = lane; c < 1024; c += 64) p.VT[(size_t)(s * 1024 + c) * Lp + pos] = srcp[2048 + c];
  }
}

#define LAS __attribute__((address_space(3)))
#define XB_TMO      128
#define XB_XCNT(j)  (256  + 64 * (j))
#define XB_XSUB(j)  (1280 + 64 * (j))
#define XB_XGEN(j)  (2304 + 64 * (j))
#define XB_TOP      3328
#define XB_TOPGEN   3392
#define XCD_BAR_WORDS 3456
#define XB_SPIN_CAP (1u << 18)
__device__ __forceinline__ unsigned xb_ld(unsigned* p) { return __hip_atomic_load(p, __ATOMIC_RELAXED, __HIP_MEMORY_SCOPE_AGENT); }
__device__ __forceinline__ unsigned xb_add(unsigned* p, unsigned v) { return __hip_atomic_fetch_add(p, v, __ATOMIC_RELAXED, __HIP_MEMORY_SCOPE_AGENT); }
__device__ __forceinline__ unsigned xb_xcc_id() { return (unsigned)__builtin_amdgcn_s_getreg((3 << 11) | 20) & 0xFu; }
#define XB_SPIN(cond, bar) do { unsigned _sp = 0; while (cond) { __builtin_amdgcn_s_sleep(1); \
    if ((++_sp & 255u) == 0u) { if (xb_ld(&(bar)[XB_TMO])) break; if (_sp > XB_SPIN_CAP) { atomicAdd(&(bar)[XB_TMO], 1u); break; } } } } while (0)
struct XcdBarrier { unsigned* bar; unsigned x; volatile LAS unsigned* st; };
__device__ __forceinline__ XcdBarrier xcd_barrier_post(unsigned* bar, volatile LAS unsigned* st) {
  XcdBarrier b; b.bar = bar; b.x = xb_xcc_id(); b.st = st;
  if (threadIdx.x == 0) (void)xb_add(&bar[XB_XCNT(b.x)], 1u);
  return b;
}
__device__ __forceinline__ void xcd_barrier_complete(unsigned* bar, unsigned x, unsigned& nloc, unsigned& nx) {
  const unsigned G = gridDim.x * gridDim.y * gridDim.z;
  unsigned sum, cnt, mine, sp = 0u;
  for (;;) {
    sum = 0u; cnt = 0u; mine = 0u;
#pragma unroll
    for (unsigned j = 0; j < 16; ++j) { const unsigned c = xb_ld(&bar[XB_XCNT(j)]); sum += c; cnt += (c > 0u) ? 1u : 0u; mine = (j == x) ? c : mine; }
    if (sum == G) break;
    __builtin_amdgcn_s_sleep(1);
    if ((++sp & 255u) == 0u) { if (xb_ld(&bar[XB_TMO])) break; if (sp > XB_SPIN_CAP) { atomicAdd(&bar[XB_TMO], 1u); break; } }
  }
  nloc = mine > 0u ? mine : 1u; nx = cnt > 0u ? cnt : 1u;
}
__device__ __forceinline__ void xcd_barrier(const XcdBarrier& b) {
  asm volatile("s_waitcnt vmcnt(0)" ::: "memory");
  __syncthreads();
  if (threadIdx.x == 0) {
    unsigned* bar = b.bar;
    __builtin_amdgcn_s_waitcnt(0);
    unsigned nloc = b.st[0], nx = b.st[1];
    if (nloc == 0u) { xcd_barrier_complete(bar, b.x, nloc, nx); b.st[0] = nloc; b.st[1] = nx; }
    const unsigned old = xb_add(&bar[XB_XSUB(b.x)], 1u);
    const unsigned gen = old / nloc;
    if (old + 1u == (gen + 1u) * nloc) {
      __builtin_amdgcn_fence(__ATOMIC_RELEASE, "agent");
      asm volatile("s_waitcnt vmcnt(0)" ::: "memory");
      const unsigned og = xb_add(&bar[XB_TOP], 1u);
      const unsigned tg = og / nx;
      if (og + 1u == (tg + 1u) * nx) xb_add(&bar[XB_TOPGEN], 1u);
      else XB_SPIN(xb_ld(&bar[XB_TOPGEN]) == tg, bar);
      __builtin_amdgcn_fence(__ATOMIC_ACQUIRE, "agent");
      xb_add(&bar[XB_XGEN(b.x)], 1u);
      asm volatile("s_waitcnt vmcnt(0)" ::: "memory");
    } else {
      XB_SPIN(xb_ld(&bar[XB_XGEN(b.x)]) == gen, bar);
      __builtin_amdgcn_fence(__ATOMIC_ACQUIRE, "agent");
      asm volatile("s_waitcnt vmcnt(0)" ::: "memory");
    }
  }
  __syncthreads();
}

#define LAS __attribute__((address_space(3)))
#define LAS __attribute__((address_space(3)))
#define LAS __attribute__((address_space(3)))
__device__ __forceinline__ void glds16(const void* gsrc, unsigned lds_dst) {
  unsigned keep;
  asm volatile("s_mov_b32 %0, m0\n\ts_mov_b32 m0, %2\n\ts_nop 0\n\tglobal_load_lds_dwordx4 %1, off\n\ts_mov_b32 m0, %0" : "=&s"(keep) : "v"(gsrc), "s"(lds_dst) : "memory");
}
struct GemmCtx {
  const u16* ap[2];
  const u16* wp[2];
  int wro[2], wsw[2], aro[2], asw[2];
  unsigned lds0;
  int tid, h;
};
__device__ __forceinline__ void g_init(GemmCtx& c, char* lds) {
  const int tid = ltid(), lane = tid & 63, wave = tid >> 6;
  const int wn = wave & 1, wt = wave >> 1, l32 = lane & 31;
  c.tid = tid; c.h = lane >> 5;
#pragma unroll
  for (int b = 0; b < 2; ++b) {
    const int wr = wn * 64 + b * 32 + l32, ar = wt * 64 + b * 32 + l32;
    c.wro[b] = wr * 64; c.wsw[b] = (wr >> 2) & 3;
    c.aro[b] = 8192 + ar * 64; c.asw[b] = (ar >> 2) & 3;
  }
  c.lds0 = __builtin_amdgcn_readfirstlane((unsigned)(uintptr_t)(LAS char*)lds + wave * 1024);
}
__device__ __forceinline__ void g_tile(GemmCtx& c, const u16* __restrict__ A, int lda, int M, int m0, const u16* __restrict__ W, int ldw, int n0) {
#pragma unroll
  for (int i = 0; i < 2; ++i) {
    const int q = c.tid + 256 * i, row = q >> 2, ch = (q & 3) ^ ((row >> 2) & 3);
    int ar = m0 + row; ar = ar < M ? ar : M - 1;
    c.ap[i] = A + (size_t)ar * lda + ch * 8;
    c.wp[i] = W + (size_t)(n0 + row) * ldw + ch * 8;
  }
}
__device__ __forceinline__ void g_stage(const GemmCtx& c, int kt) {
  const unsigned sb = c.lds0 + (kt & 3) * 16384;
#pragma unroll
  for (int i = 0; i < 2; ++i) {
    glds16(c.wp[i] + kt * 32, sb + i * 4096);
    glds16(c.ap[i] + kt * 32, sb + 8192 + i * 4096);
  }
}
__device__ __forceinline__ void g_prologue(const GemmCtx& c, int nk) {
#pragma unroll
  for (int s = 0; s < 3; ++s)
    if (s < nk) g_stage(c, s);
}
struct Frags { bf16x8 w[2][2], a[2][2]; };
__device__ __forceinline__ void g_read(Frags& f, const GemmCtx& c, int kt, const char* lds) {
  const char* st = lds + (kt & 3) * 16384;
#pragma unroll
  for (int ks = 0; ks < 2; ++ks)
#pragma unroll
    for (int b = 0; b < 2; ++b) {
      f.w[ks][b] = *(const bf16x8*)(st + c.wro[b] + (((ks * 2 + c.h) ^ c.wsw[b]) << 4));
      f.a[ks][b] = *(const bf16x8*)(st + c.aro[b] + (((ks * 2 + c.h) ^ c.asw[b]) << 4));
    }
}
__device__ __forceinline__ void g_mma(f32x16 (&acc)[2][2], const Frags& f) {
#pragma unroll
  for (int ks = 0; ks < 2; ++ks)
#pragma unroll
    for (int nb = 0; nb < 2; ++nb)
#pragma unroll
      for (int tb = 0; tb < 2; ++tb)
        acc[nb][tb] = __builtin_amdgcn_mfma_f32_32x32x16_bf16(f.w[ks][nb], f.a[ks][tb], acc[nb][tb], 0, 0, 0);
}
__device__ __forceinline__ void g_wait(int ks_needed, int issued_hi, bool drain_all) {
  const int allowed = issued_hi - ks_needed;
  if (drain_all || allowed <= 0) asm volatile("s_waitcnt vmcnt(0) lgkmcnt(0)" ::: "memory");
  else if (allowed == 1) asm volatile("s_waitcnt vmcnt(4) lgkmcnt(0)" ::: "memory");
  else asm volatile("s_waitcnt vmcnt(8) lgkmcnt(0)" ::: "memory");
  __builtin_amdgcn_s_barrier();
}
__device__ __forceinline__ void g_main(f32x16 (&acc)[2][2], const GemmCtx& c, int nk, char* lds) {
  Frags f0, f1;
  g_wait(0, nk - 1 < 2 ? nk - 1 : 2, true);
  if (3 < nk) g_stage(c, 3);
  g_read(f0, c, 0, lds);
  for (int kt = 0; kt < nk; kt += 2) {
    {
      const int hi = (kt + 3 < nk - 1) ? kt + 3 : nk - 1;
      g_wait(kt + 1, hi, false);
      if (kt + 4 < nk) g_stage(c, kt + 4);
      g_read(f1, c, kt + 1, lds);
      g_mma(acc, f0);
    }
    if (kt + 2 < nk) {
      const int hi = (kt + 4 < nk - 1) ? kt + 4 : nk - 1;
      g_wait(kt + 2, hi, false);
      if (kt + 5 < nk) g_stage(c, kt + 5);
      g_read(f0, c, kt + 2, lds);
    }
    g_mma(acc, f1);
  }
}
__device__ __forceinline__ void gemm_kloop(f32x16 (&acc)[2][2], const u16* __restrict__ A, int lda, int M, int m0,
                                           const u16* __restrict__ W, int ldw, int n0, int K, char* lds) {
  GemmCtx c;
  g_init(c, lds);
  g_tile(c, A, lda, M, m0, W, ldw, n0);
  asm volatile("s_waitcnt vmcnt(0)" ::: "memory");
  __builtin_amdgcn_s_barrier();
  g_prologue(c, K >> 5);
  g_main(acc, c, K >> 5, lds);
}

__device__ __forceinline__ void zero_acc(f32x16 (&acc)[2][2]) {
#pragma unroll
  for (int a = 0; a < 2; ++a)
#pragma unroll
    for (int b = 0; b < 2; ++b)
#pragma unroll
      for (int r = 0; r < 16; ++r) acc[a][b][r] = 0.f;
}

template <class F>
__device__ __forceinline__ void gemm_phase(const u16* A, int lda, int M, const u16* W, int K, int N, char* lds, int* ctr, F&& epi) {
  const int nN = N >> 7, nM = (M + 127) >> 7, nt = nN * nM, nk = K >> 5;
  const int xcd = (int)xb_xcc_id() & 7;
  const int tq = nt >> 3, trm = nt & 7;
  const int tstart = xcd < trm ? xcd * (tq + 1) : trm * (tq + 1) + (xcd - trm) * tq;
  const int tcnt = tq + (xcd < trm ? 1 : 0);
  auto decode = [&](int off, int& tm, int& tn) {
    const int id = tstart + off, nig = 8 * nN, grp = id / nig, fm = grp * 8;
    const int gsz = (nM - fm) < 8 ? (nM - fm) : 8, idl = id - grp * nig;
    tm = fm + idl % gsz; tn = idl / gsz;
  };
  GemmCtx c;
  g_init(c, lds);
  const int wave = c.tid >> 6;
  volatile int* bw = (volatile int*)(lds + 65536);
  int* myctr = ctr + xcd;
  int par = 0;
  if (c.tid == 0) bw[2] = atomicAdd(myctr, 1);
  asm volatile("s_waitcnt vmcnt(0) lgkmcnt(0)" ::: "memory");
  __builtin_amdgcn_s_barrier();
  int off = bw[2];
  int tm = 0, tn = 0;
  if (off < tcnt) { decode(off, tm, tn); g_tile(c, A, lda, M, tm * 128, W, K, tn * 128); g_prologue(c, nk); }
  while (off < tcnt) {
    f32x16 acc[2][2];
    zero_acc(acc);
    g_main(acc, c, nk, lds);
    const int ctm = tm, ctn = tn;
    par ^= 1;
    if (c.tid == 0) bw[2 + par] = atomicAdd(myctr, 1);
    asm volatile("s_waitcnt lgkmcnt(0)" ::: "memory");
    __builtin_amdgcn_s_barrier();
    off = bw[2 + par];
    if (off < tcnt) { decode(off, tm, tn); g_tile(c, A, lda, M, tm * 128, W, K, tn * 128); g_prologue(c, nk); }
    epi(acc, ctn * 128 + (wave & 1) * 64, ctm * 128 + (wave >> 1) * 64);
  }
}

__device__ __forceinline__ void epi_swiglu(const f32x16 (&acc)[2][2], int nbase, int tbase, int M, const float* ss, u16* ACT) {
  const int lane = ltid() & 63, l32 = lane & 31, h = lane >> 5;
  const int cb = (nbase >> 6) * 32;
#pragma unroll
  for (int tb = 0; tb < 2; ++tb) {
    const int tok = tbase + tb * 32 + l32;
    if (tok < M) {
      const float rs = rsqrtf(ss[tok] * (1.f / 1024.f) + EPSN);
      u16* dst = ACT + (size_t)tok * FFD + cb + 4 * h;
#pragma unroll
      for (int i = 0; i < 4; ++i) {
        float o[4];
#pragma unroll
        for (int j = 0; j < 4; ++j) {
          const float g = acc[0][tb][4 * i + j] * rs, u = acc[1][tb][4 * i + j] * rs;
          o[j] = g * sigm(g) * u;
        }
        *(u32x2*)(dst + 8 * i) = (u32x2){pk_bf16(o[0], o[1]), pk_bf16(o[2], o[3])};
      }
    }
  }
}

template <int MODE>
__device__ __forceinline__ void epi_resid(const f32x16 (&acc)[2][2], int nbase, int tbase, CP& p, const Grp& G) {
  const int lane = ltid() & 63, l32 = lane & 31, h = lane >> 5;
  const float scale = MODE == 1 ? 1.f : 0.5f;
  float* ssout = MODE == 0 ? p.ss1 : (MODE == 1 ? p.ss2 : p.ss3);
#pragma unroll
  for (int tb = 0; tb < 2; ++tb) {
    const int tok = tbase + tb * 32 + l32;
    const bool valid = tok < G.Mx;
    float sq = 0.f;
    if (valid) {
      float* hp = p.H + (size_t)tok * 1024;
      u16* hb = p.HB + (size_t)tok * 1024;
      const float* rp = G.x + (size_t)tok * 1024;
#pragma unroll
      for (int nb = 0; nb < 2; ++nb)
#pragma unroll
        for (int i = 0; i < 4; ++i) {
          const int n = nbase + nb * 32 + 8 * i + 4 * h;
          f32x4 r;
          if (MODE == 0) r = *(const f32x4*)(rp + n);
          else { const u32x2 rb = *(const u32x2*)(hb + n); r = (f32x4){bf_lo(rb.x), bf_hi(rb.x), bf_lo(rb.y), bf_hi(rb.y)}; }
          f32x4 v;
          v.x = r.x + scale * acc[nb][tb][4 * i + 0];
          v.y = r.y + scale * acc[nb][tb][4 * i + 1];
          v.z = r.z + scale * acc[nb][tb][4 * i + 2];
          v.w = r.w + scale * acc[nb][tb][4 * i + 3];
          sq += v.x * v.x + v.y * v.y + v.z * v.z + v.w * v.w;
          if (MODE == 2) *(f32x4*)(hp + n) = v;
          else *(u32x2*)(hb + n) = (u32x2){pk_bf16(v.x, v.y), pk_bf16(v.z, v.w)};
        }
    }
    sq += __shfl_xor(sq, 32);
    if (valid && h == 0) atomicAdd(ssout + tok, sq);
  }
}

__device__ void phase_mix(CP& p, const Grp& G) {
  const int total = G.M * 432;
  for (int idx = blockIdx.x * 256 + ltid(); idx < total; idx += gridDim.x * 256) {
    const int row = idx / 432, ch = idx - row * 432;
    int s, t;
    if (row < G.Mx) { s = row >> G.lgS; t = 16 + (row & (G.S - 1)); } else { s = (row - G.Mx) >> 4; t = (row - G.Mx) & 15; }
    const int col = ch * 8;
    const u16* pc = p.P + (size_t)row * NIN + 3072 + col;
    const u32x4 c = *(const u32x4*)pc;
    u32x4 pv = {0, 0, 0, 0}, nx = {0, 0, 0, 0};
    if (t > 0) pv = *(const u32x4*)(p.P + (size_t)rowof(G, s, t - 1) * NIN + 3072 + col);
    if (t < G.L - 1) nx = *(const u32x4*)(p.P + (size_t)rowof(G, s, t + 1) * NIN + 3072 + col);
    const f32x4 mp0 = *(const f32x4*)(p.mu_prev + col), mp1 = *(const f32x4*)(p.mu_prev + col + 4);
    const f32x4 mn0 = *(const f32x4*)(p.mu_next + col), mn1 = *(const f32x4*)(p.mu_next + col + 4);
    float o[8];
#pragma unroll
    for (int e = 0; e < 4; ++e) {
      const float c0 = bf_lo(c[e]), c1 = bf_hi(c[e]);
      const float mpa = e < 2 ? mp0[2 * e] : mp1[2 * e - 4], mpb = e < 2 ? mp0[2 * e + 1] : mp1[2 * e - 3];
      const float mna = e < 2 ? mn0[2 * e] : mn1[2 * e - 4], mnb = e < 2 ? mn0[2 * e + 1] : mn1[2 * e - 3];
      o[2 * e] = c0 + mpa * (bf_lo(pv[e]) - c0) + mna * (bf_lo(nx[e]) - c0);
      o[2 * e + 1] = c1 + mpb * (bf_hi(pv[e]) - c1) + mnb * (bf_hi(nx[e]) - c1);
    }
    if (col < 3072) {
      const int sec = col >> 10, ci = col & 1023, head = ci >> 6, c0 = ci & 63;
      const size_t ro = ((size_t)row * 16 + head) * 192 + sec * 64 + c0;
      const u32x4 pk = (u32x4){pk_f16(o[0], o[1]), pk_f16(o[2], o[3]), pk_f16(o[4], o[5]), pk_f16(o[6], o[7])};
      *(u32x4*)(p.RKV + ro) = pk;
      if (sec == 1) { *(u32x4*)(p.DIR0 + ro) = pk; *(u32x4*)(p.DIR1 + ro) = pk; }
    } else {
      const int fc = col - 3072;
      if (fc < 128) {
#pragma unroll
        for (int e = 0; e < 8; ++e) o[e] = 1.f - 2.f / (1.f + __expf(2.f * o[e]));
      } else if (fc >= 256) {
#pragma unroll
        for (int e = 0; e < 8; ++e) o[e] = sigm(o[e]);
      }
      *(u32x4*)(p.F + (size_t)row * 384 + fc) = (u32x4){pk_bf16(o[0], o[1]), pk_bf16(o[2], o[3]), pk_bf16(o[4], o[5]), pk_bf16(o[6], o[7])};
    }
  }
}

__device__ __forceinline__ void epi_decay(const f32x16 (&acc)[2][2], int nbase, int tbase, int M, const float* w0, u16* DIR) {
  const int lane = ltid() & 63, l32 = lane & 31, h = lane >> 5;
  const int head = nbase >> 6;
#pragma unroll
  for (int tb = 0; tb < 2; ++tb) {
    const int tok = tbase + tb * 32 + l32;
    if (tok < M) {
      u16* dst = DIR + ((size_t)tok * 16 + head) * 192;
#pragma unroll
      for (int nb = 0; nb < 2; ++nb)
#pragma unroll
        for (int i = 0; i < 4; ++i) {
          const int c = nb * 32 + 8 * i + 4 * h;
          const f32x4 w = *(const f32x4*)(w0 + nbase + c);
          float o[4];
#pragma unroll
          for (int j = 0; j < 4; ++j) o[j] = 0.6065306597126334f * sigm(w[j] + acc[nb][tb][4 * i + j]);
          *(u32x2*)(dst + c) = (u32x2){pk_f16(o[0], o[1]), pk_f16(o[2], o[3])};
        }
    }
  }
}

__device__ __forceinline__ void epi_adir(const f32x16 (&acc)[2][2], int nbase, int tbase, int M, CP& p, int dir) {
  const int lane = ltid() & 63, l32 = lane & 31, h = lane >> 5;
  const int head = nbase >> 6;
  u16* DIR = dir ? p.DIR1 : p.DIR0;
  const float* a0 = p.rw_a0 + dir * 1024;
#pragma unroll
  for (int tb = 0; tb < 2; ++tb) {
    const int tok = tbase + tb * 32 + l32;
    const bool valid = tok < M;
    const int tk = valid ? tok : M - 1;
    const size_t rec = ((size_t)tk * 16 + head) * 192;
    float nsq = 0.f;
#pragma unroll
    for (int nb = 0; nb < 2; ++nb)
#pragma unroll
      for (int i = 0; i < 4; ++i) {
        const int c = nb * 32 + 8 * i + 4 * h;
        const u32x2 kr = *(const u32x2*)(DIR + rec + 64 + c);
        const f32x4 kkw = *(const f32x4*)(p.k_k + nbase + c);
        const float q0 = h_lo(kr.x) * kkw[0], q1 = h_hi(kr.x) * kkw[1], q2 = h_lo(kr.y) * kkw[2], q3 = h_hi(kr.y) * kkw[3];
        nsq += q0 * q0 + q1 * q1 + q2 * q2 + q3 * q3;
      }
    nsq += __shfl_xor(nsq, 32);
    const float inv = 1.f / fmaxf(sqrtf(nsq), 1e-12f);
    if (valid) {
#pragma unroll
      for (int nb = 0; nb < 2; ++nb)
#pragma unroll
        for (int i = 0; i < 4; ++i) {
          const int c = nb * 32 + 8 * i + 4 * h;
          const u32x2 kr = *(const u32x2*)(DIR + rec + 64 + c);
          const float kv[4] = {h_lo(kr.x), h_hi(kr.x), h_lo(kr.y), h_hi(kr.y)};
          const f32x4 kkw = *(const f32x4*)(p.k_k + nbase + c);
          const f32x4 kaw = *(const f32x4*)(p.k_a + nbase + c);
          const f32x4 a0v = *(const f32x4*)(a0 + nbase + c);
          float kk[4], kd[4], bp[4];
#pragma unroll
          for (int j = 0; j < 4; ++j) {
            const float k = kv[j];
            kk[j] = k * kkw[j] * inv;
            const float aa = sigm(a0v[j] + acc[nb][tb][4 * i + j]);
            kd[j] = k * (1.f + (aa - 1.f) * kaw[j]);
            bp[j] = -kk[j] * aa;
          }
          if (dir == 0) *(u32x2*)(p.RKV + rec + 64 + c) = (u32x2){pk_f16(kk[0], kk[1]), pk_f16(kk[2], kk[3])};
          *(u32x2*)(DIR + rec + 64 + c) = (u32x2){pk_f16(kd[0], kd[1]), pk_f16(kd[2], kd[3])};
          *(u32x2*)(DIR + rec + 128 + c) = (u32x2){pk_f16(bp[0], bp[1]), pk_f16(bp[2], bp[3])};
        }
    }
  }
}

template <int LPR>
__device__ void scan_task(CP& p, const Grp& G, int task, char* lds) {
  constexpr int KPL = 64 / LPR, RPB = 256 / LPR, NSPLIT = 64 / RPB;
  const int part = task % NSPLIT, t1 = task / NSPLIT;
  const int dir = t1 & 1, head = (t1 >> 1) & 15, s = t1 >> 5;
  float* buf = (float*)lds;
  const u16* rkv = p.RKV;
  const u16* dr = dir ? p.DIR1 : p.DIR0;
  u16* Y = dir ? p.Y1 : p.Y0;
  const int tid = ltid();
  const int row = part * RPB + tid / LPR, kc = tid % LPR;
  const int L = G.L, nch = L >> 4;
  u32x4 pre[3];
  auto issue = [&](int c) {
#pragma unroll
    for (int i = 0; i < 3; ++i) {
      const int id = tid + 256 * i, st = id / 48, ci = id - st * 48;
      const int n = c * 16 + st, t = dir ? L - 1 - n : n;
      const size_t rec = ((size_t)rowof(G, s, t) * 16 + head) * 192;
      const u16* src = ci < 24 ? rkv + rec + ci * 8 : dr + rec + (ci - 24) * 8;
      pre[i] = *(const u32x4*)src;
    }
  };
  auto commit = [&](int b) {
#pragma unroll
    for (int i = 0; i < 3; ++i) {
      const int id = tid + 256 * i, st = id / 48, ci = id - st * 48;
      const int sec = ci >> 3;
      const int base = sec >= 3 ? (sec - 1) * 64 : (sec == 0 ? 64 : (sec == 1 ? 0 : 320));
      float f[8];
#pragma unroll
      for (int e = 0; e < 4; ++e) { f[2 * e] = h_lo(pre[i][e]); f[2 * e + 1] = h_hi(pre[i][e]); }
      if (sec == 3) {
#pragma unroll
        for (int e = 0; e < 8; ++e) f[e] = __expf(-f[e]);
      }
      float* d = buf + b * 6144 + st * 384 + base + (ci & 7) * 8;
      *(f32x4*)d = (f32x4){f[0], f[1], f[2], f[3]};
      *(f32x4*)(d + 4) = (f32x4){f[4], f[5], f[6], f[7]};
    }
  };
  float S[KPL];
#pragma unroll
  for (int i = 0; i < KPL; ++i) S[i] = 0.f;
  __syncthreads();
  issue(0);
  commit(0);
  __syncthreads();
  __builtin_amdgcn_s_setprio(3);
  for (int c = 0; c < nch; ++c) {
    if (c + 1 < nch) issue(c + 1);
    const float* b = buf + (c & 1) * 6144;
#pragma unroll 4
    for (int st = 0; st < 16; ++st) {
      const float* q = b + st * 384 + kc * KPL;
      f32x4 kk[KPL / 4], rr[KPL / 4], ww[KPL / 4], dd[KPL / 4], bb[KPL / 4];
#pragma unroll
      for (int j = 0; j < KPL / 4; ++j) {
        kk[j] = *(const f32x4*)(q + 4 * j);
        rr[j] = *(const f32x4*)(q + 64 + 4 * j);
        ww[j] = *(const f32x4*)(q + 128 + 4 * j);
        dd[j] = *(const f32x4*)(q + 192 + 4 * j);
        bb[j] = *(const f32x4*)(q + 256 + 4 * j);
      }
      const float vv = b[st * 384 + 320 + row];
      float sa0 = 0.f, sa1 = 0.f;
#pragma unroll
      for (int j = 0; j < KPL / 4; ++j) {
        sa0 += S[4 * j] * kk[j][0]; sa1 += S[4 * j + 1] * kk[j][1];
        sa0 += S[4 * j + 2] * kk[j][2]; sa1 += S[4 * j + 3] * kk[j][3];
      }
      float sa = sa0 + sa1;
      sa = LPR == 8 ? reduce8(sa) : reduce4(sa);
      float y0 = 0.f, y1 = 0.f;
#pragma unroll
      for (int j = 0; j < KPL / 4; ++j)
#pragma unroll
        for (int e = 0; e < 4; ++e) {
          const float sn = S[4 * j + e] * ww[j][e] + (sa * bb[j][e] + vv * dd[j][e]);
          S[4 * j + e] = sn;
          if (e & 1) y1 += sn * rr[j][e]; else y0 += sn * rr[j][e];
        }
      float y = y0 + y1;
      y = LPR == 8 ? reduce8(y) : reduce4(y);
      if (kc == 0) {
        const int n = c * 16 + st, t = dir ? L - 1 - n : n;
        Y[(size_t)rowof(G, s, t) * 1024 + head * 64 + row] = bf16_1(y);
      }
    }
    if (c + 1 < nch) commit((c + 1) & 1);
    __syncthreads();
  }
  __builtin_amdgcn_s_setprio(0);
}

__device__ void attn_tile(CP& p, const Grp& G, int s, int hd, int qb, char* lds, float lam) {
  const int tid = ltid(), lane = tid & 63, wave = tid >> 6, l32 = lane & 31, h = lane >> 5;
  const int L = G.L, Lp = (G.L + 31) & ~31;
  const u16* Pb = p.P;
  float* lutl = (float*)(lds + 36864);
  char* qfl = lds + 38912 + tid * 16;
  __syncthreads();
  for (int i = tid; i < 511; i += 256) lutl[i] = p.lut[hd * 512 + i];
  const int q = 16 + qb * 128 + wave * 32 + l32;
  const int qc = s * G.S + (q - 16);
  const int qw0 = 16 + qb * 128 + wave * 32;
  u16* odst = p.O + (size_t)qc * 1024 + hd * 128;
  const int kkey = tid >> 3, kch = (tid & 7) ^ ((kkey >> 1) & 7);
  const u16* vsrc[2];
#pragma unroll
  for (int i = 0; i < 2; ++i) {
    const int c = tid + 256 * i, dv = c >> 2, c4 = (c & 3) ^ ((dv >> 2) & 3);
    vsrc[i] = p.VT + ((size_t)(s * 1024 + hd * 128 + dv) * Lp) + c4 * 8;
  }
  const unsigned lds0 = __builtin_amdgcn_readfirstlane((unsigned)(uintptr_t)(LAS char*)lds + wave * 1024);
  const int ntile = (L + 31) >> 5;
#pragma unroll 1
  for (int br = 0; br < 2; ++br) {
#pragma unroll
    for (int ks = 0; ks < 4; ++ks) {
      const u32x4 raw = *(const u32x4*)(Pb + (size_t)qc * NIN + hd * 128 + br * 64 + ks * 16 + h * 8);
      u32x4 sc;
#pragma unroll
      for (int e = 0; e < 4; ++e) sc[e] = pk_bf16(bf_lo(raw[e]) * 0.125f, bf_hi(raw[e]) * 0.125f);
      *(u32x4*)(qfl + ks * 4096) = sc;
    }
    const u16* kp = Pb + 1024 + hd * 128 + br * 64 + kch * 8;
    auto stage = [&](int kt) {
      const int kt0 = kt * 32;
      const unsigned sb = lds0 + (kt % 3) * 12288;
      int kr = kt0 + kkey; kr = kr < L ? kr : L - 1;
      glds16(kp + (size_t)rowof(G, s, kr) * NIN, sb);
      glds16(vsrc[0] + kt0, sb + 4096);
      glds16(vsrc[1] + kt0, sb + 8192);
    };
    f32x16 O[4];
#pragma unroll
    for (int mb = 0; mb < 4; ++mb)
#pragma unroll
      for (int r = 0; r < 16; ++r) O[mb][r] = 0.f;
    float mrun = -1e30f, lrun = 0.f;
    asm volatile("s_waitcnt vmcnt(0) lgkmcnt(0)" ::: "memory");
    __builtin_amdgcn_s_barrier();
    stage(0);
    if (ntile > 1) stage(1);
    const float cneg = lutl[0], cpos = lutl[510];
    for (int kt = 0; kt < ntile; ++kt) {
      const int kt0 = kt * 32;
      if (kt + 1 < ntile) asm volatile("s_waitcnt vmcnt(3)" ::: "memory");
      else asm volatile("s_waitcnt vmcnt(0)" ::: "memory");
      __builtin_amdgcn_s_barrier();
      if (kt + 2 < ntile) stage(kt + 2);
      const char* st = lds + (kt % 3) * 12288;
      f32x16 sacc;
#pragma unroll
      for (int r = 0; r < 16; ++r) sacc[r] = 0.f;
#pragma unroll
      for (int ks = 0; ks < 4; ++ks) {
        const bf16x8 kf = *(const bf16x8*)(st + l32 * 128 + (((ks * 2 + h) ^ ((l32 >> 1) & 7)) << 4));
        const bf16x8 qv = *(const bf16x8*)(qfl + ks * 4096);
        sacc = __builtin_amdgcn_mfma_f32_32x32x16_bf16(kf, qv, sacc, 0, 0, 0);
      }
      const bool farneg = (kt0 + 31) <= (qw0 - 128);
      const bool farpos = kt0 >= (qw0 + 31 + 128);
      float mx = -1e30f;
      if (farneg || farpos) {
        const float cv = farneg ? cneg : cpos;
#pragma unroll
        for (int r = 0; r < 16; ++r) { sacc[r] = sacc[r] * LOG2E + cv; }
      } else {
#pragma unroll
        for (int r = 0; r < 16; ++r) {
          const int key = kt0 + 8 * (r >> 2) + 4 * h + (r & 3);
          int d = key - q + 255;
          d = d < 0 ? 0 : (d > 510 ? 510 : d);
          sacc[r] = sacc[r] * LOG2E + lutl[d];
        }
      }
      if (kt0 + 32 > L) {
#pragma unroll
        for (int r = 0; r < 16; ++r) {
          const int key = kt0 + 8 * (r >> 2) + 4 * h + (r & 3);
          if (key >= L) sacc[r] = -INFINITY;
        }
      }
#pragma unroll
      for (int r = 0; r < 16; ++r) mx = fmaxf(mx, sacc[r]);
      mx = fmaxf(mx, __shfl_xor(mx, 32));
      const float mnew = fmaxf(mrun, mx);
      const float alpha = __builtin_amdgcn_exp2f(mrun - mnew);
      mrun = mnew;
      float ps = 0.f;
#pragma unroll
      for (int r = 0; r < 16; ++r) { sacc[r] = __builtin_amdgcn_exp2f(sacc[r] - mnew); ps += sacc[r]; }
      lrun = lrun * alpha + ps;
      if (__any(alpha != 1.f)) {
#pragma unroll
        for (int mb = 0; mb < 4; ++mb)
#pragma unroll
          for (int r = 0; r < 16; ++r) O[mb][r] *= alpha;
      }
      bf16x8 pf[2];
#pragma unroll
      for (int s2 = 0; s2 < 2; ++s2) {
        u32x4 w;
#pragma unroll
        for (int e = 0; e < 4; ++e) w[e] = pk_bf16(sacc[8 * s2 + 2 * e], sacc[8 * s2 + 2 * e + 1]);
        pf[s2] = __builtin_bit_cast(bf16x8, w);
      }
#pragma unroll
      for (int mb = 0; mb < 4; ++mb)
#pragma unroll
        for (int s2 = 0; s2 < 2; ++s2) {
          const int vr = mb * 32 + l32;
          const bf16x8 vf = *(const bf16x8*)(st + 4096 + vr * 64 + (((2 * s2 + h) ^ ((vr >> 2) & 3)) << 4));
          O[mb] = __builtin_amdgcn_mfma_f32_32x32x16_bf16(vf, pf[s2], O[mb], 0, 0, 0);
        }
    }
    const float lt = lrun + __shfl_xor(lrun, 32);
    if (br == 0) {
      const float i1 = 1.f / lt;
#pragma unroll
      for (int mb = 0; mb < 4; ++mb)
#pragma unroll
        for (int i = 0; i < 4; ++i)
          if (q < L) *(u32x2*)(odst + mb * 32 + 8 * i + 4 * h) = (u32x2){pk_bf16(O[mb][4 * i] * i1, O[mb][4 * i + 1] * i1), pk_bf16(O[mb][4 * i + 2] * i1, O[mb][4 * i + 3] * i1)};
    } else {
      const float i2 = lam / lt;
      float ssq = 0.f;
#pragma unroll
      for (int mb = 0; mb < 4; ++mb)
#pragma unroll
        for (int i = 0; i < 4; ++i) {
          u32x2 w = {0, 0};
          if (q < L) w = *(const u32x2*)(odst + mb * 32 + 8 * i + 4 * h);
          const float o0 = bf_lo(w.x) - O[mb][4 * i] * i2, o1v = bf_hi(w.x) - O[mb][4 * i + 1] * i2, o2 = bf_lo(w.y) - O[mb][4 * i + 2] * i2, o3 = bf_hi(w.y) - O[mb][4 * i + 3] * i2;
          O[mb][4 * i] = o0; O[mb][4 * i + 1] = o1v; O[mb][4 * i + 2] = o2; O[mb][4 * i + 3] = o3;
          ssq += o0 * o0 + o1v * o1v + o2 * o2 + o3 * o3;
        }
      ssq += __shfl_xor(ssq, 32);
      const float rn = rsqrtf(ssq * (1.f / 128.f) + EPSN) * 0.8f;
      if (q < L) {
#pragma unroll
        for (int mb = 0; mb < 4; ++mb)
#pragma unroll
          for (int i = 0; i < 4; ++i) {
            const int dv = mb * 32 + 8 * i + 4 * h;
            const f32x4 g = *(const f32x4*)(p.subln + dv);
            *(u32x2*)(odst + dv) = (u32x2){pk_bf16(O[mb][4 * i] * rn * g.x, O[mb][4 * i + 1] * rn * g.y),
                                           pk_bf16(O[mb][4 * i + 2] * rn * g.z, O[mb][4 * i + 3] * rn * g.w)};
          }
      }
    }
  }
}

__device__ void phase_mixer(CP& p, const Grp& G, int g, char* lds) {
  if (G.nseq == 4) { for (int t = blockIdx.x; t < 256; t += gridDim.x) scan_task<8>(p, G, t, lds); }
  else { for (int t = blockIdx.x; t < 256; t += gridDim.x) scan_task<4>(p, G, t, lds); }
  const int nqb = G.S >> 7;
  const int natt = G.nseq * 8 * nqb;
  const float lam = p.lam[0];
  int* shw = (int*)(lds + 65536 - 16);
  while (true) {
    __syncthreads();
    if (ltid() == 0) *shw = atomicAdd(p.cnt + g, 1);
    __syncthreads();
    const int t = *shw;
    if (t >= natt) break;
    const int qb = t % nqb, r = t / nqb, hd = r & 7, s = r >> 3;
    attn_tile(p, G, s, hd, qb, lds, lam);
  }
}

__device__ void phase_post(CP& p, const Grp& G) {
  const int lane = ltid() & 63;
  const int nw = gridDim.x * 4;
  const int c0 = lane * 16, head = lane >> 2, hc = (lane & 3) * 16;
  for (int row = blockIdx.x * 4 + (ltid() >> 6); row < G.Mx; row += nw) {
    float y[16];
    {
      const u32x4 a0 = *(const u32x4*)(p.Y0 + (size_t)row * 1024 + c0), a1 = *(const u32x4*)(p.Y0 + (size_t)row * 1024 + c0 + 8);
      const u32x4 b0 = *(const u32x4*)(p.Y1 + (size_t)row * 1024 + c0), b1 = *(const u32x4*)(p.Y1 + (size_t)row * 1024 + c0 + 8);
#pragma unroll
      for (int e = 0; e < 4; ++e) {
        y[2 * e] = bf_lo(a0[e]) + bf_lo(b0[e]); y[2 * e + 1] = bf_hi(a0[e]) + bf_hi(b0[e]);
        y[8 + 2 * e] = bf_lo(a1[e]) + bf_lo(b1[e]); y[8 + 2 * e + 1] = bf_hi(a1[e]) + bf_hi(b1[e]);
      }
    }
    float s1 = 0.f;
#pragma unroll
    for (int e = 0; e < 16; ++e) s1 += y[e];
    s1 = reduce4(s1);
    const float mu = s1 * (1.f / 64.f);
    float s2 = 0.f;
#pragma unroll
    for (int e = 0; e < 16; ++e) { const float d = y[e] - mu; s2 += d * d; }
    s2 = reduce4(s2);
    const float rstd = rsqrtf(s2 * (1.f / 64.f) + 64e-5f);
    const size_t rec = ((size_t)row * 16 + head) * 192 + hc;
    float rr[16], vv[16], kd[16];
    {
      const u32x4 r0 = *(const u32x4*)(p.RKV + rec), r1 = *(const u32x4*)(p.RKV + rec + 8);
      const u32x4 v0 = *(const u32x4*)(p.RKV + rec + 128), v1 = *(const u32x4*)(p.RKV + rec + 136);
      const u32x4 f0 = *(const u32x4*)(p.DIR0 + rec + 64), f1 = *(const u32x4*)(p.DIR0 + rec + 72);
      const u32x4 g0 = *(const u32x4*)(p.DIR1 + rec + 64), g1 = *(const u32x4*)(p.DIR1 + rec + 72);
#pragma unroll
      for (int e = 0; e < 4; ++e) {
        rr[2 * e] = h_lo(r0[e]); rr[2 * e + 1] = h_hi(r0[e]); rr[8 + 2 * e] = h_lo(r1[e]); rr[8 + 2 * e + 1] = h_hi(r1[e]);
        vv[2 * e] = h_lo(v0[e]); vv[2 * e + 1] = h_hi(v0[e]); vv[8 + 2 * e] = h_lo(v1[e]); vv[8 + 2 * e + 1] = h_hi(v1[e]);
        kd[2 * e] = h_lo(f0[e]) + h_lo(g0[e]); kd[2 * e + 1] = h_hi(f0[e]) + h_hi(g0[e]);
        kd[8 + 2 * e] = h_lo(f1[e]) + h_lo(g1[e]); kd[8 + 2 * e + 1] = h_hi(f1[e]) + h_hi(g1[e]);
      }
    }
    float bs = 0.f;
#pragma unroll
    for (int e = 0; e < 16; ++e) bs += rr[e] * kd[e] * p.r_k[c0 + e];
    bs = reduce4(bs);
    const u32x4 g0 = *(const u32x4*)(p.G + (size_t)row * 1024 + c0), g1 = *(const u32x4*)(p.G + (size_t)row * 1024 + c0 + 8);
    float o[16];
#pragma unroll
    for (int e = 0; e < 16; ++e) {
      const unsigned gw = e < 8 ? g0[e >> 1] : g1[(e - 8) >> 1];
      const float gg = (e & 1) ? bf_hi(gw) : bf_lo(gw);
      o[e] = ((y[e] - mu) * rstd * p.lnx_w[c0 + e] + p.lnx_b[c0 + e] + bs * vv[e]) * gg;
    }
    u16* dst = (u16*)p.H + (size_t)row * 1024 + c0;
    *(u32x4*)dst = (u32x4){pk_bf16(o[0], o[1]), pk_bf16(o[2], o[3]), pk_bf16(o[4], o[5]), pk_bf16(o[6], o[7])};
    *(u32x4*)(dst + 8) = (u32x4){pk_bf16(o[8], o[9]), pk_bf16(o[10], o[11]), pk_bf16(o[12], o[13]), pk_bf16(o[14], o[15])};
  }
}

__device__ void phase_final(CP& p, const Grp& G) {
  const int lane = ltid() & 63;
  const int nw = gridDim.x * 4;
  for (int row = blockIdx.x * 4 + (ltid() >> 6); row < G.Mx; row += nw) {
    const float rs = rsqrtf(p.ss3[row] * (1.f / 1024.f) + EPSN);
    const float* hp = p.H + (size_t)row * 1024;
    float* op = G.out + (size_t)row * 1024;
#pragma unroll
    for (int i = 0; i < 4; ++i) {
      const f32x4 v = *(const f32x4*)(hp + i * 256 + lane * 4);
      const f32x4 g = *(const f32x4*)(p.final_norm + i * 256 + lane * 4);
      *(f32x4*)(op + i * 256 + lane * 4) = (f32x4){v.x * rs * g.x, v.y * rs * g.y, v.z * rs * g.z, v.w * rs * g.w};
    }
  }
}

__device__ void run_phase(CP& p, int ph, char* lds) {
  int* gctr = p.cnt + 64 + ph * 64;
  if (ph == 0) { phase_prep(p, lds); return; }
  int g, k;
  if (ph <= NMETA_PH) { g = -1; k = ph - 1; }
  else { g = (ph - 1 - NMETA_PH) / PH_PER_G; k = (ph - 1 - NMETA_PH) - g * PH_PER_G; }
  const Grp G = get_grp(p, g);
  const int Mall = G.M;
  const int M = G.Mx;
  u16* Pout = G.meta ? p.PM : p.P;
  switch (k) {
    case 0: phase_rows(p, G); break;
    case 1:
      gemm_phase(p.HB, 1024, M, p.W1A, 1024, 2 * FFD, lds, gctr, [&](const f32x16 (&acc)[2][2], int nb, int tb) { epi_swiglu(acc, nb, tb, M, p.ss0, p.ACT); });
      break;
    case 2:
      gemm_phase(p.ACT, FFD, M, p.WD1, FFD, 1024, lds, gctr, [&](const f32x16 (&acc)[2][2], int nb, int tb) { epi_resid<0>(acc, nb, tb, p, G); });
      break;
    case 3:
      gemm_phase(p.HB, 1024, M, p.WIN, 1024, NIN, lds, gctr, [&](const f32x16 (&acc)[2][2], int nbase, int tbase) {
        const int lane = ltid() & 63, l32 = lane & 31, h = lane >> 5;
#pragma unroll
        for (int tb = 0; tb < 2; ++tb) {
          const int tok = tbase + tb * 32 + l32;
          if (tok < M) {
            const float rs = rsqrtf(p.ss1[tok] * (1.f / 1024.f) + EPSN);
            if (!G.meta && nbase >= 2048 && nbase < 3072) {
              const int s = tok >> G.lgS, t = 16 + (tok & (G.S - 1));
              const int Lp = (G.L + 31) & ~31;
              const int pos = (t & ~12) | ((t & 4) << 1) | ((t & 8) >> 1);
              u16* vt = p.VT + ((size_t)(s * 1024 + (nbase - 2048)) * Lp) + pos;
#pragma unroll
              for (int nb = 0; nb < 2; ++nb)
#pragma unroll
                for (int r = 0; r < 16; ++r) {
                  const int dvl = nb * 32 + 8 * (r >> 2) + 4 * h + (r & 3);
                  vt[(size_t)dvl * Lp] = bf16_1(acc[nb][tb][r] * rs);
                }
            } else {
              u16* dst = Pout + (size_t)tok * NIN + nbase + 4 * h;
#pragma unroll
              for (int nb = 0; nb < 2; ++nb)
#pragma unroll
                for (int i = 0; i < 4; ++i)
                  *(u32x2*)(dst + nb * 32 + 8 * i) = (u32x2){pk_bf16(acc[nb][tb][4 * i] * rs, acc[nb][tb][4 * i + 1] * rs),
                                                             pk_bf16(acc[nb][tb][4 * i + 2] * rs, acc[nb][tb][4 * i + 3] * rs)};
            }
          }
        }
      });
      break;
    case 4: phase_mix(p, G); break;
    case 5:
      gemm_phase(p.F, 384, Mall, p.W2F, 64, 1024, lds, gctr, [&](const f32x16 (&acc)[2][2], int nb, int tb) { epi_decay(acc, nb, tb, Mall, p.rw_w0, p.DIR0); });
      gemm_phase(p.F + 64, 384, Mall, p.W2B, 64, 1024, lds, gctr + 8, [&](const f32x16 (&acc)[2][2], int nb, int tb) { epi_decay(acc, nb, tb, Mall, p.rw_w0 + 1024, p.DIR1); });
      gemm_phase(p.F + 128, 384, Mall, p.A2F, 64, 1024, lds, gctr + 16, [&](const f32x16 (&acc)[2][2], int nb, int tb) { epi_adir(acc, nb, tb, Mall, p, 0); });
      gemm_phase(p.F + 192, 384, Mall, p.A2B, 64, 1024, lds, gctr + 24, [&](const f32x16 (&acc)[2][2], int nb, int tb) { epi_adir(acc, nb, tb, Mall, p, 1); });
      gemm_phase(p.F + 256, 384, Mall, p.G2T, 128, 1024, lds, gctr + 32, [&](const f32x16 (&acc)[2][2], int nbase, int tbase) {
        const int lane = ltid() & 63, l32 = lane & 31, h = lane >> 5;
#pragma unroll
        for (int tb = 0; tb < 2; ++tb) {
          const int tok = tbase + tb * 32 + l32;
          if (tok < Mall) {
            u16* dst = p.G + (size_t)tok * 1024 + nbase + 4 * h;
#pragma unroll
            for (int nb = 0; nb < 2; ++nb)
#pragma unroll
              for (int i = 0; i < 4; ++i)
                *(u32x2*)(dst + nb * 32 + 8 * i) = (u32x2){pk_bf16(acc[nb][tb][4 * i], acc[nb][tb][4 * i + 1]), pk_bf16(acc[nb][tb][4 * i + 2], acc[nb][tb][4 * i + 3])};
          }
        }
      });
      break;
    case 6: phase_mixer(p, G, g, lds); break;
    case 7: phase_post(p, G); break;
    case 8: {
      const int nN = 8, nM = (M + 127) >> 7, nt = nN * nM;
      const int wave = ltid() >> 6;
      const int lane = ltid() & 63, l32 = lane & 31, h = lane >> 5;
      const int xcd = blockIdx.x & 7, g8 = gridDim.x >> 3;
      const int tq = nt >> 3, trm = nt & 7;
      const int tstart = xcd < trm ? xcd * (tq + 1) : trm * (tq + 1) + (xcd - trm) * tq;
      const int tcnt = tq + (xcd < trm ? 1 : 0);
      for (int off = blockIdx.x >> 3; off < tcnt; off += g8) {
        const int id = tstart + off, nig = 8 * nN, grp = id / nig, fm = grp * 8;
        const int gsz = (nM - fm) < 8 ? (nM - fm) : 8, idl = id - grp * nig;
        const int tm = fm + idl % gsz, tn = idl / gsz;
        const int nbase = tn * 128 + (wave & 1) * 64, tbase = tm * 128 + (wave >> 1) * 64;
#pragma unroll 1
        for (int pass = 0; pass < 2; ++pass) {
          f32x16 acc[2][2];
          zero_acc(acc);
          gemm_kloop(acc, pass ? (const u16*)p.H : p.O, 1024, M, tm * 128, pass ? p.WRW : p.WATT, 1024, tn * 128, 1024, lds);
#pragma unroll
          for (int tb = 0; tb < 2; ++tb) {
            const int tok = tbase + tb * 32 + l32;
            if (tok < M) {
              const u16* gp = p.P + (size_t)tok * NIN + 6528 + pass * 1024 + nbase + 4 * h;
              u16* dst = p.MERGED + (size_t)tok * 1024 + nbase + 4 * h;
#pragma unroll
              for (int nb = 0; nb < 2; ++nb)
#pragma unroll
                for (int i = 0; i < 4; ++i) {
                  const u32x2 ga = *(const u32x2*)(gp + nb * 32 + 8 * i);
                  float o0 = sigm(bf_lo(ga.x)) * acc[nb][tb][4 * i];
                  float o1 = sigm(bf_hi(ga.x)) * acc[nb][tb][4 * i + 1];
                  float o2 = sigm(bf_lo(ga.y)) * acc[nb][tb][4 * i + 2];
                  float o3 = sigm(bf_hi(ga.y)) * acc[nb][tb][4 * i + 3];
                  if (pass) {
                    const u32x2 pv = *(const u32x2*)(dst + nb * 32 + 8 * i);
                    o0 += bf_lo(pv.x); o1 += bf_hi(pv.x); o2 += bf_lo(pv.y); o3 += bf_hi(pv.y);
                  }
                  *(u32x2*)(dst + nb * 32 + 8 * i) = (u32x2){pk_bf16(o0, o1), pk_bf16(o2, o3)};
                }
            }
          }
        }
      }
    } break;
    case 9:
      gemm_phase(p.MERGED, 1024, M, p.WOUT, 1024, 1024, lds, gctr, [&](const f32x16 (&acc)[2][2], int nb, int tb) { epi_resid<1>(acc, nb, tb, p, G); });
      break;
    case 10:
      gemm_phase(p.HB, 1024, M, p.W2A, 1024, 2 * FFD, lds, gctr, [&](const f32x16 (&acc)[2][2], int nb, int tb) { epi_swiglu(acc, nb, tb, M, p.ss2, p.ACT); });
      break;
    case 11:
      gemm_phase(p.ACT, FFD, M, p.WD2, FFD, 1024, lds, gctr, [&](const f32x16 (&acc)[2][2], int nb, int tb) { epi_resid<2>(acc, nb, tb, p, G); });
      break;
    case 12: phase_final(p, G); break;
  }
}

__global__ void __launch_bounds__(256, 2) mega(Params p, int ph_lo, int ph_hi, int coop) {
  __shared__ __attribute__((aligned(16))) char lds[65536 + 16];
  uint4& xb_words = *(uint4*)(lds + 65536);
  CP* pp = (CP*)__builtin_amdgcn_kernarg_segment_ptr();
  asm volatile("" : "+s"(pp));
  if (threadIdx.x == 0) xb_words = make_uint4(0u, 0u, 0u, 0u);
  __syncthreads();
  const XcdBarrier xb = xcd_barrier_post(pp->bar, (volatile LAS unsigned*)&xb_words);
  for (int ph = ph_lo; ph < ph_hi; ++ph) {
    run_phase(*pp, ph, lds);
    if (coop && ph + 1 < ph_hi) {
      if (ph == 0) cg::this_grid().sync();
      else xcd_barrier(xb);
    }
  }
}

extern "C" void kernel_launch(void* const* d_in, const int* in_sizes, int n_in, void* d_out, int out_size, void* d_ws,
                              size_t ws_size, hipStream_t stream) {
  Params p;
  memset(&p, 0, sizeof(p));
  const float** f = (const float**)&p;
  for (int i = 0; i < 35; ++i) f[i] = (const float*)d_in[i];
  p.out = (float*)d_out;
  char* w = (char*)d_ws;
  size_t off = 0;
  auto alloc = [&](size_t bytes) { char* r = w + off; off += (bytes + 255) & ~(size_t)255; return r; };
  p.W1A = (u16*)alloc((size_t)2 * FFD * 1024 * 2);
  p.WD1 = (u16*)alloc((size_t)1024 * FFD * 2);
  p.WIN = (u16*)alloc((size_t)NIN * 1024 * 2);
  p.WATT = (u16*)alloc((size_t)1024 * 1024 * 2);
  p.WRW = (u16*)alloc((size_t)1024 * 1024 * 2);
  p.WOUT = (u16*)alloc((size_t)1024 * 1024 * 2);
  p.W2A = (u16*)alloc((size_t)2 * FFD * 1024 * 2);
  p.WD2 = (u16*)alloc((size_t)1024 * FFD * 2);
  p.W2F = (u16*)alloc((size_t)1024 * 64 * 2);
  p.W2B = (u16*)alloc((size_t)1024 * 64 * 2);
  p.A2F = (u16*)alloc((size_t)1024 * 64 * 2);
  p.A2B = (u16*)alloc((size_t)1024 * 64 * 2);
  p.G2T = (u16*)alloc((size_t)1024 * 128 * 2);
  p.lut = (float*)alloc(8 * 512 * 4);
  p.cnt = (int*)alloc((64 + NPHASES * 64) * 4);
  p.lam = (float*)alloc(256);
  p.bar = (unsigned*)alloc(XCD_BAR_WORDS * 4);
  const size_t R = MAXROWS;
  p.H = (float*)alloc(R * 1024 * 4);
  p.HB = (u16*)alloc(R * 1024 * 2);
  p.ACT = (u16*)alloc(R * FFD * 2);
  p.Y0 = p.ACT;
  p.Y1 = p.ACT + R * 1024;
  p.F = p.ACT + R * 2048;
  p.P = (u16*)alloc(R * NIN * 2);
  p.RKV = (u16*)alloc(R * 16 * 192 * 2);
  p.DIR0 = (u16*)alloc(R * 16 * 192 * 2);
  p.DIR1 = (u16*)alloc(R * 16 * 192 * 2);
  p.G = (u16*)alloc(R * 1024 * 2);
  p.O = (u16*)alloc(R * 1024 * 2);
  p.MERGED = (u16*)alloc(R * 1024 * 2);
  p.VT = (u16*)alloc((size_t)8 * 8 * 128 * 2080 * 2);
  p.PM = (u16*)alloc((size_t)16 * NIN * 2);
  p.ss0 = (float*)alloc(R * 4);
  p.ss1 = (float*)alloc(R * 4);
  p.ss2 = (float*)alloc(R * 4);
  p.ss3 = (float*)alloc(R * 4);
  if (off > ws_size) { fprintf(stderr, "workspace too small: need %zu have %zu\n", off, ws_size); return; }
  static int grid_blocks = 0;
  if (!grid_blocks) {
    int dev = 0, cus = 0, per_cu = 0;
    hipGetDevice(&dev);
    hipDeviceGetAttribute(&cus, hipDeviceAttributeMultiprocessorCount, dev);
    hipOccupancyMaxActiveBlocksPerMultiprocessor(&per_cu, mega, 256, 0);
    per_cu = 2;
    grid_blocks = cus * per_cu;
  }
  hipMemsetAsync(p.bar, 0, XCD_BAR_WORDS * 4, stream);
  hipMemsetAsync(p.cnt, 0, (64 + NPHASES * 64) * 4, stream);
  int ph_lo = 0, ph_hi = NPHASES, coop = 1;
  void* args[] = {&p, &ph_lo, &ph_hi, &coop};
  hipError_t e = hipLaunchCooperativeKernel((void*)mega, dim3(grid_blocks), dim3(256), args, 0, stream);
  if (e != hipSuccess) fprintf(stderr, "cooperative launch failed: %s (grid %d)\n", hipGetErrorString(e), grid_blocks);
}
```

```cpp
#include <hip/hip_runtime.h>
#include <hip/hip_cooperative_groups.h>
#include <stdint.h>
#include <string.h>
#include <stdio.h>
namespace cg = cooperative_groups;

typedef unsigned short u16;
typedef short bf16x8 __attribute__((ext_vector_type(8)));
typedef float f32x16 __attribute__((ext_vector_type(16)));
typedef float f32x4 __attribute__((ext_vector_type(4)));
typedef float f32x2 __attribute__((ext_vector_type(2)));
typedef unsigned u32x4 __attribute__((ext_vector_type(4)));
typedef unsigned u32x2 __attribute__((ext_vector_type(2)));
typedef __bf16 bf16x2_t __attribute__((ext_vector_type(2)));
typedef _Float16 f16x2_t __attribute__((ext_vector_type(2)));

#define NIN 8576
#define FFD 2816
#define EPSN 1e-6f
#define LOG2E 1.4426950408889634f
#define NGROUPS 6
#define PH_PER_G 13
#define NMETA_PH 4
#define NPHASES (1 + NMETA_PH + NGROUPS * PH_PER_G)
#define MAXROWS 16512

struct Params {
  const float *x_prompt, *x_sample, *meta, *rel_bias, *ffn1_norm, *ffn1_wg, *ffn1_wu, *ffn1_wd, *mix_norm, *w_in;
  const float *lq1, *lk1, *lq2, *lk2, *subln, *w_attn, *mu_prev, *mu_next, *rw_w0, *rw_w2, *rw_a0, *rw_a2, *rw_g2;
  const float *k_k, *k_a, *r_k, *lnx_w, *lnx_b, *w_rw, *w_out, *ffn2_norm, *ffn2_wg, *ffn2_wu, *ffn2_wd, *final_norm;
  float* out;
  u16 *W1A, *WD1, *WIN, *WATT, *WRW, *WOUT, *W2A, *WD2, *W2F, *W2B, *A2F, *A2B, *G2T;
  float* lut; int* cnt; float* lam; unsigned* bar; u16* VT; u16* PM;
  float* H; u16 *HB, *ACT, *P, *RKV, *DIR0, *DIR1, *G, *O, *MERGED, *Y0, *Y1, *F;
  float *ss0, *ss1, *ss2, *ss3;
};

typedef const Params __attribute__((address_space(4))) CP;
struct Grp { int nseq, L, S, lgS, M, Mx, meta; const float* x; float* out; };
__device__ __forceinline__ int rowof(const Grp& G, int s, int t) { return t < 16 ? G.Mx + s * 16 + t : s * G.S + (t - 16); }

__device__ __forceinline__ Grp get_grp(CP& p, int g) {
  Grp r;
  r.meta = 0;
  if (g < 0) {
    r.nseq = 1; r.L = 16; r.S = 16; r.lgS = 4; r.x = p.meta; r.out = nullptr; r.M = 16; r.Mx = 16; r.meta = 1;
    return r;
  }
  if (g < 4) { r.nseq = 4; r.L = 4112; r.S = 4096; r.lgS = 12; r.x = p.x_prompt + (size_t)g * 4 * 4096 * 1024; r.out = p.out + (size_t)g * 4 * 4096 * 1024; }
  else { r.nseq = 8; r.L = 2064; r.S = 2048; r.lgS = 11; r.x = p.x_sample + (size_t)(g - 4) * 8 * 2048 * 1024; r.out = p.out + (size_t)16 * 4096 * 1024 + (size_t)(g - 4) * 8 * 2048 * 1024; }
  r.M = r.nseq * r.L;
  r.Mx = r.nseq * r.S;
  return r;
}

__device__ __forceinline__ int ltid() { int t = threadIdx.x; asm volatile("" : "+v"(t)); return t; }
__device__ __forceinline__ unsigned pk_bf16(float a, float b) {
  f32x2 v = {a, b};
  bf16x2_t r = __builtin_convertvector(v, bf16x2_t);
  return __builtin_bit_cast(unsigned, r);
}
__device__ __forceinline__ float bf_lo(unsigned u) { return __uint_as_float(u << 16); }
__device__ __forceinline__ float bf_hi(unsigned u) { return __uint_as_float(u & 0xffff0000u); }
__device__ __forceinline__ unsigned pk_f16(float a, float b) {
  f32x2 v = {a, b};
  f16x2_t r = __builtin_convertvector(v, f16x2_t);
  return __builtin_bit_cast(unsigned, r);
}
__device__ __forceinline__ float h_lo(unsigned u) { f16x2_t r = __builtin_bit_cast(f16x2_t, u); return (float)r.x; }
__device__ __forceinline__ float h_hi(unsigned u) { f16x2_t r = __builtin_bit_cast(f16x2_t, u); return (float)r.y; }
__device__ __forceinline__ u16 bf16_1(float a) { return (u16)(pk_bf16(a, 0.f) & 0xffffu); }
__device__ __forceinline__ float sigm(float x) { return __builtin_amdgcn_rcpf(1.f + __builtin_amdgcn_exp2f(-LOG2E * x)); }
__device__ __forceinline__ float wave_sum(float v) {
#pragma unroll
  for (int o = 32; o > 0; o >>= 1) v += __shfl_xor(v, o);
  return v;
}
template <int CTRL> __device__ __forceinline__ float dppf(float x) {
  return __int_as_float(__builtin_amdgcn_update_dpp(0, __float_as_int(x), CTRL, 0xf, 0xf, true));
}
__device__ __forceinline__ float reduce8(float x) {
  x += dppf<0xB1>(x);
  x += dppf<0x4E>(x);
  x += dppf<0x141>(x);
  return x;
}
__device__ __forceinline__ float reduce4(float x) {
  x += dppf<0xB1>(x);
  x += dppf<0x4E>(x);
  return x;
}

__device__ void prep_transpose(const float* __restrict__ src, int K, int N, u16* __restrict__ dst,
                               const float* __restrict__ gain, int mode, char* lds) {
  float* tile = (float*)lds;
  const int tn = N / 64, nt = (K / 64) * tn;
  const int tid = ltid();
  for (int t = blockIdx.x; t < nt; t += gridDim.x) {
    const int k0 = (t / tn) * 64, n0 = (t % tn) * 64;
    const int nl = tid & 63, kq = tid >> 6;
#pragma unroll
    for (int i = 0; i < 16; ++i) {
      const int k = i * 4 + kq;
      float v = src[(size_t)(k0 + k) * N + n0 + nl];
      if (gain) v *= gain[k0 + k];
      tile[k * 65 + nl] = v;
    }
    __syncthreads();
    const int n = tid >> 2, kk = (tid & 3) * 16;
    unsigned w[8];
#pragma unroll
    for (int i = 0; i < 8; ++i) w[i] = pk_bf16(tile[(kk + 2 * i) * 65 + n], tile[(kk + 2 * i + 1) * 65 + n]);
    const int ng = n0 + n;
    const int row = mode == 0 ? ng : ((ng >> 5) * 64 + (ng & 31) + (mode == 2 ? 32 : 0));
    u32x4* d = (u32x4*)(dst + (size_t)row * K + k0 + kk);
    d[0] = (u32x4){w[0], w[1], w[2], w[3]};
    d[1] = (u32x4){w[4], w[5], w[6], w[7]};
    __syncthreads();
  }
}

__device__ void phase_prep(CP& p, char* lds) {
  if (blockIdx.x == 0) {
    const int tid = ltid();
    for (int idx = tid; idx < 8 * 511; idx += 256) {
      const int hd = idx / 511, di = idx - hd * 511, d = di - 255;
      const int n = d < 0 ? -d : d;
      int bk;
      if (n < 8) bk = n;
      else {
        const float nf = (float)n;
        int large = 8 + (int)(logf(nf / 8.0f) / 2.772588722239781f * 8.0f);
        bk = large < 15 ? large : 15;
      }
      const int bucket = (d > 0 ? 16 : 0) + bk;
      p.lut[hd * 512 + di] = p.rel_bias[bucket * 8 + hd] * LOG2E;
    }
    if (tid == 0) {
      float s1 = 0.f, s2 = 0.f;
      for (int i = 0; i < 64; ++i) { s1 += p.lq1[i] * p.lk1[i]; s2 += p.lq2[i] * p.lk2[i]; }
      p.lam[0] = expf(s1) - expf(s2) + 0.2f;
    }
  }
  prep_transpose(p.ffn1_wg, 1024, FFD, p.W1A, p.ffn1_norm, 1, lds);
  prep_transpose(p.ffn1_wu, 1024, FFD, p.W1A, p.ffn1_norm, 2, lds);
  prep_transpose(p.ffn1_wd, FFD, 1024, p.WD1, nullptr, 0, lds);
  prep_transpose(p.w_in, 1024, NIN, p.WIN, p.mix_norm, 0, lds);
  prep_transpose(p.w_attn, 1024, 1024, p.WATT, nullptr, 0, lds);
  prep_transpose(p.w_rw, 1024, 1024, p.WRW, nullptr, 0, lds);
  prep_transpose(p.w_out, 1024, 1024, p.WOUT, nullptr, 0, lds);
  prep_transpose(p.ffn2_wg, 1024, FFD, p.W2A, p.ffn2_norm, 1, lds);
  prep_transpose(p.ffn2_wu, 1024, FFD, p.W2A, p.ffn2_norm, 2, lds);
  prep_transpose(p.ffn2_wd, FFD, 1024, p.WD2, nullptr, 0, lds);
  prep_transpose(p.rw_w2, 64, 1024, p.W2F, nullptr, 0, lds);
  prep_transpose(p.rw_w2 + 64 * 1024, 64, 1024, p.W2B, nullptr, 0, lds);
  prep_transpose(p.rw_a2, 64, 1024, p.A2F, nullptr, 0, lds);
  prep_transpose(p.rw_a2 + 64 * 1024, 64, 1024, p.A2B, nullptr, 0, lds);
  prep_transpose(p.rw_g2, 128, 1024, p.G2T, nullptr, 0, lds);
}

__device__ void phase_rows(CP& p, const Grp& G) {
  const int lane = ltid() & 63;
  const int nw = gridDim.x * 4;
  const int gw = blockIdx.x * 4 + (ltid() >> 6);
  for (int row = gw; row < G.Mx; row += nw) {
    const float* src = G.x + (size_t)row * 1024;
    float ss = 0.f;
#pragma unroll
    for (int i = 0; i < 4; ++i) {
      const f32x4 v = *(const f32x4*)(src + i * 256 + lane * 4);
      ss += v.x * v.x + v.y * v.y + v.z * v.z + v.w * v.w;
      u32x2 o = {pk_bf16(v.x, v.y), pk_bf16(v.z, v.w)};
      *(u32x2*)(p.HB + (size_t)row * 1024 + i * 256 + lane * 4) = o;
    }
    ss = wave_sum(ss);
    if (lane == 0) { p.ss0[row] = ss; p.ss1[row] = 0.f; p.ss2[row] = 0.f; p.ss3[row] = 0.f; }
  }
  if (G.meta) return;
  const int Lp = (G.L + 31) & ~31;
  for (int r = gw; r < G.nseq * 16; r += nw) {
    const int s = r >> 4, t = r & 15;
    const u16* srcp = p.PM + (size_t)t * NIN;
    u16* dstp = p.P + (size_t)(G.Mx + r) * NIN;
    for (int c = lane * 8; c < NIN; c += 512)
      if (c < 2048 || c >= 3072) *(u32x4*)(dstp + c) = *(const u32x4*)(srcp + c);
    const int pos = (t & ~12) | ((t & 4) << 1) | ((t & 8) >> 1);
    for (int c = lane; c < 1024; c += 64) p.VT[(size_t)(s * 1024 + c) * Lp + pos] = srcp[2048 + c];
  }
}

#define LAS __attribute__((address_space(3)))
#define XB_TMO      128
#define XB_XCNT(j)  (256  + 64 * (j))
#define XB_XSUB(j)  (1280 + 64 * (j))
#define XB_XGEN(j)  (2304 + 64 * (j))
#define XB_TOP      3328
#define XB_TOPGEN   3392
#define XCD_BAR_WORDS 3456
#define XB_SPIN_CAP (1u << 18)
__device__ __forceinline__ unsigned xb_ld(unsigned* p) { return __hip_atomic_load(p, __ATOMIC_RELAXED, __HIP_MEMORY_SCOPE_AGENT); }
__device__ __forceinline__ unsigned xb_add(unsigned* p, unsigned v) { return __hip_atomic_fetch_add(p, v, __ATOMIC_RELAXED, __HIP_MEMORY_SCOPE_AGENT); }
__device__ __forceinline__ unsigned xb_xcc_id() { return (unsigned)__builtin_amdgcn_s_getreg((3 << 11) | 20) & 0xFu; }
#define XB_SPIN(cond, bar) do { unsigned _sp = 0; while (cond) { __builtin_amdgcn_s_sleep(1); \
    if ((++_sp & 255u) == 0u) { if (xb_ld(&(bar)[XB_TMO])) break; if (_sp > XB_SPIN_CAP) { atomicAdd(&(bar)[XB_TMO], 1u); break; } } } } while (0)
struct XcdBarrier { unsigned* bar; unsigned x; volatile LAS unsigned* st; };
__device__ __forceinline__ XcdBarrier xcd_barrier_post(unsigned* bar, volatile LAS unsigned* st) {
  XcdBarrier b; b.bar = bar; b.x = xb_xcc_id(); b.st = st;
  if (threadIdx.x == 0) (void)xb_add(&bar[XB_XCNT(b.x)], 1u);
  return b;
}
__device__ __forceinline__ void xcd_barrier_complete(unsigned* bar, unsigned x, unsigned& nloc, unsigned& nx) {
  const unsigned G = gridDim.x * gridDim.y * gridDim.z;
  unsigned sum, cnt, mine, sp = 0u;
  for (;;) {
    sum = 0u; cnt = 0u; mine = 0u;
#pragma unroll
    for (unsigned j = 0; j < 16; ++j) { const unsigned c = xb_ld(&bar[XB_XCNT(j)]); sum += c; cnt += (c > 0u) ? 1u : 0u; mine = (j == x) ? c : mine; }
    if (sum == G) break;
    __builtin_amdgcn_s_sleep(1);
    if ((++sp & 255u) == 0u) { if (xb_ld(&bar[XB_TMO])) break; if (sp > XB_SPIN_CAP) { atomicAdd(&bar[XB_TMO], 1u); break; } }
  }
  nloc = mine > 0u ? mine : 1u; nx = cnt > 0u ? cnt : 1u;
}
__device__ __forceinline__ void xcd_barrier(const XcdBarrier& b) {
  asm volatile("s_waitcnt vmcnt(0)" ::: "memory");
  __syncthreads();
  if (threadIdx.x == 0) {
    unsigned* bar = b.bar;
    __builtin_amdgcn_s_waitcnt(0);
    unsigned nloc = b.st[0], nx = b.st[1];
    if (nloc == 0u) { xcd_barrier_complete(bar, b.x, nloc, nx); b.st[0] = nloc; b.st[1] = nx; }
    const unsigned old = xb_add(&bar[XB_XSUB(b.x)], 1u);
    const unsigned gen = old / nloc;
    if (old + 1u == (gen + 1u) * nloc) {
      __builtin_amdgcn_fence(__ATOMIC_RELEASE, "agent");
      asm volatile("s_waitcnt vmcnt(0)" ::: "memory");
      const unsigned og = xb_add(&bar[XB_TOP], 1u);
      const unsigned tg = og / nx;
      if (og + 1u == (tg + 1u) * nx) xb_add(&bar[XB_TOPGEN], 1u);
      else XB_SPIN(xb_ld(&bar[XB_TOPGEN]) == tg, bar);
      __builtin_amdgcn_fence(__ATOMIC_ACQUIRE, "agent");
      xb_add(&bar[XB_XGEN(b.x)], 1u);
      asm volatile("s_waitcnt vmcnt(0)" ::: "memory");
    } else {
      XB_SPIN(xb_ld(&bar[XB_XGEN(b.x)]) == gen, bar);
      __builtin_amdgcn_fence(__ATOMIC_ACQUIRE, "agent");
      asm volatile("s_waitcnt vmcnt(0)" ::: "memory");
    }
  }
  __syncthreads();
}

#define LAS __attribute__((address_space(3)))
#define LAS __attribute__((address_space(3)))
#define LAS __attribute__((address_space(3)))
__device__ __forceinline__ void glds16(const void* gsrc, unsigned lds_dst) {
  unsigned keep;
  asm volatile("s_mov_b32 %0, m0\n\ts_mov_b32 m0, %2\n\ts_nop 0\n\tglobal_load_lds_dwordx4 %1, off\n\ts_mov_b32 m0, %0" : "=&s"(keep) : "v"(gsrc), "s"(lds_dst) : "memory");
}
struct GemmCtx {
  const u16* ap[2];
  const u16* wp[2];
  int wro[2], wsw[2], aro[2], asw[2];
  unsigned lds0;
  int tid, h;
};
__device__ __forceinline__ void g_init(GemmCtx& c, char* lds) {
  const int tid = ltid(), lane = tid & 63, wave = tid >> 6;
  const int wn = wave & 1, wt = wave >> 1, l32 = lane & 31;
  c.tid = tid; c.h = lane >> 5;
#pragma unroll
  for (int b = 0; b < 2; ++b) {
    const int wr = wn * 64 + b * 32 + l32, ar = wt * 64 + b * 32 + l32;
    c.wro[b] = wr * 64; c.wsw[b] = (wr >> 2) & 3;
    c.aro[b] = 8192 + ar * 64; c.asw[b] = (ar >> 2) & 3;
  }
  c.lds0 = __builtin_amdgcn_readfirstlane((unsigned)(uintptr_t)(LAS char*)lds + wave * 1024);
}
__device__ __forceinline__ void g_tile(GemmCtx& c, const u16* __restrict__ A, int lda, int M, int m0, const u16* __restrict__ W, int ldw, int n0) {
#pragma unroll
  for (int i = 0; i < 2; ++i) {
    const int q = c.tid + 256 * i, row = q >> 2, ch = (q & 3) ^ ((row >> 2) & 3);
    int ar = m0 + row; ar = ar < M ? ar : M - 1;
    c.ap[i] = A + (size_t)ar * lda + ch * 8;
    c.wp[i] = W + (size_t)(n0 + row) * ldw + ch * 8;
  }
}
__device__ __forceinline__ void g_stage(const GemmCtx& c, int kt) {
  const unsigned sb = c.lds0 + (kt & 3) * 16384;
#pragma unroll
  for (int i = 0; i < 2; ++i) {
    glds16(c.wp[i] + kt * 32, sb + i * 4096);
    glds16(c.ap[i] + kt * 32, sb + 8192 + i * 4096);
  }
}
__device__ __forceinline__ void g_prologue(const GemmCtx& c, int nk) {
#pragma unroll
  for (int s = 0; s < 3; ++s)
    if (s < nk) g_stage(c, s);
}
struct Frags { bf16x8 w[2][2], a[2][2]; };
__device__ __forceinline__ void g_read(Frags& f, const GemmCtx& c, int kt, const char* lds) {
  const char* st = lds + (kt & 3) * 16384;
#pragma unroll
  for (int ks = 0; ks < 2; ++ks)
#pragma unroll
    for (int b = 0; b < 2; ++b) {
      f.w[ks][b] = *(const bf16x8*)(st + c.wro[b] + (((ks * 2 + c.h) ^ c.wsw[b]) << 4));
      f.a[ks][b] = *(const bf16x8*)(st + c.aro[b] + (((ks * 2 + c.h) ^ c.asw[b]) << 4));
    }
}
__device__ __forceinline__ void g_mma(f32x16 (&acc)[2][2], const Frags& f) {
#pragma unroll
  for (int ks = 0; ks < 2; ++ks)
#pragma unroll
    for (int nb = 0; nb < 2; ++nb)
#pragma unroll
      for (int tb = 0; tb < 2; ++tb)
        acc[nb][tb] = __builtin_amdgcn_mfma_f32_32x32x16_bf16(f.w[ks][nb], f.a[ks][tb], acc[nb][tb], 0, 0, 0);
}
__device__ __forceinline__ void g_wait(int ks_needed, int issued_hi, bool drain_all) {
  const int allowed = issued_hi - ks_needed;
  if (drain_all || allowed <= 0) asm volatile("s_waitcnt vmcnt(0) lgkmcnt(0)" ::: "memory");
  else if (allowed == 1) asm volatile("s_waitcnt vmcnt(4) lgkmcnt(0)" ::: "memory");
  else asm volatile("s_waitcnt vmcnt(8) lgkmcnt(0)" ::: "memory");
  __builtin_amdgcn_s_barrier();
}
__device__ __forceinline__ void g_main(f32x16 (&acc)[2][2], const GemmCtx& c, int nk, char* lds) {
  Frags f0, f1;
  g_wait(0, nk - 1 < 2 ? nk - 1 : 2, true);
  if (3 < nk) g_stage(c, 3);
  g_read(f0, c, 0, lds);
  for (int kt = 0; kt < nk; kt += 2) {
    {
      const int hi = (kt + 3 < nk - 1) ? kt + 3 : nk - 1;
      g_wait(kt + 1, hi, false);
      if (kt + 4 < nk) g_stage(c, kt + 4);
      g_read(f1, c, kt + 1, lds);
      g_mma(acc, f0);
    }
    if (kt + 2 < nk) {
      const int hi = (kt + 4 < nk - 1) ? kt + 4 : nk - 1;
      g_wait(kt + 2, hi, false);
      if (kt + 5 < nk) g_stage(c, kt + 5);
      g_read(f0, c, kt + 2, lds);
    }
    g_mma(acc, f1);
  }
}
__device__ __forceinline__ void gemm_kloop(f32x16 (&acc)[2][2], const u16* __restrict__ A, int lda, int M, int m0,
                                           const u16* __restrict__ W, int ldw, int n0, int K, char* lds) {
  GemmCtx c;
  g_init(c, lds);
  g_tile(c, A, lda, M, m0, W, ldw, n0);
  asm volatile("s_waitcnt vmcnt(0)" ::: "memory");
  __builtin_amdgcn_s_barrier();
  g_prologue(c, K >> 5);
  g_main(acc, c, K >> 5, lds);
}

__device__ __forceinline__ void zero_acc(f32x16 (&acc)[2][2]) {
#pragma unroll
  for (int a = 0; a < 2; ++a)
#pragma unroll
    for (int b = 0; b < 2; ++b)
#pragma unroll
      for (int r = 0; r < 16; ++r) acc[a][b][r] = 0.f;
}

template <class F>
__device__ __forceinline__ void gemm_phase(const u16* A, int lda, int M, const u16* W, int K, int N, char* lds, int* ctr, F&& epi) {
  const int nN = N >> 7, nM = (M + 127) >> 7, nt = nN * nM, nk = K >> 5;
  const int xcd = (int)xb_xcc_id() & 7;
  const int tq = nt >> 3, trm = nt & 7;
  const int tstart = xcd < trm ? xcd * (tq + 1) : trm * (tq + 1) + (xcd - trm) * tq;
  const int tcnt = tq + (xcd < trm ? 1 : 0);
  auto decode = [&](int off, int& tm, int& tn) {
    const int id = tstart + off, nig = 8 * nN, grp = id / nig, fm = grp * 8;
    const int gsz = (nM - fm) < 8 ? (nM - fm) : 8, idl = id - grp * nig;
    tm = fm + idl % gsz; tn = idl / gsz;
  };
  GemmCtx c;
  g_init(c, lds);
  const int wave = c.tid >> 6;
  volatile int* bw = (volatile int*)(lds + 65536);
  int* myctr = ctr + xcd;
  int par = 0;
  if (c.tid == 0) bw[2] = atomicAdd(myctr, 1);
  asm volatile("s_waitcnt vmcnt(0) lgkmcnt(0)" ::: "memory");
  __builtin_amdgcn_s_barrier();
  int off = bw[2];
  int tm = 0, tn = 0;
  if (off < tcnt) { decode(off, tm, tn); g_tile(c, A, lda, M, tm * 128, W, K, tn * 128); g_prologue(c, nk); }
  while (off < tcnt) {
    f32x16 acc[2][2];
    zero_acc(acc);
    g_main(acc, c, nk, lds);
    const int ctm = tm, ctn = tn;
    par ^= 1;
    if (c.tid == 0) bw[2 + par] = atomicAdd(myctr, 1);
    asm volatile("s_waitcnt lgkmcnt(0)" ::: "memory");
    __builtin_amdgcn_s_barrier();
    off = bw[2 + par];
    if (off < tcnt) { decode(off, tm, tn); g_tile(c, A, lda, M, tm * 128, W, K, tn * 128); g_prologue(c, nk); }
    epi(acc, ctn * 128 + (wave & 1) * 64, ctm * 128 + (wave >> 1) * 64);
  }
}

__device__ __forceinline__ void epi_swiglu(const f32x16 (&acc)[2][2], int nbase, int tbase, int M, const float* ss, u16* ACT) {
  const int lane = ltid() & 63, l32 = lane & 31, h = lane >> 5;
  const int cb = (nbase >> 6) * 32;
#pragma unroll
  for (int tb = 0; tb < 2; ++tb) {
    const int tok = tbase + tb * 32 + l32;
    if (tok < M) {
      const float rs = rsqrtf(ss[tok] * (1.f / 1024.f) + EPSN);
      u16* dst = ACT + (size_t)tok * FFD + cb + 4 * h;
#pragma unroll
      for (int i = 0; i < 4; ++i) {
        float o[4];
#pragma unroll
        for (int j = 0; j < 4; ++j) {
          const float g = acc[0][tb][4 * i + j] * rs, u = acc[1][tb][4 * i + j] * rs;
          o[j] = g * sigm(g) * u;
        }
        *(u32x2*)(dst + 8 * i) = (u32x2){pk_bf16(o[0], o[1]), pk_bf16(o[2], o[3])};
      }
    }
  }
}

template <int MODE>
__device__ __forceinline__ void epi_resid(const f32x16 (&acc)[2][2], int nbase, int tbase, CP& p, const Grp& G) {
  const int lane = ltid() & 63, l32 = lane & 31, h = lane >> 5;
  const float scale = MODE == 1 ? 1.f : 0.5f;
  float* ssout = MODE == 0 ? p.ss1 : (MODE == 1 ? p.ss2 : p.ss3);
#pragma unroll
  for (int tb = 0; tb < 2; ++tb) {
    const int tok = tbase + tb * 32 + l32;
    const bool valid = tok < G.Mx;
    float sq = 0.f;
    if (valid) {
      float* hp = p.H + (size_t)tok * 1024;
      u16* hb = p.HB + (size_t)tok * 1024;
      const float* rp = G.x + (size_t)tok * 1024;
#pragma unroll
      for (int nb = 0; nb < 2; ++nb)
#pragma unroll
        for (int i = 0; i < 4; ++i) {
          const int n = nbase + nb * 32 + 8 * i + 4 * h;
          f32x4 r;
          if (MODE == 0) r = *(const f32x4*)(rp + n);
          else { const u32x2 rb = *(const u32x2*)(hb + n); r = (f32x4){bf_lo(rb.x), bf_hi(rb.x), bf_lo(rb.y), bf_hi(rb.y)}; }
          f32x4 v;
          v.x = r.x + scale * acc[nb][tb][4 * i + 0];
          v.y = r.y + scale * acc[nb][tb][4 * i + 1];
          v.z = r.z + scale * acc[nb][tb][4 * i + 2];
          v.w = r.w + scale * acc[nb][tb][4 * i + 3];
          sq += v.x * v.x + v.y * v.y + v.z * v.z + v.w * v.w;
          if (MODE == 2) *(f32x4*)(hp + n) = v;
          else *(u32x2*)(hb + n) = (u32x2){pk_bf16(v.x, v.y), pk_bf16(v.z, v.w)};
        }
    }
    sq += __shfl_xor(sq, 32);
    if (valid && h == 0) atomicAdd(ssout + tok, sq);
  }
}

__device__ void phase_mix(CP& p, const Grp& G) {
  const int total = G.M * 432;
  for (int idx = blockIdx.x * 256 + ltid(); idx < total; idx += gridDim.x * 256) {
    const int row = idx / 432, ch = idx - row * 432;
    int s, t;
    if (row < G.Mx) { s = row >> G.lgS; t = 16 + (row & (G.S - 1)); } else { s = (row - G.Mx) >> 4; t = (row - G.Mx) & 15; }
    const int col = ch * 8;
    const u16* pc = p.P + (size_t)row * NIN + 3072 + col;
    const u32x4 c = *(const u32x4*)pc;
    u32x4 pv = {0, 0, 0, 0}, nx = {0, 0, 0, 0};
    if (t > 0) pv = *(const u32x4*)(p.P + (size_t)rowof(G, s, t - 1) * NIN + 3072 + col);
    if (t < G.L - 1) nx = *(const u32x4*)(p.P + (size_t)rowof(G, s, t + 1) * NIN + 3072 + col);
    const f32x4 mp0 = *(const f32x4*)(p.mu_prev + col), mp1 = *(const f32x4*)(p.mu_prev + col + 4);
    const f32x4 mn0 = *(const f32x4*)(p.mu_next + col), mn1 = *(const f32x4*)(p.mu_next + col + 4);
    float o[8];
#pragma unroll
    for (int e = 0; e < 4; ++e) {
      const float c0 = bf_lo(c[e]), c1 = bf_hi(c[e]);
      const float mpa = e < 2 ? mp0[2 * e] : mp1[2 * e - 4], mpb = e < 2 ? mp0[2 * e + 1] : mp1[2 * e - 3];
      const float mna = e < 2 ? mn0[2 * e] : mn1[2 * e - 4], mnb = e < 2 ? mn0[2 * e + 1] : mn1[2 * e - 3];
      o[2 * e] = c0 + mpa * (bf_lo(pv[e]) - c0) + mna * (bf_lo(nx[e]) - c0);
      o[2 * e + 1] = c1 + mpb * (bf_hi(pv[e]) - c1) + mnb * (bf_hi(nx[e]) - c1);
    }
    if (col < 3072) {
      const int sec = col >> 10, ci = col & 1023, head = ci >> 6, c0 = ci & 63;
      const size_t ro = ((size_t)row * 16 + head) * 192 + sec * 64 + c0;
      const u32x4 pk = (u32x4){pk_f16(o[0], o[1]), pk_f16(o[2], o[3]), pk_f16(o[4], o[5]), pk_f16(o[6], o[7])};
      *(u32x4*)(p.RKV + ro) = pk;
      if (sec == 1) { *(u32x4*)(p.DIR0 + ro) = pk; *(u32x4*)(p.DIR1 + ro) = pk; }
    } else {
      const int fc = col - 3072;
      if (fc < 128) {
#pragma unroll
        for (int e = 0; e < 8; ++e) o[e] = 1.f - 2.f / (1.f + __expf(2.f * o[e]));
      } else if (fc >= 256) {
#pragma unroll
        for (int e = 0; e < 8; ++e) o[e] = sigm(o[e]);
      }
      *(u32x4*)(p.F + (size_t)row * 384 + fc) = (u32x4){pk_bf16(o[0], o[1]), pk_bf16(o[2], o[3]), pk_bf16(o[4], o[5]), pk_bf16(o[6], o[7])};
    }
  }
}

__device__ __forceinline__ void epi_decay(const f32x16 (&acc)[2][2], int nbase, int tbase, int M, const float* w0, u16* DIR) {
  const int lane = ltid() & 63, l32 = lane & 31, h = lane >> 5;
  const int head = nbase >> 6;
#pragma unroll
  for (int tb = 0; tb < 2; ++tb) {
    const int tok = tbase + tb * 32 + l32;
    if (tok < M) {
      u16* dst = DIR + ((size_t)tok * 16 + head) * 192;
#pragma unroll
      for (int nb = 0; nb < 2; ++nb)
#pragma unroll
        for (int i = 0; i < 4; ++i) {
          const int c = nb * 32 + 8 * i + 4 * h;
          const f32x4 w = *(const f32x4*)(w0 + nbase + c);
          float o[4];
#pragma unroll
          for (int j = 0; j < 4; ++j) o[j] = 0.6065306597126334f * sigm(w[j] + acc[nb][tb][4 * i + j]);
          *(u32x2*)(dst + c) = (u32x2){pk_f16(o[0], o[1]), pk_f16(o[2], o[3])};
        }
    }
  }
}

__device__ __forceinline__ void epi_adir(const f32x16 (&acc)[2][2], int nbase, int tbase, int M, CP& p, int dir) {
  const int lane = ltid() & 63, l32 = lane & 31, h = lane >> 5;
  const int head = nbase >> 6;
  u16* DIR = dir ? p.DIR1 : p.DIR0;
  const float* a0 = p.rw_a0 + dir * 1024;
#pragma unroll
  for (int tb = 0; tb < 2; ++tb) {
    const int tok = tbase + tb * 32 + l32;
    const bool valid = tok < M;
    const int tk = valid ? tok : M - 1;
    const size_t rec = ((size_t)tk * 16 + head) * 192;
    float nsq = 0.f;
#pragma unroll
    for (int nb = 0; nb < 2; ++nb)
#pragma unroll
      for (int i = 0; i < 4; ++i) {
        const int c = nb * 32 + 8 * i + 4 * h;
        const u32x2 kr = *(const u32x2*)(DIR + rec + 64 + c);
        const f32x4 kkw = *(const f32x4*)(p.k_k + nbase + c);
        const float q0 = h_lo(kr.x) * kkw[0], q1 = h_hi(kr.x) * kkw[1], q2 = h_lo(kr.y) * kkw[2], q3 = h_hi(kr.y) * kkw[3];
        nsq += q0 * q0 + q1 * q1 + q2 * q2 + q3 * q3;
      }
    nsq += __shfl_xor(nsq, 32);
    const float inv = 1.f / fmaxf(sqrtf(nsq), 1e-12f);
    if (valid) {
#pragma unroll
      for (int nb = 0; nb < 2; ++nb)
#pragma unroll
        for (int i = 0; i < 4; ++i) {
          const int c = nb * 32 + 8 * i + 4 * h;
          const u32x2 kr = *(const u32x2*)(DIR + rec + 64 + c);
          const float kv[4] = {h_lo(kr.x), h_hi(kr.x), h_lo(kr.y), h_hi(kr.y)};
          const f32x4 kkw = *(const f32x4*)(p.k_k + nbase + c);
          const f32x4 kaw = *(const f32x4*)(p.k_a + nbase + c);
          const f32x4 a0v = *(const f32x4*)(a0 + nbase + c);
          float kk[4], kd[4], bp[4];
#pragma unroll
          for (int j = 0; j < 4; ++j) {
            const float k = kv[j];
            kk[j] = k * kkw[j] * inv;
            const float aa = sigm(a0v[j] + acc[nb][tb][4 * i + j]);
            kd[j] = k * (1.f + (aa - 1.f) * kaw[j]);
            bp[j] = -kk[j] * aa;
          }
          if (dir == 0) *(u32x2*)(p.RKV + rec + 64 + c) = (u32x2){pk_f16(kk[0], kk[1]), pk_f16(kk[2], kk[3])};
          *(u32x2*)(DIR + rec + 64 + c) = (u32x2){pk_f16(kd[0], kd[1]), pk_f16(kd[2], kd[3])};
          *(u32x2*)(DIR + rec + 128 + c) = (u32x2){pk_f16(bp[0], bp[1]), pk_f16(bp[2], bp[3])};
        }
    }
  }
}

template <int LPR>
__device__ void scan_task(CP& p, const Grp& G, int task, char* lds) {
  constexpr int KPL = 64 / LPR, RPB = 256 / LPR, NSPLIT = 64 / RPB;
  const int part = task % NSPLIT, t1 = task / NSPLIT;
  const int dir = t1 & 1, head = (t1 >> 1) & 15, s = t1 >> 5;
  float* buf = (float*)lds;
  const u16* rkv = p.RKV;
  const u16* dr = dir ? p.DIR1 : p.DIR0;
  u16* Y = dir ? p.Y1 : p.Y0;
  const int tid = ltid();
  const int row = part * RPB + tid / LPR, kc = tid % LPR;
  const int L = G.L, nch = L >> 4;
  u32x4 pre[3];
  auto issue = [&](int c) {
#pragma unroll
    for (int i = 0; i < 3; ++i) {
      const int id = tid + 256 * i, st = id / 48, ci = id - st * 48;
      const int n = c * 16 + st, t = dir ? L - 1 - n : n;
      const size_t rec = ((size_t)rowof(G, s, t) * 16 + head) * 192;
      const u16* src = ci < 24 ? rkv + rec + ci * 8 : dr + rec + (ci - 24) * 8;
      pre[i] = *(const u32x4*)src;
    }
  };
  auto commit = [&](int b) {
#pragma unroll
    for (int i = 0; i < 3; ++i) {
      const int id = tid + 256 * i, st = id / 48, ci = id - st * 48;
      const int sec = ci >> 3;
      const int base = sec >= 3 ? (sec - 1) * 64 : (sec == 0 ? 64 : (sec == 1 ? 0 : 320));
      float f[8];
#pragma unroll
      for (int e = 0; e < 4; ++e) { f[2 * e] = h_lo(pre[i][e]); f[2 * e + 1] = h_hi(pre[i][e]); }
      if (sec == 3) {
#pragma unroll
        for (int e = 0; e < 8; ++e) f[e] = __expf(-f[e]);
      }
      float* d = buf + b * 6144 + st * 384 + base + (ci & 7) * 8;
      *(f32x4*)d = (f32x4){f[0], f[1], f[2], f[3]};
      *(f32x4*)(d + 4) = (f32x4){f[4], f[5], f[6], f[7]};
    }
  };
  float S[KPL];
#pragma unroll
  for (int i = 0; i < KPL; ++i) S[i] = 0.f;
  __syncthreads();
  issue(0);
  commit(0);
  __syncthreads();
  __builtin_amdgcn_s_setprio(3);
  for (int c = 0; c < nch; ++c) {
    if (c + 1 < nch) issue(c + 1);
    const float* b = buf + (c & 1) * 6144;
#pragma unroll 1
    for (int g0 = 0; g0 < 16; g0 += LPR) {
      float ykeep = 0.f;
#pragma unroll 2
      for (int j = 0; j < LPR; ++j) {
        const int st = g0 + j;
        const float* q = b + st * 384 + kc * KPL;
        f32x4 kk[KPL / 4], rr[KPL / 4], ww[KPL / 4], dd[KPL / 4], bb[KPL / 4];
#pragma unroll
        for (int jj = 0; jj < KPL / 4; ++jj) {
          kk[jj] = *(const f32x4*)(q + 4 * jj);
          rr[jj] = *(const f32x4*)(q + 64 + 4 * jj);
          ww[jj] = *(const f32x4*)(q + 128 + 4 * jj);
          dd[jj] = *(const f32x4*)(q + 192 + 4 * jj);
          bb[jj] = *(const f32x4*)(q + 256 + 4 * jj);
        }
        const float vv = b[st * 384 + 320 + row];
        float sa0 = 0.f, sa1 = 0.f;
#pragma unroll
        for (int jj = 0; jj < KPL / 4; ++jj) {
          sa0 += S[4 * jj] * kk[jj][0]; sa1 += S[4 * jj + 1] * kk[jj][1];
          sa0 += S[4 * jj + 2] * kk[jj][2]; sa1 += S[4 * jj + 3] * kk[jj][3];
        }
        float sa = sa0 + sa1;
        sa = LPR == 8 ? reduce8(sa) : reduce4(sa);
        float y0 = 0.f, y1 = 0.f;
#pragma unroll
        for (int jj = 0; jj < KPL / 4; ++jj)
#pragma unroll
          for (int e = 0; e < 4; ++e) {
            const float sn = S[4 * jj + e] * ww[jj][e] + (sa * bb[jj][e] + vv * dd[jj][e]);
            S[4 * jj + e] = sn;
            if (e & 1) y1 += sn * rr[jj][e]; else y0 += sn * rr[jj][e];
          }
        float y = y0 + y1;
        y = LPR == 8 ? reduce8(y) : reduce4(y);
        ykeep = (kc == j) ? y : ykeep;
      }
      const int n = c * 16 + g0 + kc, t = dir ? L - 1 - n : n;
      Y[(size_t)rowof(G, s, t) * 1024 + head * 64 + row] = bf16_1(ykeep);
    }
    if (c + 1 < nch) commit((c + 1) & 1);
    __syncthreads();
  }
  __builtin_amdgcn_s_setprio(0);
}

__device__ void attn_tile(CP& p, const Grp& G, int s, int hd, int qb, char* lds, float lam) {
  const int tid = ltid(), lane = tid & 63, wave = tid >> 6, l32 = lane & 31, h = lane >> 5;
  const int L = G.L, Lp = (G.L + 31) & ~31;
  const u16* Pb = p.P;
  float* lutl = (float*)(lds + 36864);
  char* qfl = lds + 38912 + tid * 16;
  __syncthreads();
  for (int i = tid; i < 511; i += 256) lutl[i] = p.lut[hd * 512 + i];
  const int q = 16 + qb * 128 + wave * 32 + l32;
  const int qc = s * G.S + (q - 16);
  const int qw0 = 16 + qb * 128 + wave * 32;
  u16* odst = p.O + (size_t)qc * 1024 + hd * 128;
  const int kkey = tid >> 3, kch = (tid & 7) ^ ((kkey >> 1) & 7);
  const u16* vsrc[2];
#pragma unroll
  for (int i = 0; i < 2; ++i) {
    const int c = tid + 256 * i, dv = c >> 2, c4 = (c & 3) ^ ((dv >> 2) & 3);
    vsrc[i] = p.VT + ((size_t)(s * 1024 + hd * 128 + dv) * Lp) + c4 * 8;
  }
  const unsigned lds0 = __builtin_amdgcn_readfirstlane((unsigned)(uintptr_t)(LAS char*)lds + wave * 1024);
  const int ntile = (L + 31) >> 5;
#pragma unroll 1
  for (int br = 0; br < 2; ++br) {
#pragma unroll
    for (int ks = 0; ks < 4; ++ks) {
      const u32x4 raw = *(const u32x4*)(Pb + (size_t)qc * NIN + hd * 128 + br * 64 + ks * 16 + h * 8);
      u32x4 sc;
#pragma unroll
      for (int e = 0; e < 4; ++e) sc[e] = pk_bf16(bf_lo(raw[e]) * 0.125f, bf_hi(raw[e]) * 0.125f);
      *(u32x4*)(qfl + ks * 4096) = sc;
    }
    const u16* kp = Pb + 1024 + hd * 128 + br * 64 + kch * 8;
    auto stage = [&](int kt) {
      const int kt0 = kt * 32;
      const unsigned sb = lds0 + (kt % 3) * 12288;
      int kr = kt0 + kkey; kr = kr < L ? kr : L - 1;
      glds16(kp + (size_t)rowof(G, s, kr) * NIN, sb);
      glds16(vsrc[0] + kt0, sb + 4096);
      glds16(vsrc[1] + kt0, sb + 8192);
    };
    f32x16 O[4];
#pragma unroll
    for (int mb = 0; mb < 4; ++mb)
#pragma unroll
      for (int r = 0; r < 16; ++r) O[mb][r] = 0.f;
    float mrun = -1e30f, lrun = 0.f;
    asm volatile("s_waitcnt vmcnt(0) lgkmcnt(0)" ::: "memory");
    __builtin_amdgcn_s_barrier();
    stage(0);
    if (ntile > 1) stage(1);
    const float cneg = lutl[0], cpos = lutl[510];
    for (int kt = 0; kt < ntile; ++kt) {
      const int kt0 = kt * 32;
      if (kt + 1 < ntile) asm volatile("s_waitcnt vmcnt(3)" ::: "memory");
      else asm volatile("s_waitcnt vmcnt(0)" ::: "memory");
      __builtin_amdgcn_s_barrier();
      if (kt + 2 < ntile) stage(kt + 2);
      const char* st = lds + (kt % 3) * 12288;
      f32x16 sacc;
#pragma unroll
      for (int r = 0; r < 16; ++r) sacc[r] = 0.f;
#pragma unroll
      for (int ks = 0; ks < 4; ++ks) {
        const bf16x8 kf = *(const bf16x8*)(st + l32 * 128 + (((ks * 2 + h) ^ ((l32 >> 1) & 7)) << 4));
        const bf16x8 qv = *(const bf16x8*)(qfl + ks * 4096);
        sacc = __builtin_amdgcn_mfma_f32_32x32x16_bf16(kf, qv, sacc, 0, 0, 0);
      }
      const bool farneg = (kt0 + 31) <= (qw0 - 128);
      const bool farpos = kt0 >= (qw0 + 31 + 128);
      float ps = 0.f, alpha;
      if ((farneg || farpos) && (kt0 + 32 <= L)) {
        const float cv = farneg ? cneg : cpos;
        float mx = fmaxf(fmaxf(sacc[0], sacc[1]), sacc[2]);
#pragma unroll
        for (int r = 3; r < 15; r += 2) mx = fmaxf(fmaxf(mx, sacc[r]), sacc[r + 1]);
        mx = fmaxf(mx, sacc[15]);
        mx = fmaxf(mx, __shfl_xor(mx, 32));
        const float mnew = fmaxf(mrun, mx * LOG2E + cv);
        alpha = __builtin_amdgcn_exp2f(mrun - mnew);
        mrun = mnew;
        const float sh = cv - mnew;
#pragma unroll
        for (int r = 0; r < 16; ++r) { sacc[r] = __builtin_amdgcn_exp2f(sacc[r] * LOG2E + sh); ps += sacc[r]; }
      } else {
        float mx = -1e30f;
        if (farneg || farpos) {
          const float cv = farneg ? cneg : cpos;
#pragma unroll
          for (int r = 0; r < 16; ++r) { sacc[r] = sacc[r] * LOG2E + cv; }
        } else {
#pragma unroll
          for (int r = 0; r < 16; ++r) {
            const int key = kt0 + 8 * (r >> 2) + 4 * h + (r & 3);
            int d = key - q + 255;
            d = d < 0 ? 0 : (d > 510 ? 510 : d);
            sacc[r] = sacc[r] * LOG2E + lutl[d];
          }
        }
        if (kt0 + 32 > L) {
#pragma unroll
          for (int r = 0; r < 16; ++r) {
            const int key = kt0 + 8 * (r >> 2) + 4 * h + (r & 3);
            if (key >= L) sacc[r] = -INFINITY;
          }
        }
#pragma unroll
        for (int r = 0; r < 16; ++r) mx = fmaxf(mx, sacc[r]);
        mx = fmaxf(mx, __shfl_xor(mx, 32));
        const float mnew = fmaxf(mrun, mx);
        alpha = __builtin_amdgcn_exp2f(mrun - mnew);
        mrun = mnew;
#pragma unroll
        for (int r = 0; r < 16; ++r) { sacc[r] = __builtin_amdgcn_exp2f(sacc[r] - mnew); ps += sacc[r]; }
      }
      lrun = lrun * alpha + ps;
      if (__any(alpha != 1.f)) {
#pragma unroll
        for (int mb = 0; mb < 4; ++mb)
#pragma unroll
          for (int r = 0; r < 16; ++r) O[mb][r] *= alpha;
      }
      bf16x8 pf[2];
#pragma unroll
      for (int s2 = 0; s2 < 2; ++s2) {
        u32x4 w;
#pragma unroll
        for (int e = 0; e < 4; ++e) w[e] = pk_bf16(sacc[8 * s2 + 2 * e], sacc[8 * s2 + 2 * e + 1]);
        pf[s2] = __builtin_bit_cast(bf16x8, w);
      }
#pragma unroll
      for (int mb = 0; mb < 4; ++mb)
#pragma unroll
        for (int s2 = 0; s2 < 2; ++s2) {
          const int vr = mb * 32 + l32;
          const bf16x8 vf = *(const bf16x8*)(st + 4096 + vr * 64 + (((2 * s2 + h) ^ ((vr >> 2) & 3)) << 4));
          O[mb] = __builtin_amdgcn_mfma_f32_32x32x16_bf16(vf, pf[s2], O[mb], 0, 0, 0);
        }
    }
    const float lt = lrun + __shfl_xor(lrun, 32);
    if (br == 0) {
      const float i1 = 1.f / lt;
#pragma unroll
      for (int mb = 0; mb < 4; ++mb)
#pragma unroll
        for (int i = 0; i < 4; ++i)
          if (q < L) *(u32x2*)(odst + mb * 32 + 8 * i + 4 * h) = (u32x2){pk_bf16(O[mb][4 * i] * i1, O[mb][4 * i + 1] * i1), pk_bf16(O[mb][4 * i + 2] * i1, O[mb][4 * i + 3] * i1)};
    } else {
      const float i2 = lam / lt;
      float ssq = 0.f;
#pragma unroll
      for (int mb = 0; mb < 4; ++mb)
#pragma unroll
        for (int i = 0; i < 4; ++i) {
          u32x2 w = {0, 0};
          if (q < L) w = *(const u32x2*)(odst + mb * 32 + 8 * i + 4 * h);
          const float o0 = bf_lo(w.x) - O[mb][4 * i] * i2, o1v = bf_hi(w.x) - O[mb][4 * i + 1] * i2, o2 = bf_lo(w.y) - O[mb][4 * i + 2] * i2, o3 = bf_hi(w.y) - O[mb][4 * i + 3] * i2;
          O[mb][4 * i] = o0; O[mb][4 * i + 1] = o1v; O[mb][4 * i + 2] = o2; O[mb][4 * i + 3] = o3;
          ssq += o0 * o0 + o1v * o1v + o2 * o2 + o3 * o3;
        }
      ssq += __shfl_xor(ssq, 32);
      const float rn = rsqrtf(ssq * (1.f / 128.f) + EPSN) * 0.8f;
      if (q < L) {
#pragma unroll
        for (int mb = 0; mb < 4; ++mb)
#pragma unroll
          for (int i = 0; i < 4; ++i) {
            const int dv = mb * 32 + 8 * i + 4 * h;
            const f32x4 g = *(const f32x4*)(p.subln + dv);
            *(u32x2*)(odst + dv) = (u32x2){pk_bf16(O[mb][4 * i] * rn * g.x, O[mb][4 * i + 1] * rn * g.y),
                                           pk_bf16(O[mb][4 * i + 2] * rn * g.z, O[mb][4 * i + 3] * rn * g.w)};
          }
      }
    }
  }
}

__device__ void phase_mixer(CP& p, const Grp& G, int g, char* lds) {
  if (G.nseq == 4) { for (int t = blockIdx.x; t < 256; t += gridDim.x) scan_task<8>(p, G, t, lds); }
  else { for (int t = blockIdx.x; t < 256; t += gridDim.x) scan_task<4>(p, G, t, lds); }
  const int nqb = G.S >> 7;
  const int natt = G.nseq * 8 * nqb;
  const float lam = p.lam[0];
  int* shw = (int*)(lds + 65536 - 16);
  while (true) {
    __syncthreads();
    if (ltid() == 0) *shw = atomicAdd(p.cnt + g, 1);
    __syncthreads();
    const int t = *shw;
    if (t >= natt) break;
    const int qb = t % nqb, r = t / nqb, hd = r & 7, s = r >> 3;
    attn_tile(p, G, s, hd, qb, lds, lam);
  }
}

__device__ void phase_post(CP& p, const Grp& G) {
  const int lane = ltid() & 63;
  const int nw = gridDim.x * 4;
  const int c0 = lane * 16, head = lane >> 2, hc = (lane & 3) * 16;
  for (int row = blockIdx.x * 4 + (ltid() >> 6); row < G.Mx; row += nw) {
    float y[16];
    {
      const u32x4 a0 = *(const u32x4*)(p.Y0 + (size_t)row * 1024 + c0), a1 = *(const u32x4*)(p.Y0 + (size_t)row * 1024 + c0 + 8);
      const u32x4 b0 = *(const u32x4*)(p.Y1 + (size_t)row * 1024 + c0), b1 = *(const u32x4*)(p.Y1 + (size_t)row * 1024 + c0 + 8);
#pragma unroll
      for (int e = 0; e < 4; ++e) {
        y[2 * e] = bf_lo(a0[e]) + bf_lo(b0[e]); y[2 * e + 1] = bf_hi(a0[e]) + bf_hi(b0[e]);
        y[8 + 2 * e] = bf_lo(a1[e]) + bf_lo(b1[e]); y[8 + 2 * e + 1] = bf_hi(a1[e]) + bf_hi(b1[e]);
      }
    }
    float s1 = 0.f;
#pragma unroll
    for (int e = 0; e < 16; ++e) s1 += y[e];
    s1 = reduce4(s1);
    const float mu = s1 * (1.f / 64.f);
    float s2 = 0.f;
#pragma unroll
    for (int e = 0; e < 16; ++e) { const float d = y[e] - mu; s2 += d * d; }
    s2 = reduce4(s2);
    const float rstd = rsqrtf(s2 * (1.f / 64.f) + 64e-5f);
    const size_t rec = ((size_t)row * 16 + head) * 192 + hc;
    float rr[16], vv[16], kd[16];
    {
      const u32x4 r0 = *(const u32x4*)(p.RKV + rec), r1 = *(const u32x4*)(p.RKV + rec + 8);
      const u32x4 v0 = *(const u32x4*)(p.RKV + rec + 128), v1 = *(const u32x4*)(p.RKV + rec + 136);
      const u32x4 f0 = *(const u32x4*)(p.DIR0 + rec + 64), f1 = *(const u32x4*)(p.DIR0 + rec + 72);
      const u32x4 g0 = *(const u32x4*)(p.DIR1 + rec + 64), g1 = *(const u32x4*)(p.DIR1 + rec + 72);
#pragma unroll
      for (int e = 0; e < 4; ++e) {
        rr[2 * e] = h_lo(r0[e]); rr[2 * e + 1] = h_hi(r0[e]); rr[8 + 2 * e] = h_lo(r1[e]); rr[8 + 2 * e + 1] = h_hi(r1[e]);
        vv[2 * e] = h_lo(v0[e]); vv[2 * e + 1] = h_hi(v0[e]); vv[8 + 2 * e] = h_lo(v1[e]); vv[8 + 2 * e + 1] = h_hi(v1[e]);
        kd[2 * e] = h_lo(f0[e]) + h_lo(g0[e]); kd[2 * e + 1] = h_hi(f0[e]) + h_hi(g0[e]);
        kd[8 + 2 * e] = h_lo(f1[e]) + h_lo(g1[e]); kd[8 + 2 * e + 1] = h_hi(f1[e]) + h_hi(g1[e]);
      }
    }
    float bs = 0.f;
#pragma unroll
    for (int e = 0; e < 16; ++e) bs += rr[e] * kd[e] * p.r_k[c0 + e];
    bs = reduce4(bs);
    const u32x4 g0 = *(const u32x4*)(p.G + (size_t)row * 1024 + c0), g1 = *(const u32x4*)(p.G + (size_t)row * 1024 + c0 + 8);
    float o[16];
#pragma unroll
    for (int e = 0; e < 16; ++e) {
      const unsigned gw = e < 8 ? g0[e >> 1] : g1[(e - 8) >> 1];
      const float gg = (e & 1) ? bf_hi(gw) : bf_lo(gw);
      o[e] = ((y[e] - mu) * rstd * p.lnx_w[c0 + e] + p.lnx_b[c0 + e] + bs * vv[e]) * gg;
    }
    u16* dst = (u16*)p.H + (size_t)row * 1024 + c0;
    *(u32x4*)dst = (u32x4){pk_bf16(o[0], o[1]), pk_bf16(o[2], o[3]), pk_bf16(o[4], o[5]), pk_bf16(o[6], o[7])};
    *(u32x4*)(dst + 8) = (u32x4){pk_bf16(o[8], o[9]), pk_bf16(o[10], o[11]), pk_bf16(o[12], o[13]), pk_bf16(o[14], o[15])};
  }
}

__device__ void phase_final(CP& p, const Grp& G) {
  const int lane = ltid() & 63;
  const int nw = gridDim.x * 4;
  for (int row = blockIdx.x * 4 + (ltid() >> 6); row < G.Mx; row += nw) {
    const float rs = rsqrtf(p.ss3[row] * (1.f / 1024.f) + EPSN);
    const float* hp = p.H + (size_t)row * 1024;
    float* op = G.out + (size_t)row * 1024;
#pragma unroll
    for (int i = 0; i < 4; ++i) {
      const f32x4 v = *(const f32x4*)(hp + i * 256 + lane * 4);
      const f32x4 g = *(const f32x4*)(p.final_norm + i * 256 + lane * 4);
      *(f32x4*)(op + i * 256 + lane * 4) = (f32x4){v.x * rs * g.x, v.y * rs * g.y, v.z * rs * g.z, v.w * rs * g.w};
    }
  }
}

__device__ void run_phase(CP& p, int ph, char* lds) {
  int* gctr = p.cnt + 64 + ph * 64;
  if (ph == 0) { phase_prep(p, lds); return; }
  int g, k;
  if (ph <= NMETA_PH) { g = -1; k = ph - 1; }
  else { g = (ph - 1 - NMETA_PH) / PH_PER_G; k = (ph - 1 - NMETA_PH) - g * PH_PER_G; }
  const Grp G = get_grp(p, g);
  const int Mall = G.M;
  const int M = G.Mx;
  u16* Pout = G.meta ? p.PM : p.P;
  switch (k) {
    case 0: phase_rows(p, G); break;
    case 1:
      gemm_phase(p.HB, 1024, M, p.W1A, 1024, 2 * FFD, lds, gctr, [&](const f32x16 (&acc)[2][2], int nb, int tb) { epi_swiglu(acc, nb, tb, M, p.ss0, p.ACT); });
      break;
    case 2:
      gemm_phase(p.ACT, FFD, M, p.WD1, FFD, 1024, lds, gctr, [&](const f32x16 (&acc)[2][2], int nb, int tb) { epi_resid<0>(acc, nb, tb, p, G); });
      break;
    case 3:
      gemm_phase(p.HB, 1024, M, p.WIN, 1024, NIN, lds, gctr, [&](const f32x16 (&acc)[2][2], int nbase, int tbase) {
        const int lane = ltid() & 63, l32 = lane & 31, h = lane >> 5;
#pragma unroll
        for (int tb = 0; tb < 2; ++tb) {
          const int tok = tbase + tb * 32 + l32;
          if (tok < M) {
            const float rs = rsqrtf(p.ss1[tok] * (1.f / 1024.f) + EPSN);
            if (!G.meta && nbase >= 2048 && nbase < 3072) {
              const int s = tok >> G.lgS, t = 16 + (tok & (G.S - 1));
              const int Lp = (G.L + 31) & ~31;
              const int pos = (t & ~12) | ((t & 4) << 1) | ((t & 8) >> 1);
              u16* vt = p.VT + ((size_t)(s * 1024 + (nbase - 2048)) * Lp) + pos;
#pragma unroll
              for (int nb = 0; nb < 2; ++nb)
#pragma unroll
                for (int r = 0; r < 16; ++r) {
                  const int dvl = nb * 32 + 8 * (r >> 2) + 4 * h + (r & 3);
                  vt[(size_t)dvl * Lp] = bf16_1(acc[nb][tb][r] * rs);
                }
            } else {
              u16* dst = Pout + (size_t)tok * NIN + nbase + 4 * h;
#pragma unroll
              for (int nb = 0; nb < 2; ++nb)
#pragma unroll
                for (int i = 0; i < 4; ++i)
                  *(u32x2*)(dst + nb * 32 + 8 * i) = (u32x2){pk_bf16(acc[nb][tb][4 * i] * rs, acc[nb][tb][4 * i + 1] * rs),
                                                             pk_bf16(acc[nb][tb][4 * i + 2] * rs, acc[nb][tb][4 * i + 3] * rs)};
            }
          }
        }
      });
      break;
    case 4: phase_mix(p, G); break;
    case 5:
      gemm_phase(p.F, 384, Mall, p.W2F, 64, 1024, lds, gctr, [&](const f32x16 (&acc)[2][2], int nb, int tb) { epi_decay(acc, nb, tb, Mall, p.rw_w0, p.DIR0); });
      gemm_phase(p.F + 64, 384, Mall, p.W2B, 64, 1024, lds, gctr + 8, [&](const f32x16 (&acc)[2][2], int nb, int tb) { epi_decay(acc, nb, tb, Mall, p.rw_w0 + 1024, p.DIR1); });
      gemm_phase(p.F + 128, 384, Mall, p.A2F, 64, 1024, lds, gctr + 16, [&](const f32x16 (&acc)[2][2], int nb, int tb) { epi_adir(acc, nb, tb, Mall, p, 0); });
      gemm_phase(p.F + 192, 384, Mall, p.A2B, 64, 1024, lds, gctr + 24, [&](const f32x16 (&acc)[2][2], int nb, int tb) { epi_adir(acc, nb, tb, Mall, p, 1); });
      gemm_phase(p.F + 256, 384, Mall, p.G2T, 128, 1024, lds, gctr + 32, [&](const f32x16 (&acc)[2][2], int nbase, int tbase) {
        const int lane = ltid() & 63, l32 = lane & 31, h = lane >> 5;
#pragma unroll
        for (int tb = 0; tb < 2; ++tb) {
          const int tok = tbase + tb * 32 + l32;
          if (tok < Mall) {
            u16* dst = p.G + (size_t)tok * 1024 + nbase + 4 * h;
#pragma unroll
            for (int nb = 0; nb < 2; ++nb)
#pragma unroll
              for (int i = 0; i < 4; ++i)
                *(u32x2*)(dst + nb * 32 + 8 * i) = (u32x2){pk_bf16(acc[nb][tb][4 * i], acc[nb][tb][4 * i + 1]), pk_bf16(acc[nb][tb][4 * i + 2], acc[nb][tb][4 * i + 3])};
          }
        }
      });
      break;
    case 6: phase_mixer(p, G, g, lds); break;
    case 7: phase_post(p, G); break;
    case 8: {
      const int nN = 8, nM = (M + 127) >> 7, nt = nN * nM;
      const int wave = ltid() >> 6;
      const int lane = ltid() & 63, l32 = lane & 31, h = lane >> 5;
      const int xcd = blockIdx.x & 7, g8 = gridDim.x >> 3;
      const int tq = nt >> 3, trm = nt & 7;
      const int tstart = xcd < trm ? xcd * (tq + 1) : trm * (tq + 1) + (xcd - trm) * tq;
      const int tcnt = tq + (xcd < trm ? 1 : 0);
      for (int off = blockIdx.x >> 3; off < tcnt; off += g8) {
        const int id = tstart + off, nig = 8 * nN, grp = id / nig, fm = grp * 8;
        const int gsz = (nM - fm) < 8 ? (nM - fm) : 8, idl = id - grp * nig;
        const int tm = fm + idl % gsz, tn = idl / gsz;
        const int nbase = tn * 128 + (wave & 1) * 64, tbase = tm * 128 + (wave >> 1) * 64;
#pragma unroll 1
        for (int pass = 0; pass < 2; ++pass) {
          f32x16 acc[2][2];
          zero_acc(acc);
          gemm_kloop(acc, pass ? (const u16*)p.H : p.O, 1024, M, tm * 128, pass ? p.WRW : p.WATT, 1024, tn * 128, 1024, lds);
#pragma unroll
          for (int tb = 0; tb < 2; ++tb) {
            const int tok = tbase + tb * 32 + l32;
            if (tok < M) {
              const u16* gp = p.P + (size_t)tok * NIN + 6528 + pass * 1024 + nbase + 4 * h;
              u16* dst = p.MERGED + (size_t)tok * 1024 + nbase + 4 * h;
#pragma unroll
              for (int nb = 0; nb < 2; ++nb)
#pragma unroll
                for (int i = 0; i < 4; ++i) {
                  const u32x2 ga = *(const u32x2*)(gp + nb * 32 + 8 * i);
                  float o0 = sigm(bf_lo(ga.x)) * acc[nb][tb][4 * i];
                  float o1 = sigm(bf_hi(ga.x)) * acc[nb][tb][4 * i + 1];
                  float o2 = sigm(bf_lo(ga.y)) * acc[nb][tb][4 * i + 2];
                  float o3 = sigm(bf_hi(ga.y)) * acc[nb][tb][4 * i + 3];
                  if (pass) {
                    const u32x2 pv = *(const u32x2*)(dst + nb * 32 + 8 * i);
                    o0 += bf_lo(pv.x); o1 += bf_hi(pv.x); o2 += bf_lo(pv.y); o3 += bf_hi(pv.y);
                  }
                  *(u32x2*)(dst + nb * 32 + 8 * i) = (u32x2){pk_bf16(o0, o1), pk_bf16(o2, o3)};
                }
            }
          }
        }
      }
    } break;
    case 9:
      gemm_phase(p.MERGED, 1024, M, p.WOUT, 1024, 1024, lds, gctr, [&](const f32x16 (&acc)[2][2], int nb, int tb) { epi_resid<1>(acc, nb, tb, p, G); });
      break;
    case 10:
      gemm_phase(p.HB, 1024, M, p.W2A, 1024, 2 * FFD, lds, gctr, [&](const f32x16 (&acc)[2][2], int nb, int tb) { epi_swiglu(acc, nb, tb, M, p.ss2, p.ACT); });
      break;
    case 11:
      gemm_phase(p.ACT, FFD, M, p.WD2, FFD, 1024, lds, gctr, [&](const f32x16 (&acc)[2][2], int nb, int tb) { epi_resid<2>(acc, nb, tb, p, G); });
      break;
    case 12: phase_final(p, G); break;
  }
}

__global__ void __launch_bounds__(256, 2) mega(Params p, int ph_lo, int ph_hi, int coop) {
  __shared__ __attribute__((aligned(16))) char lds[65536 + 16];
  uint4& xb_words = *(uint4*)(lds + 65536);
  CP* pp = (CP*)__builtin_amdgcn_kernarg_segment_ptr();
  asm volatile("" : "+s"(pp));
  if (threadIdx.x == 0) xb_words = make_uint4(0u, 0u, 0u, 0u);
  __syncthreads();
  const XcdBarrier xb = xcd_barrier_post(pp->bar, (volatile LAS unsigned*)&xb_words);
  for (int ph = ph_lo; ph < ph_hi; ++ph) {
    run_phase(*pp, ph, lds);
    if (coop && ph + 1 < ph_hi) {
      if (ph == 0) cg::this_grid().sync();
      else xcd_barrier(xb);
    }
  }
}

extern "C" void kernel_launch(void* const* d_in, const int* in_sizes, int n_in, void* d_out, int out_size, void* d_ws,
                              size_t ws_size, hipStream_t stream) {
  Params p;
  memset(&p, 0, sizeof(p));
  const float** f = (const float**)&p;
  for (int i = 0; i < 35; ++i) f[i] = (const float*)d_in[i];
  p.out = (float*)d_out;
  char* w = (char*)d_ws;
  size_t off = 0;
  auto alloc = [&](size_t bytes) { char* r = w + off; off += (bytes + 255) & ~(size_t)255; return r; };
  p.W1A = (u16*)alloc((size_t)2 * FFD * 1024 * 2);
  p.WD1 = (u16*)alloc((size_t)1024 * FFD * 2);
  p.WIN = (u16*)alloc((size_t)NIN * 1024 * 2);
  p.WATT = (u16*)alloc((size_t)1024 * 1024 * 2);
  p.WRW = (u16*)alloc((size_t)1024 * 1024 * 2);
  p.WOUT = (u16*)alloc((size_t)1024 * 1024 * 2);
  p.W2A = (u16*)alloc((size_t)2 * FFD * 1024 * 2);
  p.WD2 = (u16*)alloc((size_t)1024 * FFD * 2);
  p.W2F = (u16*)alloc((size_t)1024 * 64 * 2);
  p.W2B = (u16*)alloc((size_t)1024 * 64 * 2);
  p.A2F = (u16*)alloc((size_t)1024 * 64 * 2);
  p.A2B = (u16*)alloc((size_t)1024 * 64 * 2);
  p.G2T = (u16*)alloc((size_t)1024 * 128 * 2);
  p.lut = (float*)alloc(8 * 512 * 4);
  p.cnt = (int*)alloc((64 + NPHASES * 64) * 4);
  p.lam = (float*)alloc(256);
  p.bar = (unsigned*)alloc(XCD_BAR_WORDS * 4);
  const size_t R = MAXROWS;
  p.H = (float*)alloc(R * 1024 * 4);
  p.HB = (u16*)alloc(R * 1024 * 2);
  p.ACT = (u16*)alloc(R * FFD * 2);
  p.Y0 = p.ACT;
  p.Y1 = p.ACT + R * 1024;
  p.F = p.ACT + R * 2048;
  p.P = (u16*)alloc(R * NIN * 2);
  p.RKV = (u16*)alloc(R * 16 * 192 * 2);
  p.DIR0 = (u16*)alloc(R * 16 * 192 * 2);
  p.DIR1 = (u16*)alloc(R * 16 * 192 * 2);
  p.G = (u16*)alloc(R * 1024 * 2);
  p.O = (u16*)alloc(R * 1024 * 2);
  p.MERGED = (u16*)alloc(R * 1024 * 2);
  p.VT = (u16*)alloc((size_t)8 * 8 * 128 * 2080 * 2);
  p.PM = (u16*)alloc((size_t)16 * NIN * 2);
  p.ss0 = (float*)alloc(R * 4);
  p.ss1 = (float*)alloc(R * 4);
  p.ss2 = (float*)alloc(R * 4);
  p.ss3 = (float*)alloc(R * 4);
  if (off > ws_size) { fprintf(stderr, "workspace too small: need %zu have %zu\n", off, ws_size); return; }
  static int grid_blocks = 0;
  if (!grid_blocks) {
    int dev = 0, cus = 0, per_cu = 0;
    hipGetDevice(&dev);
    hipDeviceGetAttribute(&cus, hipDeviceAttributeMultiprocessorCount, dev);
    hipOccupancyMaxActiveBlocksPerMultiprocessor(&per_cu, mega, 256, 0);
    per_cu = 2;
    grid_blocks = cus * per_cu;
  }
  hipMemsetAsync(p.bar, 0, XCD_BAR_WORDS * 4, stream);
  hipMemsetAsync(p.cnt, 0, (64 + NPHASES * 64) * 4, stream);
  int ph_lo = 0, ph_hi = NPHASES, coop = 1;
  void* args[] = {&p, &ph_lo, &ph_hi, &coop};
  hipError_t e = hipLaunchCooperativeKernel((void*)mega, dim3(grid_blocks), dim3(256), args, 0, stream);
  if (e != hipSuccess) fprintf(stderr, "cooperative launch failed: %s (grid %d)\n", hipGetErrorString(e), grid_blocks);
}
```

```cpp
#include <hip/hip_runtime.h>
#include <hip/hip_cooperative_groups.h>
#include <stdint.h>
#include <string.h>
#include <stdio.h>
namespace cg = cooperative_groups;

typedef unsigned short u16;
typedef short bf16x8 __attribute__((ext_vector_type(8)));
typedef float f32x16 __attribute__((ext_vector_type(16)));
typedef float f32x4 __attribute__((ext_vector_type(4)));
typedef float f32x2 __attribute__((ext_vector_type(2)));
typedef unsigned u32x4 __attribute__((ext_vector_type(4)));
typedef unsigned u32x2 __attribute__((ext_vector_type(2)));
typedef __bf16 bf16x2_t __attribute__((ext_vector_type(2)));
typedef _Float16 f16x2_t __attribute__((ext_vector_type(2)));

#define NIN 8576
#define FFD 2816
#define EPSN 1e-6f
#define LOG2E 1.4426950408889634f
#define NGROUPS 6
#define PH_PER_G 13
#define NMETA_PH 4
#define NPHASES (1 + NMETA_PH + NGROUPS * PH_PER_G)
#define MAXROWS 16512

struct Params {
  const float *x_prompt, *x_sample, *meta, *rel_bias, *ffn1_norm, *ffn1_wg, *ffn1_wu, *ffn1_wd, *mix_norm, *w_in;
  const float *lq1, *lk1, *lq2, *lk2, *subln, *w_attn, *mu_prev, *mu_next, *rw_w0, *rw_w2, *rw_a0, *rw_a2, *rw_g2;
  const float *k_k, *k_a, *r_k, *lnx_w, *lnx_b, *w_rw, *w_out, *ffn2_norm, *ffn2_wg, *ffn2_wu, *ffn2_wd, *final_norm;
  float* out;
  u16 *W1A, *WD1, *WIN, *WATT, *WRW, *WOUT, *W2A, *WD2, *W2F, *W2B, *A2F, *A2B, *G2T;
  float* lut; int* cnt; float* lam; unsigned* bar; u16* VT; u16* PM;
  float* H; u16 *HB, *ACT, *P, *RKV, *DIR0, *DIR1, *G, *O, *MERGED, *Y0, *Y1, *F;
  float *ss0, *ss1, *ss2, *ss3;
};

typedef const Params __attribute__((address_space(4))) CP;
struct Grp { int nseq, L, S, lgS, M, Mx, meta; const float* x; float* out; };
__device__ __forceinline__ int rowof(const Grp& G, int s, int t) { return t < 16 ? G.Mx + s * 16 + t : s * G.S + (t - 16); }

__device__ __forceinline__ Grp get_grp(CP& p, int g) {
  Grp r;
  r.meta = 0;
  if (g < 0) {
    r.nseq = 1; r.L = 16; r.S = 16; r.lgS = 4; r.x = p.meta; r.out = nullptr; r.M = 16; r.Mx = 16; r.meta = 1;
    return r;
  }
  if (g < 4) { r.nseq = 4; r.L = 4112; r.S = 4096; r.lgS = 12; r.x = p.x_prompt + (size_t)g * 4 * 4096 * 1024; r.out = p.out + (size_t)g * 4 * 4096 * 1024; }
  else { r.nseq = 8; r.L = 2064; r.S = 2048; r.lgS = 11; r.x = p.x_sample + (size_t)(g - 4) * 8 * 2048 * 1024; r.out = p.out + (size_t)16 * 4096 * 1024 + (size_t)(g - 4) * 8 * 2048 * 1024; }
  r.M = r.nseq * r.L;
  r.Mx = r.nseq * r.S;
  return r;
}

__device__ __forceinline__ int ltid() { int t = threadIdx.x; asm volatile("" : "+v"(t)); return t; }
__device__ __forceinline__ unsigned pk_bf16(float a, float b) {
  f32x2 v = {a, b};
  bf16x2_t r = __builtin_convertvector(v, bf16x2_t);
  return __builtin_bit_cast(unsigned, r);
}
__device__ __forceinline__ float bf_lo(unsigned u) { return __uint_as_float(u << 16); }
__device__ __forceinline__ float bf_hi(unsigned u) { return __uint_as_float(u & 0xffff0000u); }
__device__ __forceinline__ unsigned pk_f16(float a, float b) {
  f32x2 v = {a, b};
  f16x2_t r = __builtin_convertvector(v, f16x2_t);
  return __builtin_bit_cast(unsigned, r);
}
__device__ __forceinline__ float h_lo(unsigned u) { f16x2_t r = __builtin_bit_cast(f16x2_t, u); return (float)r.x; }
__device__ __forceinline__ float h_hi(unsigned u) { f16x2_t r = __builtin_bit_cast(f16x2_t, u); return (float)r.y; }
__device__ __forceinline__ u16 bf16_1(float a) { return (u16)(pk_bf16(a, 0.f) & 0xffffu); }
__device__ __forceinline__ float sigm(float x) { return __builtin_amdgcn_rcpf(1.f + __builtin_amdgcn_exp2f(-LOG2E * x)); }
__device__ __forceinline__ float wave_sum(float v) {
#pragma unroll
  for (int o = 32; o > 0; o >>= 1) v += __shfl_xor(v, o);
  return v;
}
template <int CTRL> __device__ __forceinline__ float dppf(float x) {
  return __int_as_float(__builtin_amdgcn_update_dpp(0, __float_as_int(x), CTRL, 0xf, 0xf, true));
}
__device__ __forceinline__ float reduce8(float x) {
  x += dppf<0xB1>(x);
  x += dppf<0x4E>(x);
  x += dppf<0x141>(x);
  return x;
}
__device__ __forceinline__ float reduce4(float x) {
  x += dppf<0xB1>(x);
  x += dppf<0x4E>(x);
  return x;
}

__device__ void prep_transpose(const float* __restrict__ src, int K, int N, u16* __restrict__ dst,
                               const float* __restrict__ gain, int mode, char* lds) {
  float* tile = (float*)lds;
  const int tn = N / 64, nt = (K / 64) * tn;
  const int tid = ltid();
  for (int t = blockIdx.x; t < nt; t += gridDim.x) {
    const int k0 = (t / tn) * 64, n0 = (t % tn) * 64;
    const int nl = tid & 63, kq = tid >> 6;
#pragma unroll
    for (int i = 0; i < 16; ++i) {
      const int k = i * 4 + kq;
      float v = src[(size_t)(k0 + k) * N + n0 + nl];
      if (gain) v *= gain[k0 + k];
      tile[k * 65 + nl] = v;
    }
    __syncthreads();
    const int n = tid >> 2, kk = (tid & 3) * 16;
    unsigned w[8];
#pragma unroll
    for (int i = 0; i < 8; ++i) w[i] = pk_bf16(tile[(kk + 2 * i) * 65 + n], tile[(kk + 2 * i + 1) * 65 + n]);
    const int ng = n0 + n;
    const int row = mode == 0 ? ng : ((ng >> 5) * 64 + (ng & 31) + (mode == 2 ? 32 : 0));
    u32x4* d = (u32x4*)(dst + (size_t)row * K + k0 + kk);
    d[0] = (u32x4){w[0], w[1], w[2], w[3]};
    d[1] = (u32x4){w[4], w[5], w[6], w[7]};
    __syncthreads();
  }
}

__device__ void phase_prep(CP& p, char* lds) {
  if (blockIdx.x == 0) {
    const int tid = ltid();
    for (int idx = tid; idx < 8 * 511; idx += 256) {
      const int hd = idx / 511, di = idx - hd * 511, d = di - 255;
      const int n = d < 0 ? -d : d;
      int bk;
      if (n < 8) bk = n;
      else {
        const float nf = (float)n;
        int large = 8 + (int)(logf(nf / 8.0f) / 2.772588722239781f * 8.0f);
        bk = large < 15 ? large : 15;
      }
      const int bucket = (d > 0 ? 16 : 0) + bk;
      p.lut[hd * 512 + di] = p.rel_bias[bucket * 8 + hd] * LOG2E;
    }
    if (tid == 0) {
      float s1 = 0.f, s2 = 0.f;
      for (int i = 0; i < 64; ++i) { s1 += p.lq1[i] * p.lk1[i]; s2 += p.lq2[i] * p.lk2[i]; }
      p.lam[0] = expf(s1) - expf(s2) + 0.2f;
    }
  }
  prep_transpose(p.ffn1_wg, 1024, FFD, p.W1A, p.ffn1_norm, 1, lds);
  prep_transpose(p.ffn1_wu, 1024, FFD, p.W1A, p.ffn1_norm, 2, lds);
  prep_transpose(p.ffn1_wd, FFD, 1024, p.WD1, nullptr, 0, lds);
  prep_transpose(p.w_in, 1024, NIN, p.WIN, p.mix_norm, 0, lds);
  prep_transpose(p.w_attn, 1024, 1024, p.WATT, nullptr, 0, lds);
  prep_transpose(p.w_rw, 1024, 1024, p.WRW, nullptr, 0, lds);
  prep_transpose(p.w_out, 1024, 1024, p.WOUT, nullptr, 0, lds);
  prep_transpose(p.ffn2_wg, 1024, FFD, p.W2A, p.ffn2_norm, 1, lds);
  prep_transpose(p.ffn2_wu, 1024, FFD, p.W2A, p.ffn2_norm, 2, lds);
  prep_transpose(p.ffn2_wd, FFD, 1024, p.WD2, nullptr, 0, lds);
  prep_transpose(p.rw_w2, 64, 1024, p.W2F, nullptr, 0, lds);
  prep_transpose(p.rw_w2 + 64 * 1024, 64, 1024, p.W2B, nullptr, 0, lds);
  prep_transpose(p.rw_a2, 64, 1024, p.A2F, nullptr, 0, lds);
  prep_transpose(p.rw_a2 + 64 * 1024, 64, 1024, p.A2B, nullptr, 0, lds);
  prep_transpose(p.rw_g2, 128, 1024, p.G2T, nullptr, 0, lds);
}

__device__ void phase_rows(CP& p, const Grp& G) {
  const int lane = ltid() & 63;
  const int nw = gridDim.x * 4;
  const int gw = blockIdx.x * 4 + (ltid() >> 6);
  for (int row = gw; row < G.Mx; row += nw) {
    const float* src = G.x + (size_t)row * 1024;
    float ss = 0.f;
#pragma unroll
    for (int i = 0; i < 4; ++i) {
      const f32x4 v = *(const f32x4*)(src + i * 256 + lane * 4);
      ss += v.x * v.x + v.y * v.y + v.z * v.z + v.w * v.w;
      u32x2 o = {pk_bf16(v.x, v.y), pk_bf16(v.z, v.w)};
      *(u32x2*)(p.HB + (size_t)row * 1024 + i * 256 + lane * 4) = o;
    }
    ss = wave_sum(ss);
    if (lane == 0) { p.ss0[row] = ss; p.ss1[row] = 0.f; p.ss2[row] = 0.f; p.ss3[row] = 0.f; }
  }
  if (G.meta) return;
  const int Lp = (G.L + 31) & ~31;
  for (int r = gw; r < G.nseq * 16; r += nw) {
    const int s = r >> 4, t = r & 15;
    const u16* srcp = p.PM + (size_t)t * NIN;
    u16* dstp = p.P + (size_t)(G.Mx + r) * NIN;
    for (int c = lane * 8; c < NIN; c += 512)
      if (c < 2048 || c >= 3072) *(u32x4*)(dstp + c) = *(const u32x4*)(srcp + c);
    const int pos = (t & ~12) | ((t & 4) << 1) | ((t & 8) >> 1);
    for (int c = lane; c < 1024; c += 64) p.VT[(size_t)(s * 1024 + c) * Lp + pos] = srcp[2048 + c];
  }
}

#define LAS __attribute__((address_space(3)))
#define XB_TMO      128
#define XB_XCNT(j)  (256  + 64 * (j))
#define XB_XSUB(j)  (1280 + 64 * (j))
#define XB_XGEN(j)  (2304 + 64 * (j))
#define XB_TOP      3328
#define XB_TOPGEN   3392
#define XCD_BAR_WORDS 3456
#define XB_SPIN_CAP (1u << 18)
__device__ __forceinline__ unsigned xb_ld(unsigned* p) { return __hip_atomic_load(p, __ATOMIC_RELAXED, __HIP_MEMORY_SCOPE_AGENT); }
__device__ __forceinline__ unsigned xb_add(unsigned* p, unsigned v) { return __hip_atomic_fetch_add(p, v, __ATOMIC_RELAXED, __HIP_MEMORY_SCOPE_AGENT); }
__device__ __forceinline__ unsigned xb_xcc_id() { return (unsigned)__builtin_amdgcn_s_getreg((3 << 11) | 20) & 0xFu; }
#define XB_SPIN(cond, bar) do { unsigned _sp = 0; while (cond) { __builtin_amdgcn_s_sleep(1); \
    if ((++_sp & 255u) == 0u) { if (xb_ld(&(bar)[XB_TMO])) break; if (_sp > XB_SPIN_CAP) { atomicAdd(&(bar)[XB_TMO], 1u); break; } } } } while (0)
struct XcdBarrier { unsigned* bar; unsigned x; volatile LAS unsigned* st; };
__device__ __forceinline__ XcdBarrier xcd_barrier_post(unsigned* bar, volatile LAS unsigned* st) {
  XcdBarrier b; b.bar = bar; b.x = xb_xcc_id(); b.st = st;
  if (threadIdx.x == 0) (void)xb_add(&bar[XB_XCNT(b.x)], 1u);
  return b;
}
__device__ __forceinline__ void xcd_barrier_complete(unsigned* bar, unsigned x, unsigned& nloc, unsigned& nx) {
  const unsigned G = gridDim.x * gridDim.y * gridDim.z;
  unsigned sum, cnt, mine, sp = 0u;
  for (;;) {
    sum = 0u; cnt = 0u; mine = 0u;
#pragma unroll
    for (unsigned j = 0; j < 16; ++j) { const unsigned c = xb_ld(&bar[XB_XCNT(j)]); sum += c; cnt += (c > 0u) ? 1u : 0u; mine = (j == x) ? c : mine; }
    if (sum == G) break;
    __builtin_amdgcn_s_sleep(1);
    if ((++sp & 255u) == 0u) { if (xb_ld(&bar[XB_TMO])) break; if (sp > XB_SPIN_CAP) { atomicAdd(&bar[XB_TMO], 1u); break; } }
  }
  nloc = mine > 0u ? mine : 1u; nx = cnt > 0u ? cnt : 1u;
}
__device__ __forceinline__ void xcd_barrier(const XcdBarrier& b) {
  asm volatile("s_waitcnt vmcnt(0)" ::: "memory");
  __syncthreads();
  if (threadIdx.x == 0) {
    unsigned* bar = b.bar;
    __builtin_amdgcn_s_waitcnt(0);
    unsigned nloc = b.st[0], nx = b.st[1];
    if (nloc == 0u) { xcd_barrier_complete(bar, b.x, nloc, nx); b.st[0] = nloc; b.st[1] = nx; }
    const unsigned old = xb_add(&bar[XB_XSUB(b.x)], 1u);
    const unsigned gen = old / nloc;
    if (old + 1u == (gen + 1u) * nloc) {
      __builtin_amdgcn_fence(__ATOMIC_RELEASE, "agent");
      asm volatile("s_waitcnt vmcnt(0)" ::: "memory");
      const unsigned og = xb_add(&bar[XB_TOP], 1u);
      const unsigned tg = og / nx;
      if (og + 1u == (tg + 1u) * nx) xb_add(&bar[XB_TOPGEN], 1u);
      else XB_SPIN(xb_ld(&bar[XB_TOPGEN]) == tg, bar);
      __builtin_amdgcn_fence(__ATOMIC_ACQUIRE, "agent");
      xb_add(&bar[XB_XGEN(b.x)], 1u);
      asm volatile("s_waitcnt vmcnt(0)" ::: "memory");
    } else {
      XB_SPIN(xb_ld(&bar[XB_XGEN(b.x)]) == gen, bar);
      __builtin_amdgcn_fence(__ATOMIC_ACQUIRE, "agent");
      asm volatile("s_waitcnt vmcnt(0)" ::: "memory");
    }
  }
  __syncthreads();
}

#define LAS __attribute__((address_space(3)))
#define LAS __attribute__((address_space(3)))
#define LAS __attribute__((address_space(3)))
__device__ __forceinline__ void glds16(const void* gsrc, unsigned lds_dst) {
  unsigned keep;
  asm volatile("s_mov_b32 %0, m0\n\ts_mov_b32 m0, %2\n\ts_nop 0\n\tglobal_load_lds_dwordx4 %1, off\n\ts_mov_b32 m0, %0" : "=&s"(keep) : "v"(gsrc), "s"(lds_dst) : "memory");
}
struct GemmCtx {
  const u16* ap[2];
  const u16* wp[2];
  int wro[2], wsw[2], aro[2], asw[2];
  unsigned lds0;
  int tid, h;
};
__device__ __forceinline__ void g_init(GemmCtx& c, char* lds) {
  const int tid = ltid(), lane = tid & 63, wave = tid >> 6;
  const int wn = wave & 1, wt = wave >> 1, l32 = lane & 31;
  c.tid = tid; c.h = lane >> 5;
#pragma unroll
  for (int b = 0; b < 2; ++b) {
    const int wr = wn * 64 + b * 32 + l32, ar = wt * 64 + b * 32 + l32;
    c.wro[b] = wr * 64; c.wsw[b] = (wr >> 2) & 3;
    c.aro[b] = 8192 + ar * 64; c.asw[b] = (ar >> 2) & 3;
  }
  c.lds0 = __builtin_amdgcn_readfirstlane((unsigned)(uintptr_t)(LAS char*)lds + wave * 1024);
}
__device__ __forceinline__ void g_tile(GemmCtx& c, const u16* __restrict__ A, int lda, int M, int m0, const u16* __restrict__ W, int ldw, int n0) {
#pragma unroll
  for (int i = 0; i < 2; ++i) {
    const int q = c.tid + 256 * i, row = q >> 2, ch = (q & 3) ^ ((row >> 2) & 3);
    int ar = m0 + row; ar = ar < M ? ar : M - 1;
    c.ap[i] = A + (size_t)ar * lda + ch * 8;
    c.wp[i] = W + (size_t)(n0 + row) * ldw + ch * 8;
  }
}
__device__ __forceinline__ void g_stage(const GemmCtx& c, int kt) {
  const unsigned sb = c.lds0 + (kt & 3) * 16384;
#pragma unroll
  for (int i = 0; i < 2; ++i) {
    glds16(c.wp[i] + kt * 32, sb + i * 4096);
    glds16(c.ap[i] + kt * 32, sb + 8192 + i * 4096);
  }
}
__device__ __forceinline__ void g_prologue(const GemmCtx& c, int nk) {
#pragma unroll
  for (int s = 0; s < 3; ++s)
    if (s < nk) g_stage(c, s);
}
struct Frags { bf16x8 w[2][2], a[2][2]; };
__device__ __forceinline__ void g_read(Frags& f, const GemmCtx& c, int kt, const char* lds) {
  const char* st = lds + (kt & 3) * 16384;
#pragma unroll
  for (int ks = 0; ks < 2; ++ks)
#pragma unroll
    for (int b = 0; b < 2; ++b) {
      f.w[ks][b] = *(const bf16x8*)(st + c.wro[b] + (((ks * 2 + c.h) ^ c.wsw[b]) << 4));
      f.a[ks][b] = *(const bf16x8*)(st + c.aro[b] + (((ks * 2 + c.h) ^ c.asw[b]) << 4));
    }
}
__device__ __forceinline__ void g_mma(f32x16 (&acc)[2][2], const Frags& f) {
#pragma unroll
  for (int ks = 0; ks < 2; ++ks)
#pragma unroll
    for (int nb = 0; nb < 2; ++nb)
#pragma unroll
      for (int tb = 0; tb < 2; ++tb)
        acc[nb][tb] = __builtin_amdgcn_mfma_f32_32x32x16_bf16(f.w[ks][nb], f.a[ks][tb], acc[nb][tb], 0, 0, 0);
}
__device__ __forceinline__ void g_wait(int ks_needed, int issued_hi, bool drain_all) {
  const int allowed = issued_hi - ks_needed;
  if (drain_all || allowed <= 0) asm volatile("s_waitcnt vmcnt(0) lgkmcnt(0)" ::: "memory");
  else if (allowed == 1) asm volatile("s_waitcnt vmcnt(4) lgkmcnt(0)" ::: "memory");
  else asm volatile("s_waitcnt vmcnt(8) lgkmcnt(0)" ::: "memory");
  __builtin_amdgcn_s_barrier();
}
__device__ __forceinline__ void g_main(f32x16 (&acc)[2][2], const GemmCtx& c, int nk, char* lds) {
  Frags f0, f1;
  g_wait(0, nk - 1 < 2 ? nk - 1 : 2, true);
  if (3 < nk) g_stage(c, 3);
  g_read(f0, c, 0, lds);
  for (int kt = 0; kt < nk; kt += 2) {
    {
      const int hi = (kt + 3 < nk - 1) ? kt + 3 : nk - 1;
      g_wait(kt + 1, hi, false);
      if (kt + 4 < nk) g_stage(c, kt + 4);
      g_read(f1, c, kt + 1, lds);
      g_mma(acc, f0);
    }
    if (kt + 2 < nk) {
      const int hi = (kt + 4 < nk - 1) ? kt + 4 : nk - 1;
      g_wait(kt + 2, hi, false);
      if (kt + 5 < nk) g_stage(c, kt + 5);
      g_read(f0, c, kt + 2, lds);
    }
    g_mma(acc, f1);
  }
}
__device__ __forceinline__ void gemm_kloop(f32x16 (&acc)[2][2], const u16* __restrict__ A, int lda, int M, int m0,
                                           const u16* __restrict__ W, int ldw, int n0, int K, char* lds) {
  GemmCtx c;
  g_init(c, lds);
  g_tile(c, A, lda, M, m0, W, ldw, n0);
  asm volatile("s_waitcnt vmcnt(0)" ::: "memory");
  __builtin_amdgcn_s_barrier();
  g_prologue(c, K >> 5);
  g_main(acc, c, K >> 5, lds);
}

__device__ __forceinline__ void zero_acc(f32x16 (&acc)[2][2]) {
#pragma unroll
  for (int a = 0; a < 2; ++a)
#pragma unroll
    for (int b = 0; b < 2; ++b)
#pragma unroll
      for (int r = 0; r < 16; ++r) acc[a][b][r] = 0.f;
}

template <class F>
__device__ __forceinline__ void gemm_phase(const u16* A, int lda, int M, const u16* W, int K, int N, char* lds, int* ctr, F&& epi) {
  const int nN = N >> 7, nM = (M + 127) >> 7, nt = nN * nM, nk = K >> 5;
  const int xcd = (int)xb_xcc_id() & 7;
  const int tq = nt >> 3, trm = nt & 7;
  const int tstart = xcd < trm ? xcd * (tq + 1) : trm * (tq + 1) + (xcd - trm) * tq;
  const int tcnt = tq + (xcd < trm ? 1 : 0);
  auto decode = [&](int off, int& tm, int& tn) {
    const int id = tstart + off, nig = 8 * nN, grp = id / nig, fm = grp * 8;
    const int gsz = (nM - fm) < 8 ? (nM - fm) : 8, idl = id - grp * nig;
    tm = fm + idl % gsz; tn = idl / gsz;
  };
  GemmCtx c;
  g_init(c, lds);
  const int wave = c.tid >> 6;
  volatile int* bw = (volatile int*)(lds + 65536);
  int* myctr = ctr + xcd;
  int par = 0;
  if (c.tid == 0) bw[2] = atomicAdd(myctr, 1);
  asm volatile("s_waitcnt vmcnt(0) lgkmcnt(0)" ::: "memory");
  __builtin_amdgcn_s_barrier();
  int off = bw[2];
  int tm = 0, tn = 0;
  if (off < tcnt) { decode(off, tm, tn); g_tile(c, A, lda, M, tm * 128, W, K, tn * 128); g_prologue(c, nk); }
  while (off < tcnt) {
    f32x16 acc[2][2];
    zero_acc(acc);
    g_main(acc, c, nk, lds);
    const int ctm = tm, ctn = tn;
    par ^= 1;
    if (c.tid == 0) bw[2 + par] = atomicAdd(myctr, 1);
    asm volatile("s_waitcnt lgkmcnt(0)" ::: "memory");
    __builtin_amdgcn_s_barrier();
    off = bw[2 + par];
    if (off < tcnt) { decode(off, tm, tn); g_tile(c, A, lda, M, tm * 128, W, K, tn * 128); g_prologue(c, nk); }
    epi(acc, ctn * 128 + (wave & 1) * 64, ctm * 128 + (wave >> 1) * 64);
  }
}

__device__ __forceinline__ void epi_swiglu(const f32x16 (&acc)[2][2], int nbase, int tbase, int M, const float* ss, u16* ACT) {
  const int lane = ltid() & 63, l32 = lane & 31, h = lane >> 5;
  const int cb = (nbase >> 6) * 32;
#pragma unroll
  for (int tb = 0; tb < 2; ++tb) {
    const int tok = tbase + tb * 32 + l32;
    if (tok < M) {
      const float rs = rsqrtf(ss[tok] * (1.f / 1024.f) + EPSN);
      u16* dst = ACT + (size_t)tok * FFD + cb + 4 * h;
#pragma unroll
      for (int i = 0; i < 4; ++i) {
        float o[4];
#pragma unroll
        for (int j = 0; j < 4; ++j) {
          const float g = acc[0][tb][4 * i + j] * rs, u = acc[1][tb][4 * i + j] * rs;
          o[j] = g * sigm(g) * u;
        }
        *(u32x2*)(dst + 8 * i) = (u32x2){pk_bf16(o[0], o[1]), pk_bf16(o[2], o[3])};
      }
    }
  }
}

template <int MODE>
__device__ __forceinline__ void epi_resid(const f32x16 (&acc)[2][2], int nbase, int tbase, CP& p, const Grp& G) {
  const int lane = ltid() & 63, l32 = lane & 31, h = lane >> 5;
  const float scale = MODE == 1 ? 1.f : 0.5f;
  float* ssout = MODE == 0 ? p.ss1 : (MODE == 1 ? p.ss2 : p.ss3);
#pragma unroll
  for (int tb = 0; tb < 2; ++tb) {
    const int tok = tbase + tb * 32 + l32;
    const bool valid = tok < G.Mx;
    float sq = 0.f;
    if (valid) {
      float* hp = p.H + (size_t)tok * 1024;
      u16* hb = p.HB + (size_t)tok * 1024;
      const float* rp = G.x + (size_t)tok * 1024;
#pragma unroll
      for (int nb = 0; nb < 2; ++nb)
#pragma unroll
        for (int i = 0; i < 4; ++i) {
          const int n = nbase + nb * 32 + 8 * i + 4 * h;
          f32x4 r;
          if (MODE == 0) r = *(const f32x4*)(rp + n);
          else { const u32x2 rb = *(const u32x2*)(hb + n); r = (f32x4){bf_lo(rb.x), bf_hi(rb.x), bf_lo(rb.y), bf_hi(rb.y)}; }
          f32x4 v;
          v.x = r.x + scale * acc[nb][tb][4 * i + 0];
          v.y = r.y + scale * acc[nb][tb][4 * i + 1];
          v.z = r.z + scale * acc[nb][tb][4 * i + 2];
          v.w = r.w + scale * acc[nb][tb][4 * i + 3];
          sq += v.x * v.x + v.y * v.y + v.z * v.z + v.w * v.w;
          if (MODE == 2) *(f32x4*)(hp + n) = v;
          else *(u32x2*)(hb + n) = (u32x2){pk_bf16(v.x, v.y), pk_bf16(v.z, v.w)};
        }
    }
    sq += __shfl_xor(sq, 32);
    if (valid && h == 0) atomicAdd(ssout + tok, sq);
  }
}

__device__ void phase_mix(CP& p, const Grp& G) {
  const int total = G.M * 432;
  for (int idx = blockIdx.x * 256 + ltid(); idx < total; idx += gridDim.x * 256) {
    const int row = idx / 432, ch = idx - row * 432;
    int s, t;
    if (row < G.Mx) { s = row >> G.lgS; t = 16 + (row & (G.S - 1)); } else { s = (row - G.Mx) >> 4; t = (row - G.Mx) & 15; }
    const int col = ch * 8;
    const u16* pc = p.P + (size_t)row * NIN + 3072 + col;
    const u32x4 c = *(const u32x4*)pc;
    u32x4 pv = {0, 0, 0, 0}, nx = {0, 0, 0, 0};
    if (t > 0) pv = *(const u32x4*)(p.P + (size_t)rowof(G, s, t - 1) * NIN + 3072 + col);
    if (t < G.L - 1) nx = *(const u32x4*)(p.P + (size_t)rowof(G, s, t + 1) * NIN + 3072 + col);
    const f32x4 mp0 = *(const f32x4*)(p.mu_prev + col), mp1 = *(const f32x4*)(p.mu_prev + col + 4);
    const f32x4 mn0 = *(const f32x4*)(p.mu_next + col), mn1 = *(const f32x4*)(p.mu_next + col + 4);
    float o[8];
#pragma unroll
    for (int e = 0; e < 4; ++e) {
      const float c0 = bf_lo(c[e]), c1 = bf_hi(c[e]);
      const float mpa = e < 2 ? mp0[2 * e] : mp1[2 * e - 4], mpb = e < 2 ? mp0[2 * e + 1] : mp1[2 * e - 3];
      const float mna = e < 2 ? mn0[2 * e] : mn1[2 * e - 4], mnb = e < 2 ? mn0[2 * e + 1] : mn1[2 * e - 3];
      o[2 * e] = c0 + mpa * (bf_lo(pv[e]) - c0) + mna * (bf_lo(nx[e]) - c0);
      o[2 * e + 1] = c1 + mpb * (bf_hi(pv[e]) - c1) + mnb * (bf_hi(nx[e]) - c1);
    }
    if (col < 3072) {
      const int sec = col >> 10, ci = col & 1023, head = ci >> 6, c0 = ci & 63;
      const size_t ro = ((size_t)row * 16 + head) * 192 + sec * 64 + c0;
      const u32x4 pk = (u32x4){pk_f16(o[0], o[1]), pk_f16(o[2], o[3]), pk_f16(o[4], o[5]), pk_f16(o[6], o[7])};
      *(u32x4*)(p.RKV + ro) = pk;
      if (sec == 1) { *(u32x4*)(p.DIR0 + ro) = pk; *(u32x4*)(p.DIR1 + ro) = pk; }
    } else {
      const int fc = col - 3072;
      if (fc < 128) {
#pragma unroll
        for (int e = 0; e < 8; ++e) o[e] = 1.f - 2.f / (1.f + __expf(2.f * o[e]));
      } else if (fc >= 256) {
#pragma unroll
        for (int e = 0; e < 8; ++e) o[e] = sigm(o[e]);
      }
      *(u32x4*)(p.F + (size_t)row * 384 + fc) = (u32x4){pk_bf16(o[0], o[1]), pk_bf16(o[2], o[3]), pk_bf16(o[4], o[5]), pk_bf16(o[6], o[7])};
    }
  }
}

__device__ __forceinline__ void epi_decay(const f32x16 (&acc)[2][2], int nbase, int tbase, int M, const float* w0, u16* DIR) {
  const int lane = ltid() & 63, l32 = lane & 31, h = lane >> 5;
  const int head = nbase >> 6;
#pragma unroll
  for (int tb = 0; tb < 2; ++tb) {
    const int tok = tbase + tb * 32 + l32;
    if (tok < M) {
      u16* dst = DIR + ((size_t)tok * 16 + head) * 192;
#pragma unroll
      for (int nb = 0; nb < 2; ++nb)
#pragma unroll
        for (int i = 0; i < 4; ++i) {
          const int c = nb * 32 + 8 * i + 4 * h;
          const f32x4 w = *(const f32x4*)(w0 + nbase + c);
          float o[4];
#pragma unroll
          for (int j = 0; j < 4; ++j) o[j] = 0.6065306597126334f * sigm(w[j] + acc[nb][tb][4 * i + j]);
          *(u32x2*)(dst + c) = (u32x2){pk_f16(o[0], o[1]), pk_f16(o[2], o[3])};
        }
    }
  }
}

__device__ __forceinline__ void epi_adir(const f32x16 (&acc)[2][2], int nbase, int tbase, int M, CP& p, int dir) {
  const int lane = ltid() & 63, l32 = lane & 31, h = lane >> 5;
  const int head = nbase >> 6;
  u16* DIR = dir ? p.DIR1 : p.DIR0;
  const float* a0 = p.rw_a0 + dir * 1024;
#pragma unroll
  for (int tb = 0; tb < 2; ++tb) {
    const int tok = tbase + tb * 32 + l32;
    const bool valid = tok < M;
    const int tk = valid ? tok : M - 1;
    const size_t rec = ((size_t)tk * 16 + head) * 192;
    float nsq = 0.f;
#pragma unroll
    for (int nb = 0; nb < 2; ++nb)
#pragma unroll
      for (int i = 0; i < 4; ++i) {
        const int c = nb * 32 + 8 * i + 4 * h;
        const u32x2 kr = *(const u32x2*)(DIR + rec + 64 + c);
        const f32x4 kkw = *(const f32x4*)(p.k_k + nbase + c);
        const float q0 = h_lo(kr.x) * kkw[0], q1 = h_hi(kr.x) * kkw[1], q2 = h_lo(kr.y) * kkw[2], q3 = h_hi(kr.y) * kkw[3];
        nsq += q0 * q0 + q1 * q1 + q2 * q2 + q3 * q3;
      }
    nsq += __shfl_xor(nsq, 32);
    const float inv = 1.f / fmaxf(sqrtf(nsq), 1e-12f);
    if (valid) {
#pragma unroll
      for (int nb = 0; nb < 2; ++nb)
#pragma unroll
        for (int i = 0; i < 4; ++i) {
          const int c = nb * 32 + 8 * i + 4 * h;
          const u32x2 kr = *(const u32x2*)(DIR + rec + 64 + c);
          const float kv[4] = {h_lo(kr.x), h_hi(kr.x), h_lo(kr.y), h_hi(kr.y)};
          const f32x4 kkw = *(const f32x4*)(p.k_k + nbase + c);
          const f32x4 kaw = *(const f32x4*)(p.k_a + nbase + c);
          const f32x4 a0v = *(const f32x4*)(a0 + nbase + c);
          float kk[4], kd[4], bp[4];
#pragma unroll
          for (int j = 0; j < 4; ++j) {
            const float k = kv[j];
            kk[j] = k * kkw[j] * inv;
            const float aa = sigm(a0v[j] + acc[nb][tb][4 * i + j]);
            kd[j] = k * (1.f + (aa - 1.f) * kaw[j]);
            bp[j] = -kk[j] * aa;
          }
          if (dir == 0) *(u32x2*)(p.RKV + rec + 64 + c) = (u32x2){pk_f16(kk[0], kk[1]), pk_f16(kk[2], kk[3])};
          *(u32x2*)(DIR + rec + 64 + c) = (u32x2){pk_f16(kd[0], kd[1]), pk_f16(kd[2], kd[3])};
          *(u32x2*)(DIR + rec + 128 + c) = (u32x2){pk_f16(bp[0], bp[1]), pk_f16(bp[2], bp[3])};
        }
    }
  }
}

template <int LPR>
__device__ void scan_task(CP& p, const Grp& G, int task, char* lds) {
  constexpr int KPL = 64 / LPR, RPB = 256 / LPR, NSPLIT = 64 / RPB;
  const int part = task % NSPLIT, t1 = task / NSPLIT;
  const int dir = t1 & 1, head = (t1 >> 1) & 15, s = t1 >> 5;
  float* buf = (float*)lds;
  const u16* rkv = p.RKV;
  const u16* dr = dir ? p.DIR1 : p.DIR0;
  u16* Y = dir ? p.Y1 : p.Y0;
  const int tid = ltid();
  const int row = part * RPB + tid / LPR, kc = tid % LPR;
  const int L = G.L, nch = L >> 4;
  u32x4 pre[3];
  auto issue = [&](int c) {
#pragma unroll
    for (int i = 0; i < 3; ++i) {
      const int id = tid + 256 * i, st = id / 48, ci = id - st * 48;
      const int n = c * 16 + st, t = dir ? L - 1 - n : n;
      const size_t rec = ((size_t)rowof(G, s, t) * 16 + head) * 192;
      const u16* src = ci < 24 ? rkv + rec + ci * 8 : dr + rec + (ci - 24) * 8;
      pre[i] = *(const u32x4*)src;
    }
  };
  auto commit = [&](int b) {
#pragma unroll
    for (int i = 0; i < 3; ++i) {
      const int id = tid + 256 * i, st = id / 48, ci = id - st * 48;
      const int sec = ci >> 3;
      const int base = sec >= 3 ? (sec - 1) * 64 : (sec == 0 ? 64 : (sec == 1 ? 0 : 320));
      float f[8];
#pragma unroll
      for (int e = 0; e < 4; ++e) { f[2 * e] = h_lo(pre[i][e]); f[2 * e + 1] = h_hi(pre[i][e]); }
      if (sec == 3) {
#pragma unroll
        for (int e = 0; e < 8; ++e) f[e] = __expf(-f[e]);
      }
      float* d = buf + b * 6144 + st * 384 + base + (ci & 7) * 8;
      *(f32x4*)d = (f32x4){f[0], f[1], f[2], f[3]};
      *(f32x4*)(d + 4) = (f32x4){f[4], f[5], f[6], f[7]};
    }
  };
  float S[KPL];
#pragma unroll
  for (int i = 0; i < KPL; ++i) S[i] = 0.f;
  __syncthreads();
  issue(0);
  commit(0);
  __syncthreads();
  __builtin_amdgcn_s_setprio(3);
  for (int c = 0; c < nch; ++c) {
    if (c + 1 < nch) issue(c + 1);
    const float* b = buf + (c & 1) * 6144;
#pragma unroll 1
    for (int g0 = 0; g0 < 16; g0 += LPR) {
      float ykeep = 0.f;
#pragma unroll 2
      for (int j = 0; j < LPR; ++j) {
        const int st = g0 + j;
        const float* q = b + st * 384 + kc * KPL;
        f32x4 kk[KPL / 4], rr[KPL / 4], ww[KPL / 4], dd[KPL / 4], bb[KPL / 4];
#pragma unroll
        for (int jj = 0; jj < KPL / 4; ++jj) {
          kk[jj] = *(const f32x4*)(q + 4 * jj);
          rr[jj] = *(const f32x4*)(q + 64 + 4 * jj);
          ww[jj] = *(const f32x4*)(q + 128 + 4 * jj);
          dd[jj] = *(const f32x4*)(q + 192 + 4 * jj);
          bb[jj] = *(const f32x4*)(q + 256 + 4 * jj);
        }
        const float vv = b[st * 384 + 320 + row];
        float sa0 = 0.f, sa1 = 0.f;
#pragma unroll
        for (int jj = 0; jj < KPL / 4; ++jj) {
          sa0 += S[4 * jj] * kk[jj][0]; sa1 += S[4 * jj + 1] * kk[jj][1];
          sa0 += S[4 * jj + 2] * kk[jj][2]; sa1 += S[4 * jj + 3] * kk[jj][3];
        }
        float sa = sa0 + sa1;
        sa = LPR == 8 ? reduce8(sa) : reduce4(sa);
        float y0 = 0.f, y1 = 0.f;
#pragma unroll
        for (int jj = 0; jj < KPL / 4; ++jj)
#pragma unroll
          for (int e = 0; e < 4; ++e) {
            const float sn = S[4 * jj + e] * ww[jj][e] + (sa * bb[jj][e] + vv * dd[jj][e]);
            S[4 * jj + e] = sn;
            if (e & 1) y1 += sn * rr[jj][e]; else y0 += sn * rr[jj][e];
          }
        float y = y0 + y1;
        y = LPR == 8 ? reduce8(y) : reduce4(y);
        ykeep = (kc == j) ? y : ykeep;
      }
      const int n = c * 16 + g0 + kc, t = dir ? L - 1 - n : n;
      Y[(size_t)rowof(G, s, t) * 1024 + head * 64 + row] = bf16_1(ykeep);
    }
    if (c + 1 < nch) commit((c + 1) & 1);
    __syncthreads();
  }
  __builtin_amdgcn_s_setprio(0);
}

__device__ void attn_tile(CP& p, const Grp& G, int s, int hd, int qb, char* lds, float lam) {
  const int tid = ltid(), lane = tid & 63, wave = tid >> 6, l32 = lane & 31, h = lane >> 5;
  const int L = G.L, Lp = (G.L + 31) & ~31;
  const u16* Pb = p.P;
  float* lutl = (float*)(lds + 61440);
  __syncthreads();
  for (int i = tid; i < 511; i += 256) lutl[i] = p.lut[hd * 512 + i];
  const int q = 16 + qb * 128 + wave * 32 + l32;
  const int qc = s * G.S + (q - 16);
  const int qw0 = 16 + qb * 128 + wave * 32;
  u16* odst = p.O + (size_t)qc * 1024 + hd * 128;
  const int kkey = tid >> 3, kch = (tid & 7) ^ ((kkey >> 1) & 7);
  const u16* vsrc[2];
#pragma unroll
  for (int i = 0; i < 2; ++i) {
    const int c = tid + 256 * i, dv = c >> 2, c4 = (c & 3) ^ ((dv >> 2) & 3);
    vsrc[i] = p.VT + ((size_t)(s * 1024 + hd * 128 + dv) * Lp) + c4 * 8;
  }
  const unsigned lds0 = __builtin_amdgcn_readfirstlane((unsigned)(uintptr_t)(LAS char*)lds + wave * 1024);
  const int ntile = (L + 31) >> 5;
#pragma unroll 1
  for (int br = 0; br < 2; ++br) {
    bf16x8 qv[4];
#pragma unroll
    for (int ks = 0; ks < 4; ++ks) {
      const u32x4 raw = *(const u32x4*)(Pb + (size_t)qc * NIN + hd * 128 + br * 64 + ks * 16 + h * 8);
      u32x4 sc;
#pragma unroll
      for (int e = 0; e < 4; ++e) sc[e] = pk_bf16(bf_lo(raw[e]) * 0.125f, bf_hi(raw[e]) * 0.125f);
      qv[ks] = __builtin_bit_cast(bf16x8, sc);
    }
    const u16* kp = Pb + 1024 + hd * 128 + br * 64 + kch * 8;
    auto stage = [&](int kt) {
      const int kt0 = kt * 32;
      const unsigned sb = lds0 + (kt % 5) * 12288;
      int kr = kt0 + kkey; kr = kr < L ? kr : L - 1;
      glds16(kp + (size_t)rowof(G, s, kr) * NIN, sb);
      glds16(vsrc[0] + kt0, sb + 4096);
      glds16(vsrc[1] + kt0, sb + 8192);
    };
    f32x16 O[4];
#pragma unroll
    for (int mb = 0; mb < 4; ++mb)
#pragma unroll
      for (int r = 0; r < 16; ++r) O[mb][r] = 0.f;
    float mrun = -1e30f, lrun = 0.f;
    asm volatile("s_waitcnt vmcnt(0) lgkmcnt(0)" ::: "memory");
    __builtin_amdgcn_s_barrier();
#pragma unroll
    for (int s0 = 0; s0 < 4; ++s0)
      if (s0 < ntile) stage(s0);
    const float cneg = lutl[0], cpos = lutl[510];
    for (int kt = 0; kt < ntile; ++kt) {
      const int kt0 = kt * 32;
      {
        const int rem = ntile - 1 - kt;
        if (rem >= 3) asm volatile("s_waitcnt vmcnt(9)" ::: "memory");
        else if (rem == 2) asm volatile("s_waitcnt vmcnt(6)" ::: "memory");
        else if (rem == 1) asm volatile("s_waitcnt vmcnt(3)" ::: "memory");
        else asm volatile("s_waitcnt vmcnt(0)" ::: "memory");
      }
      __builtin_amdgcn_s_barrier();
      if (kt + 4 < ntile) stage(kt + 4);
      const char* st = lds + (kt % 5) * 12288;
      f32x16 sacc;
#pragma unroll
      for (int r = 0; r < 16; ++r) sacc[r] = 0.f;
      bf16x8 kf[4], vf[4][2];
#pragma unroll
      for (int ks = 0; ks < 4; ++ks) kf[ks] = *(const bf16x8*)(st + l32 * 128 + (((ks * 2 + h) ^ ((l32 >> 1) & 7)) << 4));
#pragma unroll
      for (int mb = 0; mb < 4; ++mb)
#pragma unroll
        for (int s2 = 0; s2 < 2; ++s2) {
          const int vr = mb * 32 + l32;
          vf[mb][s2] = *(const bf16x8*)(st + 4096 + vr * 64 + (((2 * s2 + h) ^ ((vr >> 2) & 3)) << 4));
        }
      __builtin_amdgcn_sched_barrier(0);
#pragma unroll
      for (int ks = 0; ks < 4; ++ks) sacc = __builtin_amdgcn_mfma_f32_32x32x16_bf16(kf[ks], qv[ks], sacc, 0, 0, 0);
      const bool farneg = (kt0 + 31) <= (qw0 - 128);
      const bool farpos = kt0 >= (qw0 + 31 + 128);
      float ps = 0.f, alpha;
      if ((farneg || farpos) && (kt0 + 32 <= L)) {
        const float cv = farneg ? cneg : cpos;
        float mx = fmaxf(fmaxf(sacc[0], sacc[1]), sacc[2]);
#pragma unroll
        for (int r = 3; r < 15; r += 2) mx = fmaxf(fmaxf(mx, sacc[r]), sacc[r + 1]);
        mx = fmaxf(mx, sacc[15]);
        mx = fmaxf(mx, __shfl_xor(mx, 32));
        const float mnew = fmaxf(mrun, mx * LOG2E + cv);
        alpha = __builtin_amdgcn_exp2f(mrun - mnew);
        mrun = mnew;
        const float sh = cv - mnew;
#pragma unroll
        for (int r = 0; r < 16; ++r) { sacc[r] = __builtin_amdgcn_exp2f(sacc[r] * LOG2E + sh); ps += sacc[r]; }
      } else {
        float mx = -1e30f;
        if (farneg || farpos) {
          const float cv = farneg ? cneg : cpos;
#pragma unroll
          for (int r = 0; r < 16; ++r) { sacc[r] = sacc[r] * LOG2E + cv; }
        } else {
#pragma unroll
          for (int r = 0; r < 16; ++r) {
            const int key = kt0 + 8 * (r >> 2) + 4 * h + (r & 3);
            int d = key - q + 255;
            d = d < 0 ? 0 : (d > 510 ? 510 : d);
            sacc[r] = sacc[r] * LOG2E + lutl[d];
          }
        }
        if (kt0 + 32 > L) {
#pragma unroll
          for (int r = 0; r < 16; ++r) {
            const int key = kt0 + 8 * (r >> 2) + 4 * h + (r & 3);
            if (key >= L) sacc[r] = -INFINITY;
          }
        }
#pragma unroll
        for (int r = 0; r < 16; ++r) mx = fmaxf(mx, sacc[r]);
        mx = fmaxf(mx, __shfl_xor(mx, 32));
        const float mnew = fmaxf(mrun, mx);
        alpha = __builtin_amdgcn_exp2f(mrun - mnew);
        mrun = mnew;
#pragma unroll
        for (int r = 0; r < 16; ++r) { sacc[r] = __builtin_amdgcn_exp2f(sacc[r] - mnew); ps += sacc[r]; }
      }
      lrun = lrun * alpha + ps;
      if (__any(alpha != 1.f)) {
#pragma unroll
        for (int mb = 0; mb < 4; ++mb)
#pragma unroll
          for (int r = 0; r < 16; ++r) O[mb][r] *= alpha;
      }
      bf16x8 pf[2];
#pragma unroll
      for (int s2 = 0; s2 < 2; ++s2) {
        u32x4 w;
#pragma unroll
        for (int e = 0; e < 4; ++e) w[e] = pk_bf16(sacc[8 * s2 + 2 * e], sacc[8 * s2 + 2 * e + 1]);
        pf[s2] = __builtin_bit_cast(bf16x8, w);
      }
      __builtin_amdgcn_sched_barrier(0);
#pragma unroll
      for (int s2 = 0; s2 < 2; ++s2)
#pragma unroll
        for (int mb = 0; mb < 4; ++mb)
          O[mb] = __builtin_amdgcn_mfma_f32_32x32x16_bf16(vf[mb][s2], pf[s2], O[mb], 0, 0, 0);
    }
    const float lt = lrun + __shfl_xor(lrun, 32);
    if (br == 0) {
      const float i1 = 1.f / lt;
#pragma unroll
      for (int mb = 0; mb < 4; ++mb)
#pragma unroll
        for (int i = 0; i < 4; ++i)
          if (q < L) *(u32x2*)(odst + mb * 32 + 8 * i + 4 * h) = (u32x2){pk_bf16(O[mb][4 * i] * i1, O[mb][4 * i + 1] * i1), pk_bf16(O[mb][4 * i + 2] * i1, O[mb][4 * i + 3] * i1)};
    } else {
      const float i2 = lam / lt;
      float ssq = 0.f;
#pragma unroll
      for (int mb = 0; mb < 4; ++mb)
#pragma unroll
        for (int i = 0; i < 4; ++i) {
          u32x2 w = {0, 0};
          if (q < L) w = *(const u32x2*)(odst + mb * 32 + 8 * i + 4 * h);
          const float o0 = bf_lo(w.x) - O[mb][4 * i] * i2, o1v = bf_hi(w.x) - O[mb][4 * i + 1] * i2, o2 = bf_lo(w.y) - O[mb][4 * i + 2] * i2, o3 = bf_hi(w.y) - O[mb][4 * i + 3] * i2;
          O[mb][4 * i] = o0; O[mb][4 * i + 1] = o1v; O[mb][4 * i + 2] = o2; O[mb][4 * i + 3] = o3;
          ssq += o0 * o0 + o1v * o1v + o2 * o2 + o3 * o3;
        }
      ssq += __shfl_xor(ssq, 32);
      const float rn = rsqrtf(ssq * (1.f / 128.f) + EPSN) * 0.8f;
      if (q < L) {
#pragma unroll
        for (int mb = 0; mb < 4; ++mb)
#pragma unroll
          for (int i = 0; i < 4; ++i) {
            const int dv = mb * 32 + 8 * i + 4 * h;
            const f32x4 g = *(const f32x4*)(p.subln + dv);
            *(u32x2*)(odst + dv) = (u32x2){pk_bf16(O[mb][4 * i] * rn * g.x, O[mb][4 * i + 1] * rn * g.y),
                                           pk_bf16(O[mb][4 * i + 2] * rn * g.z, O[mb][4 * i + 3] * rn * g.w)};
          }
      }
    }
  }
}

__device__ void phase_mixer(CP& p, const Grp& G, int g, char* lds) {
  if (G.nseq == 4) { for (int t = blockIdx.x; t < 256; t += gridDim.x) scan_task<8>(p, G, t, lds); }
  else { for (int t = blockIdx.x; t < 256; t += gridDim.x) scan_task<4>(p, G, t, lds); }
  const int nqb = G.S >> 7;
  const int natt = G.nseq * 8 * nqb;
  const float lam = p.lam[0];
  int* shw = (int*)(lds + 65536 - 16);
  while (true) {
    __syncthreads();
    if (ltid() == 0) *shw = atomicAdd(p.cnt + g, 1);
    __syncthreads();
    const int t = *shw;
    if (t >= natt) break;
    const int qb = t % nqb, r = t / nqb, hd = r & 7, s = r >> 3;
    attn_tile(p, G, s, hd, qb, lds, lam);
  }
}

__device__ void phase_post(CP& p, const Grp& G) {
  const int lane = ltid() & 63;
  const int nw = gridDim.x * 4;
  const int c0 = lane * 16, head = lane >> 2, hc = (lane & 3) * 16;
  for (int row = blockIdx.x * 4 + (ltid() >> 6); row < G.Mx; row += nw) {
    float y[16];
    {
      const u32x4 a0 = *(const u32x4*)(p.Y0 + (size_t)row * 1024 + c0), a1 = *(const u32x4*)(p.Y0 + (size_t)row * 1024 + c0 + 8);
      const u32x4 b0 = *(const u32x4*)(p.Y1 + (size_t)row * 1024 + c0), b1 = *(const u32x4*)(p.Y1 + (size_t)row * 1024 + c0 + 8);
#pragma unroll
      for (int e = 0; e < 4; ++e) {
        y[2 * e] = bf_lo(a0[e]) + bf_lo(b0[e]); y[2 * e + 1] = bf_hi(a0[e]) + bf_hi(b0[e]);
        y[8 + 2 * e] = bf_lo(a1[e]) + bf_lo(b1[e]); y[8 + 2 * e + 1] = bf_hi(a1[e]) + bf_hi(b1[e]);
      }
    }
    float s1 = 0.f;
#pragma unroll
    for (int e = 0; e < 16; ++e) s1 += y[e];
    s1 = reduce4(s1);
    const float mu = s1 * (1.f / 64.f);
    float s2 = 0.f;
#pragma unroll
    for (int e = 0; e < 16; ++e) { const float d = y[e] - mu; s2 += d * d; }
    s2 = reduce4(s2);
    const float rstd = rsqrtf(s2 * (1.f / 64.f) + 64e-5f);
    const size_t rec = ((size_t)row * 16 + head) * 192 + hc;
    float rr[16], vv[16], kd[16];
    {
      const u32x4 r0 = *(const u32x4*)(p.RKV + rec), r1 = *(const u32x4*)(p.RKV + rec + 8);
      const u32x4 v0 = *(const u32x4*)(p.RKV + rec + 128), v1 = *(const u32x4*)(p.RKV + rec + 136);
      const u32x4 f0 = *(const u32x4*)(p.DIR0 + rec + 64), f1 = *(const u32x4*)(p.DIR0 + rec + 72);
      const u32x4 g0 = *(const u32x4*)(p.DIR1 + rec + 64), g1 = *(const u32x4*)(p.DIR1 + rec + 72);
#pragma unroll
      for (int e = 0; e < 4; ++e) {
        rr[2 * e] = h_lo(r0[e]); rr[2 * e + 1] = h_hi(r0[e]); rr[8 + 2 * e] = h_lo(r1[e]); rr[8 + 2 * e + 1] = h_hi(r1[e]);
        vv[2 * e] = h_lo(v0[e]); vv[2 * e + 1] = h_hi(v0[e]); vv[8 + 2 * e] = h_lo(v1[e]); vv[8 + 2 * e + 1] = h_hi(v1[e]);
        kd[2 * e] = h_lo(f0[e]) + h_lo(g0[e]); kd[2 * e + 1] = h_hi(f0[e]) + h_hi(g0[e]);
        kd[8 + 2 * e] = h_lo(f1[e]) + h_lo(g1[e]); kd[8 + 2 * e + 1] = h_hi(f1[e]) + h_hi(g1[e]);
      }
    }
    float bs = 0.f;
#pragma unroll
    for (int e = 0; e < 16; ++e) bs += rr[e] * kd[e] * p.r_k[c0 + e];
    bs = reduce4(bs);
    const u32x4 g0 = *(const u32x4*)(p.G + (size_t)row * 1024 + c0), g1 = *(const u32x4*)(p.G + (size_t)row * 1024 + c0 + 8);
    float o[16];
#pragma unroll
    for (int e = 0; e < 16; ++e) {
      const unsigned gw = e < 8 ? g0[e >> 1] : g1[(e - 8) >> 1];
      const float gg = (e & 1) ? bf_hi(gw) : bf_lo(gw);
      o[e] = ((y[e] - mu) * rstd * p.lnx_w[c0 + e] + p.lnx_b[c0 + e] + bs * vv[e]) * gg;
    }
    u16* dst = (u16*)p.H + (size_t)row * 1024 + c0;
    *(u32x4*)dst = (u32x4){pk_bf16(o[0], o[1]), pk_bf16(o[2], o[3]), pk_bf16(o[4], o[5]), pk_bf16(o[6], o[7])};
    *(u32x4*)(dst + 8) = (u32x4){pk_bf16(o[8], o[9]), pk_bf16(o[10], o[11]), pk_bf16(o[12], o[13]), pk_bf16(o[14], o[15])};
  }
}

__device__ void phase_final(CP& p, const Grp& G) {
  const int lane = ltid() & 63;
  const int nw = gridDim.x * 4;
  for (int row = blockIdx.x * 4 + (ltid() >> 6); row < G.Mx; row += nw) {
    const float rs = rsqrtf(p.ss3[row] * (1.f / 1024.f) + EPSN);
    const float* hp = p.H + (size_t)row * 1024;
    float* op = G.out + (size_t)row * 1024;
#pragma unroll
    for (int i = 0; i < 4; ++i) {
      const f32x4 v = *(const f32x4*)(hp + i * 256 + lane * 4);
      const f32x4 g = *(const f32x4*)(p.final_norm + i * 256 + lane * 4);
      *(f32x4*)(op + i * 256 + lane * 4) = (f32x4){v.x * rs * g.x, v.y * rs * g.y, v.z * rs * g.z, v.w * rs * g.w};
    }
  }
}

__device__ void run_phase(CP& p, int ph, char* lds) {
  int* gctr = p.cnt + 64 + ph * 64;
  if (ph == 0) { phase_prep(p, lds); return; }
  int g, k;
  if (ph <= NMETA_PH) { g = -1; k = ph - 1; }
  else { g = (ph - 1 - NMETA_PH) / PH_PER_G; k = (ph - 1 - NMETA_PH) - g * PH_PER_G; }
  const Grp G = get_grp(p, g);
  const int Mall = G.M;
  const int M = G.Mx;
  u16* Pout = G.meta ? p.PM : p.P;
  switch (k) {
    case 0: phase_rows(p, G); break;
    case 1:
      gemm_phase(p.HB, 1024, M, p.W1A, 1024, 2 * FFD, lds, gctr, [&](const f32x16 (&acc)[2][2], int nb, int tb) { epi_swiglu(acc, nb, tb, M, p.ss0, p.ACT); });
      break;
    case 2:
      gemm_phase(p.ACT, FFD, M, p.WD1, FFD, 1024, lds, gctr, [&](const f32x16 (&acc)[2][2], int nb, int tb) { epi_resid<0>(acc, nb, tb, p, G); });
      break;
    case 3:
      gemm_phase(p.HB, 1024, M, p.WIN, 1024, NIN, lds, gctr, [&](const f32x16 (&acc)[2][2], int nbase, int tbase) {
        const int lane = ltid() & 63, l32 = lane & 31, h = lane >> 5;
#pragma unroll
        for (int tb = 0; tb < 2; ++tb) {
          const int tok = tbase + tb * 32 + l32;
          if (tok < M) {
            const float rs = rsqrtf(p.ss1[tok] * (1.f / 1024.f) + EPSN);
            if (!G.meta && nbase >= 2048 && nbase < 3072) {
              const int s = tok >> G.lgS, t = 16 + (tok & (G.S - 1));
              const int Lp = (G.L + 31) & ~31;
              const int pos = (t & ~12) | ((t & 4) << 1) | ((t & 8) >> 1);
              u16* vt = p.VT + ((size_t)(s * 1024 + (nbase - 2048)) * Lp) + pos;
#pragma unroll
              for (int nb = 0; nb < 2; ++nb)
#pragma unroll
                for (int r = 0; r < 16; ++r) {
                  const int dvl = nb * 32 + 8 * (r >> 2) + 4 * h + (r & 3);
                  vt[(size_t)dvl * Lp] = bf16_1(acc[nb][tb][r] * rs);
                }
            } else {
              u16* dst = Pout + (size_t)tok * NIN + nbase + 4 * h;
#pragma unroll
              for (int nb = 0; nb < 2; ++nb)
#pragma unroll
                for (int i = 0; i < 4; ++i)
                  *(u32x2*)(dst + nb * 32 + 8 * i) = (u32x2){pk_bf16(acc[nb][tb][4 * i] * rs, acc[nb][tb][4 * i + 1] * rs),
                                                             pk_bf16(acc[nb][tb][4 * i + 2] * rs, acc[nb][tb][4 * i + 3] * rs)};
            }
          }
        }
      });
      break;
    case 4: phase_mix(p, G); break;
    case 5:
      gemm_phase(p.F, 384, Mall, p.W2F, 64, 1024, lds, gctr, [&](const f32x16 (&acc)[2][2], int nb, int tb) { epi_decay(acc, nb, tb, Mall, p.rw_w0, p.DIR0); });
      gemm_phase(p.F + 64, 384, Mall, p.W2B, 64, 1024, lds, gctr + 8, [&](const f32x16 (&acc)[2][2], int nb, int tb) { epi_decay(acc, nb, tb, Mall, p.rw_w0 + 1024, p.DIR1); });
      gemm_phase(p.F + 128, 384, Mall, p.A2F, 64, 1024, lds, gctr + 16, [&](const f32x16 (&acc)[2][2], int nb, int tb) { epi_adir(acc, nb, tb, Mall, p, 0); });
      gemm_phase(p.F + 192, 384, Mall, p.A2B, 64, 1024, lds, gctr + 24, [&](const f32x16 (&acc)[2][2], int nb, int tb) { epi_adir(acc, nb, tb, Mall, p, 1); });
      gemm_phase(p.F + 256, 384, Mall, p.G2T, 128, 1024, lds, gctr + 32, [&](const f32x16 (&acc)[2][2], int nbase, int tbase) {
        const int lane = ltid() & 63, l32 = lane & 31, h = lane >> 5;
#pragma unroll
        for (int tb = 0; tb < 2; ++tb) {
          const int tok = tbase + tb * 32 + l32;
          if (tok < Mall) {
            u16* dst = p.G + (size_t)tok * 1024 + nbase + 4 * h;
#pragma unroll
            for (int nb = 0; nb < 2; ++nb)
#pragma unroll
              for (int i = 0; i < 4; ++i)
                *(u32x2*)(dst + nb * 32 + 8 * i) = (u32x2){pk_bf16(acc[nb][tb][4 * i], acc[nb][tb][4 * i + 1]), pk_bf16(acc[nb][tb][4 * i + 2], acc[nb][tb][4 * i + 3])};
          }
        }
      });
      break;
    case 6: phase_mixer(p, G, g, lds); break;
    case 7: phase_post(p, G); break;
    case 8: {
      const int nN = 8, nM = (M + 127) >> 7, nt = nN * nM;
      const int wave = ltid() >> 6;
      const int lane = ltid() & 63, l32 = lane & 31, h = lane >> 5;
      const int xcd = blockIdx.x & 7, g8 = gridDim.x >> 3;
      const int tq = nt >> 3, trm = nt & 7;
      const int tstart = xcd < trm ? xcd * (tq + 1) : trm * (tq + 1) + (xcd - trm) * tq;
      const int tcnt = tq + (xcd < trm ? 1 : 0);
      for (int off = blockIdx.x >> 3; off < tcnt; off += g8) {
        const int id = tstart + off, nig = 8 * nN, grp = id / nig, fm = grp * 8;
        const int gsz = (nM - fm) < 8 ? (nM - fm) : 8, idl = id - grp * nig;
        const int tm = fm + idl % gsz, tn = idl / gsz;
        const int nbase = tn * 128 + (wave & 1) * 64, tbase = tm * 128 + (wave >> 1) * 64;
#pragma unroll 1
        for (int pass = 0; pass < 2; ++pass) {
          f32x16 acc[2][2];
          zero_acc(acc);
          gemm_kloop(acc, pass ? (const u16*)p.H : p.O, 1024, M, tm * 128, pass ? p.WRW : p.WATT, 1024, tn * 128, 1024, lds);
#pragma unroll
          for (int tb = 0; tb < 2; ++tb) {
            const int tok = tbase + tb * 32 + l32;
            if (tok < M) {
              const u16* gp = p.P + (size_t)tok * NIN + 6528 + pass * 1024 + nbase + 4 * h;
              u16* dst = p.MERGED + (size_t)tok * 1024 + nbase + 4 * h;
#pragma unroll
              for (int nb = 0; nb < 2; ++nb)
#pragma unroll
                for (int i = 0; i < 4; ++i) {
                  const u32x2 ga = *(const u32x2*)(gp + nb * 32 + 8 * i);
                  float o0 = sigm(bf_lo(ga.x)) * acc[nb][tb][4 * i];
                  float o1 = sigm(bf_hi(ga.x)) * acc[nb][tb][4 * i + 1];
                  float o2 = sigm(bf_lo(ga.y)) * acc[nb][tb][4 * i + 2];
                  float o3 = sigm(bf_hi(ga.y)) * acc[nb][tb][4 * i + 3];
                  if (pass) {
                    const u32x2 pv = *(const u32x2*)(dst + nb * 32 + 8 * i);
                    o0 += bf_lo(pv.x); o1 += bf_hi(pv.x); o2 += bf_lo(pv.y); o3 += bf_hi(pv.y);
                  }
                  *(u32x2*)(dst + nb * 32 + 8 * i) = (u32x2){pk_bf16(o0, o1), pk_bf16(o2, o3)};
                }
            }
          }
        }
      }
    } break;
    case 9:
      gemm_phase(p.MERGED, 1024, M, p.WOUT, 1024, 1024, lds, gctr, [&](const f32x16 (&acc)[2][2], int nb, int tb) { epi_resid<1>(acc, nb, tb, p, G); });
      break;
    case 10:
      gemm_phase(p.HB, 1024, M, p.W2A, 1024, 2 * FFD, lds, gctr, [&](const f32x16 (&acc)[2][2], int nb, int tb) { epi_swiglu(acc, nb, tb, M, p.ss2, p.ACT); });
      break;
    case 11:
      gemm_phase(p.ACT, FFD, M, p.WD2, FFD, 1024, lds, gctr, [&](const f32x16 (&acc)[2][2], int nb, int tb) { epi_resid<2>(acc, nb, tb, p, G); });
      break;
    case 12: phase_final(p, G); break;
  }
}

__global__ void __launch_bounds__(256, 2) mega(Params p, int ph_lo, int ph_hi, int coop) {
  __shared__ __attribute__((aligned(16))) char lds[65536 + 16];
  uint4& xb_words = *(uint4*)(lds + 65536);
  CP* pp = (CP*)__builtin_amdgcn_kernarg_segment_ptr();
  asm volatile("" : "+s"(pp));
  if (threadIdx.x == 0) xb_words = make_uint4(0u, 0u, 0u, 0u);
  __syncthreads();
  const XcdBarrier xb = xcd_barrier_post(pp->bar, (volatile LAS unsigned*)&xb_words);
  for (int ph = ph_lo; ph < ph_hi; ++ph) {
    run_phase(*pp, ph, lds);
    if (coop && ph + 1 < ph_hi) {
      if (ph == 0) cg::this_grid().sync();
      else xcd_barrier(xb);
    }
  }
}

extern "C" void kernel_launch(void* const* d_in, const int* in_sizes, int n_in, void* d_out, int out_size, void* d_ws,
                              size_t ws_size, hipStream_t stream) {
  Params p;
  memset(&p, 0, sizeof(p));
  const float** f = (const float**)&p;
  for (int i = 0; i < 35; ++i) f[i] = (const float*)d_in[i];
  p.out = (float*)d_out;
  char* w = (char*)d_ws;
  size_t off = 0;
  auto alloc = [&](size_t bytes) { char* r = w + off; off += (bytes + 255) & ~(size_t)255; return r; };
  p.W1A = (u16*)alloc((size_t)2 * FFD * 1024 * 2);
  p.WD1 = (u16*)alloc((size_t)1024 * FFD * 2);
  p.WIN = (u16*)alloc((size_t)NIN * 1024 * 2);
  p.WATT = (u16*)alloc((size_t)1024 * 1024 * 2);
  p.WRW = (u16*)alloc((size_t)1024 * 1024 * 2);
  p.WOUT = (u16*)alloc((size_t)1024 * 1024 * 2);
  p.W2A = (u16*)alloc((size_t)2 * FFD * 1024 * 2);
  p.WD2 = (u16*)alloc((size_t)1024 * FFD * 2);
  p.W2F = (u16*)alloc((size_t)1024 * 64 * 2);
  p.W2B = (u16*)alloc((size_t)1024 * 64 * 2);
  p.A2F = (u16*)alloc((size_t)1024 * 64 * 2);
  p.A2B = (u16*)alloc((size_t)1024 * 64 * 2);
  p.G2T = (u16*)alloc((size_t)1024 * 128 * 2);
  p.lut = (float*)alloc(8 * 512 * 4);
  p.cnt = (int*)alloc((64 + NPHASES * 64) * 4);
  p.lam = (float*)alloc(256);
  p.bar = (unsigned*)alloc(XCD_BAR_WORDS * 4);
  const size_t R = MAXROWS;
  p.H = (float*)alloc(R * 1024 * 4);
  p.HB = (u16*)alloc(R * 1024 * 2);
  p.ACT = (u16*)alloc(R * FFD * 2);
  p.Y0 = p.ACT;
  p.Y1 = p.ACT + R * 1024;
  p.F = p.ACT + R * 2048;
  p.P = (u16*)alloc(R * NIN * 2);
  p.RKV = (u16*)alloc(R * 16 * 192 * 2);
  p.DIR0 = (u16*)alloc(R * 16 * 192 * 2);
  p.DIR1 = (u16*)alloc(R * 16 * 192 * 2);
  p.G = (u16*)alloc(R * 1024 * 2);
  p.O = (u16*)alloc(R * 1024 * 2);
  p.MERGED = (u16*)alloc(R * 1024 * 2);
  p.VT = (u16*)alloc((size_t)8 * 8 * 128 * 2080 * 2);
  p.PM = (u16*)alloc((size_t)16 * NIN * 2);
  p.ss0 = (float*)alloc(R * 4);
  p.ss1 = (float*)alloc(R * 4);
  p.ss2 = (float*)alloc(R * 4);
  p.ss3 = (float*)alloc(R * 4);
  if (off > ws_size) { fprintf(stderr, "workspace too small: need %zu have %zu\n", off, ws_size); return; }
  static int grid_blocks = 0;
  if (!grid_blocks) {
    int dev = 0, cus = 0, per_cu = 0;
    hipGetDevice(&dev);
    hipDeviceGetAttribute(&cus, hipDeviceAttributeMultiprocessorCount, dev);
    hipOccupancyMaxActiveBlocksPerMultiprocessor(&per_cu, mega, 256, 0);
    per_cu = 2;
    grid_blocks = cus * per_cu;
  }
  hipMemsetAsync(p.bar, 0, XCD_BAR_WORDS * 4, stream);
  hipMemsetAsync(p.cnt, 0, (64 + NPHASES * 64) * 4, stream);
  int ph_lo = 0, ph_hi = NPHASES, coop = 1;
  void* args[] = {&p, &ph_lo, &ph_hi, &coop};
  hipError_t e = hipLaunchCooperativeKernel((void*)mega, dim3(grid_blocks), dim3(256), args, 0, stream);
  if (e != hipSuccess) fprintf(stderr, "cooperative launch failed: %s (grid %d)\n", hipGetErrorString(e), grid_blocks);
}
```

```cpp
#include <hip/hip_runtime.h>
#include <hip/hip_cooperative_groups.h>
#include <stdint.h>
#include <string.h>
#include <stdio.h>
namespace cg = cooperative_groups;

typedef unsigned short u16;
typedef short bf16x8 __attribute__((ext_vector_type(8)));
typedef float f32x16 __attribute__((ext_vector_type(16)));
typedef float f32x4 __attribute__((ext_vector_type(4)));
typedef float f32x2 __attribute__((ext_vector_type(2)));
typedef unsigned u32x4 __attribute__((ext_vector_type(4)));
typedef unsigned u32x2 __attribute__((ext_vector_type(2)));
typedef __bf16 bf16x2_t __attribute__((ext_vector_type(2)));
typedef _Float16 f16x2_t __attribute__((ext_vector_type(2)));

#define NIN 8576
#define FFD 2816
#define EPSN 1e-6f
#define LOG2E 1.4426950408889634f
#define NGROUPS 6
#define PH_PER_G 13
#define NMETA_PH 4
#define NPHASES (1 + NMETA_PH + NGROUPS * PH_PER_G)
#define MAXROWS 16512

struct Params {
  const float *x_prompt, *x_sample, *meta, *rel_bias, *ffn1_norm, *ffn1_wg, *ffn1_wu, *ffn1_wd, *mix_norm, *w_in;
  const float *lq1, *lk1, *lq2, *lk2, *subln, *w_attn, *mu_prev, *mu_next, *rw_w0, *rw_w2, *rw_a0, *rw_a2, *rw_g2;
  const float *k_k, *k_a, *r_k, *lnx_w, *lnx_b, *w_rw, *w_out, *ffn2_norm, *ffn2_wg, *ffn2_wu, *ffn2_wd, *final_norm;
  float* out;
  u16 *W1A, *WD1, *WIN, *WATT, *WRW, *WOUT, *W2A, *WD2, *W2F, *W2B, *A2F, *A2B, *G2T;
  float* lut; int* cnt; float* lam; unsigned* bar; u16* VT; u16* PM;
  float* H; u16 *HB, *ACT, *P, *RKV, *DIR0, *DIR1, *G, *O, *MERGED, *Y0, *Y1, *F;
  float *ss0, *ss1, *ss2, *ss3;
};

typedef const Params __attribute__((address_space(4))) CP;
struct Grp { int nseq, L, S, lgS, M, Mx, meta; const float* x; float* out; };
__device__ __forceinline__ int rowof(const Grp& G, int s, int t) { return t < 16 ? G.Mx + s * 16 + t : s * G.S + (t - 16); }

__device__ __forceinline__ Grp get_grp(CP& p, int g) {
  Grp r;
  r.meta = 0;
  if (g < 0) {
    r.nseq = 1; r.L = 16; r.S = 16; r.lgS = 4; r.x = p.meta; r.out = nullptr; r.M = 16; r.Mx = 16; r.meta = 1;
    return r;
  }
  if (g < 4) { r.nseq = 4; r.L = 4112; r.S = 4096; r.lgS = 12; r.x = p.x_prompt + (size_t)g * 4 * 4096 * 1024; r.out = p.out + (size_t)g * 4 * 4096 * 1024; }
  else { r.nseq = 8; r.L = 2064; r.S = 2048; r.lgS = 11; r.x = p.x_sample + (size_t)(g - 4) * 8 * 2048 * 1024; r.out = p.out + (size_t)16 * 4096 * 1024 + (size_t)(g - 4) * 8 * 2048 * 1024; }
  r.M = r.nseq * r.L;
  r.Mx = r.nseq * r.S;
  return r;
}

__device__ __forceinline__ int ltid() { int t = threadIdx.x; asm volatile("" : "+v"(t)); return t; }
__device__ __forceinline__ unsigned pk_bf16(float a, float b) {
  f32x2 v = {a, b};
  bf16x2_t r = __builtin_convertvector(v, bf16x2_t);
  return __builtin_bit_cast(unsigned, r);
}
__device__ __forceinline__ float bf_lo(unsigned u) { return __uint_as_float(u << 16); }
__device__ __forceinline__ float bf_hi(unsigned u) { return __uint_as_float(u & 0xffff0000u); }
__device__ __forceinline__ unsigned pk_f16(float a, float b) {
  f32x2 v = {a, b};
  f16x2_t r = __builtin_convertvector(v, f16x2_t);
  return __builtin_bit_cast(unsigned, r);
}
__device__ __forceinline__ float h_lo(unsigned u) { f16x2_t r = __builtin_bit_cast(f16x2_t, u); return (float)r.x; }
__device__ __forceinline__ float h_hi(unsigned u) { f16x2_t r = __builtin_bit_cast(f16x2_t, u); return (float)r.y; }
__device__ __forceinline__ u16 bf16_1(float a) { return (u16)(pk_bf16(a, 0.f) & 0xffffu); }
__device__ __forceinline__ float sigm(float x) { return __builtin_amdgcn_rcpf(1.f + __builtin_amdgcn_exp2f(-LOG2E * x)); }
__device__ __forceinline__ float wave_sum(float v) {
#pragma unroll
  for (int o = 32; o > 0; o >>= 1) v += __shfl_xor(v, o);
  return v;
}
template <int CTRL> __device__ __forceinline__ float dppf(float x) {
  return __int_as_float(__builtin_amdgcn_update_dpp(0, __float_as_int(x), CTRL, 0xf, 0xf, true));
}
__device__ __forceinline__ float reduce8(float x) {
  x += dppf<0xB1>(x);
  x += dppf<0x4E>(x);
  x += dppf<0x141>(x);
  return x;
}
__device__ __forceinline__ float reduce4(float x) {
  x += dppf<0xB1>(x);
  x += dppf<0x4E>(x);
  return x;
}

__device__ void prep_transpose(const float* __restrict__ src, int K, int N, u16* __restrict__ dst,
                               const float* __restrict__ gain, int mode, char* lds) {
  float* tile = (float*)lds;
  const int tn = N / 64, nt = (K / 64) * tn;
  const int tid = ltid();
  for (int t = blockIdx.x; t < nt; t += gridDim.x) {
    const int k0 = (t / tn) * 64, n0 = (t % tn) * 64;
    const int nl = tid & 63, kq = tid >> 6;
#pragma unroll
    for (int i = 0; i < 16; ++i) {
      const int k = i * 4 + kq;
      float v = src[(size_t)(k0 + k) * N + n0 + nl];
      if (gain) v *= gain[k0 + k];
      tile[k * 65 + nl] = v;
    }
    __syncthreads();
    const int n = tid >> 2, kk = (tid & 3) * 16;
    unsigned w[8];
#pragma unroll
    for (int i = 0; i < 8; ++i) w[i] = pk_bf16(tile[(kk + 2 * i) * 65 + n], tile[(kk + 2 * i + 1) * 65 + n]);
    const int ng = n0 + n;
    const int row = mode == 0 ? ng : ((ng >> 5) * 64 + (ng & 31) + (mode == 2 ? 32 : 0));
    u32x4* d = (u32x4*)(dst + (size_t)row * K + k0 + kk);
    d[0] = (u32x4){w[0], w[1], w[2], w[3]};
    d[1] = (u32x4){w[4], w[5], w[6], w[7]};
    __syncthreads();
  }
}

__device__ void phase_prep(CP& p, char* lds) {
  if (blockIdx.x == 0) {
    const int tid = ltid();
    for (int idx = tid; idx < 8 * 511; idx += 256) {
      const int hd = idx / 511, di = idx - hd * 511, d = di - 255;
      const int n = d < 0 ? -d : d;
      int bk;
      if (n < 8) bk = n;
      else {
        const float nf = (float)n;
        int large = 8 + (int)(logf(nf / 8.0f) / 2.772588722239781f * 8.0f);
        bk = large < 15 ? large : 15;
      }
      const int bucket = (d > 0 ? 16 : 0) + bk;
      p.lut[hd * 512 + di] = p.rel_bias[bucket * 8 + hd] * LOG2E;
    }
    if (tid == 0) {
      float s1 = 0.f, s2 = 0.f;
      for (int i = 0; i < 64; ++i) { s1 += p.lq1[i] * p.lk1[i]; s2 += p.lq2[i] * p.lk2[i]; }
      p.lam[0] = expf(s1) - expf(s2) + 0.2f;
    }
  }
  prep_transpose(p.ffn1_wg, 1024, FFD, p.W1A, p.ffn1_norm, 1, lds);
  prep_transpose(p.ffn1_wu, 1024, FFD, p.W1A, p.ffn1_norm, 2, lds);
  prep_transpose(p.ffn1_wd, FFD, 1024, p.WD1, nullptr, 0, lds);
  prep_transpose(p.w_in, 1024, NIN, p.WIN, p.mix_norm, 0, lds);
  prep_transpose(p.w_attn, 1024, 1024, p.WATT, nullptr, 0, lds);
  prep_transpose(p.w_rw, 1024, 1024, p.WRW, nullptr, 0, lds);
  prep_transpose(p.w_out, 1024, 1024, p.WOUT, nullptr, 0, lds);
  prep_transpose(p.ffn2_wg, 1024, FFD, p.W2A, p.ffn2_norm, 1, lds);
  prep_transpose(p.ffn2_wu, 1024, FFD, p.W2A, p.ffn2_norm, 2, lds);
  prep_transpose(p.ffn2_wd, FFD, 1024, p.WD2, nullptr, 0, lds);
  prep_transpose(p.rw_w2, 64, 1024, p.W2F, nullptr, 0, lds);
  prep_transpose(p.rw_w2 + 64 * 1024, 64, 1024, p.W2B, nullptr, 0, lds);
  prep_transpose(p.rw_a2, 64, 1024, p.A2F, nullptr, 0, lds);
  prep_transpose(p.rw_a2 + 64 * 1024, 64, 1024, p.A2B, nullptr, 0, lds);
  prep_transpose(p.rw_g2, 128, 1024, p.G2T, nullptr, 0, lds);
}

__device__ void phase_rows(CP& p, const Grp& G) {
  const int lane = ltid() & 63;
  const int nw = gridDim.x * 4;
  const int gw = blockIdx.x * 4 + (ltid() >> 6);
  for (int row = gw; row < G.Mx; row += nw) {
    const float* src = G.x + (size_t)row * 1024;
    float ss = 0.f;
#pragma unroll
    for (int i = 0; i < 4; ++i) {
      const f32x4 v = *(const f32x4*)(src + i * 256 + lane * 4);
      ss += v.x * v.x + v.y * v.y + v.z * v.z + v.w * v.w;
      u32x2 o = {pk_bf16(v.x, v.y), pk_bf16(v.z, v.w)};
      *(u32x2*)(p.HB + (size_t)row * 1024 + i * 256 + lane * 4) = o;
    }
    ss = wave_sum(ss);
    if (lane == 0) { p.ss0[row] = ss; p.ss1[row] = 0.f; p.ss2[row] = 0.f; p.ss3[row] = 0.f; }
  }
  if (G.meta) return;
  const int Lp = (G.L + 31) & ~31;
  for (int r = gw; r < G.nseq * 16; r += nw) {
    const int s = r >> 4, t = r & 15;
    const u16* srcp = p.PM + (size_t)t * NIN;
    u16* dstp = p.P + (size_t)(G.Mx + r) * NIN;
    for (int c = lane * 8; c < NIN; c += 512)
      if (c < 2048 || c >= 3072) *(u32x4*)(dstp + c) = *(const u32x4*)(srcp + c);
    const int pos = (t & ~12) | ((t & 4) << 1) | ((t & 8) >> 1);
    for (int c = lane; c < 1024; c += 64) p.VT[(size_t)(s * 1024 + c) * Lp + pos] = srcp[2048 + c];
  }
}

#define LAS __attribute__((address_space(3)))
#define XB_TMO      128
#define XB_XCNT(j)  (256  + 64 * (j))
#define XB_XSUB(j)  (1280 + 64 * (j))
#define XB_XGEN(j)  (2304 + 64 * (j))
#define XB_TOP      3328
#define XB_TOPGEN   3392
#define XCD_BAR_WORDS 3456
#define XB_SPIN_CAP (1u << 18)
__device__ __forceinline__ unsigned xb_ld(unsigned* p) { return __hip_atomic_load(p, __ATOMIC_RELAXED, __HIP_MEMORY_SCOPE_AGENT); }
__device__ __forceinline__ unsigned xb_add(unsigned* p, unsigned v) { return __hip_atomic_fetch_add(p, v, __ATOMIC_RELAXED, __HIP_MEMORY_SCOPE_AGENT); }
__device__ __forceinline__ unsigned xb_xcc_id() { return (unsigned)__builtin_amdgcn_s_getreg((3 << 11) | 20) & 0xFu; }
#define XB_SPIN(cond, bar) do { unsigned _sp = 0; while (cond) { __builtin_amdgcn_s_sleep(1); \
    if ((++_sp & 255u) == 0u) { if (xb_ld(&(bar)[XB_TMO])) break; if (_sp > XB_SPIN_CAP) { atomicAdd(&(bar)[XB_TMO], 1u); break; } } } } while (0)
struct XcdBarrier { unsigned* bar; unsigned x; volatile LAS unsigned* st; };
__device__ __forceinline__ XcdBarrier xcd_barrier_post(unsigned* bar, volatile LAS unsigned* st) {
  XcdBarrier b; b.bar = bar; b.x = xb_xcc_id(); b.st = st;
  if (threadIdx.x == 0) (void)xb_add(&bar[XB_XCNT(b.x)], 1u);
  return b;
}
__device__ __forceinline__ void xcd_barrier_complete(unsigned* bar, unsigned x, unsigned& nloc, unsigned& nx) {
  const unsigned G = gridDim.x * gridDim.y * gridDim.z;
  unsigned sum, cnt, mine, sp = 0u;
  for (;;) {
    sum = 0u; cnt = 0u; mine = 0u;
#pragma unroll
    for (unsigned j = 0; j < 16; ++j) { const unsigned c = xb_ld(&bar[XB_XCNT(j)]); sum += c; cnt += (c > 0u) ? 1u : 0u; mine = (j == x) ? c : mine; }
    if (sum == G) break;
    __builtin_amdgcn_s_sleep(1);
    if ((++sp & 255u) == 0u) { if (xb_ld(&bar[XB_TMO])) break; if (sp > XB_SPIN_CAP) { atomicAdd(&bar[XB_TMO], 1u); break; } }
  }
  nloc = mine > 0u ? mine : 1u; nx = cnt > 0u ? cnt : 1u;
}
__device__ __forceinline__ void xcd_barrier(const XcdBarrier& b) {
  asm volatile("s_waitcnt vmcnt(0)" ::: "memory");
  __syncthreads();
  if (threadIdx.x == 0) {
    unsigned* bar = b.bar;
    __builtin_amdgcn_s_waitcnt(0);
    unsigned nloc = b.st[0], nx = b.st[1];
    if (nloc == 0u) { xcd_barrier_complete(bar, b.x, nloc, nx); b.st[0] = nloc; b.st[1] = nx; }
    const unsigned old = xb_add(&bar[XB_XSUB(b.x)], 1u);
    const unsigned gen = old / nloc;
    if (old + 1u == (gen + 1u) * nloc) {
      __builtin_amdgcn_fence(__ATOMIC_RELEASE, "agent");
      asm volatile("s_waitcnt vmcnt(0)" ::: "memory");
      const unsigned og = xb_add(&bar[XB_TOP], 1u);
      const unsigned tg = og / nx;
      if (og + 1u == (tg + 1u) * nx) xb_add(&bar[XB_TOPGEN], 1u);
      else XB_SPIN(xb_ld(&bar[XB_TOPGEN]) == tg, bar);
      __builtin_amdgcn_fence(__ATOMIC_ACQUIRE, "agent");
      xb_add(&bar[XB_XGEN(b.x)], 1u);
      asm volatile("s_waitcnt vmcnt(0)" ::: "memory");
    } else {
      XB_SPIN(xb_ld(&bar[XB_XGEN(b.x)]) == gen, bar);
      __builtin_amdgcn_fence(__ATOMIC_ACQUIRE, "agent");
      asm volatile("s_waitcnt vmcnt(0)" ::: "memory");
    }
  }
  __syncthreads();
}

#define LAS __attribute__((address_space(3)))
#define LAS __attribute__((address_space(3)))
#define LAS __attribute__((address_space(3)))
__device__ __forceinline__ void glds16(const void* gsrc, unsigned lds_dst) {
  unsigned keep;
  asm volatile("s_mov_b32 %0, m0\n\ts_mov_b32 m0, %2\n\ts_nop 0\n\tglobal_load_lds_dwordx4 %1, off\n\ts_mov_b32 m0, %0" : "=&s"(keep) : "v"(gsrc), "s"(lds_dst) : "memory");
}
struct GemmCtx {
  const u16* ap[2];
  const u16* wp[2];
  int wro[2], wsw[2], aro[2], asw[2];
  unsigned lds0;
  int tid, h;
};
__device__ __forceinline__ void g_init(GemmCtx& c, char* lds) {
  const int tid = ltid(), lane = tid & 63, wave = tid >> 6;
  const int wn = wave & 1, wt = wave >> 1, l32 = lane & 31;
  c.tid = tid; c.h = lane >> 5;
#pragma unroll
  for (int b = 0; b < 2; ++b) {
    const int wr = wn * 64 + b * 32 + l32, ar = wt * 64 + b * 32 + l32;
    c.wro[b] = wr * 64; c.wsw[b] = (wr >> 2) & 3;
    c.aro[b] = 8192 + ar * 64; c.asw[b] = (ar >> 2) & 3;
  }
  c.lds0 = __builtin_amdgcn_readfirstlane((unsigned)(uintptr_t)(LAS char*)lds + wave * 1024);
}
__device__ __forceinline__ void g_tile(GemmCtx& c, const u16* __restrict__ A, int lda, int M, int m0, const u16* __restrict__ W, int ldw, int n0) {
#pragma unroll
  for (int i = 0; i < 2; ++i) {
    const int q = c.tid + 256 * i, row = q >> 2, ch = (q & 3) ^ ((row >> 2) & 3);
    int ar = m0 + row; ar = ar < M ? ar : M - 1;
    c.ap[i] = A + (size_t)ar * lda + ch * 8;
    c.wp[i] = W + (size_t)(n0 + row) * ldw + ch * 8;
  }
}
__device__ __forceinline__ void g_stage(const GemmCtx& c, int kt) {
  const unsigned sb = c.lds0 + (kt & 3) * 16384;
#pragma unroll
  for (int i = 0; i < 2; ++i) {
    glds16(c.wp[i] + kt * 32, sb + i * 4096);
    glds16(c.ap[i] + kt * 32, sb + 8192 + i * 4096);
  }
}
__device__ __forceinline__ void g_prologue(const GemmCtx& c, int nk) {
#pragma unroll
  for (int s = 0; s < 3; ++s)
    if (s < nk) g_stage(c, s);
}
struct Frags { bf16x8 w[2][2], a[2][2]; };
__device__ __forceinline__ void g_read(Frags& f, const GemmCtx& c, int kt, const char* lds) {
  const char* st = lds + (kt & 3) * 16384;
#pragma unroll
  for (int ks = 0; ks < 2; ++ks)
#pragma unroll
    for (int b = 0; b < 2; ++b) {
      f.w[ks][b] = *(const bf16x8*)(st + c.wro[b] + (((ks * 2 + c.h) ^ c.wsw[b]) << 4));
      f.a[ks][b] = *(const bf16x8*)(st + c.aro[b] + (((ks * 2 + c.h) ^ c.asw[b]) << 4));
    }
}
__device__ __forceinline__ void g_mma(f32x16 (&acc)[2][2], const Frags& f) {
#pragma unroll
  for (int ks = 0; ks < 2; ++ks)
#pragma unroll
    for (int nb = 0; nb < 2; ++nb)
#pragma unroll
      for (int tb = 0; tb < 2; ++tb)
        acc[nb][tb] = __builtin_amdgcn_mfma_f32_32x32x16_bf16(f.w[ks][nb], f.a[ks][tb], acc[nb][tb], 0, 0, 0);
}
__device__ __forceinline__ void g_wait(int ks_needed, int issued_hi, bool drain_all) {
  const int allowed = issued_hi - ks_needed;
  if (drain_all || allowed <= 0) asm volatile("s_waitcnt vmcnt(0) lgkmcnt(0)" ::: "memory");
  else if (allowed == 1) asm volatile("s_waitcnt vmcnt(4) lgkmcnt(0)" ::: "memory");
  else asm volatile("s_waitcnt vmcnt(8) lgkmcnt(0)" ::: "memory");
  __builtin_amdgcn_s_barrier();
}
__device__ __forceinline__ void g_main(f32x16 (&acc)[2][2], const GemmCtx& c, int nk, char* lds) {
  Frags f0, f1;
  g_wait(0, nk - 1 < 2 ? nk - 1 : 2, true);
  if (3 < nk) g_stage(c, 3);
  g_read(f0, c, 0, lds);
  for (int kt = 0; kt < nk; kt += 2) {
    {
      const int hi = (kt + 3 < nk - 1) ? kt + 3 : nk - 1;
      g_wait(kt + 1, hi, false);
      if (kt + 4 < nk) g_stage(c, kt + 4);
      g_read(f1, c, kt + 1, lds);
      g_mma(acc, f0);
    }
    if (kt + 2 < nk) {
      const int hi = (kt + 4 < nk - 1) ? kt + 4 : nk - 1;
      g_wait(kt + 2, hi, false);
      if (kt + 5 < nk) g_stage(c, kt + 5);
      g_read(f0, c, kt + 2, lds);
    }
    g_mma(acc, f1);
  }
}
__device__ __forceinline__ void gemm_kloop(f32x16 (&acc)[2][2], const u16* __restrict__ A, int lda, int M, int m0,
                                           const u16* __restrict__ W, int ldw, int n0, int K, char* lds) {
  GemmCtx c;
  g_init(c, lds);
  g_tile(c, A, lda, M, m0, W, ldw, n0);
  asm volatile("s_waitcnt vmcnt(0)" ::: "memory");
  __builtin_amdgcn_s_barrier();
  g_prologue(c, K >> 5);
  g_main(acc, c, K >> 5, lds);
}

__device__ __forceinline__ void zero_acc(f32x16 (&acc)[2][2]) {
#pragma unroll
  for (int a = 0; a < 2; ++a)
#pragma unroll
    for (int b = 0; b < 2; ++b)
#pragma unroll
      for (int r = 0; r < 16; ++r) acc[a][b][r] = 0.f;
}

template <class F>
__device__ __forceinline__ void gemm_phase(const u16* A, int lda, int M, const u16* W, int K, int N, char* lds, int* ctr, F&& epi) {
  const int nN = N >> 7, nM = (M + 127) >> 7, nt = nN * nM, nk = K >> 5;
  const int xcd = (int)xb_xcc_id() & 7;
  const int tq = nt >> 3, trm = nt & 7;
  const int tstart = xcd < trm ? xcd * (tq + 1) : trm * (tq + 1) + (xcd - trm) * tq;
  const int tcnt = tq + (xcd < trm ? 1 : 0);
  auto decode = [&](int off, int& tm, int& tn) {
    const int id = tstart + off, nig = 8 * nN, grp = id / nig, fm = grp * 8;
    const int gsz = (nM - fm) < 8 ? (nM - fm) : 8, idl = id - grp * nig;
    tm = fm + idl % gsz; tn = idl / gsz;
  };
  GemmCtx c;
  g_init(c, lds);
  const int wave = c.tid >> 6;
  volatile int* bw = (volatile int*)(lds + 65536);
  int* myctr = ctr + xcd;
  int par = 0;
  if (c.tid == 0) bw[2] = atomicAdd(myctr, 1);
  asm volatile("s_waitcnt vmcnt(0) lgkmcnt(0)" ::: "memory");
  __builtin_amdgcn_s_barrier();
  int off = bw[2];
  int tm = 0, tn = 0;
  if (off < tcnt) { decode(off, tm, tn); g_tile(c, A, lda, M, tm * 128, W, K, tn * 128); g_prologue(c, nk); }
  while (off < tcnt) {
    f32x16 acc[2][2];
    zero_acc(acc);
    g_main(acc, c, nk, lds);
    const int ctm = tm, ctn = tn;
    par ^= 1;
    if (c.tid == 0) bw[2 + par] = atomicAdd(myctr, 1);
    asm volatile("s_waitcnt lgkmcnt(0)" ::: "memory");
    __builtin_amdgcn_s_barrier();
    off = bw[2 + par];
    if (off < tcnt) { decode(off, tm, tn); g_tile(c, A, lda, M, tm * 128, W, K, tn * 128); g_prologue(c, nk); }
    epi(acc, ctn * 128 + (wave & 1) * 64, ctm * 128 + (wave >> 1) * 64);
  }
}

struct WideCtx {
  const u16* ap[4];
  const u16* wp[2];
  int wro[2], wsw[2], aro[2][2], asw[2][2];
  unsigned lds0;
  int tid, h;
};
__device__ __forceinline__ void h_init(WideCtx& c, char* lds) {
  const int tid = ltid(), lane = tid & 63, wave = tid >> 6;
  const int wn = wave & 1, wt = wave >> 1, l32 = lane & 31;
  c.tid = tid; c.h = lane >> 5;
#pragma unroll
  for (int b = 0; b < 2; ++b) {
    const int wr = wn * 64 + b * 32 + l32;
    c.wro[b] = wr * 64; c.wsw[b] = (wr >> 2) & 3;
#pragma unroll
    for (int j = 0; j < 2; ++j) {
      const int ar = j * 128 + wt * 64 + b * 32 + l32;
      c.aro[j][b] = 8192 + ar * 64; c.asw[j][b] = (ar >> 2) & 3;
    }
  }
  c.lds0 = __builtin_amdgcn_readfirstlane((unsigned)(uintptr_t)(LAS char*)lds + wave * 1024);
}
__device__ __forceinline__ void h_tile(WideCtx& c, const u16* __restrict__ A, int lda, int M, int m0, const u16* __restrict__ W, int ldw, int n0) {
#pragma unroll
  for (int i = 0; i < 2; ++i) {
    const int q = c.tid + 256 * i, row = q >> 2, ch = (q & 3) ^ ((row >> 2) & 3);
    c.wp[i] = W + (size_t)(n0 + row) * ldw + ch * 8;
  }
#pragma unroll
  for (int i = 0; i < 4; ++i) {
    const int q = c.tid + 256 * i, row = q >> 2, ch = (q & 3) ^ ((row >> 2) & 3);
    int ar = m0 + row; ar = ar < M ? ar : M - 1;
    c.ap[i] = A + (size_t)ar * lda + ch * 8;
  }
}
__device__ __forceinline__ void h_stage(const WideCtx& c, int kt) {
  const unsigned sb = c.lds0 + (kt & 1) * 24576;
#pragma unroll
  for (int i = 0; i < 2; ++i) glds16(c.wp[i] + kt * 32, sb + i * 4096);
#pragma unroll
  for (int i = 0; i < 4; ++i) glds16(c.ap[i] + kt * 32, sb + 8192 + i * 4096);
}
__device__ __forceinline__ void h_main(f32x16 (&acc0)[2][2], f32x16 (&acc1)[2][2], const WideCtx& c, int nk, char* lds) {
  const int h = c.h;
  for (int kt = 0; kt < nk; ++kt) {
    asm volatile("s_waitcnt vmcnt(0)" ::: "memory");
    __builtin_amdgcn_s_barrier();
    if (kt + 1 < nk) h_stage(c, kt + 1);
    const char* st = lds + (kt & 1) * 24576;
#pragma unroll
    for (int ks = 0; ks < 2; ++ks) {
      bf16x8 wf[2], a0[2], a1[2];
#pragma unroll
      for (int b = 0; b < 2; ++b) {
        wf[b] = *(const bf16x8*)(st + c.wro[b] + (((ks * 2 + h) ^ c.wsw[b]) << 4));
        a0[b] = *(const bf16x8*)(st + c.aro[0][b] + (((ks * 2 + h) ^ c.asw[0][b]) << 4));
        a1[b] = *(const bf16x8*)(st + c.aro[1][b] + (((ks * 2 + h) ^ c.asw[1][b]) << 4));
      }
#pragma unroll
      for (int nb = 0; nb < 2; ++nb)
#pragma unroll
        for (int tb = 0; tb < 2; ++tb) {
          acc0[nb][tb] = __builtin_amdgcn_mfma_f32_32x32x16_bf16(wf[nb], a0[tb], acc0[nb][tb], 0, 0, 0);
          acc1[nb][tb] = __builtin_amdgcn_mfma_f32_32x32x16_bf16(wf[nb], a1[tb], acc1[nb][tb], 0, 0, 0);
        }
    }
  }
}
template <class F>
__device__ __forceinline__ void gemm_phase_w(const u16* A, int lda, int M, const u16* W, int K, int N, char* lds, int* ctr, F&& epi) {
  const int nN = N >> 7, nM = (M + 255) >> 8, nt = nN * nM, nk = K >> 5;
  const int xcd = (int)xb_xcc_id() & 7;
  const int tq = nt >> 3, trm = nt & 7;
  const int tstart = xcd < trm ? xcd * (tq + 1) : trm * (tq + 1) + (xcd - trm) * tq;
  const int tcnt = tq + (xcd < trm ? 1 : 0);
  auto decode = [&](int off, int& tm, int& tn) {
    const int id = tstart + off, nig = 4 * nN, grp = id / nig, fm = grp * 4;
    const int gsz = (nM - fm) < 4 ? (nM - fm) : 4, idl = id - grp * nig;
    tm = fm + idl % gsz; tn = idl / gsz;
  };
  WideCtx c;
  h_init(c, lds);
  const int wave = c.tid >> 6;
  volatile int* bw = (volatile int*)(lds + 65536);
  int* myctr = ctr + xcd;
  int par = 0;
  if (c.tid == 0) bw[2] = atomicAdd(myctr, 1);
  asm volatile("s_waitcnt vmcnt(0) lgkmcnt(0)" ::: "memory");
  __builtin_amdgcn_s_barrier();
  int off = bw[2];
  int tm = 0, tn = 0;
  if (off < tcnt) { decode(off, tm, tn); h_tile(c, A, lda, M, tm * 256, W, K, tn * 128); h_stage(c, 0); }
  while (off < tcnt) {
    f32x16 acc0[2][2], acc1[2][2];
    zero_acc(acc0);
    zero_acc(acc1);
    h_main(acc0, acc1, c, nk, lds);
    const int ctm = tm, ctn = tn;
    par ^= 1;
    if (c.tid == 0) bw[2 + par] = atomicAdd(myctr, 1);
    asm volatile("s_waitcnt lgkmcnt(0)" ::: "memory");
    __builtin_amdgcn_s_barrier();
    off = bw[2 + par];
    if (off < tcnt) { decode(off, tm, tn); h_tile(c, A, lda, M, tm * 256, W, K, tn * 128); h_stage(c, 0); }
    epi(acc0, ctn * 128 + (wave & 1) * 64, ctm * 256 + (wave >> 1) * 64);
    epi(acc1, ctn * 128 + (wave & 1) * 64, ctm * 256 + 128 + (wave >> 1) * 64);
  }
}


__device__ __forceinline__ void epi_swiglu(const f32x16 (&acc)[2][2], int nbase, int tbase, int M, const float* ss, u16* ACT) {
  const int lane = ltid() & 63, l32 = lane & 31, h = lane >> 5;
  const int cb = (nbase >> 6) * 32;
#pragma unroll
  for (int tb = 0; tb < 2; ++tb) {
    const int tok = tbase + tb * 32 + l32;
    if (tok < M) {
      const float rs = rsqrtf(ss[tok] * (1.f / 1024.f) + EPSN);
      u16* dst = ACT + (size_t)tok * FFD + cb + 4 * h;
#pragma unroll
      for (int i = 0; i < 4; ++i) {
        float o[4];
#pragma unroll
        for (int j = 0; j < 4; ++j) {
          const float g = acc[0][tb][4 * i + j] * rs, u = acc[1][tb][4 * i + j] * rs;
          o[j] = g * sigm(g) * u;
        }
        *(u32x2*)(dst + 8 * i) = (u32x2){pk_bf16(o[0], o[1]), pk_bf16(o[2], o[3])};
      }
    }
  }
}

template <int MODE>
__device__ __forceinline__ void epi_resid(const f32x16 (&acc)[2][2], int nbase, int tbase, CP& p, const Grp& G) {
  const int lane = ltid() & 63, l32 = lane & 31, h = lane >> 5;
  const float scale = MODE == 1 ? 1.f : 0.5f;
  float* ssout = MODE == 0 ? p.ss1 : (MODE == 1 ? p.ss2 : p.ss3);
#pragma unroll
  for (int tb = 0; tb < 2; ++tb) {
    const int tok = tbase + tb * 32 + l32;
    const bool valid = tok < G.Mx;
    float sq = 0.f;
    if (valid) {
      float* hp = p.H + (size_t)tok * 1024;
      u16* hb = p.HB + (size_t)tok * 1024;
      const float* rp = G.x + (size_t)tok * 1024;
#pragma unroll
      for (int nb = 0; nb < 2; ++nb)
#pragma unroll
        for (int i = 0; i < 4; ++i) {
          const int n = nbase + nb * 32 + 8 * i + 4 * h;
          f32x4 r;
          if (MODE == 0) r = *(const f32x4*)(rp + n);
          else { const u32x2 rb = *(const u32x2*)(hb + n); r = (f32x4){bf_lo(rb.x), bf_hi(rb.x), bf_lo(rb.y), bf_hi(rb.y)}; }
          f32x4 v;
          v.x = r.x + scale * acc[nb][tb][4 * i + 0];
          v.y = r.y + scale * acc[nb][tb][4 * i + 1];
          v.z = r.z + scale * acc[nb][tb][4 * i + 2];
          v.w = r.w + scale * acc[nb][tb][4 * i + 3];
          sq += v.x * v.x + v.y * v.y + v.z * v.z + v.w * v.w;
          if (MODE == 2) *(f32x4*)(hp + n) = v;
          else *(u32x2*)(hb + n) = (u32x2){pk_bf16(v.x, v.y), pk_bf16(v.z, v.w)};
        }
    }
    sq += __shfl_xor(sq, 32);
    if (valid && h == 0) atomicAdd(ssout + tok, sq);
  }
}

__device__ void phase_mix(CP& p, const Grp& G) {
  const int total = G.M * 432;
  for (int idx = blockIdx.x * 256 + ltid(); idx < total; idx += gridDim.x * 256) {
    const int row = idx / 432, ch = idx - row * 432;
    int s, t;
    if (row < G.Mx) { s = row >> G.lgS; t = 16 + (row & (G.S - 1)); } else { s = (row - G.Mx) >> 4; t = (row - G.Mx) & 15; }
    const int col = ch * 8;
    const u16* pc = p.P + (size_t)row * NIN + 3072 + col;
    const u32x4 c = *(const u32x4*)pc;
    u32x4 pv = {0, 0, 0, 0}, nx = {0, 0, 0, 0};
    if (t > 0) pv = *(const u32x4*)(p.P + (size_t)rowof(G, s, t - 1) * NIN + 3072 + col);
    if (t < G.L - 1) nx = *(const u32x4*)(p.P + (size_t)rowof(G, s, t + 1) * NIN + 3072 + col);
    const f32x4 mp0 = *(const f32x4*)(p.mu_prev + col), mp1 = *(const f32x4*)(p.mu_prev + col + 4);
    const f32x4 mn0 = *(const f32x4*)(p.mu_next + col), mn1 = *(const f32x4*)(p.mu_next + col + 4);
    float o[8];
#pragma unroll
    for (int e = 0; e < 4; ++e) {
      const float c0 = bf_lo(c[e]), c1 = bf_hi(c[e]);
      const float mpa = e < 2 ? mp0[2 * e] : mp1[2 * e - 4], mpb = e < 2 ? mp0[2 * e + 1] : mp1[2 * e - 3];
      const float mna = e < 2 ? mn0[2 * e] : mn1[2 * e - 4], mnb = e < 2 ? mn0[2 * e + 1] : mn1[2 * e - 3];
      o[2 * e] = c0 + mpa * (bf_lo(pv[e]) - c0) + mna * (bf_lo(nx[e]) - c0);
      o[2 * e + 1] = c1 + mpb * (bf_hi(pv[e]) - c1) + mnb * (bf_hi(nx[e]) - c1);
    }
    if (col < 3072) {
      const int sec = col >> 10, ci = col & 1023, head = ci >> 6, c0 = ci & 63;
      const size_t ro = ((size_t)row * 16 + head) * 192 + sec * 64 + c0;
      const u32x4 pk = (u32x4){pk_f16(o[0], o[1]), pk_f16(o[2], o[3]), pk_f16(o[4], o[5]), pk_f16(o[6], o[7])};
      *(u32x4*)(p.RKV + ro) = pk;
      if (sec == 1) { *(u32x4*)(p.DIR0 + ro) = pk; *(u32x4*)(p.DIR1 + ro) = pk; }
    } else {
      const int fc = col - 3072;
      if (fc < 128) {
#pragma unroll
        for (int e = 0; e < 8; ++e) o[e] = 1.f - 2.f / (1.f + __expf(2.f * o[e]));
      } else if (fc >= 256) {
#pragma unroll
        for (int e = 0; e < 8; ++e) o[e] = sigm(o[e]);
      }
      *(u32x4*)(p.F + (size_t)row * 384 + fc) = (u32x4){pk_bf16(o[0], o[1]), pk_bf16(o[2], o[3]), pk_bf16(o[4], o[5]), pk_bf16(o[6], o[7])};
    }
  }
}

__device__ __forceinline__ void epi_decay(const f32x16 (&acc)[2][2], int nbase, int tbase, int M, const float* w0, u16* DIR) {
  const int lane = ltid() & 63, l32 = lane & 31, h = lane >> 5;
  const int head = nbase >> 6;
#pragma unroll
  for (int tb = 0; tb < 2; ++tb) {
    const int tok = tbase + tb * 32 + l32;
    if (tok < M) {
      u16* dst = DIR + ((size_t)tok * 16 + head) * 192;
#pragma unroll
      for (int nb = 0; nb < 2; ++nb)
#pragma unroll
        for (int i = 0; i < 4; ++i) {
          const int c = nb * 32 + 8 * i + 4 * h;
          const f32x4 w = *(const f32x4*)(w0 + nbase + c);
          float o[4];
#pragma unroll
          for (int j = 0; j < 4; ++j) o[j] = 0.6065306597126334f * sigm(w[j] + acc[nb][tb][4 * i + j]);
          *(u32x2*)(dst + c) = (u32x2){pk_f16(o[0], o[1]), pk_f16(o[2], o[3])};
        }
    }
  }
}

__device__ __forceinline__ void epi_adir(const f32x16 (&acc)[2][2], int nbase, int tbase, int M, CP& p, int dir) {
  const int lane = ltid() & 63, l32 = lane & 31, h = lane >> 5;
  const int head = nbase >> 6;
  u16* DIR = dir ? p.DIR1 : p.DIR0;
  const float* a0 = p.rw_a0 + dir * 1024;
#pragma unroll
  for (int tb = 0; tb < 2; ++tb) {
    const int tok = tbase + tb * 32 + l32;
    const bool valid = tok < M;
    const int tk = valid ? tok : M - 1;
    const size_t rec = ((size_t)tk * 16 + head) * 192;
    float nsq = 0.f;
#pragma unroll
    for (int nb = 0; nb < 2; ++nb)
#pragma unroll
      for (int i = 0; i < 4; ++i) {
        const int c = nb * 32 + 8 * i + 4 * h;
        const u32x2 kr = *(const u32x2*)(DIR + rec + 64 + c);
        const f32x4 kkw = *(const f32x4*)(p.k_k + nbase + c);
        const float q0 = h_lo(kr.x) * kkw[0], q1 = h_hi(kr.x) * kkw[1], q2 = h_lo(kr.y) * kkw[2], q3 = h_hi(kr.y) * kkw[3];
        nsq += q0 * q0 + q1 * q1 + q2 * q2 + q3 * q3;
      }
    nsq += __shfl_xor(nsq, 32);
    const float inv = 1.f / fmaxf(sqrtf(nsq), 1e-12f);
    if (valid) {
#pragma unroll
      for (int nb = 0; nb < 2; ++nb)
#pragma unroll
        for (int i = 0; i < 4; ++i) {
          const int c = nb * 32 + 8 * i + 4 * h;
          const u32x2 kr = *(const u32x2*)(DIR + rec + 64 + c);
          const float kv[4] = {h_lo(kr.x), h_hi(kr.x), h_lo(kr.y), h_hi(kr.y)};
          const f32x4 kkw = *(const f32x4*)(p.k_k + nbase + c);
          const f32x4 kaw = *(const f32x4*)(p.k_a + nbase + c);
          const f32x4 a0v = *(const f32x4*)(a0 + nbase + c);
          float kk[4], kd[4], bp[4];
#pragma unroll
          for (int j = 0; j < 4; ++j) {
            const float k = kv[j];
            kk[j] = k * kkw[j] * inv;
            const float aa = sigm(a0v[j] + acc[nb][tb][4 * i + j]);
            kd[j] = k * (1.f + (aa - 1.f) * kaw[j]);
            bp[j] = -kk[j] * aa;
          }
          if (dir == 0) *(u32x2*)(p.RKV + rec + 64 + c) = (u32x2){pk_f16(kk[0], kk[1]), pk_f16(kk[2], kk[3])};
          *(u32x2*)(DIR + rec + 64 + c) = (u32x2){pk_f16(kd[0], kd[1]), pk_f16(kd[2], kd[3])};
          *(u32x2*)(DIR + rec + 128 + c) = (u32x2){pk_f16(bp[0], bp[1]), pk_f16(bp[2], bp[3])};
        }
    }
  }
}

template <int LPR>
__device__ void scan_task(CP& p, const Grp& G, int task, char* lds) {
  constexpr int KPL = 64 / LPR, RPB = 256 / LPR, NSPLIT = 64 / RPB;
  const int part = task % NSPLIT, t1 = task / NSPLIT;
  const int dir = t1 & 1, head = (t1 >> 1) & 15, s = t1 >> 5;
  float* buf = (float*)lds;
  const u16* rkv = p.RKV;
  const u16* dr = dir ? p.DIR1 : p.DIR0;
  u16* Y = dir ? p.Y1 : p.Y0;
  const int tid = ltid();
  const int row = part * RPB + tid / LPR, kc = tid % LPR;
  const int L = G.L, nch = L >> 4;
  u32x4 pre[3];
  auto issue = [&](int c) {
#pragma unroll
    for (int i = 0; i < 3; ++i) {
      const int id = tid + 256 * i, st = id / 48, ci = id - st * 48;
      const int n = c * 16 + st, t = dir ? L - 1 - n : n;
      const size_t rec = ((size_t)rowof(G, s, t) * 16 + head) * 192;
      const u16* src = ci < 24 ? rkv + rec + ci * 8 : dr + rec + (ci - 24) * 8;
      pre[i] = *(const u32x4*)src;
    }
  };
  auto commit = [&](int b) {
#pragma unroll
    for (int i = 0; i < 3; ++i) {
      const int id = tid + 256 * i, st = id / 48, ci = id - st * 48;
      const int sec = ci >> 3;
      const int base = sec >= 3 ? (sec - 1) * 64 : (sec == 0 ? 64 : (sec == 1 ? 0 : 320));
      float f[8];
#pragma unroll
      for (int e = 0; e < 4; ++e) { f[2 * e] = h_lo(pre[i][e]); f[2 * e + 1] = h_hi(pre[i][e]); }
      if (sec == 3) {
#pragma unroll
        for (int e = 0; e < 8; ++e) f[e] = __expf(-f[e]);
      }
      float* d = buf + b * 6144 + st * 384 + base + (ci & 7) * 8;
      *(f32x4*)d = (f32x4){f[0], f[1], f[2], f[3]};
      *(f32x4*)(d + 4) = (f32x4){f[4], f[5], f[6], f[7]};
    }
  };
  float S[KPL];
#pragma unroll
  for (int i = 0; i < KPL; ++i) S[i] = 0.f;
  __syncthreads();
  issue(0);
  commit(0);
  __syncthreads();
  __builtin_amdgcn_s_setprio(3);
  for (int c = 0; c < nch; ++c) {
    if (c + 1 < nch) issue(c + 1);
    const float* b = buf + (c & 1) * 6144;
#pragma unroll 1
    for (int g0 = 0; g0 < 16; g0 += LPR) {
      float ykeep = 0.f;
#pragma unroll 2
      for (int j = 0; j < LPR; ++j) {
        const int st = g0 + j;
        const float* q = b + st * 384 + kc * KPL;
        f32x4 kk[KPL / 4], rr[KPL / 4], ww[KPL / 4], dd[KPL / 4], bb[KPL / 4];
#pragma unroll
        for (int jj = 0; jj < KPL / 4; ++jj) {
          kk[jj] = *(const f32x4*)(q + 4 * jj);
          rr[jj] = *(const f32x4*)(q + 64 + 4 * jj);
          ww[jj] = *(const f32x4*)(q + 128 + 4 * jj);
          dd[jj] = *(const f32x4*)(q + 192 + 4 * jj);
          bb[jj] = *(const f32x4*)(q + 256 + 4 * jj);
        }
        const float vv = b[st * 384 + 320 + row];
        float sa0 = 0.f, sa1 = 0.f;
#pragma unroll
        for (int jj = 0; jj < KPL / 4; ++jj) {
          sa0 += S[4 * jj] * kk[jj][0]; sa1 += S[4 * jj + 1] * kk[jj][1];
          sa0 += S[4 * jj + 2] * kk[jj][2]; sa1 += S[4 * jj + 3] * kk[jj][3];
        }
        float sa = sa0 + sa1;
        sa = LPR == 8 ? reduce8(sa) : reduce4(sa);
        float y0 = 0.f, y1 = 0.f;
#pragma unroll
        for (int jj = 0; jj < KPL / 4; ++jj)
#pragma unroll
          for (int e = 0; e < 4; ++e) {
            const float sn = S[4 * jj + e] * ww[jj][e] + (sa * bb[jj][e] + vv * dd[jj][e]);
            S[4 * jj + e] = sn;
            if (e & 1) y1 += sn * rr[jj][e]; else y0 += sn * rr[jj][e];
          }
        float y = y0 + y1;
        y = LPR == 8 ? reduce8(y) : reduce4(y);
        ykeep = (kc == j) ? y : ykeep;
      }
      const int n = c * 16 + g0 + kc, t = dir ? L - 1 - n : n;
      Y[(size_t)rowof(G, s, t) * 1024 + head * 64 + row] = bf16_1(ykeep);
    }
    if (c + 1 < nch) commit((c + 1) & 1);
    __syncthreads();
  }
  __builtin_amdgcn_s_setprio(0);
}

__device__ void attn_tile(CP& p, const Grp& G, int s, int hd, int qb, char* lds, float lam) {
  const int tid = ltid(), lane = tid & 63, wave = tid >> 6, l32 = lane & 31, h = lane >> 5;
  const int L = G.L, Lp = (G.L + 31) & ~31;
  const u16* Pb = p.P;
  float* lutl = (float*)(lds + 61440);
  __syncthreads();
  for (int i = tid; i < 511; i += 256) lutl[i] = p.lut[hd * 512 + i];
  const int q = 16 + qb * 128 + wave * 32 + l32;
  const int qc = s * G.S + (q - 16);
  const int qw0 = 16 + qb * 128 + wave * 32;
  u16* odst = p.O + (size_t)qc * 1024 + hd * 128;
  const int kkey = tid >> 3, kch = (tid & 7) ^ ((kkey >> 1) & 7);
  const u16* vsrc[2];
#pragma unroll
  for (int i = 0; i < 2; ++i) {
    const int c = tid + 256 * i, dv = c >> 2, c4 = (c & 3) ^ ((dv >> 2) & 3);
    vsrc[i] = p.VT + ((size_t)(s * 1024 + hd * 128 + dv) * Lp) + c4 * 8;
  }
  const unsigned lds0 = __builtin_amdgcn_readfirstlane((unsigned)(uintptr_t)(LAS char*)lds + wave * 1024);
  const int ntile = (L + 31) >> 5;
#pragma unroll 1
  for (int br = 0; br < 2; ++br) {
    bf16x8 qv[4];
#pragma unroll
    for (int ks = 0; ks < 4; ++ks) {
      const u32x4 raw = *(const u32x4*)(Pb + (size_t)qc * NIN + hd * 128 + br * 64 + ks * 16 + h * 8);
      u32x4 sc;
#pragma unroll
      for (int e = 0; e < 4; ++e) sc[e] = pk_bf16(bf_lo(raw[e]) * 0.125f, bf_hi(raw[e]) * 0.125f);
      qv[ks] = __builtin_bit_cast(bf16x8, sc);
    }
    const u16* kp = Pb + 1024 + hd * 128 + br * 64 + kch * 8;
    auto stage = [&](int kt) {
      const int kt0 = kt * 32;
      const unsigned sb = lds0 + (kt % 5) * 12288;
      int kr = kt0 + kkey; kr = kr < L ? kr : L - 1;
      glds16(kp + (size_t)rowof(G, s, kr) * NIN, sb);
      glds16(vsrc[0] + kt0, sb + 4096);
      glds16(vsrc[1] + kt0, sb + 8192);
    };
    f32x16 O[4];
#pragma unroll
    for (int mb = 0; mb < 4; ++mb)
#pragma unroll
      for (int r = 0; r < 16; ++r) O[mb][r] = 0.f;
    float mrun = -1e30f, lrun = 0.f;
    asm volatile("s_waitcnt vmcnt(0) lgkmcnt(0)" ::: "memory");
    __builtin_amdgcn_s_barrier();
#pragma unroll
    for (int s0 = 0; s0 < 4; ++s0)
      if (s0 < ntile) stage(s0);
    const float cneg = lutl[0], cpos = lutl[510];
    for (int kt = 0; kt < ntile; ++kt) {
      const int kt0 = kt * 32;
      {
        const int rem = ntile - 1 - kt;
        if (rem >= 3) asm volatile("s_waitcnt vmcnt(9)" ::: "memory");
        else if (rem == 2) asm volatile("s_waitcnt vmcnt(6)" ::: "memory");
        else if (rem == 1) asm volatile("s_waitcnt vmcnt(3)" ::: "memory");
        else asm volatile("s_waitcnt vmcnt(0)" ::: "memory");
      }
      __builtin_amdgcn_s_barrier();
      if (kt + 4 < ntile) stage(kt + 4);
      const char* st = lds + (kt % 5) * 12288;
      f32x16 sacc;
#pragma unroll
      for (int r = 0; r < 16; ++r) sacc[r] = 0.f;
      bf16x8 kf[4], vf[4][2];
#pragma unroll
      for (int ks = 0; ks < 4; ++ks) kf[ks] = *(const bf16x8*)(st + l32 * 128 + (((ks * 2 + h) ^ ((l32 >> 1) & 7)) << 4));
#pragma unroll
      for (int mb = 0; mb < 4; ++mb)
#pragma unroll
        for (int s2 = 0; s2 < 2; ++s2) {
          const int vr = mb * 32 + l32;
          vf[mb][s2] = *(const bf16x8*)(st + 4096 + vr * 64 + (((2 * s2 + h) ^ ((vr >> 2) & 3)) << 4));
        }
      __builtin_amdgcn_sched_barrier(0);
#pragma unroll
      for (int ks = 0; ks < 4; ++ks) sacc = __builtin_amdgcn_mfma_f32_32x32x16_bf16(kf[ks], qv[ks], sacc, 0, 0, 0);
      const bool farneg = (kt0 + 31) <= (qw0 - 128);
      const bool farpos = kt0 >= (qw0 + 31 + 128);
      float ps = 0.f, alpha;
      if ((farneg || farpos) && (kt0 + 32 <= L)) {
        const float cv = farneg ? cneg : cpos;
        float mx = fmaxf(fmaxf(sacc[0], sacc[1]), sacc[2]);
#pragma unroll
        for (int r = 3; r < 15; r += 2) mx = fmaxf(fmaxf(mx, sacc[r]), sacc[r + 1]);
        mx = fmaxf(mx, sacc[15]);
        mx = fmaxf(mx, __shfl_xor(mx, 32));
        const float mnew = fmaxf(mrun, mx * LOG2E + cv);
        alpha = __builtin_amdgcn_exp2f(mrun - mnew);
        mrun = mnew;
        const float sh = cv - mnew;
#pragma unroll
        for (int r = 0; r < 16; ++r) { sacc[r] = __builtin_amdgcn_exp2f(sacc[r] * LOG2E + sh); ps += sacc[r]; }
      } else {
        float mx = -1e30f;
        if (farneg || farpos) {
          const float cv = farneg ? cneg : cpos;
#pragma unroll
          for (int r = 0; r < 16; ++r) { sacc[r] = sacc[r] * LOG2E + cv; }
        } else {
#pragma unroll
          for (int r = 0; r < 16; ++r) {
            const int key = kt0 + 8 * (r >> 2) + 4 * h + (r & 3);
            int d = key - q + 255;
            d = d < 0 ? 0 : (d > 510 ? 510 : d);
            sacc[r] = sacc[r] * LOG2E + lutl[d];
          }
        }
        if (kt0 + 32 > L) {
#pragma unroll
          for (int r = 0; r < 16; ++r) {
            const int key = kt0 + 8 * (r >> 2) + 4 * h + (r & 3);
            if (key >= L) sacc[r] = -INFINITY;
          }
        }
#pragma unroll
        for (int r = 0; r < 16; ++r) mx = fmaxf(mx, sacc[r]);
        mx = fmaxf(mx, __shfl_xor(mx, 32));
        const float mnew = fmaxf(mrun, mx);
        alpha = __builtin_amdgcn_exp2f(mrun - mnew);
        mrun = mnew;
#pragma unroll
        for (int r = 0; r < 16; ++r) { sacc[r] = __builtin_amdgcn_exp2f(sacc[r] - mnew); ps += sacc[r]; }
      }
      lrun = lrun * alpha + ps;
      if (__any(alpha != 1.f)) {
#pragma unroll
        for (int mb = 0; mb < 4; ++mb)
#pragma unroll
          for (int r = 0; r < 16; ++r) O[mb][r] *= alpha;
      }
      bf16x8 pf[2];
#pragma unroll
      for (int s2 = 0; s2 < 2; ++s2) {
        u32x4 w;
#pragma unroll
        for (int e = 0; e < 4; ++e) w[e] = pk_bf16(sacc[8 * s2 + 2 * e], sacc[8 * s2 + 2 * e + 1]);
        pf[s2] = __builtin_bit_cast(bf16x8, w);
      }
      __builtin_amdgcn_sched_barrier(0);
#pragma unroll
      for (int s2 = 0; s2 < 2; ++s2)
#pragma unroll
        for (int mb = 0; mb < 4; ++mb)
          O[mb] = __builtin_amdgcn_mfma_f32_32x32x16_bf16(vf[mb][s2], pf[s2], O[mb], 0, 0, 0);
    }
    const float lt = lrun + __shfl_xor(lrun, 32);
    if (br == 0) {
      const float i1 = 1.f / lt;
#pragma unroll
      for (int mb = 0; mb < 4; ++mb)
#pragma unroll
        for (int i = 0; i < 4; ++i)
          if (q < L) *(u32x2*)(odst + mb * 32 + 8 * i + 4 * h) = (u32x2){pk_bf16(O[mb][4 * i] * i1, O[mb][4 * i + 1] * i1), pk_bf16(O[mb][4 * i + 2] * i1, O[mb][4 * i + 3] * i1)};
    } else {
      const float i2 = lam / lt;
      float ssq = 0.f;
#pragma unroll
      for (int mb = 0; mb < 4; ++mb)
#pragma unroll
        for (int i = 0; i < 4; ++i) {
          u32x2 w = {0, 0};
          if (q < L) w = *(const u32x2*)(odst + mb * 32 + 8 * i + 4 * h);
          const float o0 = bf_lo(w.x) - O[mb][4 * i] * i2, o1v = bf_hi(w.x) - O[mb][4 * i + 1] * i2, o2 = bf_lo(w.y) - O[mb][4 * i + 2] * i2, o3 = bf_hi(w.y) - O[mb][4 * i + 3] * i2;
          O[mb][4 * i] = o0; O[mb][4 * i + 1] = o1v; O[mb][4 * i + 2] = o2; O[mb][4 * i + 3] = o3;
          ssq += o0 * o0 + o1v * o1v + o2 * o2 + o3 * o3;
        }
      ssq += __shfl_xor(ssq, 32);
      const float rn = rsqrtf(ssq * (1.f / 128.f) + EPSN) * 0.8f;
      if (q < L) {
#pragma unroll
        for (int mb = 0; mb < 4; ++mb)
#pragma unroll
          for (int i = 0; i < 4; ++i) {
            const int dv = mb * 32 + 8 * i + 4 * h;
            const f32x4 g = *(const f32x4*)(p.subln + dv);
            *(u32x2*)(odst + dv) = (u32x2){pk_bf16(O[mb][4 * i] * rn * g.x, O[mb][4 * i + 1] * rn * g.y),
                                           pk_bf16(O[mb][4 * i + 2] * rn * g.z, O[mb][4 * i + 3] * rn * g.w)};
          }
      }
    }
  }
}

__device__ void phase_mixer(CP& p, const Grp& G, int g, char* lds) {
  if (G.nseq == 4) { for (int t = blockIdx.x; t < 256; t += gridDim.x) scan_task<8>(p, G, t, lds); }
  else { for (int t = blockIdx.x; t < 256; t += gridDim.x) scan_task<4>(p, G, t, lds); }
  const int nqb = G.S >> 7;
  const int natt = G.nseq * 8 * nqb;
  const float lam = p.lam[0];
  int* shw = (int*)(lds + 65536 - 16);
  while (true) {
    __syncthreads();
    if (ltid() == 0) *shw = atomicAdd(p.cnt + g, 1);
    __syncthreads();
    const int t = *shw;
    if (t >= natt) break;
    const int qb = t % nqb, r = t / nqb, hd = r & 7, s = r >> 3;
    attn_tile(p, G, s, hd, qb, lds, lam);
  }
}

__device__ void phase_post(CP& p, const Grp& G) {
  const int lane = ltid() & 63;
  const int nw = gridDim.x * 4;
  const int c0 = lane * 16, head = lane >> 2, hc = (lane & 3) * 16;
  for (int row = blockIdx.x * 4 + (ltid() >> 6); row < G.Mx; row += nw) {
    float y[16];
    {
      const u32x4 a0 = *(const u32x4*)(p.Y0 + (size_t)row * 1024 + c0), a1 = *(const u32x4*)(p.Y0 + (size_t)row * 1024 + c0 + 8);
      const u32x4 b0 = *(const u32x4*)(p.Y1 + (size_t)row * 1024 + c0), b1 = *(const u32x4*)(p.Y1 + (size_t)row * 1024 + c0 + 8);
#pragma unroll
      for (int e = 0; e < 4; ++e) {
        y[2 * e] = bf_lo(a0[e]) + bf_lo(b0[e]); y[2 * e + 1] = bf_hi(a0[e]) + bf_hi(b0[e]);
        y[8 + 2 * e] = bf_lo(a1[e]) + bf_lo(b1[e]); y[8 + 2 * e + 1] = bf_hi(a1[e]) + bf_hi(b1[e]);
      }
    }
    float s1 = 0.f;
#pragma unroll
    for (int e = 0; e < 16; ++e) s1 += y[e];
    s1 = reduce4(s1);
    const float mu = s1 * (1.f / 64.f);
    float s2 = 0.f;
#pragma unroll
    for (int e = 0; e < 16; ++e) { const float d = y[e] - mu; s2 += d * d; }
    s2 = reduce4(s2);
    const float rstd = rsqrtf(s2 * (1.f / 64.f) + 64e-5f);
    const size_t rec = ((size_t)row * 16 + head) * 192 + hc;
    float rr[16], vv[16], kd[16];
    {
      const u32x4 r0 = *(const u32x4*)(p.RKV + rec), r1 = *(const u32x4*)(p.RKV + rec + 8);
      const u32x4 v0 = *(const u32x4*)(p.RKV + rec + 128), v1 = *(const u32x4*)(p.RKV + rec + 136);
      const u32x4 f0 = *(const u32x4*)(p.DIR0 + rec + 64), f1 = *(const u32x4*)(p.DIR0 + rec + 72);
      const u32x4 g0 = *(const u32x4*)(p.DIR1 + rec + 64), g1 = *(const u32x4*)(p.DIR1 + rec + 72);
#pragma unroll
      for (int e = 0; e < 4; ++e) {
        rr[2 * e] = h_lo(r0[e]); rr[2 * e + 1] = h_hi(r0[e]); rr[8 + 2 * e] = h_lo(r1[e]); rr[8 + 2 * e + 1] = h_hi(r1[e]);
        vv[2 * e] = h_lo(v0[e]); vv[2 * e + 1] = h_hi(v0[e]); vv[8 + 2 * e] = h_lo(v1[e]); vv[8 + 2 * e + 1] = h_hi(v1[e]);
        kd[2 * e] = h_lo(f0[e]) + h_lo(g0[e]); kd[2 * e + 1] = h_hi(f0[e]) + h_hi(g0[e]);
        kd[8 + 2 * e] = h_lo(f1[e]) + h_lo(g1[e]); kd[8 + 2 * e + 1] = h_hi(f1[e]) + h_hi(g1[e]);
      }
    }
    float bs = 0.f;
#pragma unroll
    for (int e = 0; e < 16; ++e) bs += rr[e] * kd[e] * p.r_k[c0 + e];
    bs = reduce4(bs);
    const u32x4 g0 = *(const u32x4*)(p.G + (size_t)row * 1024 + c0), g1 = *(const u32x4*)(p.G + (size_t)row * 1024 + c0 + 8);
    float o[16];
#pragma unroll
    for (int e = 0; e < 16; ++e) {
      const unsigned gw = e < 8 ? g0[e >> 1] : g1[(e - 8) >> 1];
      const float gg = (e & 1) ? bf_hi(gw) : bf_lo(gw);
      o[e] = ((y[e] - mu) * rstd * p.lnx_w[c0 + e] + p.lnx_b[c0 + e] + bs * vv[e]) * gg;
    }
    u16* dst = (u16*)p.H + (size_t)row * 1024 + c0;
    *(u32x4*)dst = (u32x4){pk_bf16(o[0], o[1]), pk_bf16(o[2], o[3]), pk_bf16(o[4], o[5]), pk_bf16(o[6], o[7])};
    *(u32x4*)(dst + 8) = (u32x4){pk_bf16(o[8], o[9]), pk_bf16(o[10], o[11]), pk_bf16(o[12], o[13]), pk_bf16(o[14], o[15])};
  }
}

__device__ void phase_final(CP& p, const Grp& G) {
  const int lane = ltid() & 63;
  const int nw = gridDim.x * 4;
  for (int row = blockIdx.x * 4 + (ltid() >> 6); row < G.Mx; row += nw) {
    const float rs = rsqrtf(p.ss3[row] * (1.f / 1024.f) + EPSN);
    const float* hp = p.H + (size_t)row * 1024;
    float* op = G.out + (size_t)row * 1024;
#pragma unroll
    for (int i = 0; i < 4; ++i) {
      const f32x4 v = *(const f32x4*)(hp + i * 256 + lane * 4);
      const f32x4 g = *(const f32x4*)(p.final_norm + i * 256 + lane * 4);
      *(f32x4*)(op + i * 256 + lane * 4) = (f32x4){v.x * rs * g.x, v.y * rs * g.y, v.z * rs * g.z, v.w * rs * g.w};
    }
  }
}

__device__ void run_phase(CP& p, int ph, char* lds) {
  int* gctr = p.cnt + 64 + ph * 64;
  if (ph == 0) { phase_prep(p, lds); return; }
  int g, k;
  if (ph <= NMETA_PH) { g = -1; k = ph - 1; }
  else { g = (ph - 1 - NMETA_PH) / PH_PER_G; k = (ph - 1 - NMETA_PH) - g * PH_PER_G; }
  const Grp G = get_grp(p, g);
  const int Mall = G.M;
  const int M = G.Mx;
  u16* Pout = G.meta ? p.PM : p.P;
  switch (k) {
    case 0: phase_rows(p, G); break;
    case 1:
      gemm_phase_w(p.HB, 1024, M, p.W1A, 1024, 2 * FFD, lds, gctr, [&](const f32x16 (&acc)[2][2], int nb, int tb) { epi_swiglu(acc, nb, tb, M, p.ss0, p.ACT); });
      break;
    case 2:
      gemm_phase_w(p.ACT, FFD, M, p.WD1, FFD, 1024, lds, gctr, [&](const f32x16 (&acc)[2][2], int nb, int tb) { epi_resid<0>(acc, nb, tb, p, G); });
      break;
    case 3:
      gemm_phase_w(p.HB, 1024, M, p.WIN, 1024, NIN, lds, gctr, [&](const f32x16 (&acc)[2][2], int nbase, int tbase) {
        const int lane = ltid() & 63, l32 = lane & 31, h = lane >> 5;
#pragma unroll
        for (int tb = 0; tb < 2; ++tb) {
          const int tok = tbase + tb * 32 + l32;
          if (tok < M) {
            const float rs = rsqrtf(p.ss1[tok] * (1.f / 1024.f) + EPSN);
            if (!G.meta && nbase >= 2048 && nbase < 3072) {
              const int s = tok >> G.lgS, t = 16 + (tok & (G.S - 1));
              const int Lp = (G.L + 31) & ~31;
              const int pos = (t & ~12) | ((t & 4) << 1) | ((t & 8) >> 1);
              u16* vt = p.VT + ((size_t)(s * 1024 + (nbase - 2048)) * Lp) + pos;
#pragma unroll
              for (int nb = 0; nb < 2; ++nb)
#pragma unroll
                for (int r = 0; r < 16; ++r) {
                  const int dvl = nb * 32 + 8 * (r >> 2) + 4 * h + (r & 3);
                  vt[(size_t)dvl * Lp] = bf16_1(acc[nb][tb][r] * rs);
                }
            } else {
              u16* dst = Pout + (size_t)tok * NIN + nbase + 4 * h;
#pragma unroll
              for (int nb = 0; nb < 2; ++nb)
#pragma unroll
                for (int i = 0; i < 4; ++i)
                  *(u32x2*)(dst + nb * 32 + 8 * i) = (u32x2){pk_bf16(acc[nb][tb][4 * i] * rs, acc[nb][tb][4 * i + 1] * rs),
                                                             pk_bf16(acc[nb][tb][4 * i + 2] * rs, acc[nb][tb][4 * i + 3] * rs)};
            }
          }
        }
      });
      break;
    case 4: phase_mix(p, G); break;
    case 5:
      gemm_phase(p.F, 384, Mall, p.W2F, 64, 1024, lds, gctr, [&](const f32x16 (&acc)[2][2], int nb, int tb) { epi_decay(acc, nb, tb, Mall, p.rw_w0, p.DIR0); });
      gemm_phase(p.F + 64, 384, Mall, p.W2B, 64, 1024, lds, gctr + 8, [&](const f32x16 (&acc)[2][2], int nb, int tb) { epi_decay(acc, nb, tb, Mall, p.rw_w0 + 1024, p.DIR1); });
      gemm_phase(p.F + 128, 384, Mall, p.A2F, 64, 1024, lds, gctr + 16, [&](const f32x16 (&acc)[2][2], int nb, int tb) { epi_adir(acc, nb, tb, Mall, p, 0); });
      gemm_phase(p.F + 192, 384, Mall, p.A2B, 64, 1024, lds, gctr + 24, [&](const f32x16 (&acc)[2][2], int nb, int tb) { epi_adir(acc, nb, tb, Mall, p, 1); });
      gemm_phase(p.F + 256, 384, Mall, p.G2T, 128, 1024, lds, gctr + 32, [&](const f32x16 (&acc)[2][2], int nbase, int tbase) {
        const int lane = ltid() & 63, l32 = lane & 31, h = lane >> 5;
#pragma unroll
        for (int tb = 0; tb < 2; ++tb) {
          const int tok = tbase + tb * 32 + l32;
          if (tok < Mall) {
            u16* dst = p.G + (size_t)tok * 1024 + nbase + 4 * h;
#pragma unroll
            for (int nb = 0; nb < 2; ++nb)
#pragma unroll
              for (int i = 0; i < 4; ++i)
                *(u32x2*)(dst + nb * 32 + 8 * i) = (u32x2){pk_bf16(acc[nb][tb][4 * i], acc[nb][tb][4 * i + 1]), pk_bf16(acc[nb][tb][4 * i + 2], acc[nb][tb][4 * i + 3])};
          }
        }
      });
      break;
    case 6: phase_mixer(p, G, g, lds); break;
    case 7: phase_post(p, G); break;
    case 8: {
      const int nN = 8, nM = (M + 127) >> 7, nt = nN * nM;
      const int wave = ltid() >> 6;
      const int lane = ltid() & 63, l32 = lane & 31, h = lane >> 5;
      const int xcd = blockIdx.x & 7, g8 = gridDim.x >> 3;
      const int tq = nt >> 3, trm = nt & 7;
      const int tstart = xcd < trm ? xcd * (tq + 1) : trm * (tq + 1) + (xcd - trm) * tq;
      const int tcnt = tq + (xcd < trm ? 1 : 0);
      for (int off = blockIdx.x >> 3; off < tcnt; off += g8) {
        const int id = tstart + off, nig = 8 * nN, grp = id / nig, fm = grp * 8;
        const int gsz = (nM - fm) < 8 ? (nM - fm) : 8, idl = id - grp * nig;
        const int tm = fm + idl % gsz, tn = idl / gsz;
        const int nbase = tn * 128 + (wave & 1) * 64, tbase = tm * 128 + (wave >> 1) * 64;
#pragma unroll 1
        for (int pass = 0; pass < 2; ++pass) {
          f32x16 acc[2][2];
          zero_acc(acc);
          gemm_kloop(acc, pass ? (const u16*)p.H : p.O, 1024, M, tm * 128, pass ? p.WRW : p.WATT, 1024, tn * 128, 1024, lds);
#pragma unroll
          for (int tb = 0; tb < 2; ++tb) {
            const int tok = tbase + tb * 32 + l32;
            if (tok < M) {
              const u16* gp = p.P + (size_t)tok * NIN + 6528 + pass * 1024 + nbase + 4 * h;
              u16* dst = p.MERGED + (size_t)tok * 1024 + nbase + 4 * h;
#pragma unroll
              for (int nb = 0; nb < 2; ++nb)
#pragma unroll
                for (int i = 0; i < 4; ++i) {
                  const u32x2 ga = *(const u32x2*)(gp + nb * 32 + 8 * i);
                  float o0 = sigm(bf_lo(ga.x)) * acc[nb][tb][4 * i];
                  float o1 = sigm(bf_hi(ga.x)) * acc[nb][tb][4 * i + 1];
                  float o2 = sigm(bf_lo(ga.y)) * acc[nb][tb][4 * i + 2];
                  float o3 = sigm(bf_hi(ga.y)) * acc[nb][tb][4 * i + 3];
                  if (pass) {
                    const u32x2 pv = *(const u32x2*)(dst + nb * 32 + 8 * i);
                    o0 += bf_lo(pv.x); o1 += bf_hi(pv.x); o2 += bf_lo(pv.y); o3 += bf_hi(pv.y);
                  }
                  *(u32x2*)(dst + nb * 32 + 8 * i) = (u32x2){pk_bf16(o0, o1), pk_bf16(o2, o3)};
                }
            }
          }
        }
      }
    } break;
    case 9:
      gemm_phase_w(p.MERGED, 1024, M, p.WOUT, 1024, 1024, lds, gctr, [&](const f32x16 (&acc)[2][2], int nb, int tb) { epi_resid<1>(acc, nb, tb, p, G); });
      break;
    case 10:
      gemm_phase_w(p.HB, 1024, M, p.W2A, 1024, 2 * FFD, lds, gctr, [&](const f32x16 (&acc)[2][2], int nb, int tb) { epi_swiglu(acc, nb, tb, M, p.ss2, p.ACT); });
      break;
    case 11:
      gemm_phase_w(p.ACT, FFD, M, p.WD2, FFD, 1024, lds, gctr, [&](const f32x16 (&acc)[2][2], int nb, int tb) { epi_resid<2>(acc, nb, tb, p, G); });
      break;
    case 12: phase_final(p, G); break;
  }
}

__global__ void __launch_bounds__(256, 2) mega(Params p, int ph_lo, int ph_hi, int coop) {
  __shared__ __attribute__((aligned(16))) char lds[65536 + 16];
  uint4& xb_words = *(uint4*)(lds + 65536);
  CP* pp = (CP*)__builtin_amdgcn_kernarg_segment_ptr();
  asm volatile("" : "+s"(pp));
  if (threadIdx.x == 0) xb_words = make_uint4(0u, 0u, 0u, 0u);
  __syncthreads();
  const XcdBarrier xb = xcd_barrier_post(pp->bar, (volatile LAS unsigned*)&xb_words);
  for (int ph = ph_lo; ph < ph_hi; ++ph) {
    run_phase(*pp, ph, lds);
    if (coop && ph + 1 < ph_hi) {
      if (ph == 0) cg::this_grid().sync();
      else xcd_barrier(xb);
    }
  }
}

extern "C" void kernel_launch(void* const* d_in, const int* in_sizes, int n_in, void* d_out, int out_size, void* d_ws,
                              size_t ws_size, hipStream_t stream) {
  Params p;
  memset(&p, 0, sizeof(p));
  const float** f = (const float**)&p;
  for (int i = 0; i < 35; ++i) f[i] = (const float*)d_in[i];
  p.out = (float*)d_out;
  char* w = (char*)d_ws;
  size_t off = 0;
  auto alloc = [&](size_t bytes) { char* r = w + off; off += (bytes + 255) & ~(size_t)255; return r; };
  p.W1A = (u16*)alloc((size_t)2 * FFD * 1024 * 2);
  p.WD1 = (u16*)alloc((size_t)1024 * FFD * 2);
  p.WIN = (u16*)alloc((size_t)NIN * 1024 * 2);
  p.WATT = (u16*)alloc((size_t)1024 * 1024 * 2);
  p.WRW = (u16*)alloc((size_t)1024 * 1024 * 2);
  p.WOUT = (u16*)alloc((size_t)1024 * 1024 * 2);
  p.W2A = (u16*)alloc((size_t)2 * FFD * 1024 * 2);
  p.WD2 = (u16*)alloc((size_t)1024 * FFD * 2);
  p.W2F = (u16*)alloc((size_t)1024 * 64 * 2);
  p.W2B = (u16*)alloc((size_t)1024 * 64 * 2);
  p.A2F = (u16*)alloc((size_t)1024 * 64 * 2);
  p.A2B = (u16*)alloc((size_t)1024 * 64 * 2);
  p.G2T = (u16*)alloc((size_t)1024 * 128 * 2);
  p.lut = (float*)alloc(8 * 512 * 4);
  p.cnt = (int*)alloc((64 + NPHASES * 64) * 4);
  p.lam = (float*)alloc(256);
  p.bar = (unsigned*)alloc(XCD_BAR_WORDS * 4);
  const size_t R = MAXROWS;
  p.H = (float*)alloc(R * 1024 * 4);
  p.HB = (u16*)alloc(R * 1024 * 2);
  p.ACT = (u16*)alloc(R * FFD * 2);
  p.Y0 = p.ACT;
  p.Y1 = p.ACT + R * 1024;
  p.F = p.ACT + R * 2048;
  p.P = (u16*)alloc(R * NIN * 2);
  p.RKV = (u16*)alloc(R * 16 * 192 * 2);
  p.DIR0 = (u16*)alloc(R * 16 * 192 * 2);
  p.DIR1 = (u16*)alloc(R * 16 * 192 * 2);
  p.G = (u16*)alloc(R * 1024 * 2);
  p.O = (u16*)alloc(R * 1024 * 2);
  p.MERGED = (u16*)alloc(R * 1024 * 2);
  p.VT = (u16*)alloc((size_t)8 * 8 * 128 * 2080 * 2);
  p.PM = (u16*)alloc((size_t)16 * NIN * 2);
  p.ss0 = (float*)alloc(R * 4);
  p.ss1 = (float*)alloc(R * 4);
  p.ss2 = (float*)alloc(R * 4);
  p.ss3 = (float*)alloc(R * 4);
  if (off > ws_size) { fprintf(stderr, "workspace too small: need %zu have %zu\n", off, ws_size); return; }
  static int grid_blocks = 0;
  if (!grid_blocks) {
    int dev = 0, cus = 0, per_cu = 0;
    hipGetDevice(&dev);
    hipDeviceGetAttribute(&cus, hipDeviceAttributeMultiprocessorCount, dev);
    hipOccupancyMaxActiveBlocksPerMultiprocessor(&per_cu, mega, 256, 0);
    per_cu = 2;
    grid_blocks = cus * per_cu;
  }
  hipMemsetAsync(p.bar, 0, XCD_BAR_WORDS * 4, stream);
  hipMemsetAsync(p.cnt, 0, (64 + NPHASES * 64) * 4, stream);
  int ph_lo = 0, ph_hi = NPHASES, coop = 1;
  void* args[] = {&p, &ph_lo, &ph_hi, &coop};
  hipError_t e = hipLaunchCooperativeKernel((void*)mega, dim3(grid_blocks), dim3(256), args, 0, stream);
  if (e != hipSuccess) fprintf(stderr, "cooperative launch failed: %s (grid %d)\n", hipGetErrorString(e), grid_blocks);
}
```

```cpp
#include <hip/hip_runtime.h>
#include <hip/hip_cooperative_groups.h>
#include <stdint.h>
#include <string.h>
#include <stdio.h>
namespace cg = cooperative_groups;

typedef unsigned short u16;
typedef short bf16x8 __attribute__((ext_vector_type(8)));
typedef float f32x16 __attribute__((ext_vector_type(16)));
typedef float f32x4 __attribute__((ext_vector_type(4)));
typedef float f32x2 __attribute__((ext_vector_type(2)));
typedef unsigned u32x4 __attribute__((ext_vector_type(4)));
typedef unsigned u32x2 __attribute__((ext_vector_type(2)));
typedef __bf16 bf16x2_t __attribute__((ext_vector_type(2)));
typedef _Float16 f16x2_t __attribute__((ext_vector_type(2)));

#define NIN 8576
#define FFD 2816
#define EPSN 1e-6f
#define LOG2E 1.4426950408889634f
#define NGROUPS 6
#define PH_PER_G 13
#define NMETA_PH 4
#define NPHASES (1 + NMETA_PH + NGROUPS * PH_PER_G)
#define MAXROWS 16512

struct Params {
  const float *x_prompt, *x_sample, *meta, *rel_bias, *ffn1_norm, *ffn1_wg, *ffn1_wu, *ffn1_wd, *mix_norm, *w_in;
  const float *lq1, *lk1, *lq2, *lk2, *subln, *w_attn, *mu_prev, *mu_next, *rw_w0, *rw_w2, *rw_a0, *rw_a2, *rw_g2;
  const float *k_k, *k_a, *r_k, *lnx_w, *lnx_b, *w_rw, *w_out, *ffn2_norm, *ffn2_wg, *ffn2_wu, *ffn2_wd, *final_norm;
  float* out;
  u16 *W1A, *WD1, *WIN, *WATT, *WRW, *WOUT, *W2A, *WD2, *W2F, *W2B, *A2F, *A2B, *G2T;
  float* lut; int* cnt; float* lam; unsigned* bar; u16* VT; u16* PM;
  float* H; u16 *HB, *ACT, *P, *RKV, *DIR0, *DIR1, *G, *O, *MERGED, *Y0, *Y1, *F;
  float *ss0, *ss1, *ss2, *ss3;
};

typedef const Params __attribute__((address_space(4))) CP;
struct Grp { int nseq, L, S, lgS, M, Mx, meta; const float* x; float* out; };
__device__ __forceinline__ int rowof(const Grp& G, int s, int t) { return t < 16 ? G.Mx + s * 16 + t : s * G.S + (t - 16); }

__device__ __forceinline__ Grp get_grp(CP& p, int g) {
  Grp r;
  r.meta = 0;
  if (g < 0) {
    r.nseq = 1; r.L = 16; r.S = 16; r.lgS = 4; r.x = p.meta; r.out = nullptr; r.M = 16; r.Mx = 16; r.meta = 1;
    return r;
  }
  if (g < 4) { r.nseq = 4; r.L = 4112; r.S = 4096; r.lgS = 12; r.x = p.x_prompt + (size_t)g * 4 * 4096 * 1024; r.out = p.out + (size_t)g * 4 * 4096 * 1024; }
  else { r.nseq = 8; r.L = 2064; r.S = 2048; r.lgS = 11; r.x = p.x_sample + (size_t)(g - 4) * 8 * 2048 * 1024; r.out = p.out + (size_t)16 * 4096 * 1024 + (size_t)(g - 4) * 8 * 2048 * 1024; }
  r.M = r.nseq * r.L;
  r.Mx = r.nseq * r.S;
  return r;
}

__device__ __forceinline__ int ltid() { int t = threadIdx.x; asm volatile("" : "+v"(t)); return t; }
__device__ __forceinline__ unsigned pk_bf16(float a, float b) {
  f32x2 v = {a, b};
  bf16x2_t r = __builtin_convertvector(v, bf16x2_t);
  return __builtin_bit_cast(unsigned, r);
}
__device__ __forceinline__ float bf_lo(unsigned u) { return __uint_as_float(u << 16); }
__device__ __forceinline__ float bf_hi(unsigned u) { return __uint_as_float(u & 0xffff0000u); }
__device__ __forceinline__ unsigned pk_f16(float a, float b) {
  f32x2 v = {a, b};
  f16x2_t r = __builtin_convertvector(v, f16x2_t);
  return __builtin_bit_cast(unsigned, r);
}
__device__ __forceinline__ float h_lo(unsigned u) { f16x2_t r = __builtin_bit_cast(f16x2_t, u); return (float)r.x; }
__device__ __forceinline__ float h_hi(unsigned u) { f16x2_t r = __builtin_bit_cast(f16x2_t, u); return (float)r.y; }
__device__ __forceinline__ u16 bf16_1(float a) { return (u16)(pk_bf16(a, 0.f) & 0xffffu); }
__device__ __forceinline__ float sigm(float x) { return __builtin_amdgcn_rcpf(1.f + __builtin_amdgcn_exp2f(-LOG2E * x)); }
__device__ __forceinline__ float wave_sum(float v) {
#pragma unroll
  for (int o = 32; o > 0; o >>= 1) v += __shfl_xor(v, o);
  return v;
}
template <int CTRL> __device__ __forceinline__ float dppf(float x) {
  return __int_as_float(__builtin_amdgcn_update_dpp(0, __float_as_int(x), CTRL, 0xf, 0xf, true));
}
__device__ __forceinline__ float reduce8(float x) {
  x += dppf<0xB1>(x);
  x += dppf<0x4E>(x);
  x += dppf<0x141>(x);
  return x;
}
__device__ __forceinline__ float reduce4(float x) {
  x += dppf<0xB1>(x);
  x += dppf<0x4E>(x);
  return x;
}

__device__ void prep_transpose(const float* __restrict__ src, int K, int N, u16* __restrict__ dst,
                               const float* __restrict__ gain, int mode, char* lds) {
  float* tile = (float*)lds;
  const int tn = N / 64, nt = (K / 64) * tn;
  const int tid = ltid();
  for (int t = blockIdx.x; t < nt; t += gridDim.x) {
    const int k0 = (t / tn) * 64, n0 = (t % tn) * 64;
    const int nl = tid & 63, kq = tid >> 6;
#pragma unroll
    for (int i = 0; i < 16; ++i) {
      const int k = i * 4 + kq;
      float v = src[(size_t)(k0 + k) * N + n0 + nl];
      if (gain) v *= gain[k0 + k];
      tile[k * 65 + nl] = v;
    }
    __syncthreads();
    const int n = tid >> 2, kk = (tid & 3) * 16;
    unsigned w[8];
#pragma unroll
    for (int i = 0; i < 8; ++i) w[i] = pk_bf16(tile[(kk + 2 * i) * 65 + n], tile[(kk + 2 * i + 1) * 65 + n]);
    const int ng = n0 + n;
    const int row = mode == 0 ? ng : ((ng >> 5) * 64 + (ng & 31) + (mode == 2 ? 32 : 0));
    u32x4* d = (u32x4*)(dst + (size_t)row * K + k0 + kk);
    d[0] = (u32x4){w[0], w[1], w[2], w[3]};
    d[1] = (u32x4){w[4], w[5], w[6], w[7]};
    __syncthreads();
  }
}

__device__ void phase_prep(CP& p, char* lds) {
  if (blockIdx.x == 0) {
    const int tid = ltid();
    for (int idx = tid; idx < 8 * 511; idx += 256) {
      const int hd = idx / 511, di = idx - hd * 511, d = di - 255;
      const int n = d < 0 ? -d : d;
      int bk;
      if (n < 8) bk = n;
      else {
        const float nf = (float)n;
        int large = 8 + (int)(logf(nf / 8.0f) / 2.772588722239781f * 8.0f);
        bk = large < 15 ? large : 15;
      }
      const int bucket = (d > 0 ? 16 : 0) + bk;
      p.lut[hd * 512 + di] = p.rel_bias[bucket * 8 + hd] * LOG2E;
    }
    if (tid == 0) {
      float s1 = 0.f, s2 = 0.f;
      for (int i = 0; i < 64; ++i) { s1 += p.lq1[i] * p.lk1[i]; s2 += p.lq2[i] * p.lk2[i]; }
      p.lam[0] = expf(s1) - expf(s2) + 0.2f;
    }
  }
  prep_transpose(p.ffn1_wg, 1024, FFD, p.W1A, p.ffn1_norm, 1, lds);
  prep_transpose(p.ffn1_wu, 1024, FFD, p.W1A, p.ffn1_norm, 2, lds);
  prep_transpose(p.ffn1_wd, FFD, 1024, p.WD1, nullptr, 0, lds);
  prep_transpose(p.w_in, 1024, NIN, p.WIN, p.mix_norm, 0, lds);
  prep_transpose(p.w_attn, 1024, 1024, p.WATT, nullptr, 0, lds);
  prep_transpose(p.w_rw, 1024, 1024, p.WRW, nullptr, 0, lds);
  prep_transpose(p.w_out, 1024, 1024, p.WOUT, nullptr, 0, lds);
  prep_transpose(p.ffn2_wg, 1024, FFD, p.W2A, p.ffn2_norm, 1, lds);
  prep_transpose(p.ffn2_wu, 1024, FFD, p.W2A, p.ffn2_norm, 2, lds);
  prep_transpose(p.ffn2_wd, FFD, 1024, p.WD2, nullptr, 0, lds);
  prep_transpose(p.rw_w2, 64, 1024, p.W2F, nullptr, 0, lds);
  prep_transpose(p.rw_w2 + 64 * 1024, 64, 1024, p.W2B, nullptr, 0, lds);
  prep_transpose(p.rw_a2, 64, 1024, p.A2F, nullptr, 0, lds);
  prep_transpose(p.rw_a2 + 64 * 1024, 64, 1024, p.A2B, nullptr, 0, lds);
  prep_transpose(p.rw_g2, 128, 1024, p.G2T, nullptr, 0, lds);
}

__device__ void phase_rows(CP& p, const Grp& G) {
  const int lane = ltid() & 63;
  const int nw = gridDim.x * 4;
  const int gw = blockIdx.x * 4 + (ltid() >> 6);
  for (int row = gw; row < G.Mx; row += nw) {
    const float* src = G.x + (size_t)row * 1024;
    float ss = 0.f;
#pragma unroll
    for (int i = 0; i < 4; ++i) {
      const f32x4 v = *(const f32x4*)(src + i * 256 + lane * 4);
      ss += v.x * v.x + v.y * v.y + v.z * v.z + v.w * v.w;
      u32x2 o = {pk_bf16(v.x, v.y), pk_bf16(v.z, v.w)};
      *(u32x2*)(p.HB + (size_t)row * 1024 + i * 256 + lane * 4) = o;
    }
    ss = wave_sum(ss);
    if (lane == 0) { p.ss0[row] = ss; p.ss1[row] = 0.f; p.ss2[row] = 0.f; p.ss3[row] = 0.f; }
  }
  if (G.meta) return;
  const int Lp = (G.L + 31) & ~31;
  for (int r = gw; r < G.nseq * 16; r += nw) {
    const int s = r >> 4, t = r & 15;
    const u16* srcp = p.PM + (size_t)t * NIN;
    u16* dstp = p.P + (size_t)(G.Mx + r) * NIN;
    for (int c = lane * 8; c < NIN; c += 512)
      if (c < 2048 || c >= 3072) *(u32x4*)(dstp + c) = *(const u32x4*)(srcp + c);
    const int pos = (t & ~12) | ((t & 4) << 1) | ((t & 8) >> 1);
    for (int c = lane; c < 1024; c += 64) p.VT[(size_t)(s * 1024 + c) * Lp + pos] = srcp[2048 + c];
  }
}

#define LAS __attribute__((address_space(3)))
#define XB_TMO      128
#define XB_XCNT(j)  (256  + 64 * (j))
#define XB_XSUB(j)  (1280 + 64 * (j))
#define XB_XGEN(j)  (2304 + 64 * (j))
#define XB_TOP      3328
#define XB_TOPGEN   3392
#define XCD_BAR_WORDS 3456
#define XB_SPIN_CAP (1u << 18)
__device__ __forceinline__ unsigned xb_ld(unsigned* p) { return __hip_atomic_load(p, __ATOMIC_RELAXED, __HIP_MEMORY_SCOPE_AGENT); }
__device__ __forceinline__ unsigned xb_add(unsigned* p, unsigned v) { return __hip_atomic_fetch_add(p, v, __ATOMIC_RELAXED, __HIP_MEMORY_SCOPE_AGENT); }
__device__ __forceinline__ unsigned xb_xcc_id() { return (unsigned)__builtin_amdgcn_s_getreg((3 << 11) | 20) & 0xFu; }
#define XB_SPIN(cond, bar) do { unsigned _sp = 0; while (cond) { __builtin_amdgcn_s_sleep(1); \
    if ((++_sp & 255u) == 0u) { if (xb_ld(&(bar)[XB_TMO])) break; if (_sp > XB_SPIN_CAP) { atomicAdd(&(bar)[XB_TMO], 1u); break; } } } } while (0)
struct XcdBarrier { unsigned* bar; unsigned x; volatile LAS unsigned* st; };
__device__ __forceinline__ XcdBarrier xcd_barrier_post(unsigned* bar, volatile LAS unsigned* st) {
  XcdBarrier b; b.bar = bar; b.x = xb_xcc_id(); b.st = st;
  if (threadIdx.x == 0) (void)xb_add(&bar[XB_XCNT(b.x)], 1u);
  return b;
}
__device__ __forceinline__ void xcd_barrier_complete(unsigned* bar, unsigned x, unsigned& nloc, unsigned& nx) {
  const unsigned G = gridDim.x * gridDim.y * gridDim.z;
  unsigned sum, cnt, mine, sp = 0u;
  for (;;) {
    sum = 0u; cnt = 0u; mine = 0u;
#pragma unroll
    for (unsigned j = 0; j < 16; ++j) { const unsigned c = xb_ld(&bar[XB_XCNT(j)]); sum += c; cnt += (c > 0u) ? 1u : 0u; mine = (j == x) ? c : mine; }
    if (sum == G) break;
    __builtin_amdgcn_s_sleep(1);
    if ((++sp & 255u) == 0u) { if (xb_ld(&bar[XB_TMO])) break; if (sp > XB_SPIN_CAP) { atomicAdd(&bar[XB_TMO], 1u); break; } }
  }
  nloc = mine > 0u ? mine : 1u; nx = cnt > 0u ? cnt : 1u;
}
__device__ __forceinline__ void xcd_barrier(const XcdBarrier& b) {
  asm volatile("s_waitcnt vmcnt(0)" ::: "memory");
  __syncthreads();
  if (threadIdx.x == 0) {
    unsigned* bar = b.bar;
    __builtin_amdgcn_s_waitcnt(0);
    unsigned nloc = b.st[0], nx = b.st[1];
    if (nloc == 0u) { xcd_barrier_complete(bar, b.x, nloc, nx); b.st[0] = nloc; b.st[1] = nx; }
    const unsigned old = xb_add(&bar[XB_XSUB(b.x)], 1u);
    const unsigned gen = old / nloc;
    if (old + 1u == (gen + 1u) * nloc) {
      __builtin_amdgcn_fence(__ATOMIC_RELEASE, "agent");
      asm volatile("s_waitcnt vmcnt(0)" ::: "memory");
      const unsigned og = xb_add(&bar[XB_TOP], 1u);
      const unsigned tg = og / nx;
      if (og + 1u == (tg + 1u) * nx) xb_add(&bar[XB_TOPGEN], 1u);
      else XB_SPIN(xb_ld(&bar[XB_TOPGEN]) == tg, bar);
      __builtin_amdgcn_fence(__ATOMIC_ACQUIRE, "agent");
      xb_add(&bar[XB_XGEN(b.x)], 1u);
      asm volatile("s_waitcnt vmcnt(0)" ::: "memory");
    } else {
      XB_SPIN(xb_ld(&bar[XB_XGEN(b.x)]) == gen, bar);
      __builtin_amdgcn_fence(__ATOMIC_ACQUIRE, "agent");
      asm volatile("s_waitcnt vmcnt(0)" ::: "memory");
    }
  }
  __syncthreads();
}

#define LAS __attribute__((address_space(3)))
#define LAS __attribute__((address_space(3)))
#define LAS __attribute__((address_space(3)))
__device__ __forceinline__ void glds16(const void* gsrc, unsigned lds_dst) {
  unsigned keep;
  asm volatile("s_mov_b32 %0, m0\n\ts_mov_b32 m0, %2\n\ts_nop 0\n\tglobal_load_lds_dwordx4 %1, off\n\ts_mov_b32 m0, %0" : "=&s"(keep) : "v"(gsrc), "s"(lds_dst) : "memory");
}
struct GemmCtx {
  const u16* ap[2];
  const u16* wp[2];
  int wro[2], wsw[2], aro[2], asw[2];
  unsigned lds0;
  int tid, h;
};
__device__ __forceinline__ void g_init(GemmCtx& c, char* lds) {
  const int tid = ltid(), lane = tid & 63, wave = tid >> 6;
  const int wn = wave & 1, wt = wave >> 1, l32 = lane & 31;
  c.tid = tid; c.h = lane >> 5;
#pragma unroll
  for (int b = 0; b < 2; ++b) {
    const int wr = wn * 64 + b * 32 + l32, ar = wt * 64 + b * 32 + l32;
    c.wro[b] = wr * 64; c.wsw[b] = (wr >> 2) & 3;
    c.aro[b] = 8192 + ar * 64; c.asw[b] = (ar >> 2) & 3;
  }
  c.lds0 = __builtin_amdgcn_readfirstlane((unsigned)(uintptr_t)(LAS char*)lds + wave * 1024);
}
__device__ __forceinline__ void g_tile(GemmCtx& c, const u16* __restrict__ A, int lda, int M, int m0, const u16* __restrict__ W, int ldw, int n0) {
#pragma unroll
  for (int i = 0; i < 2; ++i) {
    const int q = c.tid + 256 * i, row = q >> 2, ch = (q & 3) ^ ((row >> 2) & 3);
    int ar = m0 + row; ar = ar < M ? ar : M - 1;
    c.ap[i] = A + (size_t)ar * lda + ch * 8;
    c.wp[i] = W + (size_t)(n0 + row) * ldw + ch * 8;
  }
}
__device__ __forceinline__ void g_stage(const GemmCtx& c, int kt) {
  const unsigned sb = c.lds0 + (kt & 3) * 16384;
#pragma unroll
  for (int i = 0; i < 2; ++i) {
    glds16(c.wp[i] + kt * 32, sb + i * 4096);
    glds16(c.ap[i] + kt * 32, sb + 8192 + i * 4096);
  }
}
__device__ __forceinline__ void g_prologue(const GemmCtx& c, int nk) {
#pragma unroll
  for (int s = 0; s < 3; ++s)
    if (s < nk) g_stage(c, s);
}
struct Frags { bf16x8 w[2][2], a[2][2]; };
__device__ __forceinline__ void g_read(Frags& f, const GemmCtx& c, int kt, const char* lds) {
  const char* st = lds + (kt & 3) * 16384;
#pragma unroll
  for (int ks = 0; ks < 2; ++ks)
#pragma unroll
    for (int b = 0; b < 2; ++b) {
      f.w[ks][b] = *(const bf16x8*)(st + c.wro[b] + (((ks * 2 + c.h) ^ c.wsw[b]) << 4));
      f.a[ks][b] = *(const bf16x8*)(st + c.aro[b] + (((ks * 2 + c.h) ^ c.asw[b]) << 4));
    }
}
__device__ __forceinline__ void g_mma(f32x16 (&acc)[2][2], const Frags& f) {
#pragma unroll
  for (int ks = 0; ks < 2; ++ks)
#pragma unroll
    for (int nb = 0; nb < 2; ++nb)
#pragma unroll
      for (int tb = 0; tb < 2; ++tb)
        acc[nb][tb] = __builtin_amdgcn_mfma_f32_32x32x16_bf16(f.w[ks][nb], f.a[ks][tb], acc[nb][tb], 0, 0, 0);
}
__device__ __forceinline__ void g_wait(int ks_needed, int issued_hi, bool drain_all) {
  const int allowed = issued_hi - ks_needed;
  if (drain_all || allowed <= 0) asm volatile("s_waitcnt vmcnt(0) lgkmcnt(0)" ::: "memory");
  else if (allowed == 1) asm volatile("s_waitcnt vmcnt(4) lgkmcnt(0)" ::: "memory");
  else asm volatile("s_waitcnt vmcnt(8) lgkmcnt(0)" ::: "memory");
  __builtin_amdgcn_s_barrier();
}
__device__ __forceinline__ void g_main(f32x16 (&acc)[2][2], const GemmCtx& c, int nk, char* lds) {
  Frags f0, f1;
  g_wait(0, nk - 1 < 2 ? nk - 1 : 2, true);
  if (3 < nk) g_stage(c, 3);
  g_read(f0, c, 0, lds);
  for (int kt = 0; kt < nk; kt += 2) {
    {
      const int hi = (kt + 3 < nk - 1) ? kt + 3 : nk - 1;
      g_wait(kt + 1, hi, false);
      if (kt + 4 < nk) g_stage(c, kt + 4);
      g_read(f1, c, kt + 1, lds);
      g_mma(acc, f0);
    }
    if (kt + 2 < nk) {
      const int hi = (kt + 4 < nk - 1) ? kt + 4 : nk - 1;
      g_wait(kt + 2, hi, false);
      if (kt + 5 < nk) g_stage(c, kt + 5);
      g_read(f0, c, kt + 2, lds);
    }
    g_mma(acc, f1);
  }
}
__device__ __forceinline__ void gemm_kloop(f32x16 (&acc)[2][2], const u16* __restrict__ A, int lda, int M, int m0,
                                           const u16* __restrict__ W, int ldw, int n0, int K, char* lds) {
  GemmCtx c;
  g_init(c, lds);
  g_tile(c, A, lda, M, m0, W, ldw, n0);
  asm volatile("s_waitcnt vmcnt(0)" ::: "memory");
  __builtin_amdgcn_s_barrier();
  g_prologue(c, K >> 5);
  g_main(acc, c, K >> 5, lds);
}

__device__ __forceinline__ void zero_acc(f32x16 (&acc)[2][2]) {
#pragma unroll
  for (int a = 0; a < 2; ++a)
#pragma unroll
    for (int b = 0; b < 2; ++b)
#pragma unroll
      for (int r = 0; r < 16; ++r) acc[a][b][r] = 0.f;
}

template <class F>
__device__ __forceinline__ void gemm_phase(const u16* A, int lda, int M, const u16* W, int K, int N, char* lds, int* ctr, F&& epi) {
  const int nN = N >> 7, nM = (M + 127) >> 7, nt = nN * nM, nk = K >> 5;
  const int xcd = (int)xb_xcc_id() & 7;
  const int tq = nt >> 3, trm = nt & 7;
  const int tstart = xcd < trm ? xcd * (tq + 1) : trm * (tq + 1) + (xcd - trm) * tq;
  const int tcnt = tq + (xcd < trm ? 1 : 0);
  auto decode = [&](int off, int& tm, int& tn) {
    const int id = tstart + off, nig = 8 * nN, grp = id / nig, fm = grp * 8;
    const int gsz = (nM - fm) < 8 ? (nM - fm) : 8, idl = id - grp * nig;
    tm = fm + idl % gsz; tn = idl / gsz;
  };
  GemmCtx c;
  g_init(c, lds);
  const int wave = c.tid >> 6;
  volatile int* bw = (volatile int*)(lds + 65536);
  int* myctr = ctr + xcd;
  int par = 0;
  if (c.tid == 0) bw[2] = atomicAdd(myctr, 1);
  asm volatile("s_waitcnt vmcnt(0) lgkmcnt(0)" ::: "memory");
  __builtin_amdgcn_s_barrier();
  int off = bw[2];
  int tm = 0, tn = 0;
  if (off < tcnt) { decode(off, tm, tn); g_tile(c, A, lda, M, tm * 128, W, K, tn * 128); g_prologue(c, nk); }
  while (off < tcnt) {
    f32x16 acc[2][2];
    zero_acc(acc);
    g_main(acc, c, nk, lds);
    const int ctm = tm, ctn = tn;
    par ^= 1;
    if (c.tid == 0) bw[2 + par] = atomicAdd(myctr, 1);
    asm volatile("s_waitcnt lgkmcnt(0)" ::: "memory");
    __builtin_amdgcn_s_barrier();
    off = bw[2 + par];
    if (off < tcnt) { decode(off, tm, tn); g_tile(c, A, lda, M, tm * 128, W, K, tn * 128); g_prologue(c, nk); }
    epi(acc, ctn * 128 + (wave & 1) * 64, ctm * 128 + (wave >> 1) * 64);
  }
}

struct WideCtx {
  const u16* ap[4];
  const u16* wp[2];
  int wro[2], wsw[2], aro[2][2], asw[2][2];
  unsigned lds0;
  int tid, h;
};
__device__ __forceinline__ void h_init(WideCtx& c, char* lds) {
  const int tid = ltid(), lane = tid & 63, wave = tid >> 6;
  const int wn = wave & 1, wt = wave >> 1, l32 = lane & 31;
  c.tid = tid; c.h = lane >> 5;
#pragma unroll
  for (int b = 0; b < 2; ++b) {
    const int wr = wn * 64 + b * 32 + l32;
    c.wro[b] = wr * 64; c.wsw[b] = (wr >> 2) & 3;
#pragma unroll
    for (int j = 0; j < 2; ++j) {
      const int ar = j * 128 + wt * 64 + b * 32 + l32;
      c.aro[j][b] = 8192 + ar * 64; c.asw[j][b] = (ar >> 2) & 3;
    }
  }
  c.lds0 = __builtin_amdgcn_readfirstlane((unsigned)(uintptr_t)(LAS char*)lds + wave * 1024);
}
__device__ __forceinline__ void h_tile(WideCtx& c, const u16* __restrict__ A, int lda, int M, int m0, const u16* __restrict__ W, int ldw, int n0) {
#pragma unroll
  for (int i = 0; i < 2; ++i) {
    const int q = c.tid + 256 * i, row = q >> 2, ch = (q & 3) ^ ((row >> 2) & 3);
    c.wp[i] = W + (size_t)(n0 + row) * ldw + ch * 8;
  }
#pragma unroll
  for (int i = 0; i < 4; ++i) {
    const int q = c.tid + 256 * i, row = q >> 2, ch = (q & 3) ^ ((row >> 2) & 3);
    int ar = m0 + row; ar = ar < M ? ar : M - 1;
    c.ap[i] = A + (size_t)ar * lda + ch * 8;
  }
}
__device__ __forceinline__ void h_stage(const WideCtx& c, int kt) {
  const unsigned sb = c.lds0 + (kt & 1) * 24576;
#pragma unroll
  for (int i = 0; i < 2; ++i) glds16(c.wp[i] + kt * 32, sb + i * 4096);
#pragma unroll
  for (int i = 0; i < 4; ++i) glds16(c.ap[i] + kt * 32, sb + 8192 + i * 4096);
}
__device__ __forceinline__ void h_main(f32x16 (&acc0)[2][2], f32x16 (&acc1)[2][2], const WideCtx& c, int nk, char* lds) {
  const int h = c.h;
  for (int kt = 0; kt < nk; ++kt) {
    asm volatile("s_waitcnt vmcnt(0)" ::: "memory");
    __builtin_amdgcn_s_barrier();
    if (kt + 1 < nk) h_stage(c, kt + 1);
    const char* st = lds + (kt & 1) * 24576;
#pragma unroll
    for (int ks = 0; ks < 2; ++ks) {
      bf16x8 wf[2], a0[2], a1[2];
#pragma unroll
      for (int b = 0; b < 2; ++b) {
        wf[b] = *(const bf16x8*)(st + c.wro[b] + (((ks * 2 + h) ^ c.wsw[b]) << 4));
        a0[b] = *(const bf16x8*)(st + c.aro[0][b] + (((ks * 2 + h) ^ c.asw[0][b]) << 4));
        a1[b] = *(const bf16x8*)(st + c.aro[1][b] + (((ks * 2 + h) ^ c.asw[1][b]) << 4));
      }
#pragma unroll
      for (int nb = 0; nb < 2; ++nb)
#pragma unroll
        for (int tb = 0; tb < 2; ++tb) {
          acc0[nb][tb] = __builtin_amdgcn_mfma_f32_32x32x16_bf16(wf[nb], a0[tb], acc0[nb][tb], 0, 0, 0);
          acc1[nb][tb] = __builtin_amdgcn_mfma_f32_32x32x16_bf16(wf[nb], a1[tb], acc1[nb][tb], 0, 0, 0);
        }
    }
  }
}
template <class F>
__device__ __forceinline__ void gemm_phase_w(const u16* A, int lda, int M, const u16* W, int K, int N, char* lds, int* ctr, F&& epi) {
  const int nN = N >> 7, nM = (M + 255) >> 8, nt = nN * nM, nk = K >> 5;
  const int xcd = (int)xb_xcc_id() & 7;
  const int tq = nt >> 3, trm = nt & 7;
  const int tstart = xcd < trm ? xcd * (tq + 1) : trm * (tq + 1) + (xcd - trm) * tq;
  const int tcnt = tq + (xcd < trm ? 1 : 0);
  auto decode = [&](int off, int& tm, int& tn) {
    const int id = tstart + off, nig = 4 * nN, grp = id / nig, fm = grp * 4;
    const int gsz = (nM - fm) < 4 ? (nM - fm) : 4, idl = id - grp * nig;
    tm = fm + idl % gsz; tn = idl / gsz;
  };
  WideCtx c;
  h_init(c, lds);
  const int wave = c.tid >> 6;
  volatile int* bw = (volatile int*)(lds + 65536);
  int* myctr = ctr + xcd;
  int par = 0;
  if (c.tid == 0) bw[2] = atomicAdd(myctr, 1);
  asm volatile("s_waitcnt vmcnt(0) lgkmcnt(0)" ::: "memory");
  __builtin_amdgcn_s_barrier();
  int off = bw[2];
  int tm = 0, tn = 0;
  if (off < tcnt) { decode(off, tm, tn); h_tile(c, A, lda, M, tm * 256, W, K, tn * 128); h_stage(c, 0); }
  while (off < tcnt) {
    f32x16 acc0[2][2], acc1[2][2];
    zero_acc(acc0);
    zero_acc(acc1);
    h_main(acc0, acc1, c, nk, lds);
    const int ctm = tm, ctn = tn;
    par ^= 1;
    if (c.tid == 0) bw[2 + par] = atomicAdd(myctr, 1);
    asm volatile("s_waitcnt lgkmcnt(0)" ::: "memory");
    __builtin_amdgcn_s_barrier();
    off = bw[2 + par];
    if (off < tcnt) { decode(off, tm, tn); h_tile(c, A, lda, M, tm * 256, W, K, tn * 128); h_stage(c, 0); }
    epi(acc0, ctn * 128 + (wave & 1) * 64, ctm * 256 + (wave >> 1) * 64);
    epi(acc1, ctn * 128 + (wave & 1) * 64, ctm * 256 + 128 + (wave >> 1) * 64);
  }
}


__device__ __forceinline__ void epi_swiglu(const f32x16 (&acc)[2][2], int nbase, int tbase, int M, const float* ss, u16* ACT) {
  const int lane = ltid() & 63, l32 = lane & 31, h = lane >> 5;
  const int cb = (nbase >> 6) * 32;
#pragma unroll
  for (int tb = 0; tb < 2; ++tb) {
    const int tok = tbase + tb * 32 + l32;
    if (tok < M) {
      const float rs = rsqrtf(ss[tok] * (1.f / 1024.f) + EPSN);
      u16* dst = ACT + (size_t)tok * FFD + cb + 4 * h;
#pragma unroll
      for (int i = 0; i < 4; ++i) {
        float o[4];
#pragma unroll
        for (int j = 0; j < 4; ++j) {
          const float g = acc[0][tb][4 * i + j] * rs, u = acc[1][tb][4 * i + j] * rs;
          o[j] = g * sigm(g) * u;
        }
        *(u32x2*)(dst + 8 * i) = (u32x2){pk_bf16(o[0], o[1]), pk_bf16(o[2], o[3])};
      }
    }
  }
}

template <int MODE>
__device__ __forceinline__ void epi_resid(const f32x16 (&acc)[2][2], int nbase, int tbase, CP& p, const Grp& G) {
  const int lane = ltid() & 63, l32 = lane & 31, h = lane >> 5;
  const float scale = MODE == 1 ? 1.f : 0.5f;
  float* ssout = MODE == 0 ? p.ss1 : (MODE == 1 ? p.ss2 : p.ss3);
#pragma unroll
  for (int tb = 0; tb < 2; ++tb) {
    const int tok = tbase + tb * 32 + l32;
    const bool valid = tok < G.Mx;
    float sq = 0.f;
    if (valid) {
      float* hp = p.H + (size_t)tok * 1024;
      u16* hb = p.HB + (size_t)tok * 1024;
      const float* rp = G.x + (size_t)tok * 1024;
#pragma unroll
      for (int nb = 0; nb < 2; ++nb)
#pragma unroll
        for (int i = 0; i < 4; ++i) {
          const int n = nbase + nb * 32 + 8 * i + 4 * h;
          f32x4 r;
          if (MODE == 0) r = *(const f32x4*)(rp + n);
          else { const u32x2 rb = *(const u32x2*)(hb + n); r = (f32x4){bf_lo(rb.x), bf_hi(rb.x), bf_lo(rb.y), bf_hi(rb.y)}; }
          f32x4 v;
          v.x = r.x + scale * acc[nb][tb][4 * i + 0];
          v.y = r.y + scale * acc[nb][tb][4 * i + 1];
          v.z = r.z + scale * acc[nb][tb][4 * i + 2];
          v.w = r.w + scale * acc[nb][tb][4 * i + 3];
          sq += v.x * v.x + v.y * v.y + v.z * v.z + v.w * v.w;
          if (MODE == 2) *(f32x4*)(hp + n) = v;
          else *(u32x2*)(hb + n) = (u32x2){pk_bf16(v.x, v.y), pk_bf16(v.z, v.w)};
        }
    }
    sq += __shfl_xor(sq, 32);
    if (valid && h == 0) atomicAdd(ssout + tok, sq);
  }
}

__device__ void phase_mix(CP& p, const Grp& G) {
  const int total = G.M * 432;
  for (int idx = blockIdx.x * 256 + ltid(); idx < total; idx += gridDim.x * 256) {
    const int row = idx / 432, ch = idx - row * 432;
    int s, t;
    if (row < G.Mx) { s = row >> G.lgS; t = 16 + (row & (G.S - 1)); } else { s = (row - G.Mx) >> 4; t = (row - G.Mx) & 15; }
    const int col = ch * 8;
    const u16* pc = p.P + (size_t)row * NIN + 3072 + col;
    const u32x4 c = *(const u32x4*)pc;
    u32x4 pv = {0, 0, 0, 0}, nx = {0, 0, 0, 0};
    if (t > 0) pv = *(const u32x4*)(p.P + (size_t)rowof(G, s, t - 1) * NIN + 3072 + col);
    if (t < G.L - 1) nx = *(const u32x4*)(p.P + (size_t)rowof(G, s, t + 1) * NIN + 3072 + col);
    const f32x4 mp0 = *(const f32x4*)(p.mu_prev + col), mp1 = *(const f32x4*)(p.mu_prev + col + 4);
    const f32x4 mn0 = *(const f32x4*)(p.mu_next + col), mn1 = *(const f32x4*)(p.mu_next + col + 4);
    float o[8];
#pragma unroll
    for (int e = 0; e < 4; ++e) {
      const float c0 = bf_lo(c[e]), c1 = bf_hi(c[e]);
      const float mpa = e < 2 ? mp0[2 * e] : mp1[2 * e - 4], mpb = e < 2 ? mp0[2 * e + 1] : mp1[2 * e - 3];
      const float mna = e < 2 ? mn0[2 * e] : mn1[2 * e - 4], mnb = e < 2 ? mn0[2 * e + 1] : mn1[2 * e - 3];
      o[2 * e] = c0 + mpa * (bf_lo(pv[e]) - c0) + mna * (bf_lo(nx[e]) - c0);
      o[2 * e + 1] = c1 + mpb * (bf_hi(pv[e]) - c1) + mnb * (bf_hi(nx[e]) - c1);
    }
    if (col < 3072) {
      const int sec = col >> 10, ci = col & 1023, head = ci >> 6, c0 = ci & 63;
      const size_t ro = ((size_t)row * 16 + head) * 192 + sec * 64 + c0;
      const u32x4 pk = (u32x4){pk_f16(o[0], o[1]), pk_f16(o[2], o[3]), pk_f16(o[4], o[5]), pk_f16(o[6], o[7])};
      *(u32x4*)(p.RKV + ro) = pk;
      if (sec == 1) { *(u32x4*)(p.DIR0 + ro) = pk; *(u32x4*)(p.DIR1 + ro) = pk; }
    } else {
      const int fc = col - 3072;
      if (fc < 128) {
#pragma unroll
        for (int e = 0; e < 8; ++e) o[e] = 1.f - 2.f / (1.f + __expf(2.f * o[e]));
      } else if (fc >= 256) {
#pragma unroll
        for (int e = 0; e < 8; ++e) o[e] = sigm(o[e]);
      }
      *(u32x4*)(p.F + (size_t)row * 384 + fc) = (u32x4){pk_bf16(o[0], o[1]), pk_bf16(o[2], o[3]), pk_bf16(o[4], o[5]), pk_bf16(o[6], o[7])};
    }
  }
}

__device__ __forceinline__ void epi_decay(const f32x16 (&acc)[2][2], int nbase, int tbase, int M, const float* w0, u16* DIR) {
  const int lane = ltid() & 63, l32 = lane & 31, h = lane >> 5;
  const int head = nbase >> 6;
#pragma unroll
  for (int tb = 0; tb < 2; ++tb) {
    const int tok = tbase + tb * 32 + l32;
    if (tok < M) {
      u16* dst = DIR + ((size_t)tok * 16 + head) * 192;
#pragma unroll
      for (int nb = 0; nb < 2; ++nb)
#pragma unroll
        for (int i = 0; i < 4; ++i) {
          const int c = nb * 32 + 8 * i + 4 * h;
          const f32x4 w = *(const f32x4*)(w0 + nbase + c);
          float o[4];
#pragma unroll
          for (int j = 0; j < 4; ++j) o[j] = 0.6065306597126334f * sigm(w[j] + acc[nb][tb][4 * i + j]);
          *(u32x2*)(dst + c) = (u32x2){pk_f16(o[0], o[1]), pk_f16(o[2], o[3])};
        }
    }
  }
}

__device__ __forceinline__ void epi_adir(const f32x16 (&acc)[2][2], int nbase, int tbase, int M, CP& p, int dir) {
  const int lane = ltid() & 63, l32 = lane & 31, h = lane >> 5;
  const int head = nbase >> 6;
  u16* DIR = dir ? p.DIR1 : p.DIR0;
  const float* a0 = p.rw_a0 + dir * 1024;
#pragma unroll
  for (int tb = 0; tb < 2; ++tb) {
    const int tok = tbase + tb * 32 + l32;
    const bool valid = tok < M;
    const int tk = valid ? tok : M - 1;
    const size_t rec = ((size_t)tk * 16 + head) * 192;
    float nsq = 0.f;
#pragma unroll
    for (int nb = 0; nb < 2; ++nb)
#pragma unroll
      for (int i = 0; i < 4; ++i) {
        const int c = nb * 32 + 8 * i + 4 * h;
        const u32x2 kr = *(const u32x2*)(DIR + rec + 64 + c);
        const f32x4 kkw = *(const f32x4*)(p.k_k + nbase + c);
        const float q0 = h_lo(kr.x) * kkw[0], q1 = h_hi(kr.x) * kkw[1], q2 = h_lo(kr.y) * kkw[2], q3 = h_hi(kr.y) * kkw[3];
        nsq += q0 * q0 + q1 * q1 + q2 * q2 + q3 * q3;
      }
    nsq += __shfl_xor(nsq, 32);
    const float inv = 1.f / fmaxf(sqrtf(nsq), 1e-12f);
    if (valid) {
#pragma unroll
      for (int nb = 0; nb < 2; ++nb)
#pragma unroll
        for (int i = 0; i < 4; ++i) {
          const int c = nb * 32 + 8 * i + 4 * h;
          const u32x2 kr = *(const u32x2*)(DIR + rec + 64 + c);
          const float kv[4] = {h_lo(kr.x), h_hi(kr.x), h_lo(kr.y), h_hi(kr.y)};
          const f32x4 kkw = *(const f32x4*)(p.k_k + nbase + c);
          const f32x4 kaw = *(const f32x4*)(p.k_a + nbase + c);
          const f32x4 a0v = *(const f32x4*)(a0 + nbase + c);
          float kk[4], kd[4], bp[4];
#pragma unroll
          for (int j = 0; j < 4; ++j) {
            const float k = kv[j];
            kk[j] = k * kkw[j] * inv;
            const float aa = sigm(a0v[j] + acc[nb][tb][4 * i + j]);
            kd[j] = k * (1.f + (aa - 1.f) * kaw[j]);
            bp[j] = -kk[j] * aa;
          }
          if (dir == 0) *(u32x2*)(p.RKV + rec + 64 + c) = (u32x2){pk_f16(kk[0], kk[1]), pk_f16(kk[2], kk[3])};
          *(u32x2*)(DIR + rec + 64 + c) = (u32x2){pk_f16(kd[0], kd[1]), pk_f16(kd[2], kd[3])};
          *(u32x2*)(DIR + rec + 128 + c) = (u32x2){pk_f16(bp[0], bp[1]), pk_f16(bp[2], bp[3])};
        }
    }
  }
}

template <int LPR>
__device__ void scan_task(CP& p, const Grp& G, int task, char* lds) {
  constexpr int KPL = 64 / LPR, RPB = 256 / LPR, NSPLIT = 64 / RPB;
  const int part = task % NSPLIT, t1 = task / NSPLIT;
  const int dir = t1 & 1, head = (t1 >> 1) & 15, s = t1 >> 5;
  float* buf = (float*)lds;
  const u16* rkv = p.RKV;
  const u16* dr = dir ? p.DIR1 : p.DIR0;
  u16* Y = dir ? p.Y1 : p.Y0;
  const int tid = ltid();
  const int row = part * RPB + tid / LPR, kc = tid % LPR;
  const int L = G.L, nch = L >> 4;
  u32x4 pre[3];
  auto issue = [&](int c) {
#pragma unroll
    for (int i = 0; i < 3; ++i) {
      const int id = tid + 256 * i, st = id / 48, ci = id - st * 48;
      const int n = c * 16 + st, t = dir ? L - 1 - n : n;
      const size_t rec = ((size_t)rowof(G, s, t) * 16 + head) * 192;
      const u16* src = ci < 24 ? rkv + rec + ci * 8 : dr + rec + (ci - 24) * 8;
      pre[i] = *(const u32x4*)src;
    }
  };
  auto commit = [&](int b) {
#pragma unroll
    for (int i = 0; i < 3; ++i) {
      const int id = tid + 256 * i, st = id / 48, ci = id - st * 48;
      const int sec = ci >> 3;
      const int base = sec >= 3 ? (sec - 1) * 64 : (sec == 0 ? 64 : (sec == 1 ? 0 : 320));
      float f[8];
#pragma unroll
      for (int e = 0; e < 4; ++e) { f[2 * e] = h_lo(pre[i][e]); f[2 * e + 1] = h_hi(pre[i][e]); }
      if (sec == 3) {
#pragma unroll
        for (int e = 0; e < 8; ++e) f[e] = __expf(-f[e]);
      }
      float* d = buf + b * 6144 + st * 384 + base + (ci & 7) * 8;
      *(f32x4*)d = (f32x4){f[0], f[1], f[2], f[3]};
      *(f32x4*)(d + 4) = (f32x4){f[4], f[5], f[6], f[7]};
    }
  };
  float S[KPL];
#pragma unroll
  for (int i = 0; i < KPL; ++i) S[i] = 0.f;
  __syncthreads();
  issue(0);
  commit(0);
  __syncthreads();
  __builtin_amdgcn_s_setprio(3);
  for (int c = 0; c < nch; ++c) {
    if (c + 1 < nch) issue(c + 1);
    const float* b = buf + (c & 1) * 6144;
#pragma unroll 1
    for (int g0 = 0; g0 < 16; g0 += LPR) {
      float ykeep = 0.f;
#pragma unroll 2
      for (int j = 0; j < LPR; ++j) {
        const int st = g0 + j;
        const float* q = b + st * 384 + kc * KPL;
        f32x4 kk[KPL / 4], rr[KPL / 4], ww[KPL / 4], dd[KPL / 4], bb[KPL / 4];
#pragma unroll
        for (int jj = 0; jj < KPL / 4; ++jj) {
          kk[jj] = *(const f32x4*)(q + 4 * jj);
          rr[jj] = *(const f32x4*)(q + 64 + 4 * jj);
          ww[jj] = *(const f32x4*)(q + 128 + 4 * jj);
          dd[jj] = *(const f32x4*)(q + 192 + 4 * jj);
          bb[jj] = *(const f32x4*)(q + 256 + 4 * jj);
        }
        const float vv = b[st * 384 + 320 + row];
        float sa0 = 0.f, sa1 = 0.f;
#pragma unroll
        for (int jj = 0; jj < KPL / 4; ++jj) {
          sa0 += S[4 * jj] * kk[jj][0]; sa1 += S[4 * jj + 1] * kk[jj][1];
          sa0 += S[4 * jj + 2] * kk[jj][2]; sa1 += S[4 * jj + 3] * kk[jj][3];
        }
        float sa = sa0 + sa1;
        sa = LPR == 8 ? reduce8(sa) : reduce4(sa);
        float y0 = 0.f, y1 = 0.f;
#pragma unroll
        for (int jj = 0; jj < KPL / 4; ++jj)
#pragma unroll
          for (int e = 0; e < 4; ++e) {
            const float sn = S[4 * jj + e] * ww[jj][e] + (sa * bb[jj][e] + vv * dd[jj][e]);
            S[4 * jj + e] = sn;
            if (e & 1) y1 += sn * rr[jj][e]; else y0 += sn * rr[jj][e];
          }
        float y = y0 + y1;
        y = LPR == 8 ? reduce8(y) : reduce4(y);
        ykeep = (kc == j) ? y : ykeep;
      }
      const int n = c * 16 + g0 + kc, t = dir ? L - 1 - n : n;
      Y[(size_t)rowof(G, s, t) * 1024 + head * 64 + row] = bf16_1(ykeep);
    }
    if (c + 1 < nch) commit((c + 1) & 1);
    __syncthreads();
  }
  __builtin_amdgcn_s_setprio(0);
}

__device__ void attn_tile(CP& p, const Grp& G, int s, int hd, int qb, char* lds, float lam) {
  const int tid = ltid(), lane = tid & 63, wave = tid >> 6, l32 = lane & 31, h = lane >> 5;
  const int L = G.L, Lp = (G.L + 31) & ~31;
  const u16* Pb = p.P;
  float* lutl = (float*)(lds + 61440);
  __syncthreads();
  for (int i = tid; i < 511; i += 256) lutl[i] = p.lut[hd * 512 + i];
  const int q = 16 + qb * 128 + wave * 32 + l32;
  const int qc = s * G.S + (q - 16);
  const int qw0 = 16 + qb * 128 + wave * 32;
  u16* odst = p.O + (size_t)qc * 1024 + hd * 128;
  const int kkey = tid >> 3, kch = (tid & 7) ^ ((kkey >> 1) & 7);
  const u16* vsrc[2];
#pragma unroll
  for (int i = 0; i < 2; ++i) {
    const int c = tid + 256 * i, dv = c >> 2, c4 = (c & 3) ^ ((dv >> 2) & 3);
    vsrc[i] = p.VT + ((size_t)(s * 1024 + hd * 128 + dv) * Lp) + c4 * 8;
  }
  const unsigned lds0 = __builtin_amdgcn_readfirstlane((unsigned)(uintptr_t)(LAS char*)lds + wave * 1024);
  const int ntile = (L + 31) >> 5;
#pragma unroll 1
  for (int br = 0; br < 2; ++br) {
    bf16x8 qv[4];
#pragma unroll
    for (int ks = 0; ks < 4; ++ks) {
      const u32x4 raw = *(const u32x4*)(Pb + (size_t)qc * NIN + hd * 128 + br * 64 + ks * 16 + h * 8);
      u32x4 sc;
#pragma unroll
      for (int e = 0; e < 4; ++e) sc[e] = pk_bf16(bf_lo(raw[e]) * 0.125f, bf_hi(raw[e]) * 0.125f);
      qv[ks] = __builtin_bit_cast(bf16x8, sc);
    }
    const u16* kp = Pb + 1024 + hd * 128 + br * 64 + kch * 8;
    auto stage = [&](int kt) {
      const int kt0 = kt * 32;
      const unsigned sb = lds0 + (kt % 5) * 12288;
      int kr = kt0 + kkey; kr = kr < L ? kr : L - 1;
      glds16(kp + (size_t)rowof(G, s, kr) * NIN, sb);
      glds16(vsrc[0] + kt0, sb + 4096);
      glds16(vsrc[1] + kt0, sb + 8192);
    };
    f32x16 O[4];
#pragma unroll
    for (int mb = 0; mb < 4; ++mb)
#pragma unroll
      for (int r = 0; r < 16; ++r) O[mb][r] = 0.f;
    float mrun = -1e30f, lrun = 0.f;
    asm volatile("s_waitcnt vmcnt(0) lgkmcnt(0)" ::: "memory");
    __builtin_amdgcn_s_barrier();
#pragma unroll
    for (int s0 = 0; s0 < 4; ++s0)
      if (s0 < ntile) stage(s0);
    const float cneg = lutl[0], cpos = lutl[510];
    for (int kt = 0; kt < ntile; ++kt) {
      const int kt0 = kt * 32;
      {
        const int rem = ntile - 1 - kt;
        if (rem >= 3) asm volatile("s_waitcnt vmcnt(9)" ::: "memory");
        else if (rem == 2) asm volatile("s_waitcnt vmcnt(6)" ::: "memory");
        else if (rem == 1) asm volatile("s_waitcnt vmcnt(3)" ::: "memory");
        else asm volatile("s_waitcnt vmcnt(0)" ::: "memory");
      }
      __builtin_amdgcn_s_barrier();
      if (kt + 4 < ntile) stage(kt + 4);
      const char* st = lds + (kt % 5) * 12288;
      f32x16 sacc;
#pragma unroll
      for (int r = 0; r < 16; ++r) sacc[r] = 0.f;
      bf16x8 kf[4], vf[4][2];
#pragma unroll
      for (int ks = 0; ks < 4; ++ks) kf[ks] = *(const bf16x8*)(st + l32 * 128 + (((ks * 2 + h) ^ ((l32 >> 1) & 7)) << 4));
#pragma unroll
      for (int mb = 0; mb < 4; ++mb)
#pragma unroll
        for (int s2 = 0; s2 < 2; ++s2) {
          const int vr = mb * 32 + l32;
          vf[mb][s2] = *(const bf16x8*)(st + 4096 + vr * 64 + (((2 * s2 + h) ^ ((vr >> 2) & 3)) << 4));
        }
      __builtin_amdgcn_sched_barrier(0);
#pragma unroll
      for (int ks = 0; ks < 4; ++ks) sacc = __builtin_amdgcn_mfma_f32_32x32x16_bf16(kf[ks], qv[ks], sacc, 0, 0, 0);
      const bool farneg = (kt0 + 31) <= (qw0 - 128);
      const bool farpos = kt0 >= (qw0 + 31 + 128);
      float ps = 0.f, alpha;
      if ((farneg || farpos) && (kt0 + 32 <= L)) {
        const float cv = farneg ? cneg : cpos;
        float mx = fmaxf(fmaxf(sacc[0], sacc[1]), sacc[2]);
#pragma unroll
        for (int r = 3; r < 15; r += 2) mx = fmaxf(fmaxf(mx, sacc[r]), sacc[r + 1]);
        mx = fmaxf(mx, sacc[15]);
        mx = fmaxf(mx, __shfl_xor(mx, 32));
        const float mnew = fmaxf(mrun, mx * LOG2E + cv);
        alpha = __builtin_amdgcn_exp2f(mrun - mnew);
        mrun = mnew;
        const float sh = cv - mnew;
#pragma unroll
        for (int r = 0; r < 16; ++r) { sacc[r] = __builtin_amdgcn_exp2f(sacc[r] * LOG2E + sh); ps += sacc[r]; }
      } else {
        float mx = -1e30f;
        if (farneg || farpos) {
          const float cv = farneg ? cneg : cpos;
#pragma unroll
          for (int r = 0; r < 16; ++r) { sacc[r] = sacc[r] * LOG2E + cv; }
        } else {
#pragma unroll
          for (int r = 0; r < 16; ++r) {
            const int key = kt0 + 8 * (r >> 2) + 4 * h + (r & 3);
            int d = key - q + 255;
            d = d < 0 ? 0 : (d > 510 ? 510 : d);
            sacc[r] = sacc[r] * LOG2E + lutl[d];
          }
        }
        if (kt0 + 32 > L) {
#pragma unroll
          for (int r = 0; r < 16; ++r) {
            const int key = kt0 + 8 * (r >> 2) + 4 * h + (r & 3);
            if (key >= L) sacc[r] = -INFINITY;
          }
        }
#pragma unroll
        for (int r = 0; r < 16; ++r) mx = fmaxf(mx, sacc[r]);
        mx = fmaxf(mx, __shfl_xor(mx, 32));
        const float mnew = fmaxf(mrun, mx);
        alpha = __builtin_amdgcn_exp2f(mrun - mnew);
        mrun = mnew;
#pragma unroll
        for (int r = 0; r < 16; ++r) { sacc[r] = __builtin_amdgcn_exp2f(sacc[r] - mnew); ps += sacc[r]; }
      }
      lrun = lrun * alpha + ps;
      if (__any(alpha != 1.f)) {
#pragma unroll
        for (int mb = 0; mb < 4; ++mb)
#pragma unroll
          for (int r = 0; r < 16; ++r) O[mb][r] *= alpha;
      }
      bf16x8 pf[2];
#pragma unroll
      for (int s2 = 0; s2 < 2; ++s2) {
        u32x4 w;
#pragma unroll
        for (int e = 0; e < 4; ++e) w[e] = pk_bf16(sacc[8 * s2 + 2 * e], sacc[8 * s2 + 2 * e + 1]);
        pf[s2] = __builtin_bit_cast(bf16x8, w);
      }
      __builtin_amdgcn_sched_barrier(0);
#pragma unroll
      for (int s2 = 0; s2 < 2; ++s2)
#pragma unroll
        for (int mb = 0; mb < 4; ++mb)
          O[mb] = __builtin_amdgcn_mfma_f32_32x32x16_bf16(vf[mb][s2], pf[s2], O[mb], 0, 0, 0);
    }
    const float lt = lrun + __shfl_xor(lrun, 32);
    if (br == 0) {
      const float i1 = 1.f / lt;
#pragma unroll
      for (int mb = 0; mb < 4; ++mb)
#pragma unroll
        for (int i = 0; i < 4; ++i)
          if (q < L) *(u32x2*)(odst + mb * 32 + 8 * i + 4 * h) = (u32x2){pk_bf16(O[mb][4 * i] * i1, O[mb][4 * i + 1] * i1), pk_bf16(O[mb][4 * i + 2] * i1, O[mb][4 * i + 3] * i1)};
    } else {
      const float i2 = lam / lt;
      float ssq = 0.f;
#pragma unroll
      for (int mb = 0; mb < 4; ++mb)
#pragma unroll
        for (int i = 0; i < 4; ++i) {
          u32x2 w = {0, 0};
          if (q < L) w = *(const u32x2*)(odst + mb * 32 + 8 * i + 4 * h);
          const float o0 = bf_lo(w.x) - O[mb][4 * i] * i2, o1v = bf_hi(w.x) - O[mb][4 * i + 1] * i2, o2 = bf_lo(w.y) - O[mb][4 * i + 2] * i2, o3 = bf_hi(w.y) - O[mb][4 * i + 3] * i2;
          O[mb][4 * i] = o0; O[mb][4 * i + 1] = o1v; O[mb][4 * i + 2] = o2; O[mb][4 * i + 3] = o3;
          ssq += o0 * o0 + o1v * o1v + o2 * o2 + o3 * o3;
        }
      ssq += __shfl_xor(ssq, 32);
      const float rn = rsqrtf(ssq * (1.f / 128.f) + EPSN) * 0.8f;
      if (q < L) {
#pragma unroll
        for (int mb = 0; mb < 4; ++mb)
#pragma unroll
          for (int i = 0; i < 4; ++i) {
            const int dv = mb * 32 + 8 * i + 4 * h;
            const f32x4 g = *(const f32x4*)(p.subln + dv);
            *(u32x2*)(odst + dv) = (u32x2){pk_bf16(O[mb][4 * i] * rn * g.x, O[mb][4 * i + 1] * rn * g.y),
                                           pk_bf16(O[mb][4 * i + 2] * rn * g.z, O[mb][4 * i + 3] * rn * g.w)};
          }
      }
    }
  }
}

__device__ void phase_mixer(CP& p, const Grp& G, int g, char* lds) {
  if (G.nseq == 4) { for (int t = blockIdx.x; t < 256; t += gridDim.x) scan_task<8>(p, G, t, lds); }
  else { for (int t = blockIdx.x; t < 256; t += gridDim.x) scan_task<4>(p, G, t, lds); }
  const int nqb = G.S >> 7;
  const int natt = G.nseq * 8 * nqb;
  const float lam = p.lam[0];
  int* shw = (int*)(lds + 65536 - 16);
  while (true) {
    __syncthreads();
    if (ltid() == 0) *shw = atomicAdd(p.cnt + g, 1);
    __syncthreads();
    const int t = *shw;
    if (t >= natt) break;
    const int qb = t % nqb, r = t / nqb, hd = r & 7, s = r >> 3;
    attn_tile(p, G, s, hd, qb, lds, lam);
  }
}

__device__ void phase_post(CP& p, const Grp& G) {
  const int lane = ltid() & 63;
  const int nw = gridDim.x * 4;
  const int c0 = lane * 16, head = lane >> 2, hc = (lane & 3) * 16;
  for (int row = blockIdx.x * 4 + (ltid() >> 6); row < G.Mx; row += nw) {
    float y[16];
    {
      const u32x4 a0 = *(const u32x4*)(p.Y0 + (size_t)row * 1024 + c0), a1 = *(const u32x4*)(p.Y0 + (size_t)row * 1024 + c0 + 8);
      const u32x4 b0 = *(const u32x4*)(p.Y1 + (size_t)row * 1024 + c0), b1 = *(const u32x4*)(p.Y1 + (size_t)row * 1024 + c0 + 8);
#pragma unroll
      for (int e = 0; e < 4; ++e) {
        y[2 * e] = bf_lo(a0[e]) + bf_lo(b0[e]); y[2 * e + 1] = bf_hi(a0[e]) + bf_hi(b0[e]);
        y[8 + 2 * e] = bf_lo(a1[e]) + bf_lo(b1[e]); y[8 + 2 * e + 1] = bf_hi(a1[e]) + bf_hi(b1[e]);
      }
    }
    float s1 = 0.f;
#pragma unroll
    for (int e = 0; e < 16; ++e) s1 += y[e];
    s1 = reduce4(s1);
    const float mu = s1 * (1.f / 64.f);
    float s2 = 0.f;
#pragma unroll
    for (int e = 0; e < 16; ++e) { const float d = y[e] - mu; s2 += d * d; }
    s2 = reduce4(s2);
    const float rstd = rsqrtf(s2 * (1.f / 64.f) + 64e-5f);
    const size_t rec = ((size_t)row * 16 + head) * 192 + hc;
    float rr[16], vv[16], kd[16];
    {
      const u32x4 r0 = *(const u32x4*)(p.RKV + rec), r1 = *(const u32x4*)(p.RKV + rec + 8);
      const u32x4 v0 = *(const u32x4*)(p.RKV + rec + 128), v1 = *(const u32x4*)(p.RKV + rec + 136);
      const u32x4 f0 = *(const u32x4*)(p.DIR0 + rec + 64), f1 = *(const u32x4*)(p.DIR0 + rec + 72);
      const u32x4 g0 = *(const u32x4*)(p.DIR1 + rec + 64), g1 = *(const u32x4*)(p.DIR1 + rec + 72);
#pragma unroll
      for (int e = 0; e < 4; ++e) {
        rr[2 * e] = h_lo(r0[e]); rr[2 * e + 1] = h_hi(r0[e]); rr[8 + 2 * e] = h_lo(r1[e]); rr[8 + 2 * e + 1] = h_hi(r1[e]);
        vv[2 * e] = h_lo(v0[e]); vv[2 * e + 1] = h_hi(v0[e]); vv[8 + 2 * e] = h_lo(v1[e]); vv[8 + 2 * e + 1] = h_hi(v1[e]);
        kd[2 * e] = h_lo(f0[e]) + h_lo(g0[e]); kd[2 * e + 1] = h_hi(f0[e]) + h_hi(g0[e]);
        kd[8 + 2 * e] = h_lo(f1[e]) + h_lo(g1[e]); kd[8 + 2 * e + 1] = h_hi(f1[e]) + h_hi(g1[e]);
      }
    }
    float bs = 0.f;
#pragma unroll
    for (int e = 0; e < 16; ++e) bs += rr[e] * kd[e] * p.r_k[c0 + e];
    bs = reduce4(bs);
    const u32x4 g0 = *(const u32x4*)(p.G + (size_t)row * 1024 + c0), g1 = *(const u32x4*)(p.G + (size_t)row * 1024 + c0 + 8);
    float o[16];
#pragma unroll
    for (int e = 0; e < 16; ++e) {
      const unsigned gw = e < 8 ? g0[e >> 1] : g1[(e - 8) >> 1];
      const float gg = (e & 1) ? bf_hi(gw) : bf_lo(gw);
      o[e] = ((y[e] - mu) * rstd * p.lnx_w[c0 + e] + p.lnx_b[c0 + e] + bs * vv[e]) * gg;
    }
    u16* dst = (u16*)p.H + (size_t)row * 1024 + c0;
    *(u32x4*)dst = (u32x4){pk_bf16(o[0], o[1]), pk_bf16(o[2], o[3]), pk_bf16(o[4], o[5]), pk_bf16(o[6], o[7])};
    *(u32x4*)(dst + 8) = (u32x4){pk_bf16(o[8], o[9]), pk_bf16(o[10], o[11]), pk_bf16(o[12], o[13]), pk_bf16(o[14], o[15])};
  }
}

__device__ void phase_final(CP& p, const Grp& G) {
  const int lane = ltid() & 63;
  const int nw = gridDim.x * 4;
  for (int row = blockIdx.x * 4 + (ltid() >> 6); row < G.Mx; row += nw) {
    const float rs = rsqrtf(p.ss3[row] * (1.f / 1024.f) + EPSN);
    const float* hp = p.H + (size_t)row * 1024;
    float* op = G.out + (size_t)row * 1024;
#pragma unroll
    for (int i = 0; i < 4; ++i) {
      const f32x4 v = *(const f32x4*)(hp + i * 256 + lane * 4);
      const f32x4 g = *(const f32x4*)(p.final_norm + i * 256 + lane * 4);
      *(f32x4*)(op + i * 256 + lane * 4) = (f32x4){v.x * rs * g.x, v.y * rs * g.y, v.z * rs * g.z, v.w * rs * g.w};
    }
  }
}

__device__ void run_phase(CP& p, int ph, char* lds) {
  int* gctr = p.cnt + 64 + ph * 64;
  if (ph == 0) { phase_prep(p, lds); return; }
  int g, k;
  if (ph <= NMETA_PH) { g = -1; k = ph - 1; }
  else { g = (ph - 1 - NMETA_PH) / PH_PER_G; k = (ph - 1 - NMETA_PH) - g * PH_PER_G; }
  const Grp G = get_grp(p, g);
  const int Mall = G.M;
  const int M = G.Mx;
  u16* Pout = G.meta ? p.PM : p.P;
  switch (k) {
    case 0: phase_rows(p, G); break;
    case 1:
      gemm_phase_w(p.HB, 1024, M, p.W1A, 1024, 2 * FFD, lds, gctr, [&](const f32x16 (&acc)[2][2], int nb, int tb) { epi_swiglu(acc, nb, tb, M, p.ss0, p.ACT); });
      break;
    case 2:
      gemm_phase_w(p.ACT, FFD, M, p.WD1, FFD, 1024, lds, gctr, [&](const f32x16 (&acc)[2][2], int nb, int tb) { epi_resid<0>(acc, nb, tb, p, G); });
      break;
    case 3:
      gemm_phase_w(p.HB, 1024, M, p.WIN, 1024, NIN, lds, gctr, [&](const f32x16 (&acc)[2][2], int nbase, int tbase) {
        const int lane = ltid() & 63, l32 = lane & 31, h = lane >> 5;
#pragma unroll
        for (int tb = 0; tb < 2; ++tb) {
          const int tok = tbase + tb * 32 + l32;
          if (tok < M) {
            const float rs = rsqrtf(p.ss1[tok] * (1.f / 1024.f) + EPSN);
            if (!G.meta && nbase >= 2048 && nbase < 3072) {
              const int s = tok >> G.lgS, t = 16 + (tok & (G.S - 1));
              const int Lp = (G.L + 31) & ~31;
              const int pos = (t & ~12) | ((t & 4) << 1) | ((t & 8) >> 1);
              u16* vt = p.VT + ((size_t)(s * 1024 + (nbase - 2048)) * Lp) + pos;
#pragma unroll
              for (int nb = 0; nb < 2; ++nb)
#pragma unroll
                for (int r = 0; r < 16; ++r) {
                  const int dvl = nb * 32 + 8 * (r >> 2) + 4 * h + (r & 3);
                  vt[(size_t)dvl * Lp] = bf16_1(acc[nb][tb][r] * rs);
                }
            } else {
              u16* dst = Pout + (size_t)tok * NIN + nbase + 4 * h;
#pragma unroll
              for (int nb = 0; nb < 2; ++nb)
#pragma unroll
                for (int i = 0; i < 4; ++i)
                  *(u32x2*)(dst + nb * 32 + 8 * i) = (u32x2){pk_bf16(acc[nb][tb][4 * i] * rs, acc[nb][tb][4 * i + 1] * rs),
                                                             pk_bf16(acc[nb][tb][4 * i + 2] * rs, acc[nb][tb][4 * i + 3] * rs)};
            }
          }
        }
      });
      break;
    case 4: phase_mix(p, G); break;
    case 5:
      gemm_phase(p.F, 384, Mall, p.W2F, 64, 1024, lds, gctr, [&](const f32x16 (&acc)[2][2], int nb, int tb) { epi_decay(acc, nb, tb, Mall, p.rw_w0, p.DIR0); });
      gemm_phase(p.F + 64, 384, Mall, p.W2B, 64, 1024, lds, gctr + 8, [&](const f32x16 (&acc)[2][2], int nb, int tb) { epi_decay(acc, nb, tb, Mall, p.rw_w0 + 1024, p.DIR1); });
      gemm_phase(p.F + 128, 384, Mall, p.A2F, 64, 1024, lds, gctr + 16, [&](const f32x16 (&acc)[2][2], int nb, int tb) { epi_adir(acc, nb, tb, Mall, p, 0); });
      gemm_phase(p.F + 192, 384, Mall, p.A2B, 64, 1024, lds, gctr + 24, [&](const f32x16 (&acc)[2][2], int nb, int tb) { epi_adir(acc, nb, tb, Mall, p, 1); });
      gemm_phase(p.F + 256, 384, Mall, p.G2T, 128, 1024, lds, gctr + 32, [&](const f32x16 (&acc)[2][2], int nbase, int tbase) {
        const int lane = ltid() & 63, l32 = lane & 31, h = lane >> 5;
#pragma unroll
        for (int tb = 0; tb < 2; ++tb) {
          const int tok = tbase + tb * 32 + l32;
          if (tok < Mall) {
            u16* dst = p.G + (size_t)tok * 1024 + nbase + 4 * h;
#pragma unroll
            for (int nb = 0; nb < 2; ++nb)
#pragma unroll
              for (int i = 0; i < 4; ++i)
                *(u32x2*)(dst + nb * 32 + 8 * i) = (u32x2){pk_bf16(acc[nb][tb][4 * i], acc[nb][tb][4 * i + 1]), pk_bf16(acc[nb][tb][4 * i + 2], acc[nb][tb][4 * i + 3])};
          }
        }
      });
      break;
    case 6: phase_mixer(p, G, g, lds); break;
    case 7: phase_post(p, G); break;
    case 8: {
      const int nN = 8, nM = (M + 255) >> 8, nt = nN * nM;
      const int wave = ltid() >> 6;
      const int lane = ltid() & 63, l32 = lane & 31, h = lane >> 5;
      const int xcd = blockIdx.x & 7, g8 = gridDim.x >> 3;
      const int tq = nt >> 3, trm = nt & 7;
      const int tstart = xcd < trm ? xcd * (tq + 1) : trm * (tq + 1) + (xcd - trm) * tq;
      const int tcnt = tq + (xcd < trm ? 1 : 0);
      WideCtx c;
      h_init(c, lds);
      for (int off = blockIdx.x >> 3; off < tcnt; off += g8) {
        const int id = tstart + off, nig = 4 * nN, grp = id / nig, fm = grp * 4;
        const int gsz = (nM - fm) < 4 ? (nM - fm) : 4, idl = id - grp * nig;
        const int tm = fm + idl % gsz, tn = idl / gsz;
        const int nbase = tn * 128 + (wave & 1) * 64;
#pragma unroll 1
        for (int pass = 0; pass < 2; ++pass) {
          f32x16 acc0[2][2], acc1[2][2];
          zero_acc(acc0);
          zero_acc(acc1);
          h_tile(c, pass ? (const u16*)p.H : p.O, 1024, M, tm * 256, pass ? p.WRW : p.WATT, 1024, tn * 128);
          asm volatile("s_waitcnt vmcnt(0) lgkmcnt(0)" ::: "memory");
          __builtin_amdgcn_s_barrier();
          h_stage(c, 0);
          h_main(acc0, acc1, c, 32, lds);
          auto epi = [&](const f32x16 (&acc)[2][2], int tbase) {
#pragma unroll
            for (int tb = 0; tb < 2; ++tb) {
              const int tok = tbase + tb * 32 + l32;
              if (tok < M) {
                const u16* gp = p.P + (size_t)tok * NIN + 6528 + pass * 1024 + nbase + 4 * h;
                u16* dst = p.MERGED + (size_t)tok * 1024 + nbase + 4 * h;
#pragma unroll
                for (int nb = 0; nb < 2; ++nb)
#pragma unroll
                  for (int i = 0; i < 4; ++i) {
                    const u32x2 ga = *(const u32x2*)(gp + nb * 32 + 8 * i);
                    float o0 = sigm(bf_lo(ga.x)) * acc[nb][tb][4 * i];
                    float o1 = sigm(bf_hi(ga.x)) * acc[nb][tb][4 * i + 1];
                    float o2 = sigm(bf_lo(ga.y)) * acc[nb][tb][4 * i + 2];
                    float o3 = sigm(bf_hi(ga.y)) * acc[nb][tb][4 * i + 3];
                    if (pass) {
                      const u32x2 pv = *(const u32x2*)(dst + nb * 32 + 8 * i);
                      o0 += bf_lo(pv.x); o1 += bf_hi(pv.x); o2 += bf_lo(pv.y); o3 += bf_hi(pv.y);
                    }
                    *(u32x2*)(dst + nb * 32 + 8 * i) = (u32x2){pk_bf16(o0, o1), pk_bf16(o2, o3)};
                  }
              }
            }
          };
          epi(acc0, tm * 256 + (wave >> 1) * 64);
          epi(acc1, tm * 256 + 128 + (wave >> 1) * 64);
        }
      }
    } break;
    case 9:
      gemm_phase_w(p.MERGED, 1024, M, p.WOUT, 1024, 1024, lds, gctr, [&](const f32x16 (&acc)[2][2], int nb, int tb) { epi_resid<1>(acc, nb, tb, p, G); });
      break;
    case 10:
      gemm_phase_w(p.HB, 1024, M, p.W2A, 1024, 2 * FFD, lds, gctr, [&](const f32x16 (&acc)[2][2], int nb, int tb) { epi_swiglu(acc, nb, tb, M, p.ss2, p.ACT); });
      break;
    case 11:
      gemm_phase_w(p.ACT, FFD, M, p.WD2, FFD, 1024, lds, gctr, [&](const f32x16 (&acc)[2][2], int nb, int tb) { epi_resid<2>(acc, nb, tb, p, G); });
      break;
    case 12: phase_final(p, G); break;
  }
}

__global__ void __launch_bounds__(256, 2) mega(Params p, int ph_lo, int ph_hi, int coop) {
  __shared__ __attribute__((aligned(16))) char lds[65536 + 16];
  uint4& xb_words = *(uint4*)(lds + 65536);
  CP* pp = (CP*)__builtin_amdgcn_kernarg_segment_ptr();
  asm volatile("" : "+s"(pp));
  if (threadIdx.x == 0) xb_words = make_uint4(0u, 0u, 0u, 0u);
  __syncthreads();
  const XcdBarrier xb = xcd_barrier_post(pp->bar, (volatile LAS unsigned*)&xb_words);
  for (int ph = ph_lo; ph < ph_hi; ++ph) {
    run_phase(*pp, ph, lds);
    if (coop && ph + 1 < ph_hi) {
      if (ph == 0) cg::this_grid().sync();
      else xcd_barrier(xb);
    }
  }
}

extern "C" void kernel_launch(void* const* d_in, const int* in_sizes, int n_in, void* d_out, int out_size, void* d_ws,
                              size_t ws_size, hipStream_t stream) {
  Params p;
  memset(&p, 0, sizeof(p));
  const float** f = (const float**)&p;
  for (int i = 0; i < 35; ++i) f[i] = (const float*)d_in[i];
  p.out = (float*)d_out;
  char* w = (char*)d_ws;
  size_t off = 0;
  auto alloc = [&](size_t bytes) { char* r = w + off; off += (bytes + 255) & ~(size_t)255; return r; };
  p.W1A = (u16*)alloc((size_t)2 * FFD * 1024 * 2);
  p.WD1 = (u16*)alloc((size_t)1024 * FFD * 2);
  p.WIN = (u16*)alloc((size_t)NIN * 1024 * 2);
  p.WATT = (u16*)alloc((size_t)1024 * 1024 * 2);
  p.WRW = (u16*)alloc((size_t)1024 * 1024 * 2);
  p.WOUT = (u16*)alloc((size_t)1024 * 1024 * 2);
  p.W2A = (u16*)alloc((size_t)2 * FFD * 1024 * 2);
  p.WD2 = (u16*)alloc((size_t)1024 * FFD * 2);
  p.W2F = (u16*)alloc((size_t)1024 * 64 * 2);
  p.W2B = (u16*)alloc((size_t)1024 * 64 * 2);
  p.A2F = (u16*)alloc((size_t)1024 * 64 * 2);
  p.A2B = (u16*)alloc((size_t)1024 * 64 * 2);
  p.G2T = (u16*)alloc((size_t)1024 * 128 * 2);
  p.lut = (float*)alloc(8 * 512 * 4);
  p.cnt = (int*)alloc((64 + NPHASES * 64) * 4);
  p.lam = (float*)alloc(256);
  p.bar = (unsigned*)alloc(XCD_BAR_WORDS * 4);
  const size_t R = MAXROWS;
  p.H = (float*)alloc(R * 1024 * 4);
  p.HB = (u16*)alloc(R * 1024 * 2);
  p.ACT = (u16*)alloc(R * FFD * 2);
  p.Y0 = p.ACT;
  p.Y1 = p.ACT + R * 1024;
  p.F = p.ACT + R * 2048;
  p.P = (u16*)alloc(R * NIN * 2);
  p.RKV = (u16*)alloc(R * 16 * 192 * 2);
  p.DIR0 = (u16*)alloc(R * 16 * 192 * 2);
  p.DIR1 = (u16*)alloc(R * 16 * 192 * 2);
  p.G = (u16*)alloc(R * 1024 * 2);
  p.O = (u16*)alloc(R * 1024 * 2);
  p.MERGED = (u16*)alloc(R * 1024 * 2);
  p.VT = (u16*)alloc((size_t)8 * 8 * 128 * 2080 * 2);
  p.PM = (u16*)alloc((size_t)16 * NIN * 2);
  p.ss0 = (float*)alloc(R * 4);
  p.ss1 = (float*)alloc(R * 4);
  p.ss2 = (float*)alloc(R * 4);
  p.ss3 = (float*)alloc(R * 4);
  if (off > ws_size) { fprintf(stderr, "workspace too small: need %zu have %zu\n", off, ws_size); return; }
  static int grid_blocks = 0;
  if (!grid_blocks) {
    int dev = 0, cus = 0, per_cu = 0;
    hipGetDevice(&dev);
    hipDeviceGetAttribute(&cus, hipDeviceAttributeMultiprocessorCount, dev);
    hipOccupancyMaxActiveBlocksPerMultiprocessor(&per_cu, mega, 256, 0);
    per_cu = 2;
    grid_blocks = cus * per_cu;
  }
  hipMemsetAsync(p.bar, 0, XCD_BAR_WORDS * 4, stream);
  hipMemsetAsync(p.cnt, 0, (64 + NPHASES * 64) * 4, stream);
  int ph_lo = 0, ph_hi = NPHASES, coop = 1;
  void* args[] = {&p, &ph_lo, &ph_hi, &coop};
  hipError_t e = hipLaunchCooperativeKernel((void*)mega, dim3(grid_blocks), dim3(256), args, 0, stream);
  if (e != hipSuccess) fprintf(stderr, "cooperative launch failed: %s (grid %d)\n", hipGetErrorString(e), grid_blocks);
}
```

```cpp
#include <hip/hip_runtime.h>
#include <hip/hip_cooperative_groups.h>
#include <stdint.h>
#include <string.h>
#include <stdio.h>
namespace cg = cooperative_groups;

typedef unsigned short u16;
typedef short bf16x8 __attribute__((ext_vector_type(8)));
typedef float f32x16 __attribute__((ext_vector_type(16)));
typedef float f32x4 __attribute__((ext_vector_type(4)));
typedef float f32x2 __attribute__((ext_vector_type(2)));
typedef unsigned u32x4 __attribute__((ext_vector_type(4)));
typedef unsigned u32x2 __attribute__((ext_vector_type(2)));
typedef __bf16 bf16x2_t __attribute__((ext_vector_type(2)));
typedef _Float16 f16x2_t __attribute__((ext_vector_type(2)));

#define NIN 8576
#define FFD 2816
#define EPSN 1e-6f
#define LOG2E 1.4426950408889634f
#define NGROUPS 6
#define PH_PER_G 13
#define NMETA_PH 4
#define NPHASES (1 + NMETA_PH + NGROUPS * PH_PER_G)
#define MAXROWS 16512

struct Params {
  const float *x_prompt, *x_sample, *meta, *rel_bias, *ffn1_norm, *ffn1_wg, *ffn1_wu, *ffn1_wd, *mix_norm, *w_in;
  const float *lq1, *lk1, *lq2, *lk2, *subln, *w_attn, *mu_prev, *mu_next, *rw_w0, *rw_w2, *rw_a0, *rw_a2, *rw_g2;
  const float *k_k, *k_a, *r_k, *lnx_w, *lnx_b, *w_rw, *w_out, *ffn2_norm, *ffn2_wg, *ffn2_wu, *ffn2_wd, *final_norm;
  float* out;
  u16 *W1A, *WD1, *WIN, *WATT, *WRW, *WOUT, *W2A, *WD2, *W2F, *W2B, *A2F, *A2B, *G2T;
  float* lut; int* cnt; float* lam; unsigned* bar; u16* VT; u16* PM;
  float* H; u16 *HB, *ACT, *P, *RKV, *DIR0, *DIR1, *G, *O, *MERGED, *Y0, *Y1, *F;
  float *ss0, *ss1, *ss2, *ss3;
};

typedef const Params __attribute__((address_space(4))) CP;
struct Grp { int nseq, L, S, lgS, M, Mx, meta; const float* x; float* out; };
__device__ __forceinline__ int rowof(const Grp& G, int s, int t) { return t < 16 ? G.Mx + s * 16 + t : s * G.S + (t - 16); }

__device__ __forceinline__ Grp get_grp(CP& p, int g) {
  Grp r;
  r.meta = 0;
  if (g < 0) {
    r.nseq = 1; r.L = 16; r.S = 16; r.lgS = 4; r.x = p.meta; r.out = nullptr; r.M = 16; r.Mx = 16; r.meta = 1;
    return r;
  }
  if (g < 4) { r.nseq = 4; r.L = 4112; r.S = 4096; r.lgS = 12; r.x = p.x_prompt + (size_t)g * 4 * 4096 * 1024; r.out = p.out + (size_t)g * 4 * 4096 * 1024; }
  else { r.nseq = 8; r.L = 2064; r.S = 2048; r.lgS = 11; r.x = p.x_sample + (size_t)(g - 4) * 8 * 2048 * 1024; r.out = p.out + (size_t)16 * 4096 * 1024 + (size_t)(g - 4) * 8 * 2048 * 1024; }
  r.M = r.nseq * r.L;
  r.Mx = r.nseq * r.S;
  return r;
}

__device__ __forceinline__ int ltid() { int t = threadIdx.x; asm volatile("" : "+v"(t)); return t; }
__device__ __forceinline__ unsigned pk_bf16(float a, float b) {
  f32x2 v = {a, b};
  bf16x2_t r = __builtin_convertvector(v, bf16x2_t);
  return __builtin_bit_cast(unsigned, r);
}
__device__ __forceinline__ float bf_lo(unsigned u) { return __uint_as_float(u << 16); }
__device__ __forceinline__ float bf_hi(unsigned u) { return __uint_as_float(u & 0xffff0000u); }
__device__ __forceinline__ unsigned pk_f16(float a, float b) {
  f32x2 v = {a, b};
  f16x2_t r = __builtin_convertvector(v, f16x2_t);
  return __builtin_bit_cast(unsigned, r);
}
__device__ __forceinline__ float h_lo(unsigned u) { f16x2_t r = __builtin_bit_cast(f16x2_t, u); return (float)r.x; }
__device__ __forceinline__ float h_hi(unsigned u) { f16x2_t r = __builtin_bit_cast(f16x2_t, u); return (float)r.y; }
__device__ __forceinline__ u16 bf16_1(float a) { return (u16)(pk_bf16(a, 0.f) & 0xffffu); }
__device__ __forceinline__ float sigm(float x) { return __builtin_amdgcn_rcpf(1.f + __builtin_amdgcn_exp2f(-LOG2E * x)); }
__device__ __forceinline__ float wave_sum(float v) {
#pragma unroll
  for (int o = 32; o > 0; o >>= 1) v += __shfl_xor(v, o);
  return v;
}
template <int CTRL> __device__ __forceinline__ float dppf(float x) {
  return __int_as_float(__builtin_amdgcn_update_dpp(0, __float_as_int(x), CTRL, 0xf, 0xf, true));
}
__device__ __forceinline__ float reduce8(float x) {
  x += dppf<0xB1>(x);
  x += dppf<0x4E>(x);
  x += dppf<0x141>(x);
  return x;
}
__device__ __forceinline__ float reduce4(float x) {
  x += dppf<0xB1>(x);
  x += dppf<0x4E>(x);
  return x;
}

__device__ void prep_transpose(const float* __restrict__ src, int K, int N, u16* __restrict__ dst,
                               const float* __restrict__ gain, int mode, char* lds) {
  float* tile = (float*)lds;
  const int tn = N / 64, nt = (K / 64) * tn;
  const int tid = ltid();
  for (int t = blockIdx.x; t < nt; t += gridDim.x) {
    const int k0 = (t / tn) * 64, n0 = (t % tn) * 64;
    const int nl = tid & 63, kq = tid >> 6;
#pragma unroll
    for (int i = 0; i < 16; ++i) {
      const int k = i * 4 + kq;
      float v = src[(size_t)(k0 + k) * N + n0 + nl];
      if (gain) v *= gain[k0 + k];
      tile[k * 65 + nl] = v;
    }
    __syncthreads();
    const int n = tid >> 2, kk = (tid & 3) * 16;
    unsigned w[8];
#pragma unroll
    for (int i = 0; i < 8; ++i) w[i] = pk_bf16(tile[(kk + 2 * i) * 65 + n], tile[(kk + 2 * i + 1) * 65 + n]);
    const int ng = n0 + n;
    const int row = mode == 0 ? ng : ((ng >> 5) * 64 + (ng & 31) + (mode == 2 ? 32 : 0));
    u32x4* d = (u32x4*)(dst + (size_t)row * K + k0 + kk);
    d[0] = (u32x4){w[0], w[1], w[2], w[3]};
    d[1] = (u32x4){w[4], w[5], w[6], w[7]};
    __syncthreads();
  }
}

__device__ void phase_prep(CP& p, char* lds) {
  if (blockIdx.x == 0) {
    const int tid = ltid();
    for (int idx = tid; idx < 8 * 511; idx += 256) {
      const int hd = idx / 511, di = idx - hd * 511, d = di - 255;
      const int n = d < 0 ? -d : d;
      int bk;
      if (n < 8) bk = n;
      else {
        const float nf = (float)n;
        int large = 8 + (int)(logf(nf / 8.0f) / 2.772588722239781f * 8.0f);
        bk = large < 15 ? large : 15;
      }
      const int bucket = (d > 0 ? 16 : 0) + bk;
      p.lut[hd * 512 + di] = p.rel_bias[bucket * 8 + hd] * LOG2E;
    }
    if (tid == 0) {
      float s1 = 0.f, s2 = 0.f;
      for (int i = 0; i < 64; ++i) { s1 += p.lq1[i] * p.lk1[i]; s2 += p.lq2[i] * p.lk2[i]; }
      p.lam[0] = expf(s1) - expf(s2) + 0.2f;
    }
  }
  prep_transpose(p.ffn1_wg, 1024, FFD, p.W1A, p.ffn1_norm, 1, lds);
  prep_transpose(p.ffn1_wu, 1024, FFD, p.W1A, p.ffn1_norm, 2, lds);
  prep_transpose(p.ffn1_wd, FFD, 1024, p.WD1, nullptr, 0, lds);
  prep_transpose(p.w_in, 1024, NIN, p.WIN, p.mix_norm, 0, lds);
  prep_transpose(p.w_attn, 1024, 1024, p.WATT, nullptr, 0, lds);
  prep_transpose(p.w_rw, 1024, 1024, p.WRW, nullptr, 0, lds);
  prep_transpose(p.w_out, 1024, 1024, p.WOUT, nullptr, 0, lds);
  prep_transpose(p.ffn2_wg, 1024, FFD, p.W2A, p.ffn2_norm, 1, lds);
  prep_transpose(p.ffn2_wu, 1024, FFD, p.W2A, p.ffn2_norm, 2, lds);
  prep_transpose(p.ffn2_wd, FFD, 1024, p.WD2, nullptr, 0, lds);
  prep_transpose(p.rw_w2, 64, 1024, p.W2F, nullptr, 0, lds);
  prep_transpose(p.rw_w2 + 64 * 1024, 64, 1024, p.W2B, nullptr, 0, lds);
  prep_transpose(p.rw_a2, 64, 1024, p.A2F, nullptr, 0, lds);
  prep_transpose(p.rw_a2 + 64 * 1024, 64, 1024, p.A2B, nullptr, 0, lds);
  prep_transpose(p.rw_g2, 128, 1024, p.G2T, nullptr, 0, lds);
}

__device__ void phase_rows(CP& p, const Grp& G) {
  const int lane = ltid() & 63;
  const int nw = gridDim.x * 4;
  const int gw = blockIdx.x * 4 + (ltid() >> 6);
#pragma unroll 2
  for (int row = gw; row < G.Mx; row += nw) {
    const float* src = G.x + (size_t)row * 1024;
    float ss = 0.f;
#pragma unroll
    for (int i = 0; i < 4; ++i) {
      const f32x4 v = *(const f32x4*)(src + i * 256 + lane * 4);
      ss += v.x * v.x + v.y * v.y + v.z * v.z + v.w * v.w;
      u32x2 o = {pk_bf16(v.x, v.y), pk_bf16(v.z, v.w)};
      *(u32x2*)(p.HB + (size_t)row * 1024 + i * 256 + lane * 4) = o;
    }
    ss = wave_sum(ss);
    if (lane == 0) { p.ss0[row] = ss; p.ss1[row] = 0.f; p.ss2[row] = 0.f; p.ss3[row] = 0.f; }
  }
  if (G.meta) return;
  const int Lp = (G.L + 63) & ~63;
  for (int r = gw; r < G.nseq * 16; r += nw) {
    const int s = r >> 4, t = r & 15;
    const u16* srcp = p.PM + (size_t)t * NIN;
    u16* dstp = p.P + (size_t)(G.Mx + r) * NIN;
    for (int c = lane * 8; c < NIN; c += 512)
      if (c < 2048 || c >= 3072) *(u32x4*)(dstp + c) = *(const u32x4*)(srcp + c);
    const int pos = (t & ~12) | ((t & 4) << 1) | ((t & 8) >> 1);
    for (int c = lane; c < 1024; c += 64) p.VT[(size_t)(s * 1024 + c) * Lp + pos] = srcp[2048 + c];
  }
}

#define LAS __attribute__((address_space(3)))
#define XB_TMO      128
#define XB_XCNT(j)  (256  + 64 * (j))
#define XB_XSUB(j)  (1280 + 64 * (j))
#define XB_XGEN(j)  (2304 + 64 * (j))
#define XB_TOP      3328
#define XB_TOPGEN   3392
#define XCD_BAR_WORDS 3456
#define XB_SPIN_CAP (1u << 18)
__device__ __forceinline__ unsigned xb_ld(unsigned* p) { return __hip_atomic_load(p, __ATOMIC_RELAXED, __HIP_MEMORY_SCOPE_AGENT); }
__device__ __forceinline__ unsigned xb_add(unsigned* p, unsigned v) { return __hip_atomic_fetch_add(p, v, __ATOMIC_RELAXED, __HIP_MEMORY_SCOPE_AGENT); }
__device__ __forceinline__ unsigned xb_xcc_id() { return (unsigned)__builtin_amdgcn_s_getreg((3 << 11) | 20) & 0xFu; }
#define XB_SPIN(cond, bar) do { unsigned _sp = 0; while (cond) { __builtin_amdgcn_s_sleep(1); \
    if ((++_sp & 255u) == 0u) { if (xb_ld(&(bar)[XB_TMO])) break; if (_sp > XB_SPIN_CAP) { atomicAdd(&(bar)[XB_TMO], 1u); break; } } } } while (0)
struct XcdBarrier { unsigned* bar; unsigned x; volatile LAS unsigned* st; };
__device__ __forceinline__ XcdBarrier xcd_barrier_post(unsigned* bar, volatile LAS unsigned* st) {
  XcdBarrier b; b.bar = bar; b.x = xb_xcc_id(); b.st = st;
  if (threadIdx.x == 0) (void)xb_add(&bar[XB_XCNT(b.x)], 1u);
  return b;
}
__device__ __forceinline__ void xcd_barrier_complete(unsigned* bar, unsigned x, unsigned& nloc, unsigned& nx) {
  const unsigned G = gridDim.x * gridDim.y * gridDim.z;
  unsigned sum, cnt, mine, sp = 0u;
  for (;;) {
    sum = 0u; cnt = 0u; mine = 0u;
#pragma unroll
    for (unsigned j = 0; j < 16; ++j) { const unsigned c = xb_ld(&bar[XB_XCNT(j)]); sum += c; cnt += (c > 0u) ? 1u : 0u; mine = (j == x) ? c : mine; }
    if (sum == G) break;
    __builtin_amdgcn_s_sleep(1);
    if ((++sp & 255u) == 0u) { if (xb_ld(&bar[XB_TMO])) break; if (sp > XB_SPIN_CAP) { atomicAdd(&bar[XB_TMO], 1u); break; } }
  }
  nloc = mine > 0u ? mine : 1u; nx = cnt > 0u ? cnt : 1u;
}
__device__ __forceinline__ void xcd_barrier(const XcdBarrier& b) {
  asm volatile("s_waitcnt vmcnt(0)" ::: "memory");
  __syncthreads();
  if (threadIdx.x == 0) {
    unsigned* bar = b.bar;
    __builtin_amdgcn_s_waitcnt(0);
    unsigned nloc = b.st[0], nx = b.st[1];
    if (nloc == 0u) { xcd_barrier_complete(bar, b.x, nloc, nx); b.st[0] = nloc; b.st[1] = nx; }
    const unsigned old = xb_add(&bar[XB_XSUB(b.x)], 1u);
    const unsigned gen = old / nloc;
    if (old + 1u == (gen + 1u) * nloc) {
      __builtin_amdgcn_fence(__ATOMIC_RELEASE, "agent");
      asm volatile("s_waitcnt vmcnt(0)" ::: "memory");
      const unsigned og = xb_add(&bar[XB_TOP], 1u);
      const unsigned tg = og / nx;
      if (og + 1u == (tg + 1u) * nx) xb_add(&bar[XB_TOPGEN], 1u);
      else XB_SPIN(xb_ld(&bar[XB_TOPGEN]) == tg, bar);
      __builtin_amdgcn_fence(__ATOMIC_ACQUIRE, "agent");
      xb_add(&bar[XB_XGEN(b.x)], 1u);
      asm volatile("s_waitcnt vmcnt(0)" ::: "memory");
    } else {
      XB_SPIN(xb_ld(&bar[XB_XGEN(b.x)]) == gen, bar);
      __builtin_amdgcn_fence(__ATOMIC_ACQUIRE, "agent");
      asm volatile("s_waitcnt vmcnt(0)" ::: "memory");
    }
  }
  __syncthreads();
}

#define LAS __attribute__((address_space(3)))
#define LAS __attribute__((address_space(3)))
#define LAS __attribute__((address_space(3)))
__device__ __forceinline__ void glds16(const void* gsrc, unsigned lds_dst) {
  unsigned keep;
  asm volatile("s_mov_b32 %0, m0\n\ts_mov_b32 m0, %2\n\ts_nop 0\n\tglobal_load_lds_dwordx4 %1, off\n\ts_mov_b32 m0, %0" : "=&s"(keep) : "v"(gsrc), "s"(lds_dst) : "memory");
}
struct GemmCtx {
  const u16* ap[2];
  const u16* wp[2];
  int wro[2], wsw[2], aro[2], asw[2];
  unsigned lds0;
  int tid, h;
};
__device__ __forceinline__ void g_init(GemmCtx& c, char* lds) {
  const int tid = ltid(), lane = tid & 63, wave = tid >> 6;
  const int wn = wave & 1, wt = wave >> 1, l32 = lane & 31;
  c.tid = tid; c.h = lane >> 5;
#pragma unroll
  for (int b = 0; b < 2; ++b) {
    const int wr = wn * 64 + b * 32 + l32, ar = wt * 64 + b * 32 + l32;
    c.wro[b] = wr * 64; c.wsw[b] = (wr >> 2) & 3;
    c.aro[b] = 8192 + ar * 64; c.asw[b] = (ar >> 2) & 3;
  }
  c.lds0 = __builtin_amdgcn_readfirstlane((unsigned)(uintptr_t)(LAS char*)lds + wave * 1024);
}
__device__ __forceinline__ void g_tile(GemmCtx& c, const u16* __restrict__ A, int lda, int M, int m0, const u16* __restrict__ W, int ldw, int n0) {
#pragma unroll
  for (int i = 0; i < 2; ++i) {
    const int q = c.tid + 256 * i, row = q >> 2, ch = (q & 3) ^ ((row >> 2) & 3);
    int ar = m0 + row; ar = ar < M ? ar : M - 1;
    c.ap[i] = A + (size_t)ar * lda + ch * 8;
    c.wp[i] = W + (size_t)(n0 + row) * ldw + ch * 8;
  }
}
__device__ __forceinline__ void g_stage(const GemmCtx& c, int kt) {
  const unsigned sb = c.lds0 + (kt & 3) * 16384;
#pragma unroll
  for (int i = 0; i < 2; ++i) {
    glds16(c.wp[i] + kt * 32, sb + i * 4096);
    glds16(c.ap[i] + kt * 32, sb + 8192 + i * 4096);
  }
}
__device__ __forceinline__ void g_prologue(const GemmCtx& c, int nk) {
#pragma unroll
  for (int s = 0; s < 3; ++s)
    if (s < nk) g_stage(c, s);
}
struct Frags { bf16x8 w[2][2], a[2][2]; };
__device__ __forceinline__ void g_read(Frags& f, const GemmCtx& c, int kt, const char* lds) {
  const char* st = lds + (kt & 3) * 16384;
#pragma unroll
  for (int ks = 0; ks < 2; ++ks)
#pragma unroll
    for (int b = 0; b < 2; ++b) {
      f.w[ks][b] = *(const bf16x8*)(st + c.wro[b] + (((ks * 2 + c.h) ^ c.wsw[b]) << 4));
      f.a[ks][b] = *(const bf16x8*)(st + c.aro[b] + (((ks * 2 + c.h) ^ c.asw[b]) << 4));
    }
}
__device__ __forceinline__ void g_mma(f32x16 (&acc)[2][2], const Frags& f) {
#pragma unroll
  for (int ks = 0; ks < 2; ++ks)
#pragma unroll
    for (int nb = 0; nb < 2; ++nb)
#pragma unroll
      for (int tb = 0; tb < 2; ++tb)
        acc[nb][tb] = __builtin_amdgcn_mfma_f32_32x32x16_bf16(f.w[ks][nb], f.a[ks][tb], acc[nb][tb], 0, 0, 0);
}
__device__ __forceinline__ void g_wait(int ks_needed, int issued_hi, bool drain_all) {
  const int allowed = issued_hi - ks_needed;
  if (drain_all || allowed <= 0) asm volatile("s_waitcnt vmcnt(0) lgkmcnt(0)" ::: "memory");
  else if (allowed == 1) asm volatile("s_waitcnt vmcnt(4) lgkmcnt(0)" ::: "memory");
  else asm volatile("s_waitcnt vmcnt(8) lgkmcnt(0)" ::: "memory");
  __builtin_amdgcn_s_barrier();
}
__device__ __forceinline__ void g_main(f32x16 (&acc)[2][2], const GemmCtx& c, int nk, char* lds) {
  Frags f0, f1;
  g_wait(0, nk - 1 < 2 ? nk - 1 : 2, true);
  if (3 < nk) g_stage(c, 3);
  g_read(f0, c, 0, lds);
  for (int kt = 0; kt < nk; kt += 2) {
    {
      const int hi = (kt + 3 < nk - 1) ? kt + 3 : nk - 1;
      g_wait(kt + 1, hi, false);
      if (kt + 4 < nk) g_stage(c, kt + 4);
      g_read(f1, c, kt + 1, lds);
      g_mma(acc, f0);
    }
    if (kt + 2 < nk) {
      const int hi = (kt + 4 < nk - 1) ? kt + 4 : nk - 1;
      g_wait(kt + 2, hi, false);
      if (kt + 5 < nk) g_stage(c, kt + 5);
      g_read(f0, c, kt + 2, lds);
    }
    g_mma(acc, f1);
  }
}
__device__ __forceinline__ void gemm_kloop(f32x16 (&acc)[2][2], const u16* __restrict__ A, int lda, int M, int m0,
                                           const u16* __restrict__ W, int ldw, int n0, int K, char* lds) {
  GemmCtx c;
  g_init(c, lds);
  g_tile(c, A, lda, M, m0, W, ldw, n0);
  asm volatile("s_waitcnt vmcnt(0)" ::: "memory");
  __builtin_amdgcn_s_barrier();
  g_prologue(c, K >> 5);
  g_main(acc, c, K >> 5, lds);
}

__device__ __forceinline__ void zero_acc(f32x16 (&acc)[2][2]) {
#pragma unroll
  for (int a = 0; a < 2; ++a)
#pragma unroll
    for (int b = 0; b < 2; ++b)
#pragma unroll
      for (int r = 0; r < 16; ++r) acc[a][b][r] = 0.f;
}

template <class F>
__device__ __forceinline__ void gemm_phase(const u16* A, int lda, int M, const u16* W, int K, int N, char* lds, int* ctr, F&& epi) {
  const int nN = N >> 7, nM = (M + 127) >> 7, nt = nN * nM, nk = K >> 5;
  const int xcd = (int)xb_xcc_id() & 7;
  const int tq = nt >> 3, trm = nt & 7;
  const int tstart = xcd < trm ? xcd * (tq + 1) : trm * (tq + 1) + (xcd - trm) * tq;
  const int tcnt = tq + (xcd < trm ? 1 : 0);
  auto decode = [&](int off, int& tm, int& tn) {
    const int id = tstart + off, nig = 8 * nN, grp = id / nig, fm = grp * 8;
    const int gsz = (nM - fm) < 8 ? (nM - fm) : 8, idl = id - grp * nig;
    tm = fm + idl % gsz; tn = idl / gsz;
  };
  GemmCtx c;
  g_init(c, lds);
  const int wave = c.tid >> 6;
  volatile int* bw = (volatile int*)(lds + 65536);
  int* myctr = ctr + xcd;
  int par = 0;
  if (c.tid == 0) bw[2] = atomicAdd(myctr, 1);
  asm volatile("s_waitcnt vmcnt(0) lgkmcnt(0)" ::: "memory");
  __builtin_amdgcn_s_barrier();
  int off = bw[2];
  int tm = 0, tn = 0;
  if (off < tcnt) { decode(off, tm, tn); g_tile(c, A, lda, M, tm * 128, W, K, tn * 128); g_prologue(c, nk); }
  while (off < tcnt) {
    f32x16 acc[2][2];
    zero_acc(acc);
    g_main(acc, c, nk, lds);
    const int ctm = tm, ctn = tn;
    par ^= 1;
    if (c.tid == 0) bw[2 + par] = atomicAdd(myctr, 1);
    asm volatile("s_waitcnt lgkmcnt(0)" ::: "memory");
    __builtin_amdgcn_s_barrier();
    off = bw[2 + par];
    if (off < tcnt) { decode(off, tm, tn); g_tile(c, A, lda, M, tm * 128, W, K, tn * 128); g_prologue(c, nk); }
    epi(acc, ctn * 128 + (wave & 1) * 64, ctm * 128 + (wave >> 1) * 64);
  }
}

struct WideCtx {
  const u16* ap[4];
  const u16* wp[2];
  int wro[2], wsw[2], aro[2][2], asw[2][2];
  unsigned lds0;
  int tid, h;
};
__device__ __forceinline__ void h_init(WideCtx& c, char* lds) {
  const int tid = ltid(), lane = tid & 63, wave = tid >> 6;
  const int wn = wave & 1, wt = wave >> 1, l32 = lane & 31;
  c.tid = tid; c.h = lane >> 5;
#pragma unroll
  for (int b = 0; b < 2; ++b) {
    const int wr = wn * 64 + b * 32 + l32;
    c.wro[b] = wr * 64; c.wsw[b] = (wr >> 2) & 3;
#pragma unroll
    for (int j = 0; j < 2; ++j) {
      const int ar = j * 128 + wt * 64 + b * 32 + l32;
      c.aro[j][b] = 8192 + ar * 64; c.asw[j][b] = (ar >> 2) & 3;
    }
  }
  c.lds0 = __builtin_amdgcn_readfirstlane((unsigned)(uintptr_t)(LAS char*)lds + wave * 1024);
}
__device__ __forceinline__ void h_tile(WideCtx& c, const u16* __restrict__ A, int lda, int M, int m0, const u16* __restrict__ W, int ldw, int n0) {
#pragma unroll
  for (int i = 0; i < 2; ++i) {
    const int q = c.tid + 256 * i, row = q >> 2, ch = (q & 3) ^ ((row >> 2) & 3);
    c.wp[i] = W + (size_t)(n0 + row) * ldw + ch * 8;
  }
#pragma unroll
  for (int i = 0; i < 4; ++i) {
    const int q = c.tid + 256 * i, row = q >> 2, ch = (q & 3) ^ ((row >> 2) & 3);
    int ar = m0 + row; ar = ar < M ? ar : M - 1;
    c.ap[i] = A + (size_t)ar * lda + ch * 8;
  }
}
__device__ __forceinline__ void h_stage(const WideCtx& c, int kt) {
  const unsigned sb = c.lds0 + (kt & 1) * 24576;
#pragma unroll
  for (int i = 0; i < 2; ++i) glds16(c.wp[i] + kt * 32, sb + i * 4096);
#pragma unroll
  for (int i = 0; i < 4; ++i) glds16(c.ap[i] + kt * 32, sb + 8192 + i * 4096);
}
__device__ __forceinline__ void h_main(f32x16 (&acc0)[2][2], f32x16 (&acc1)[2][2], const WideCtx& c, int nk, char* lds) {
  const int h = c.h;
  for (int kt = 0; kt < nk; ++kt) {
    asm volatile("s_waitcnt vmcnt(0)" ::: "memory");
    __builtin_amdgcn_s_barrier();
    if (kt + 1 < nk) h_stage(c, kt + 1);
    const char* st = lds + (kt & 1) * 24576;
#pragma unroll
    for (int ks = 0; ks < 2; ++ks) {
      bf16x8 wf[2], a0[2], a1[2];
#pragma unroll
      for (int b = 0; b < 2; ++b) {
        wf[b] = *(const bf16x8*)(st + c.wro[b] + (((ks * 2 + h) ^ c.wsw[b]) << 4));
        a0[b] = *(const bf16x8*)(st + c.aro[0][b] + (((ks * 2 + h) ^ c.asw[0][b]) << 4));
        a1[b] = *(const bf16x8*)(st + c.aro[1][b] + (((ks * 2 + h) ^ c.asw[1][b]) << 4));
      }
#pragma unroll
      for (int nb = 0; nb < 2; ++nb)
#pragma unroll
        for (int tb = 0; tb < 2; ++tb) {
          acc0[nb][tb] = __builtin_amdgcn_mfma_f32_32x32x16_bf16(wf[nb], a0[tb], acc0[nb][tb], 0, 0, 0);
          acc1[nb][tb] = __builtin_amdgcn_mfma_f32_32x32x16_bf16(wf[nb], a1[tb], acc1[nb][tb], 0, 0, 0);
        }
    }
  }
}
template <class F>
__device__ __forceinline__ void gemm_phase_w(const u16* A, int lda, int M, const u16* W, int K, int N, char* lds, int* ctr, F&& epi) {
  const int nN = N >> 7, nM = (M + 255) >> 8, nt = nN * nM, nk = K >> 5;
  const int xcd = (int)xb_xcc_id() & 7;
  const int tq = nt >> 3, trm = nt & 7;
  const int tstart = xcd < trm ? xcd * (tq + 1) : trm * (tq + 1) + (xcd - trm) * tq;
  const int tcnt = tq + (xcd < trm ? 1 : 0);
  auto decode = [&](int off, int& tm, int& tn) {
    const int id = tstart + off, nig = 4 * nN, grp = id / nig, fm = grp * 4;
    const int gsz = (nM - fm) < 4 ? (nM - fm) : 4, idl = id - grp * nig;
    tm = fm + idl % gsz; tn = idl / gsz;
  };
  WideCtx c;
  h_init(c, lds);
  const int wave = c.tid >> 6;
  volatile int* bw = (volatile int*)(lds + 65536);
  int* myctr = ctr + xcd;
  int par = 0;
  if (c.tid == 0) bw[2] = atomicAdd(myctr, 1);
  asm volatile("s_waitcnt vmcnt(0) lgkmcnt(0)" ::: "memory");
  __builtin_amdgcn_s_barrier();
  int off = bw[2];
  int tm = 0, tn = 0;
  if (off < tcnt) { decode(off, tm, tn); h_tile(c, A, lda, M, tm * 256, W, K, tn * 128); h_stage(c, 0); }
  while (off < tcnt) {
    f32x16 acc0[2][2], acc1[2][2];
    zero_acc(acc0);
    zero_acc(acc1);
    h_main(acc0, acc1, c, nk, lds);
    const int ctm = tm, ctn = tn;
    par ^= 1;
    if (c.tid == 0) bw[2 + par] = atomicAdd(myctr, 1);
    asm volatile("s_waitcnt lgkmcnt(0)" ::: "memory");
    __builtin_amdgcn_s_barrier();
    off = bw[2 + par];
    if (off < tcnt) { decode(off, tm, tn); h_tile(c, A, lda, M, tm * 256, W, K, tn * 128); h_stage(c, 0); }
    epi(acc0, ctn * 128 + (wave & 1) * 64, ctm * 256 + (wave >> 1) * 64);
    epi(acc1, ctn * 128 + (wave & 1) * 64, ctm * 256 + 128 + (wave >> 1) * 64);
  }
}


__device__ __forceinline__ void epi_swiglu(const f32x16 (&acc)[2][2], int nbase, int tbase, int M, const float* ss, u16* ACT) {
  const int lane = ltid() & 63, l32 = lane & 31, h = lane >> 5;
  const int cb = (nbase >> 6) * 32;
#pragma unroll
  for (int tb = 0; tb < 2; ++tb) {
    const int tok = tbase + tb * 32 + l32;
    if (tok < M) {
      const float rs = rsqrtf(ss[tok] * (1.f / 1024.f) + EPSN);
      u16* dst = ACT + (size_t)tok * FFD + cb + 4 * h;
#pragma unroll
      for (int i = 0; i < 4; ++i) {
        float o[4];
#pragma unroll
        for (int j = 0; j < 4; ++j) {
          const float g = acc[0][tb][4 * i + j] * rs, u = acc[1][tb][4 * i + j] * rs;
          o[j] = g * sigm(g) * u;
        }
        *(u32x2*)(dst + 8 * i) = (u32x2){pk_bf16(o[0], o[1]), pk_bf16(o[2], o[3])};
      }
    }
  }
}

template <int MODE>
__device__ __forceinline__ void epi_resid(const f32x16 (&acc)[2][2], int nbase, int tbase, CP& p, const Grp& G) {
  const int lane = ltid() & 63, l32 = lane & 31, h = lane >> 5;
  const float scale = MODE == 1 ? 1.f : 0.5f;
  float* ssout = MODE == 0 ? p.ss1 : (MODE == 1 ? p.ss2 : p.ss3);
#pragma unroll
  for (int tb = 0; tb < 2; ++tb) {
    const int tok = tbase + tb * 32 + l32;
    const bool valid = tok < G.Mx;
    float sq = 0.f;
    if (valid) {
      float* hp = p.H + (size_t)tok * 1024;
      u16* hb = p.HB + (size_t)tok * 1024;
      const float* rp = G.x + (size_t)tok * 1024;
#pragma unroll
      for (int nb = 0; nb < 2; ++nb)
#pragma unroll
        for (int i = 0; i < 4; ++i) {
          const int n = nbase + nb * 32 + 8 * i + 4 * h;
          f32x4 r;
          if (MODE == 0) r = *(const f32x4*)(rp + n);
          else { const u32x2 rb = *(const u32x2*)(hb + n); r = (f32x4){bf_lo(rb.x), bf_hi(rb.x), bf_lo(rb.y), bf_hi(rb.y)}; }
          f32x4 v;
          v.x = r.x + scale * acc[nb][tb][4 * i + 0];
          v.y = r.y + scale * acc[nb][tb][4 * i + 1];
          v.z = r.z + scale * acc[nb][tb][4 * i + 2];
          v.w = r.w + scale * acc[nb][tb][4 * i + 3];
          sq += v.x * v.x + v.y * v.y + v.z * v.z + v.w * v.w;
          if (MODE == 2) *(f32x4*)(hp + n) = v;
          else *(u32x2*)(hb + n) = (u32x2){pk_bf16(v.x, v.y), pk_bf16(v.z, v.w)};
        }
    }
    sq += __shfl_xor(sq, 32);
    if (valid && h == 0) atomicAdd(ssout + tok, sq);
  }
}

__device__ void phase_mix(CP& p, const Grp& G) {
  const int total = G.M * 432;
#pragma unroll 2
  for (int idx = blockIdx.x * 256 + ltid(); idx < total; idx += gridDim.x * 256) {
    const int row = idx / 432, ch = idx - row * 432;
    int s, t;
    if (row < G.Mx) { s = row >> G.lgS; t = 16 + (row & (G.S - 1)); } else { s = (row - G.Mx) >> 4; t = (row - G.Mx) & 15; }
    const int col = ch * 8;
    const u16* pc = p.P + (size_t)row * NIN + 3072 + col;
    const u32x4 c = *(const u32x4*)pc;
    u32x4 pv = {0, 0, 0, 0}, nx = {0, 0, 0, 0};
    if (t > 0) pv = *(const u32x4*)(p.P + (size_t)rowof(G, s, t - 1) * NIN + 3072 + col);
    if (t < G.L - 1) nx = *(const u32x4*)(p.P + (size_t)rowof(G, s, t + 1) * NIN + 3072 + col);
    const f32x4 mp0 = *(const f32x4*)(p.mu_prev + col), mp1 = *(const f32x4*)(p.mu_prev + col + 4);
    const f32x4 mn0 = *(const f32x4*)(p.mu_next + col), mn1 = *(const f32x4*)(p.mu_next + col + 4);
    float o[8];
#pragma unroll
    for (int e = 0; e < 4; ++e) {
      const float c0 = bf_lo(c[e]), c1 = bf_hi(c[e]);
      const float mpa = e < 2 ? mp0[2 * e] : mp1[2 * e - 4], mpb = e < 2 ? mp0[2 * e + 1] : mp1[2 * e - 3];
      const float mna = e < 2 ? mn0[2 * e] : mn1[2 * e - 4], mnb = e < 2 ? mn0[2 * e + 1] : mn1[2 * e - 3];
      o[2 * e] = c0 + mpa * (bf_lo(pv[e]) - c0) + mna * (bf_lo(nx[e]) - c0);
      o[2 * e + 1] = c1 + mpb * (bf_hi(pv[e]) - c1) + mnb * (bf_hi(nx[e]) - c1);
    }
    if (col < 3072) {
      const int sec = col >> 10, ci = col & 1023, head = ci >> 6, c0 = ci & 63;
      const size_t ro = ((size_t)row * 16 + head) * 192 + sec * 64 + c0;
      const u32x4 pk = (u32x4){pk_f16(o[0], o[1]), pk_f16(o[2], o[3]), pk_f16(o[4], o[5]), pk_f16(o[6], o[7])};
      *(u32x4*)(p.RKV + ro) = pk;
      if (sec == 1) { *(u32x4*)(p.DIR0 + ro) = pk; *(u32x4*)(p.DIR1 + ro) = pk; }
    } else {
      const int fc = col - 3072;
      if (fc < 128) {
#pragma unroll
        for (int e = 0; e < 8; ++e) o[e] = 1.f - 2.f / (1.f + __expf(2.f * o[e]));
      } else if (fc >= 256) {
#pragma unroll
        for (int e = 0; e < 8; ++e) o[e] = sigm(o[e]);
      }
      *(u32x4*)(p.F + (size_t)row * 384 + fc) = (u32x4){pk_bf16(o[0], o[1]), pk_bf16(o[2], o[3]), pk_bf16(o[4], o[5]), pk_bf16(o[6], o[7])};
    }
  }
}

__device__ __forceinline__ void epi_decay(const f32x16 (&acc)[2][2], int nbase, int tbase, int M, const float* w0, u16* DIR) {
  const int lane = ltid() & 63, l32 = lane & 31, h = lane >> 5;
  const int head = nbase >> 6;
#pragma unroll
  for (int tb = 0; tb < 2; ++tb) {
    const int tok = tbase + tb * 32 + l32;
    if (tok < M) {
      u16* dst = DIR + ((size_t)tok * 16 + head) * 192;
#pragma unroll
      for (int nb = 0; nb < 2; ++nb)
#pragma unroll
        for (int i = 0; i < 4; ++i) {
          const int c = nb * 32 + 8 * i + 4 * h;
          const f32x4 w = *(const f32x4*)(w0 + nbase + c);
          float o[4];
#pragma unroll
          for (int j = 0; j < 4; ++j) o[j] = 0.6065306597126334f * sigm(w[j] + acc[nb][tb][4 * i + j]);
          *(u32x2*)(dst + c) = (u32x2){pk_f16(o[0], o[1]), pk_f16(o[2], o[3])};
        }
    }
  }
}

__device__ __forceinline__ void epi_adir(const f32x16 (&acc)[2][2], int nbase, int tbase, int M, CP& p, int dir) {
  const int lane = ltid() & 63, l32 = lane & 31, h = lane >> 5;
  const int head = nbase >> 6;
  u16* DIR = dir ? p.DIR1 : p.DIR0;
  const float* a0 = p.rw_a0 + dir * 1024;
#pragma unroll
  for (int tb = 0; tb < 2; ++tb) {
    const int tok = tbase + tb * 32 + l32;
    const bool valid = tok < M;
    const int tk = valid ? tok : M - 1;
    const size_t rec = ((size_t)tk * 16 + head) * 192;
    float nsq = 0.f;
#pragma unroll
    for (int nb = 0; nb < 2; ++nb)
#pragma unroll
      for (int i = 0; i < 4; ++i) {
        const int c = nb * 32 + 8 * i + 4 * h;
        const u32x2 kr = *(const u32x2*)(DIR + rec + 64 + c);
        const f32x4 kkw = *(const f32x4*)(p.k_k + nbase + c);
        const float q0 = h_lo(kr.x) * kkw[0], q1 = h_hi(kr.x) * kkw[1], q2 = h_lo(kr.y) * kkw[2], q3 = h_hi(kr.y) * kkw[3];
        nsq += q0 * q0 + q1 * q1 + q2 * q2 + q3 * q3;
      }
    nsq += __shfl_xor(nsq, 32);
    const float inv = 1.f / fmaxf(sqrtf(nsq), 1e-12f);
    if (valid) {
#pragma unroll
      for (int nb = 0; nb < 2; ++nb)
#pragma unroll
        for (int i = 0; i < 4; ++i) {
          const int c = nb * 32 + 8 * i + 4 * h;
          const u32x2 kr = *(const u32x2*)(DIR + rec + 64 + c);
          const float kv[4] = {h_lo(kr.x), h_hi(kr.x), h_lo(kr.y), h_hi(kr.y)};
          const f32x4 kkw = *(const f32x4*)(p.k_k + nbase + c);
          const f32x4 kaw = *(const f32x4*)(p.k_a + nbase + c);
          const f32x4 a0v = *(const f32x4*)(a0 + nbase + c);
          float kk[4], kd[4], bp[4];
#pragma unroll
          for (int j = 0; j < 4; ++j) {
            const float k = kv[j];
            kk[j] = k * kkw[j] * inv;
            const float aa = sigm(a0v[j] + acc[nb][tb][4 * i + j]);
            kd[j] = k * (1.f + (aa - 1.f) * kaw[j]);
            bp[j] = -kk[j] * aa;
          }
          if (dir == 0) *(u32x2*)(p.RKV + rec + 64 + c) = (u32x2){pk_f16(kk[0], kk[1]), pk_f16(kk[2], kk[3])};
          *(u32x2*)(DIR + rec + 64 + c) = (u32x2){pk_f16(kd[0], kd[1]), pk_f16(kd[2], kd[3])};
          *(u32x2*)(DIR + rec + 128 + c) = (u32x2){pk_f16(bp[0], bp[1]), pk_f16(bp[2], bp[3])};
        }
    }
  }
}

template <int LPR>
__device__ void scan_task(CP& p, const Grp& G, int task, char* lds) {
  constexpr int KPL = 64 / LPR, RPB = 256 / LPR, NSPLIT = 64 / RPB;
  const int part = task % NSPLIT, t1 = task / NSPLIT;
  const int dir = t1 & 1, head = (t1 >> 1) & 15, s = t1 >> 5;
  float* buf = (float*)lds;
  const u16* rkv = p.RKV;
  const u16* dr = dir ? p.DIR1 : p.DIR0;
  u16* Y = dir ? p.Y1 : p.Y0;
  const int tid = ltid();
  const int row = part * RPB + tid / LPR, kc = tid % LPR;
  const int L = G.L, nch = L >> 4;
  u32x4 pre[3];
  auto issue = [&](int c) {
#pragma unroll
    for (int i = 0; i < 3; ++i) {
      const int id = tid + 256 * i, st = id / 48, ci = id - st * 48;
      const int n = c * 16 + st, t = dir ? L - 1 - n : n;
      const size_t rec = ((size_t)rowof(G, s, t) * 16 + head) * 192;
      const u16* src = ci < 24 ? rkv + rec + ci * 8 : dr + rec + (ci - 24) * 8;
      pre[i] = *(const u32x4*)src;
    }
  };
  auto commit = [&](int b) {
#pragma unroll
    for (int i = 0; i < 3; ++i) {
      const int id = tid + 256 * i, st = id / 48, ci = id - st * 48;
      const int sec = ci >> 3;
      const int base = sec >= 3 ? (sec - 1) * 64 : (sec == 0 ? 64 : (sec == 1 ? 0 : 320));
      float f[8];
#pragma unroll
      for (int e = 0; e < 4; ++e) { f[2 * e] = h_lo(pre[i][e]); f[2 * e + 1] = h_hi(pre[i][e]); }
      if (sec == 3) {
#pragma unroll
        for (int e = 0; e < 8; ++e) f[e] = __expf(-f[e]);
      }
      float* d = buf + b * 6144 + st * 384 + base + (ci & 7) * 8;
      *(f32x4*)d = (f32x4){f[0], f[1], f[2], f[3]};
      *(f32x4*)(d + 4) = (f32x4){f[4], f[5], f[6], f[7]};
    }
  };
  float S[KPL];
#pragma unroll
  for (int i = 0; i < KPL; ++i) S[i] = 0.f;
  __syncthreads();
  issue(0);
  commit(0);
  __syncthreads();
  __builtin_amdgcn_s_setprio(3);
  for (int c = 0; c < nch; ++c) {
    if (c + 1 < nch) issue(c + 1);
    const float* b = buf + (c & 1) * 6144;
#pragma unroll 1
    for (int g0 = 0; g0 < 16; g0 += LPR) {
      float ykeep = 0.f;
#pragma unroll 2
      for (int j = 0; j < LPR; ++j) {
        const int st = g0 + j;
        const float* q = b + st * 384 + kc * KPL;
        f32x4 kk[KPL / 4], rr[KPL / 4], ww[KPL / 4], dd[KPL / 4], bb[KPL / 4];
#pragma unroll
        for (int jj = 0; jj < KPL / 4; ++jj) {
          kk[jj] = *(const f32x4*)(q + 4 * jj);
          rr[jj] = *(const f32x4*)(q + 64 + 4 * jj);
          ww[jj] = *(const f32x4*)(q + 128 + 4 * jj);
          dd[jj] = *(const f32x4*)(q + 192 + 4 * jj);
          bb[jj] = *(const f32x4*)(q + 256 + 4 * jj);
        }
        const float vv = b[st * 384 + 320 + row];
        float sa0 = 0.f, sa1 = 0.f;
#pragma unroll
        for (int jj = 0; jj < KPL / 4; ++jj) {
          sa0 += S[4 * jj] * kk[jj][0]; sa1 += S[4 * jj + 1] * kk[jj][1];
          sa0 += S[4 * jj + 2] * kk[jj][2]; sa1 += S[4 * jj + 3] * kk[jj][3];
        }
        float sa = sa0 + sa1;
        sa = LPR == 8 ? reduce8(sa) : reduce4(sa);
        float y0 = 0.f, y1 = 0.f;
#pragma unroll
        for (int jj = 0; jj < KPL / 4; ++jj)
#pragma unroll
          for (int e = 0; e < 4; ++e) {
            const float sn = S[4 * jj + e] * ww[jj][e] + (sa * bb[jj][e] + vv * dd[jj][e]);
            S[4 * jj + e] = sn;
            if (e & 1) y1 += sn * rr[jj][e]; else y0 += sn * rr[jj][e];
          }
        float y = y0 + y1;
        y = LPR == 8 ? reduce8(y) : reduce4(y);
        ykeep = (kc == j) ? y : ykeep;
      }
      const int n = c * 16 + g0 + kc, t = dir ? L - 1 - n : n;
      Y[(size_t)rowof(G, s, t) * 1024 + head * 64 + row] = bf16_1(ykeep);
    }
    if (c + 1 < nch) commit((c + 1) & 1);
    __syncthreads();
  }
  __builtin_amdgcn_s_setprio(0);
}

__device__ void attn_tile(CP& p, const Grp& G, int s, int hd, int qb, char* lds, float lam) {
  const int tid = ltid(), lane = tid & 63, wave = tid >> 6, l32 = lane & 31, h = lane >> 5;
  const int L = G.L, Lp = (G.L + 63) & ~63;
  const u16* Pb = p.P;
  float* lutl = (float*)(lds + 49152);
  __syncthreads();
  for (int i = tid; i < 511; i += 256) lutl[i] = p.lut[hd * 512 + i];
  const int q = 16 + qb * 128 + wave * 32 + l32;
  const int qc = s * G.S + (q - 16);
  const int qw0 = 16 + qb * 128 + wave * 32;
  u16* odst = p.O + (size_t)qc * 1024 + hd * 128;
  int kkey[2], kchn[2];
#pragma unroll
  for (int i = 0; i < 2; ++i) { const int c = tid + 256 * i; kkey[i] = c >> 3; kchn[i] = (c & 7) ^ ((kkey[i] >> 1) & 7); }
  const u16* vsrc[4];
#pragma unroll
  for (int i = 0; i < 4; ++i) {
    const int c = tid + 256 * i, dv = c >> 3, c8 = (c & 7) ^ ((dv >> 1) & 7);
    vsrc[i] = p.VT + ((size_t)(s * 1024 + hd * 128 + dv) * Lp) + c8 * 8;
  }
  const unsigned lds0 = __builtin_amdgcn_readfirstlane((unsigned)(uintptr_t)(LAS char*)lds + wave * 1024);
  const int n64 = (L + 63) >> 6;
#pragma unroll 1
  for (int br = 0; br < 2; ++br) {
    bf16x8 qv[4];
#pragma unroll
    for (int ks = 0; ks < 4; ++ks) {
      const u32x4 raw = *(const u32x4*)(Pb + (size_t)qc * NIN + hd * 128 + br * 64 + ks * 16 + h * 8);
      u32x4 sc;
#pragma unroll
      for (int e = 0; e < 4; ++e) sc[e] = pk_bf16(bf_lo(raw[e]) * 0.125f, bf_hi(raw[e]) * 0.125f);
      qv[ks] = __builtin_bit_cast(bf16x8, sc);
    }
    const u16* kp = Pb + 1024 + hd * 128 + br * 64;
    auto stage = [&](int kt) {
      const int k0 = kt * 64;
      const unsigned sb = lds0 + (kt & 1) * 24576;
#pragma unroll
      for (int i = 0; i < 2; ++i) {
        int kr = k0 + kkey[i]; kr = kr < L ? kr : L - 1;
        glds16(kp + (size_t)rowof(G, s, kr) * NIN + kchn[i] * 8, sb + i * 4096);
      }
#pragma unroll
      for (int i = 0; i < 4; ++i) glds16(vsrc[i] + k0, sb + 8192 + i * 4096);
    };
    f32x16 O[4];
#pragma unroll
    for (int mb = 0; mb < 4; ++mb)
#pragma unroll
      for (int r = 0; r < 16; ++r) O[mb][r] = 0.f;
    float mrun = -1e30f, lrun = 0.f;
    asm volatile("s_waitcnt vmcnt(0) lgkmcnt(0)" ::: "memory");
    __builtin_amdgcn_s_barrier();
    stage(0);
    const float cneg = lutl[0], cpos = lutl[510];
    for (int kt = 0; kt < n64; ++kt) {
      asm volatile("s_waitcnt vmcnt(0)" ::: "memory");
      __builtin_amdgcn_s_barrier();
      if (kt + 1 < n64) stage(kt + 1);
      const char* st64 = lds + (kt & 1) * 24576;
#pragma unroll 1
      for (int hf = 0; hf < 2; ++hf) {
      const int kt0 = kt * 64 + hf * 32;
      if (kt0 >= L) break;
      const char* st = st64 + hf * 4096;
      f32x16 sacc;
#pragma unroll
      for (int r = 0; r < 16; ++r) sacc[r] = 0.f;
      bf16x8 kf[4], vf[4][2];
#pragma unroll
      for (int ks = 0; ks < 4; ++ks) kf[ks] = *(const bf16x8*)(st + l32 * 128 + (((ks * 2 + h) ^ ((l32 >> 1) & 7)) << 4));
#pragma unroll
      for (int mb = 0; mb < 4; ++mb)
#pragma unroll
        for (int s2 = 0; s2 < 2; ++s2) {
          const int vr = mb * 32 + l32;
          vf[mb][s2] = *(const bf16x8*)(st64 + 8192 + vr * 128 + (((hf * 4 + 2 * s2 + h) ^ ((vr >> 1) & 7)) << 4));
        }
      __builtin_amdgcn_sched_barrier(0);
#pragma unroll
      for (int ks = 0; ks < 4; ++ks) sacc = __builtin_amdgcn_mfma_f32_32x32x16_bf16(kf[ks], qv[ks], sacc, 0, 0, 0);
      const bool farneg = (kt0 + 31) <= (qw0 - 128);
      const bool farpos = kt0 >= (qw0 + 31 + 128);
      float ps = 0.f, alpha;
      if ((farneg || farpos) && (kt0 + 32 <= L)) {
        const float cv = farneg ? cneg : cpos;
        float mx = fmaxf(fmaxf(sacc[0], sacc[1]), sacc[2]);
#pragma unroll
        for (int r = 3; r < 15; r += 2) mx = fmaxf(fmaxf(mx, sacc[r]), sacc[r + 1]);
        mx = fmaxf(mx, sacc[15]);
        mx = fmaxf(mx, __shfl_xor(mx, 32));
        const float mnew = fmaxf(mrun, mx * LOG2E + cv);
        alpha = __builtin_amdgcn_exp2f(mrun - mnew);
        mrun = mnew;
        const float sh = cv - mnew;
#pragma unroll
        for (int r = 0; r < 16; ++r) { sacc[r] = __builtin_amdgcn_exp2f(sacc[r] * LOG2E + sh); ps += sacc[r]; }
      } else {
        float mx = -1e30f;
        if (farneg || farpos) {
          const float cv = farneg ? cneg : cpos;
#pragma unroll
          for (int r = 0; r < 16; ++r) { sacc[r] = sacc[r] * LOG2E + cv; }
        } else {
#pragma unroll
          for (int r = 0; r < 16; ++r) {
            const int key = kt0 + 8 * (r >> 2) + 4 * h + (r & 3);
            int d = key - q + 255;
            d = d < 0 ? 0 : (d > 510 ? 510 : d);
            sacc[r] = sacc[r] * LOG2E + lutl[d];
          }
        }
        if (kt0 + 32 > L) {
#pragma unroll
          for (int r = 0; r < 16; ++r) {
            const int key = kt0 + 8 * (r >> 2) + 4 * h + (r & 3);
            if (key >= L) sacc[r] = -INFINITY;
          }
        }
#pragma unroll
        for (int r = 0; r < 16; ++r) mx = fmaxf(mx, sacc[r]);
        mx = fmaxf(mx, __shfl_xor(mx, 32));
        const float mnew = fmaxf(mrun, mx);
        alpha = __builtin_amdgcn_exp2f(mrun - mnew);
        mrun = mnew;
#pragma unroll
        for (int r = 0; r < 16; ++r) { sacc[r] = __builtin_amdgcn_exp2f(sacc[r] - mnew); ps += sacc[r]; }
      }
      lrun = lrun * alpha + ps;
      if (__any(alpha != 1.f)) {
#pragma unroll
        for (int mb = 0; mb < 4; ++mb)
#pragma unroll
          for (int r = 0; r < 16; ++r) O[mb][r] *= alpha;
      }
      bf16x8 pf[2];
#pragma unroll
      for (int s2 = 0; s2 < 2; ++s2) {
        u32x4 w;
#pragma unroll
        for (int e = 0; e < 4; ++e) w[e] = pk_bf16(sacc[8 * s2 + 2 * e], sacc[8 * s2 + 2 * e + 1]);
        pf[s2] = __builtin_bit_cast(bf16x8, w);
      }
      __builtin_amdgcn_sched_barrier(0);
#pragma unroll
      for (int s2 = 0; s2 < 2; ++s2)
#pragma unroll
        for (int mb = 0; mb < 4; ++mb)
          O[mb] = __builtin_amdgcn_mfma_f32_32x32x16_bf16(vf[mb][s2], pf[s2], O[mb], 0, 0, 0);
      }
    }
    const float lt = lrun + __shfl_xor(lrun, 32);
    if (br == 0) {
      const float i1 = 1.f / lt;
#pragma unroll
      for (int mb = 0; mb < 4; ++mb)
#pragma unroll
        for (int i = 0; i < 4; ++i)
          if (q < L) *(u32x2*)(odst + mb * 32 + 8 * i + 4 * h) = (u32x2){pk_bf16(O[mb][4 * i] * i1, O[mb][4 * i + 1] * i1), pk_bf16(O[mb][4 * i + 2] * i1, O[mb][4 * i + 3] * i1)};
    } else {
      const float i2 = lam / lt;
      float ssq = 0.f;
#pragma unroll
      for (int mb = 0; mb < 4; ++mb)
#pragma unroll
        for (int i = 0; i < 4; ++i) {
          u32x2 w = {0, 0};
          if (q < L) w = *(const u32x2*)(odst + mb * 32 + 8 * i + 4 * h);
          const float o0 = bf_lo(w.x) - O[mb][4 * i] * i2, o1v = bf_hi(w.x) - O[mb][4 * i + 1] * i2, o2 = bf_lo(w.y) - O[mb][4 * i + 2] * i2, o3 = bf_hi(w.y) - O[mb][4 * i + 3] * i2;
          O[mb][4 * i] = o0; O[mb][4 * i + 1] = o1v; O[mb][4 * i + 2] = o2; O[mb][4 * i + 3] = o3;
          ssq += o0 * o0 + o1v * o1v + o2 * o2 + o3 * o3;
        }
      ssq += __shfl_xor(ssq, 32);
      const float rn = rsqrtf(ssq * (1.f / 128.f) + EPSN) * 0.8f;
      if (q < L) {
#pragma unroll
        for (int mb = 0; mb < 4; ++mb)
#pragma unroll
          for (int i = 0; i < 4; ++i) {
            const int dv = mb * 32 + 8 * i + 4 * h;
            const f32x4 g = *(const f32x4*)(p.subln + dv);
            *(u32x2*)(odst + dv) = (u32x2){pk_bf16(O[mb][4 * i] * rn * g.x, O[mb][4 * i + 1] * rn * g.y),
                                           pk_bf16(O[mb][4 * i + 2] * rn * g.z, O[mb][4 * i + 3] * rn * g.w)};
          }
      }
    }
  }
}

__device__ void phase_mixer(CP& p, const Grp& G, int g, char* lds) {
  if (G.nseq == 4) { for (int t = blockIdx.x; t < 256; t += gridDim.x) scan_task<8>(p, G, t, lds); }
  else { for (int t = blockIdx.x; t < 256; t += gridDim.x) scan_task<4>(p, G, t, lds); }
  const int nqb = G.S >> 7;
  const int natt = G.nseq * 8 * nqb;
  const float lam = p.lam[0];
  int* shw = (int*)(lds + 65536 - 16);
  while (true) {
    __syncthreads();
    if (ltid() == 0) *shw = atomicAdd(p.cnt + g, 1);
    __syncthreads();
    const int t = *shw;
    if (t >= natt) break;
    const int qb = t % nqb, r = t / nqb, hd = r & 7, s = r >> 3;
    attn_tile(p, G, s, hd, qb, lds, lam);
  }
}

__device__ void phase_post(CP& p, const Grp& G) {
  const int lane = ltid() & 63;
  const int nw = gridDim.x * 4;
  const int c0 = lane * 16, head = lane >> 2, hc = (lane & 3) * 16;
  for (int row = blockIdx.x * 4 + (ltid() >> 6); row < G.Mx; row += nw) {
    float y[16];
    {
      const u32x4 a0 = *(const u32x4*)(p.Y0 + (size_t)row * 1024 + c0), a1 = *(const u32x4*)(p.Y0 + (size_t)row * 1024 + c0 + 8);
      const u32x4 b0 = *(const u32x4*)(p.Y1 + (size_t)row * 1024 + c0), b1 = *(const u32x4*)(p.Y1 + (size_t)row * 1024 + c0 + 8);
#pragma unroll
      for (int e = 0; e < 4; ++e) {
        y[2 * e] = bf_lo(a0[e]) + bf_lo(b0[e]); y[2 * e + 1] = bf_hi(a0[e]) + bf_hi(b0[e]);
        y[8 + 2 * e] = bf_lo(a1[e]) + bf_lo(b1[e]); y[8 + 2 * e + 1] = bf_hi(a1[e]) + bf_hi(b1[e]);
      }
    }
    float s1 = 0.f;
#pragma unroll
    for (int e = 0; e < 16; ++e) s1 += y[e];
    s1 = reduce4(s1);
    const float mu = s1 * (1.f / 64.f);
    float s2 = 0.f;
#pragma unroll
    for (int e = 0; e < 16; ++e) { const float d = y[e] - mu; s2 += d * d; }
    s2 = reduce4(s2);
    const float rstd = rsqrtf(s2 * (1.f / 64.f) + 64e-5f);
    const size_t rec = ((size_t)row * 16 + head) * 192 + hc;
    float rr[16], vv[16], kd[16];
    {
      const u32x4 r0 = *(const u32x4*)(p.RKV + rec), r1 = *(const u32x4*)(p.RKV + rec + 8);
      const u32x4 v0 = *(const u32x4*)(p.RKV + rec + 128), v1 = *(const u32x4*)(p.RKV + rec + 136);
      const u32x4 f0 = *(const u32x4*)(p.DIR0 + rec + 64), f1 = *(const u32x4*)(p.DIR0 + rec + 72);
      const u32x4 g0 = *(const u32x4*)(p.DIR1 + rec + 64), g1 = *(const u32x4*)(p.DIR1 + rec + 72);
#pragma unroll
      for (int e = 0; e < 4; ++e) {
        rr[2 * e] = h_lo(r0[e]); rr[2 * e + 1] = h_hi(r0[e]); rr[8 + 2 * e] = h_lo(r1[e]); rr[8 + 2 * e + 1] = h_hi(r1[e]);
        vv[2 * e] = h_lo(v0[e]); vv[2 * e + 1] = h_hi(v0[e]); vv[8 + 2 * e] = h_lo(v1[e]); vv[8 + 2 * e + 1] = h_hi(v1[e]);
        kd[2 * e] = h_lo(f0[e]) + h_lo(g0[e]); kd[2 * e + 1] = h_hi(f0[e]) + h_hi(g0[e]);
        kd[8 + 2 * e] = h_lo(f1[e]) + h_lo(g1[e]); kd[8 + 2 * e + 1] = h_hi(f1[e]) + h_hi(g1[e]);
      }
    }
    float bs = 0.f;
#pragma unroll
    for (int e = 0; e < 16; ++e) bs += rr[e] * kd[e] * p.r_k[c0 + e];
    bs = reduce4(bs);
    const u32x4 g0 = *(const u32x4*)(p.G + (size_t)row * 1024 + c0), g1 = *(const u32x4*)(p.G + (size_t)row * 1024 + c0 + 8);
    float o[16];
#pragma unroll
    for (int e = 0; e < 16; ++e) {
      const unsigned gw = e < 8 ? g0[e >> 1] : g1[(e - 8) >> 1];
      const float gg = (e & 1) ? bf_hi(gw) : bf_lo(gw);
      o[e] = ((y[e] - mu) * rstd * p.lnx_w[c0 + e] + p.lnx_b[c0 + e] + bs * vv[e]) * gg;
    }
    u16* dst = (u16*)p.H + (size_t)row * 1024 + c0;
    *(u32x4*)dst = (u32x4){pk_bf16(o[0], o[1]), pk_bf16(o[2], o[3]), pk_bf16(o[4], o[5]), pk_bf16(o[6], o[7])};
    *(u32x4*)(dst + 8) = (u32x4){pk_bf16(o[8], o[9]), pk_bf16(o[10], o[11]), pk_bf16(o[12], o[13]), pk_bf16(o[14], o[15])};
  }
}

__device__ void phase_final(CP& p, const Grp& G) {
  const int lane = ltid() & 63;
  const int nw = gridDim.x * 4;
#pragma unroll 2
  for (int row = blockIdx.x * 4 + (ltid() >> 6); row < G.Mx; row += nw) {
    const float rs = rsqrtf(p.ss3[row] * (1.f / 1024.f) + EPSN);
    const float* hp = p.H + (size_t)row * 1024;
    float* op = G.out + (size_t)row * 1024;
#pragma unroll
    for (int i = 0; i < 4; ++i) {
      const f32x4 v = *(const f32x4*)(hp + i * 256 + lane * 4);
      const f32x4 g = *(const f32x4*)(p.final_norm + i * 256 + lane * 4);
      *(f32x4*)(op + i * 256 + lane * 4) = (f32x4){v.x * rs * g.x, v.y * rs * g.y, v.z * rs * g.z, v.w * rs * g.w};
    }
  }
}

__device__ void run_phase(CP& p, int ph, char* lds) {
  int* gctr = p.cnt + 64 + ph * 64;
  if (ph == 0) { phase_prep(p, lds); return; }
  int g, k;
  if (ph <= NMETA_PH) { g = -1; k = ph - 1; }
  else { g = (ph - 1 - NMETA_PH) / PH_PER_G; k = (ph - 1 - NMETA_PH) - g * PH_PER_G; }
  const Grp G = get_grp(p, g);
  const int Mall = G.M;
  const int M = G.Mx;
  u16* Pout = G.meta ? p.PM : p.P;
  switch (k) {
    case 0: phase_rows(p, G); break;
    case 1:
      gemm_phase_w(p.HB, 1024, M, p.W1A, 1024, 2 * FFD, lds, gctr, [&](const f32x16 (&acc)[2][2], int nb, int tb) { epi_swiglu(acc, nb, tb, M, p.ss0, p.ACT); });
      break;
    case 2:
      gemm_phase_w(p.ACT, FFD, M, p.WD1, FFD, 1024, lds, gctr, [&](const f32x16 (&acc)[2][2], int nb, int tb) { epi_resid<0>(acc, nb, tb, p, G); });
      break;
    case 3:
      gemm_phase_w(p.HB, 1024, M, p.WIN, 1024, NIN, lds, gctr, [&](const f32x16 (&acc)[2][2], int nbase, int tbase) {
        const int lane = ltid() & 63, l32 = lane & 31, h = lane >> 5;
#pragma unroll
        for (int tb = 0; tb < 2; ++tb) {
          const int tok = tbase + tb * 32 + l32;
          if (tok < M) {
            const float rs = rsqrtf(p.ss1[tok] * (1.f / 1024.f) + EPSN);
            if (!G.meta && nbase >= 2048 && nbase < 3072) {
              const int s = tok >> G.lgS, t = 16 + (tok & (G.S - 1));
              const int Lp = (G.L + 63) & ~63;
              const int pos = (t & ~12) | ((t & 4) << 1) | ((t & 8) >> 1);
              u16* vt = p.VT + ((size_t)(s * 1024 + (nbase - 2048)) * Lp) + pos;
#pragma unroll
              for (int nb = 0; nb < 2; ++nb)
#pragma unroll
                for (int r = 0; r < 16; ++r) {
                  const int dvl = nb * 32 + 8 * (r >> 2) + 4 * h + (r & 3);
                  vt[(size_t)dvl * Lp] = bf16_1(acc[nb][tb][r] * rs);
                }
            } else {
              u16* dst = Pout + (size_t)tok * NIN + nbase + 4 * h;
#pragma unroll
              for (int nb = 0; nb < 2; ++nb)
#pragma unroll
                for (int i = 0; i < 4; ++i)
                  *(u32x2*)(dst + nb * 32 + 8 * i) = (u32x2){pk_bf16(acc[nb][tb][4 * i] * rs, acc[nb][tb][4 * i + 1] * rs),
                                                             pk_bf16(acc[nb][tb][4 * i + 2] * rs, acc[nb][tb][4 * i + 3] * rs)};
            }
          }
        }
      });
      break;
    case 4: phase_mix(p, G); break;
    case 5:
      gemm_phase(p.F, 384, Mall, p.W2F, 64, 1024, lds, gctr, [&](const f32x16 (&acc)[2][2], int nb, int tb) { epi_decay(acc, nb, tb, Mall, p.rw_w0, p.DIR0); });
      gemm_phase(p.F + 64, 384, Mall, p.W2B, 64, 1024, lds, gctr + 8, [&](const f32x16 (&acc)[2][2], int nb, int tb) { epi_decay(acc, nb, tb, Mall, p.rw_w0 + 1024, p.DIR1); });
      gemm_phase(p.F + 128, 384, Mall, p.A2F, 64, 1024, lds, gctr + 16, [&](const f32x16 (&acc)[2][2], int nb, int tb) { epi_adir(acc, nb, tb, Mall, p, 0); });
      gemm_phase(p.F + 192, 384, Mall, p.A2B, 64, 1024, lds, gctr + 24, [&](const f32x16 (&acc)[2][2], int nb, int tb) { epi_adir(acc, nb, tb, Mall, p, 1); });
      gemm_phase(p.F + 256, 384, Mall, p.G2T, 128, 1024, lds, gctr + 32, [&](const f32x16 (&acc)[2][2], int nbase, int tbase) {
        const int lane = ltid() & 63, l32 = lane & 31, h = lane >> 5;
#pragma unroll
        for (int tb = 0; tb < 2; ++tb) {
          const int tok = tbase + tb * 32 + l32;
          if (tok < Mall) {
            u16* dst = p.G + (size_t)tok * 1024 + nbase + 4 * h;
#pragma unroll
            for (int nb = 0; nb < 2; ++nb)
#pragma unroll
              for (int i = 0; i < 4; ++i)
                *(u32x2*)(dst + nb * 32 + 8 * i) = (u32x2){pk_bf16(acc[nb][tb][4 * i], acc[nb][tb][4 * i + 1]), pk_bf16(acc[nb][tb][4 * i + 2], acc[nb][tb][4 * i + 3])};
          }
        }
      });
      break;
    case 6: phase_mixer(p, G, g, lds); break;
    case 7: phase_post(p, G); break;
    case 8: {
      const int nN = 8, nM = (M + 255) >> 8, nt = nN * nM;
      const int wave = ltid() >> 6;
      const int lane = ltid() & 63, l32 = lane & 31, h = lane >> 5;
      const int xcd = blockIdx.x & 7, g8 = gridDim.x >> 3;
      const int tq = nt >> 3, trm = nt & 7;
      const int tstart = xcd < trm ? xcd * (tq + 1) : trm * (tq + 1) + (xcd - trm) * tq;
      const int tcnt = tq + (xcd < trm ? 1 : 0);
      WideCtx c;
      h_init(c, lds);
      for (int off = blockIdx.x >> 3; off < tcnt; off += g8) {
        const int id = tstart + off, nig = 4 * nN, grp = id / nig, fm = grp * 4;
        const int gsz = (nM - fm) < 4 ? (nM - fm) : 4, idl = id - grp * nig;
        const int tm = fm + idl % gsz, tn = idl / gsz;
        const int nbase = tn * 128 + (wave & 1) * 64;
#pragma unroll 1
        for (int pass = 0; pass < 2; ++pass) {
          f32x16 acc0[2][2], acc1[2][2];
          zero_acc(acc0);
          zero_acc(acc1);
          h_tile(c, pass ? (const u16*)p.H : p.O, 1024, M, tm * 256, pass ? p.WRW : p.WATT, 1024, tn * 128);
          asm volatile("s_waitcnt vmcnt(0) lgkmcnt(0)" ::: "memory");
          __builtin_amdgcn_s_barrier();
          h_stage(c, 0);
          h_main(acc0, acc1, c, 32, lds);
          auto epi = [&](const f32x16 (&acc)[2][2], int tbase) {
#pragma unroll
            for (int tb = 0; tb < 2; ++tb) {
              const int tok = tbase + tb * 32 + l32;
              if (tok < M) {
                const u16* gp = p.P + (size_t)tok * NIN + 6528 + pass * 1024 + nbase + 4 * h;
                u16* dst = p.MERGED + (size_t)tok * 1024 + nbase + 4 * h;
#pragma unroll
                for (int nb = 0; nb < 2; ++nb)
#pragma unroll
                  for (int i = 0; i < 4; ++i) {
                    const u32x2 ga = *(const u32x2*)(gp + nb * 32 + 8 * i);
                    float o0 = sigm(bf_lo(ga.x)) * acc[nb][tb][4 * i];
                    float o1 = sigm(bf_hi(ga.x)) * acc[nb][tb][4 * i + 1];
                    float o2 = sigm(bf_lo(ga.y)) * acc[nb][tb][4 * i + 2];
                    float o3 = sigm(bf_hi(ga.y)) * acc[nb][tb][4 * i + 3];
                    if (pass) {
                      const u32x2 pv = *(const u32x2*)(dst + nb * 32 + 8 * i);
                      o0 += bf_lo(pv.x); o1 += bf_hi(pv.x); o2 += bf_lo(pv.y); o3 += bf_hi(pv.y);
                    }
                    *(u32x2*)(dst + nb * 32 + 8 * i) = (u32x2){pk_bf16(o0, o1), pk_bf16(o2, o3)};
                  }
              }
            }
          };
          epi(acc0, tm * 256 + (wave >> 1) * 64);
          epi(acc1, tm * 256 + 128 + (wave >> 1) * 64);
        }
      }
    } break;
    case 9:
      gemm_phase_w(p.MERGED, 1024, M, p.WOUT, 1024, 1024, lds, gctr, [&](const f32x16 (&acc)[2][2], int nb, int tb) { epi_resid<1>(acc, nb, tb, p, G); });
      break;
    case 10:
      gemm_phase_w(p.HB, 1024, M, p.W2A, 1024, 2 * FFD, lds, gctr, [&](const f32x16 (&acc)[2][2], int nb, int tb) { epi_swiglu(acc, nb, tb, M, p.ss2, p.ACT); });
      break;
    case 11:
      gemm_phase_w(p.ACT, FFD, M, p.WD2, FFD, 1024, lds, gctr, [&](const f32x16 (&acc)[2][2], int nb, int tb) { epi_resid<2>(acc, nb, tb, p, G); });
      break;
    case 12: phase_final(p, G); break;
  }
}

__global__ void __launch_bounds__(256, 2) mega(Params p, int ph_lo, int ph_hi, int coop) {
  __shared__ __attribute__((aligned(16))) char lds[65536 + 16];
  uint4& xb_words = *(uint4*)(lds + 65536);
  CP* pp = (CP*)__builtin_amdgcn_kernarg_segment_ptr();
  asm volatile("" : "+s"(pp));
  if (threadIdx.x == 0) xb_words = make_uint4(0u, 0u, 0u, 0u);
  __syncthreads();
  const XcdBarrier xb = xcd_barrier_post(pp->bar, (volatile LAS unsigned*)&xb_words);
  for (int ph = ph_lo; ph < ph_hi; ++ph) {
    run_phase(*pp, ph, lds);
    if (coop && ph + 1 < ph_hi) {
      if (ph == 0) cg::this_grid().sync();
      else xcd_barrier(xb);
    }
  }
}

extern "C" void kernel_launch(void* const* d_in, const int* in_sizes, int n_in, void* d_out, int out_size, void* d_ws,
                              size_t ws_size, hipStream_t stream) {
  Params p;
  memset(&p, 0, sizeof(p));
  const float** f = (const float**)&p;
  for (int i = 0; i < 35; ++i) f[i] = (const float*)d_in[i];
  p.out = (float*)d_out;
  char* w = (char*)d_ws;
  size_t off = 0;
  auto alloc = [&](size_t bytes) { char* r = w + off; off += (bytes + 255) & ~(size_t)255; return r; };
  p.W1A = (u16*)alloc((size_t)2 * FFD * 1024 * 2);
  p.WD1 = (u16*)alloc((size_t)1024 * FFD * 2);
  p.WIN = (u16*)alloc((size_t)NIN * 1024 * 2);
  p.WATT = (u16*)alloc((size_t)1024 * 1024 * 2);
  p.WRW = (u16*)alloc((size_t)1024 * 1024 * 2);
  p.WOUT = (u16*)alloc((size_t)1024 * 1024 * 2);
  p.W2A = (u16*)alloc((size_t)2 * FFD * 1024 * 2);
  p.WD2 = (u16*)alloc((size_t)1024 * FFD * 2);
  p.W2F = (u16*)alloc((size_t)1024 * 64 * 2);
  p.W2B = (u16*)alloc((size_t)1024 * 64 * 2);
  p.A2F = (u16*)alloc((size_t)1024 * 64 * 2);
  p.A2B = (u16*)alloc((size_t)1024 * 64 * 2);
  p.G2T = (u16*)alloc((size_t)1024 * 128 * 2);
  p.lut = (float*)alloc(8 * 512 * 4);
  p.cnt = (int*)alloc((64 + NPHASES * 64) * 4);
  p.lam = (float*)alloc(256);
  p.bar = (unsigned*)alloc(XCD_BAR_WORDS * 4);
  const size_t R = MAXROWS;
  p.H = (float*)alloc(R * 1024 * 4);
  p.HB = (u16*)alloc(R * 1024 * 2);
  p.ACT = (u16*)alloc(R * FFD * 2);
  p.Y0 = p.ACT;
  p.Y1 = p.ACT + R * 1024;
  p.F = p.ACT + R * 2048;
  p.P = (u16*)alloc(R * NIN * 2);
  p.RKV = (u16*)alloc(R * 16 * 192 * 2);
  p.DIR0 = (u16*)alloc(R * 16 * 192 * 2);
  p.DIR1 = (u16*)alloc(R * 16 * 192 * 2);
  p.G = (u16*)alloc(R * 1024 * 2);
  p.O = (u16*)alloc(R * 1024 * 2);
  p.MERGED = (u16*)alloc(R * 1024 * 2);
  p.VT = (u16*)alloc((size_t)8 * 8 * 128 * 2112 * 2);
  p.PM = (u16*)alloc((size_t)16 * NIN * 2);
  p.ss0 = (float*)alloc(R * 4);
  p.ss1 = (float*)alloc(R * 4);
  p.ss2 = (float*)alloc(R * 4);
  p.ss3 = (float*)alloc(R * 4);
  if (off > ws_size) { fprintf(stderr, "workspace too small: need %zu have %zu\n", off, ws_size); return; }
  static int grid_blocks = 0;
  if (!grid_blocks) {
    int dev = 0, cus = 0, per_cu = 0;
    hipGetDevice(&dev);
    hipDeviceGetAttribute(&cus, hipDeviceAttributeMultiprocessorCount, dev);
    hipOccupancyMaxActiveBlocksPerMultiprocessor(&per_cu, mega, 256, 0);
    per_cu = 2;
    grid_blocks = cus * per_cu;
  }
  hipMemsetAsync(p.bar, 0, XCD_BAR_WORDS * 4, stream);
  hipMemsetAsync(p.cnt, 0, (64 + NPHASES * 64) * 4, stream);
  int ph_lo = 0, ph_hi = NPHASES, coop = 1;
  void* args[] = {&p, &ph_lo, &ph_hi, &coop};
  hipError_t e = hipLaunchCooperativeKernel((void*)mega, dim3(grid_blocks), dim3(256), args, 0, stream);
  if (e != hipSuccess) fprintf(stderr, "cooperative launch failed: %s (grid %d)\n", hipGetErrorString(e), grid_blocks);
}
```

```cpp
#include <hip/hip_runtime.h>
#include <hip/hip_cooperative_groups.h>
#include <stdint.h>
#include <string.h>
#include <stdio.h>
namespace cg = cooperative_groups;

typedef unsigned short u16;
typedef short bf16x8 __attribute__((ext_vector_type(8)));
typedef float f32x16 __attribute__((ext_vector_type(16)));
typedef float f32x4 __attribute__((ext_vector_type(4)));
typedef float f32x2 __attribute__((ext_vector_type(2)));
typedef unsigned u32x4 __attribute__((ext_vector_type(4)));
typedef unsigned u32x2 __attribute__((ext_vector_type(2)));
typedef __bf16 bf16x2_t __attribute__((ext_vector_type(2)));
typedef _Float16 f16x2_t __attribute__((ext_vector_type(2)));

#define NIN 8576
#define FFD 2816
#define EPSN 1e-6f
#define LOG2E 1.4426950408889634f
#define NGROUPS 6
#define PH_PER_G 13
#define NMETA_PH 4
#define NPHASES (1 + NMETA_PH + NGROUPS * PH_PER_G)
#define MAXROWS 16512

struct Params {
  const float *x_prompt, *x_sample, *meta, *rel_bias, *ffn1_norm, *ffn1_wg, *ffn1_wu, *ffn1_wd, *mix_norm, *w_in;
  const float *lq1, *lk1, *lq2, *lk2, *subln, *w_attn, *mu_prev, *mu_next, *rw_w0, *rw_w2, *rw_a0, *rw_a2, *rw_g2;
  const float *k_k, *k_a, *r_k, *lnx_w, *lnx_b, *w_rw, *w_out, *ffn2_norm, *ffn2_wg, *ffn2_wu, *ffn2_wd, *final_norm;
  float* out;
  u16 *W1A, *WD1, *WIN, *WATT, *WRW, *WOUT, *W2A, *WD2, *W2F, *W2B, *A2F, *A2B, *G2T;
  float* lut; int* cnt; float* lam; unsigned* bar; u16* VT; u16* PM;
  float* H; u16 *HB, *ACT, *P, *RKV, *DIR0, *DIR1, *G, *O, *MERGED, *Y0, *Y1, *F;
  float *ss0, *ss1, *ss2, *ss3;
};

typedef const Params __attribute__((address_space(4))) CP;
struct Grp { int nseq, L, S, lgS, M, Mx, meta; const float* x; float* out; };
__device__ __forceinline__ int rowof(const Grp& G, int s, int t) { return t < 16 ? G.Mx + s * 16 + t : s * G.S + (t - 16); }

__device__ __forceinline__ Grp get_grp(CP& p, int g) {
  Grp r;
  r.meta = 0;
  if (g < 0) {
    r.nseq = 1; r.L = 16; r.S = 16; r.lgS = 4; r.x = p.meta; r.out = nullptr; r.M = 16; r.Mx = 16; r.meta = 1;
    return r;
  }
  if (g < 4) { r.nseq = 4; r.L = 4112; r.S = 4096; r.lgS = 12; r.x = p.x_prompt + (size_t)g * 4 * 4096 * 1024; r.out = p.out + (size_t)g * 4 * 4096 * 1024; }
  else { r.nseq = 8; r.L = 2064; r.S = 2048; r.lgS = 11; r.x = p.x_sample + (size_t)(g - 4) * 8 * 2048 * 1024; r.out = p.out + (size_t)16 * 4096 * 1024 + (size_t)(g - 4) * 8 * 2048 * 1024; }
  r.M = r.nseq * r.L;
  r.Mx = r.nseq * r.S;
  return r;
}

__device__ __forceinline__ int ltid() { int t = threadIdx.x; asm volatile("" : "+v"(t)); return t; }
__device__ __forceinline__ unsigned pk_bf16(float a, float b) {
  f32x2 v = {a, b};
  bf16x2_t r = __builtin_convertvector(v, bf16x2_t);
  return __builtin_bit_cast(unsigned, r);
}
__device__ __forceinline__ float bf_lo(unsigned u) { return __uint_as_float(u << 16); }
__device__ __forceinline__ float bf_hi(unsigned u) { return __uint_as_float(u & 0xffff0000u); }
__device__ __forceinline__ unsigned pk_f16(float a, float b) {
  f32x2 v = {a, b};
  f16x2_t r = __builtin_convertvector(v, f16x2_t);
  return __builtin_bit_cast(unsigned, r);
}
__device__ __forceinline__ float h_lo(unsigned u) { f16x2_t r = __builtin_bit_cast(f16x2_t, u); return (float)r.x; }
__device__ __forceinline__ float h_hi(unsigned u) { f16x2_t r = __builtin_bit_cast(f16x2_t, u); return (float)r.y; }
__device__ __forceinline__ u16 bf16_1(float a) { return (u16)(pk_bf16(a, 0.f) & 0xffffu); }
__device__ __forceinline__ float sigm(float x) { return __builtin_amdgcn_rcpf(1.f + __builtin_amdgcn_exp2f(-LOG2E * x)); }
__device__ __forceinline__ float wave_sum(float v) {
#pragma unroll
  for (int o = 32; o > 0; o >>= 1) v += __shfl_xor(v, o);
  return v;
}
template <int CTRL> __device__ __forceinline__ float dppf(float x) {
  return __int_as_float(__builtin_amdgcn_update_dpp(0, __float_as_int(x), CTRL, 0xf, 0xf, true));
}
__device__ __forceinline__ float xmax32(float x) {
  const auto r = __builtin_amdgcn_permlane32_swap(__float_as_uint(x), __float_as_uint(x), false, false);
  return fmaxf(__uint_as_float(r[0]), __uint_as_float(r[1]));
}
__device__ __forceinline__ float reduce8(float x) {
  x += dppf<0xB1>(x);
  x += dppf<0x4E>(x);
  x += dppf<0x141>(x);
  return x;
}
__device__ __forceinline__ float reduce4(float x) {
  x += dppf<0xB1>(x);
  x += dppf<0x4E>(x);
  return x;
}

__device__ void prep_transpose(const float* __restrict__ src, int K, int N, u16* __restrict__ dst,
                               const float* __restrict__ gain, int mode, char* lds) {
  float* tile = (float*)lds;
  const int tn = N / 64, nt = (K / 64) * tn;
  const int tid = ltid();
  for (int t = blockIdx.x; t < nt; t += gridDim.x) {
    const int k0 = (t / tn) * 64, n0 = (t % tn) * 64;
    const int nl = tid & 63, kq = tid >> 6;
#pragma unroll
    for (int i = 0; i < 16; ++i) {
      const int k = i * 4 + kq;
      float v = src[(size_t)(k0 + k) * N + n0 + nl];
      if (gain) v *= gain[k0 + k];
      tile[k * 65 + nl] = v;
    }
    __syncthreads();
    const int n = tid >> 2, kk = (tid & 3) * 16;
    unsigned w[8];
#pragma unroll
    for (int i = 0; i < 8; ++i) w[i] = pk_bf16(tile[(kk + 2 * i) * 65 + n], tile[(kk + 2 * i + 1) * 65 + n]);
    const int ng = n0 + n;
    const int row = mode == 0 ? ng : ((ng >> 5) * 64 + (ng & 31) + (mode == 2 ? 32 : 0));
    u32x4* d = (u32x4*)(dst + (size_t)row * K + k0 + kk);
    d[0] = (u32x4){w[0], w[1], w[2], w[3]};
    d[1] = (u32x4){w[4], w[5], w[6], w[7]};
    __syncthreads();
  }
}

__device__ void phase_prep(CP& p, char* lds) {
  if (blockIdx.x == 0) {
    const int tid = ltid();
    for (int idx = tid; idx < 8 * 511; idx += 256) {
      const int hd = idx / 511, di = idx - hd * 511, d = di - 255;
      const int n = d < 0 ? -d : d;
      int bk;
      if (n < 8) bk = n;
      else {
        const float nf = (float)n;
        int large = 8 + (int)(logf(nf / 8.0f) / 2.772588722239781f * 8.0f);
        bk = large < 15 ? large : 15;
      }
      const int bucket = (d > 0 ? 16 : 0) + bk;
      p.lut[hd * 512 + di] = p.rel_bias[bucket * 8 + hd] * LOG2E;
    }
    if (tid == 0) {
      float s1 = 0.f, s2 = 0.f;
      for (int i = 0; i < 64; ++i) { s1 += p.lq1[i] * p.lk1[i]; s2 += p.lq2[i] * p.lk2[i]; }
      p.lam[0] = expf(s1) - expf(s2) + 0.2f;
    }
  }
  prep_transpose(p.ffn1_wg, 1024, FFD, p.W1A, p.ffn1_norm, 1, lds);
  prep_transpose(p.ffn1_wu, 1024, FFD, p.W1A, p.ffn1_norm, 2, lds);
  prep_transpose(p.ffn1_wd, FFD, 1024, p.WD1, nullptr, 0, lds);
  prep_transpose(p.w_in, 1024, NIN, p.WIN, p.mix_norm, 0, lds);
  prep_transpose(p.w_attn, 1024, 1024, p.WATT, nullptr, 0, lds);
  prep_transpose(p.w_rw, 1024, 1024, p.WRW, nullptr, 0, lds);
  prep_transpose(p.w_out, 1024, 1024, p.WOUT, nullptr, 0, lds);
  prep_transpose(p.ffn2_wg, 1024, FFD, p.W2A, p.ffn2_norm, 1, lds);
  prep_transpose(p.ffn2_wu, 1024, FFD, p.W2A, p.ffn2_norm, 2, lds);
  prep_transpose(p.ffn2_wd, FFD, 1024, p.WD2, nullptr, 0, lds);
  prep_transpose(p.rw_w2, 64, 1024, p.W2F, nullptr, 0, lds);
  prep_transpose(p.rw_w2 + 64 * 1024, 64, 1024, p.W2B, nullptr, 0, lds);
  prep_transpose(p.rw_a2, 64, 1024, p.A2F, nullptr, 0, lds);
  prep_transpose(p.rw_a2 + 64 * 1024, 64, 1024, p.A2B, nullptr, 0, lds);
  prep_transpose(p.rw_g2, 128, 1024, p.G2T, nullptr, 0, lds);
}

__device__ void phase_rows(CP& p, const Grp& G) {
  const int lane = ltid() & 63;
  const int nw = gridDim.x * 4;
  const int gw = blockIdx.x * 4 + (ltid() >> 6);
#pragma unroll 2
  for (int row = gw; row < G.Mx; row += nw) {
    const float* src = G.x + (size_t)row * 1024;
    float ss = 0.f;
#pragma unroll
    for (int i = 0; i < 4; ++i) {
      const f32x4 v = *(const f32x4*)(src + i * 256 + lane * 4);
      ss += v.x * v.x + v.y * v.y + v.z * v.z + v.w * v.w;
      u32x2 o = {pk_bf16(v.x, v.y), pk_bf16(v.z, v.w)};
      *(u32x2*)(p.HB + (size_t)row * 1024 + i * 256 + lane * 4) = o;
    }
    ss = wave_sum(ss);
    if (lane == 0) { p.ss0[row] = ss; p.ss1[row] = 0.f; p.ss2[row] = 0.f; p.ss3[row] = 0.f; }
  }
  if (G.meta) return;
  const int Lp = (G.L + 63) & ~63;
  for (int r = gw; r < G.nseq * 16; r += nw) {
    const int s = r >> 4, t = r & 15;
    const u16* srcp = p.PM + (size_t)t * NIN;
    u16* dstp = p.P + (size_t)(G.Mx + r) * NIN;
    for (int c = lane * 8; c < NIN; c += 512)
      if (c < 2048 || c >= 3072) *(u32x4*)(dstp + c) = *(const u32x4*)(srcp + c);
    const int pos = (t & ~12) | ((t & 4) << 1) | ((t & 8) >> 1);
    for (int c = lane; c < 1024; c += 64) p.VT[(size_t)(s * 1024 + c) * Lp + pos] = srcp[2048 + c];
  }
}

#define LAS __attribute__((address_space(3)))
#define XB_TMO      128
#define XB_XCNT(j)  (256  + 64 * (j))
#define XB_XSUB(j)  (1280 + 64 * (j))
#define XB_XGEN(j)  (2304 + 64 * (j))
#define XB_TOP      3328
#define XB_TOPGEN   3392
#define XCD_BAR_WORDS 3456
#define XB_SPIN_CAP (1u << 18)
__device__ __forceinline__ unsigned xb_ld(unsigned* p) { return __hip_atomic_load(p, __ATOMIC_RELAXED, __HIP_MEMORY_SCOPE_AGENT); }
__device__ __forceinline__ unsigned xb_add(unsigned* p, unsigned v) { return __hip_atomic_fetch_add(p, v, __ATOMIC_RELAXED, __HIP_MEMORY_SCOPE_AGENT); }
__device__ __forceinline__ unsigned xb_xcc_id() { return (unsigned)__builtin_amdgcn_s_getreg((3 << 11) | 20) & 0xFu; }
#define XB_SPIN(cond, bar) do { unsigned _sp = 0; while (cond) { __builtin_amdgcn_s_sleep(1); \
    if ((++_sp & 255u) == 0u) { if (xb_ld(&(bar)[XB_TMO])) break; if (_sp > XB_SPIN_CAP) { atomicAdd(&(bar)[XB_TMO], 1u); break; } } } } while (0)
struct XcdBarrier { unsigned* bar; unsigned x; volatile LAS unsigned* st; };
__device__ __forceinline__ XcdBarrier xcd_barrier_post(unsigned* bar, volatile LAS unsigned* st) {
  XcdBarrier b; b.bar = bar; b.x = xb_xcc_id(); b.st = st;
  if (threadIdx.x == 0) (void)xb_add(&bar[XB_XCNT(b.x)], 1u);
  return b;
}
__device__ __forceinline__ void xcd_barrier_complete(unsigned* bar, unsigned x, unsigned& nloc, unsigned& nx) {
  const unsigned G = gridDim.x * gridDim.y * gridDim.z;
  unsigned sum, cnt, mine, sp = 0u;
  for (;;) {
    sum = 0u; cnt = 0u; mine = 0u;
#pragma unroll
    for (unsigned j = 0; j < 16; ++j) { const unsigned c = xb_ld(&bar[XB_XCNT(j)]); sum += c; cnt += (c > 0u) ? 1u : 0u; mine = (j == x) ? c : mine; }
    if (sum == G) break;
    __builtin_amdgcn_s_sleep(1);
    if ((++sp & 255u) == 0u) { if (xb_ld(&bar[XB_TMO])) break; if (sp > XB_SPIN_CAP) { atomicAdd(&bar[XB_TMO], 1u); break; } }
  }
  nloc = mine > 0u ? mine : 1u; nx = cnt > 0u ? cnt : 1u;
}
__device__ __forceinline__ void xcd_barrier(const XcdBarrier& b) {
  asm volatile("s_waitcnt vmcnt(0)" ::: "memory");
  __syncthreads();
  if (threadIdx.x == 0) {
    unsigned* bar = b.bar;
    __builtin_amdgcn_s_waitcnt(0);
    unsigned nloc = b.st[0], nx = b.st[1];
    if (nloc == 0u) { xcd_barrier_complete(bar, b.x, nloc, nx); b.st[0] = nloc; b.st[1] = nx; }
    const unsigned old = xb_add(&bar[XB_XSUB(b.x)], 1u);
    const unsigned gen = old / nloc;
    if (old + 1u == (gen + 1u) * nloc) {
      __builtin_amdgcn_fence(__ATOMIC_RELEASE, "agent");
      asm volatile("s_waitcnt vmcnt(0)" ::: "memory");
      const unsigned og = xb_add(&bar[XB_TOP], 1u);
      const unsigned tg = og / nx;
      if (og + 1u == (tg + 1u) * nx) xb_add(&bar[XB_TOPGEN], 1u);
      else XB_SPIN(xb_ld(&bar[XB_TOPGEN]) == tg, bar);
      __builtin_amdgcn_fence(__ATOMIC_ACQUIRE, "agent");
      xb_add(&bar[XB_XGEN(b.x)], 1u);
      asm volatile("s_waitcnt vmcnt(0)" ::: "memory");
    } else {
      XB_SPIN(xb_ld(&bar[XB_XGEN(b.x)]) == gen, bar);
      __builtin_amdgcn_fence(__ATOMIC_ACQUIRE, "agent");
      asm volatile("s_waitcnt vmcnt(0)" ::: "memory");
    }
  }
  __syncthreads();
}

#define LAS __attribute__((address_space(3)))
#define LAS __attribute__((address_space(3)))
#define LAS __attribute__((address_space(3)))
__device__ __forceinline__ void glds16(const void* gsrc, unsigned lds_dst) {
  unsigned keep;
  asm volatile("s_mov_b32 %0, m0\n\ts_mov_b32 m0, %2\n\ts_nop 0\n\tglobal_load_lds_dwordx4 %1, off\n\ts_mov_b32 m0, %0" : "=&s"(keep) : "v"(gsrc), "s"(lds_dst) : "memory");
}
struct GemmCtx {
  const u16* ap[2];
  const u16* wp[2];
  int wro[2], wsw[2], aro[2], asw[2];
  unsigned lds0;
  int tid, h;
};
__device__ __forceinline__ void g_init(GemmCtx& c, char* lds) {
  const int tid = ltid(), lane = tid & 63, wave = tid >> 6;
  const int wn = wave & 1, wt = wave >> 1, l32 = lane & 31;
  c.tid = tid; c.h = lane >> 5;
#pragma unroll
  for (int b = 0; b < 2; ++b) {
    const int wr = wn * 64 + b * 32 + l32, ar = wt * 64 + b * 32 + l32;
    c.wro[b] = wr * 64; c.wsw[b] = (wr >> 2) & 3;
    c.aro[b] = 8192 + ar * 64; c.asw[b] = (ar >> 2) & 3;
  }
  c.lds0 = __builtin_amdgcn_readfirstlane((unsigned)(uintptr_t)(LAS char*)lds + wave * 1024);
}
__device__ __forceinline__ void g_tile(GemmCtx& c, const u16* __restrict__ A, int lda, int M, int m0, const u16* __restrict__ W, int ldw, int n0) {
#pragma unroll
  for (int i = 0; i < 2; ++i) {
    const int q = c.tid + 256 * i, row = q >> 2, ch = (q & 3) ^ ((row >> 2) & 3);
    int ar = m0 + row; ar = ar < M ? ar : M - 1;
    c.ap[i] = A + (size_t)ar * lda + ch * 8;
    c.wp[i] = W + (size_t)(n0 + row) * ldw + ch * 8;
  }
}
__device__ __forceinline__ void g_stage(const GemmCtx& c, int kt) {
  const unsigned sb = c.lds0 + (kt & 3) * 16384;
#pragma unroll
  for (int i = 0; i < 2; ++i) {
    glds16(c.wp[i] + kt * 32, sb + i * 4096);
    glds16(c.ap[i] + kt * 32, sb + 8192 + i * 4096);
  }
}
__device__ __forceinline__ void g_prologue(const GemmCtx& c, int nk) {
#pragma unroll
  for (int s = 0; s < 3; ++s)
    if (s < nk) g_stage(c, s);
}
struct Frags { bf16x8 w[2][2], a[2][2]; };
__device__ __forceinline__ void g_read(Frags& f, const GemmCtx& c, int kt, const char* lds) {
  const char* st = lds + (kt & 3) * 16384;
#pragma unroll
  for (int ks = 0; ks < 2; ++ks)
#pragma unroll
    for (int b = 0; b < 2; ++b) {
      f.w[ks][b] = *(const bf16x8*)(st + c.wro[b] + (((ks * 2 + c.h) ^ c.wsw[b]) << 4));
      f.a[ks][b] = *(const bf16x8*)(st + c.aro[b] + (((ks * 2 + c.h) ^ c.asw[b]) << 4));
    }
}
__device__ __forceinline__ void g_mma(f32x16 (&acc)[2][2], const Frags& f) {
#pragma unroll
  for (int ks = 0; ks < 2; ++ks)
#pragma unroll
    for (int nb = 0; nb < 2; ++nb)
#pragma unroll
      for (int tb = 0; tb < 2; ++tb)
        acc[nb][tb] = __builtin_amdgcn_mfma_f32_32x32x16_bf16(f.w[ks][nb], f.a[ks][tb], acc[nb][tb], 0, 0, 0);
}
__device__ __forceinline__ void g_wait(int ks_needed, int issued_hi, bool drain_all) {
  const int allowed = issued_hi - ks_needed;
  if (drain_all || allowed <= 0) asm volatile("s_waitcnt vmcnt(0) lgkmcnt(0)" ::: "memory");
  else if (allowed == 1) asm volatile("s_waitcnt vmcnt(4) lgkmcnt(0)" ::: "memory");
  else asm volatile("s_waitcnt vmcnt(8) lgkmcnt(0)" ::: "memory");
  __builtin_amdgcn_s_barrier();
}
__device__ __forceinline__ void g_main(f32x16 (&acc)[2][2], const GemmCtx& c, int nk, char* lds) {
  Frags f0, f1;
  g_wait(0, nk - 1 < 2 ? nk - 1 : 2, true);
  if (3 < nk) g_stage(c, 3);
  g_read(f0, c, 0, lds);
  for (int kt = 0; kt < nk; kt += 2) {
    {
      const int hi = (kt + 3 < nk - 1) ? kt + 3 : nk - 1;
      g_wait(kt + 1, hi, false);
      if (kt + 4 < nk) g_stage(c, kt + 4);
      g_read(f1, c, kt + 1, lds);
      g_mma(acc, f0);
    }
    if (kt + 2 < nk) {
      const int hi = (kt + 4 < nk - 1) ? kt + 4 : nk - 1;
      g_wait(kt + 2, hi, false);
      if (kt + 5 < nk) g_stage(c, kt + 5);
      g_read(f0, c, kt + 2, lds);
    }
    g_mma(acc, f1);
  }
}
__device__ __forceinline__ void gemm_kloop(f32x16 (&acc)[2][2], const u16* __restrict__ A, int lda, int M, int m0,
                                           const u16* __restrict__ W, int ldw, int n0, int K, char* lds) {
  GemmCtx c;
  g_init(c, lds);
  g_tile(c, A, lda, M, m0, W, ldw, n0);
  asm volatile("s_waitcnt vmcnt(0)" ::: "memory");
  __builtin_amdgcn_s_barrier();
  g_prologue(c, K >> 5);
  g_main(acc, c, K >> 5, lds);
}

__device__ __forceinline__ void zero_acc(f32x16 (&acc)[2][2]) {
#pragma unroll
  for (int a = 0; a < 2; ++a)
#pragma unroll
    for (int b = 0; b < 2; ++b)
#pragma unroll
      for (int r = 0; r < 16; ++r) acc[a][b][r] = 0.f;
}

template <class F>
__device__ __forceinline__ void gemm_phase(const u16* A, int lda, int M, const u16* W, int K, int N, char* lds, int* ctr, F&& epi) {
  const int nN = N >> 7, nM = (M + 127) >> 7, nt = nN * nM, nk = K >> 5;
  const int xcd = (int)xb_xcc_id() & 7;
  const int tq = nt >> 3, trm = nt & 7;
  const int tstart = xcd < trm ? xcd * (tq + 1) : trm * (tq + 1) + (xcd - trm) * tq;
  const int tcnt = tq + (xcd < trm ? 1 : 0);
  auto decode = [&](int off, int& tm, int& tn) {
    const int id = tstart + off, nig = 8 * nN, grp = id / nig, fm = grp * 8;
    const int gsz = (nM - fm) < 8 ? (nM - fm) : 8, idl = id - grp * nig;
    tm = fm + idl % gsz; tn = idl / gsz;
  };
  GemmCtx c;
  g_init(c, lds);
  const int wave = c.tid >> 6;
  volatile int* bw = (volatile int*)(lds + 65536);
  int* myctr = ctr + xcd;
  int par = 0;
  if (c.tid == 0) bw[2] = atomicAdd(myctr, 1);
  asm volatile("s_waitcnt vmcnt(0) lgkmcnt(0)" ::: "memory");
  __builtin_amdgcn_s_barrier();
  int off = bw[2];
  int tm = 0, tn = 0;
  if (off < tcnt) { decode(off, tm, tn); g_tile(c, A, lda, M, tm * 128, W, K, tn * 128); g_prologue(c, nk); }
  while (off < tcnt) {
    f32x16 acc[2][2];
    zero_acc(acc);
    g_main(acc, c, nk, lds);
    const int ctm = tm, ctn = tn;
    par ^= 1;
    if (c.tid == 0) bw[2 + par] = atomicAdd(myctr, 1);
    asm volatile("s_waitcnt lgkmcnt(0)" ::: "memory");
    __builtin_amdgcn_s_barrier();
    off = bw[2 + par];
    if (off < tcnt) { decode(off, tm, tn); g_tile(c, A, lda, M, tm * 128, W, K, tn * 128); g_prologue(c, nk); }
    epi(acc, ctn * 128 + (wave & 1) * 64, ctm * 128 + (wave >> 1) * 64);
  }
}

struct WideCtx {
  const u16* ap[4];
  const u16* wp[2];
  int wro[2], wsw[2], aro[2][2], asw[2][2];
  unsigned lds0;
  int tid, h;
};
__device__ __forceinline__ void h_init(WideCtx& c, char* lds) {
  const int tid = ltid(), lane = tid & 63, wave = tid >> 6;
  const int wn = wave & 1, wt = wave >> 1, l32 = lane & 31;
  c.tid = tid; c.h = lane >> 5;
#pragma unroll
  for (int b = 0; b < 2; ++b) {
    const int wr = wn * 64 + b * 32 + l32;
    c.wro[b] = wr * 64; c.wsw[b] = (wr >> 2) & 3;
#pragma unroll
    for (int j = 0; j < 2; ++j) {
      const int ar = j * 128 + wt * 64 + b * 32 + l32;
      c.aro[j][b] = 8192 + ar * 64; c.asw[j][b] = (ar >> 2) & 3;
    }
  }
  c.lds0 = __builtin_amdgcn_readfirstlane((unsigned)(uintptr_t)(LAS char*)lds + wave * 1024);
}
__device__ __forceinline__ void h_tile(WideCtx& c, const u16* __restrict__ A, int lda, int M, int m0, const u16* __restrict__ W, int ldw, int n0) {
#pragma unroll
  for (int i = 0; i < 2; ++i) {
    const int q = c.tid + 256 * i, row = q >> 2, ch = (q & 3) ^ ((row >> 2) & 3);
    c.wp[i] = W + (size_t)(n0 + row) * ldw + ch * 8;
  }
#pragma unroll
  for (int i = 0; i < 4; ++i) {
    const int q = c.tid + 256 * i, row = q >> 2, ch = (q & 3) ^ ((row >> 2) & 3);
    int ar = m0 + row; ar = ar < M ? ar : M - 1;
    c.ap[i] = A + (size_t)ar * lda + ch * 8;
  }
}
__device__ __forceinline__ void h_stage(const WideCtx& c, int kt) {
  const unsigned sb = c.lds0 + (kt & 1) * 24576;
#pragma unroll
  for (int i = 0; i < 2; ++i) glds16(c.wp[i] + kt * 32, sb + i * 4096);
#pragma unroll
  for (int i = 0; i < 4; ++i) glds16(c.ap[i] + kt * 32, sb + 8192 + i * 4096);
}
__device__ __forceinline__ void h_main(f32x16 (&acc0)[2][2], f32x16 (&acc1)[2][2], const WideCtx& c, int nk, char* lds) {
  const int h = c.h;
  for (int kt = 0; kt < nk; ++kt) {
    asm volatile("s_waitcnt vmcnt(0)" ::: "memory");
    __builtin_amdgcn_s_barrier();
    if (kt + 1 < nk) h_stage(c, kt + 1);
    const char* st = lds + (kt & 1) * 24576;
#pragma unroll
    for (int ks = 0; ks < 2; ++ks) {
      bf16x8 wf[2], a0[2], a1[2];
#pragma unroll
      for (int b = 0; b < 2; ++b) {
        wf[b] = *(const bf16x8*)(st + c.wro[b] + (((ks * 2 + h) ^ c.wsw[b]) << 4));
        a0[b] = *(const bf16x8*)(st + c.aro[0][b] + (((ks * 2 + h) ^ c.asw[0][b]) << 4));
        a1[b] = *(const bf16x8*)(st + c.aro[1][b] + (((ks * 2 + h) ^ c.asw[1][b]) << 4));
      }
#pragma unroll
      for (int nb = 0; nb < 2; ++nb)
#pragma unroll
        for (int tb = 0; tb < 2; ++tb) {
          acc0[nb][tb] = __builtin_amdgcn_mfma_f32_32x32x16_bf16(wf[nb], a0[tb], acc0[nb][tb], 0, 0, 0);
          acc1[nb][tb] = __builtin_amdgcn_mfma_f32_32x32x16_bf16(wf[nb], a1[tb], acc1[nb][tb], 0, 0, 0);
        }
    }
  }
}
template <class F>
__device__ __forceinline__ void gemm_phase_w(const u16* A, int lda, int M, const u16* W, int K, int N, char* lds, int* ctr, F&& epi) {
  const int nN = N >> 7, nM = (M + 255) >> 8, nt = nN * nM, nk = K >> 5;
  const int xcd = (int)xb_xcc_id() & 7;
  const int tq = nt >> 3, trm = nt & 7;
  const int tstart = xcd < trm ? xcd * (tq + 1) : trm * (tq + 1) + (xcd - trm) * tq;
  const int tcnt = tq + (xcd < trm ? 1 : 0);
  auto decode = [&](int off, int& tm, int& tn) {
    const int id = tstart + off, nig = 4 * nN, grp = id / nig, fm = grp * 4;
    const int gsz = (nM - fm) < 4 ? (nM - fm) : 4, idl = id - grp * nig;
    tm = fm + idl % gsz; tn = idl / gsz;
  };
  WideCtx c;
  h_init(c, lds);
  const int wave = c.tid >> 6;
  volatile int* bw = (volatile int*)(lds + 65536);
  int* myctr = ctr + xcd;
  int par = 0;
  if (c.tid == 0) bw[2] = atomicAdd(myctr, 1);
  asm volatile("s_waitcnt vmcnt(0) lgkmcnt(0)" ::: "memory");
  __builtin_amdgcn_s_barrier();
  int off = bw[2];
  int tm = 0, tn = 0;
  if (off < tcnt) { decode(off, tm, tn); h_tile(c, A, lda, M, tm * 256, W, K, tn * 128); h_stage(c, 0); }
  while (off < tcnt) {
    f32x16 acc0[2][2], acc1[2][2];
    zero_acc(acc0);
    zero_acc(acc1);
    h_main(acc0, acc1, c, nk, lds);
    const int ctm = tm, ctn = tn;
    par ^= 1;
    if (c.tid == 0) bw[2 + par] = atomicAdd(myctr, 1);
    asm volatile("s_waitcnt lgkmcnt(0)" ::: "memory");
    __builtin_amdgcn_s_barrier();
    off = bw[2 + par];
    if (off < tcnt) { decode(off, tm, tn); h_tile(c, A, lda, M, tm * 256, W, K, tn * 128); h_stage(c, 0); }
    epi(acc0, ctn * 128 + (wave & 1) * 64, ctm * 256 + (wave >> 1) * 64);
    epi(acc1, ctn * 128 + (wave & 1) * 64, ctm * 256 + 128 + (wave >> 1) * 64);
  }
}


__device__ __forceinline__ void epi_swiglu(const f32x16 (&acc)[2][2], int nbase, int tbase, int M, const float* ss, u16* ACT) {
  const int lane = ltid() & 63, l32 = lane & 31, h = lane >> 5;
  const int cb = (nbase >> 6) * 32;
#pragma unroll
  for (int tb = 0; tb < 2; ++tb) {
    const int tok = tbase + tb * 32 + l32;
    if (tok < M) {
      const float rs = rsqrtf(ss[tok] * (1.f / 1024.f) + EPSN);
      u16* dst = ACT + (size_t)tok * FFD + cb + 4 * h;
#pragma unroll
      for (int i = 0; i < 4; ++i) {
        float o[4];
#pragma unroll
        for (int j = 0; j < 4; ++j) {
          const float g = acc[0][tb][4 * i + j] * rs, u = acc[1][tb][4 * i + j] * rs;
          o[j] = g * sigm(g) * u;
        }
        *(u32x2*)(dst + 8 * i) = (u32x2){pk_bf16(o[0], o[1]), pk_bf16(o[2], o[3])};
      }
    }
  }
}

template <int MODE>
__device__ __forceinline__ void epi_resid(const f32x16 (&acc)[2][2], int nbase, int tbase, CP& p, const Grp& G) {
  const int lane = ltid() & 63, l32 = lane & 31, h = lane >> 5;
  const float scale = MODE == 1 ? 1.f : 0.5f;
  float* ssout = MODE == 0 ? p.ss1 : (MODE == 1 ? p.ss2 : p.ss3);
#pragma unroll
  for (int tb = 0; tb < 2; ++tb) {
    const int tok = tbase + tb * 32 + l32;
    const bool valid = tok < G.Mx;
    float sq = 0.f;
    if (valid) {
      float* hp = p.H + (size_t)tok * 1024;
      u16* hb = p.HB + (size_t)tok * 1024;
      const float* rp = G.x + (size_t)tok * 1024;
#pragma unroll
      for (int nb = 0; nb < 2; ++nb)
#pragma unroll
        for (int i = 0; i < 4; ++i) {
          const int n = nbase + nb * 32 + 8 * i + 4 * h;
          f32x4 r;
          if (MODE == 0) r = *(const f32x4*)(rp + n);
          else { const u32x2 rb = *(const u32x2*)(hb + n); r = (f32x4){bf_lo(rb.x), bf_hi(rb.x), bf_lo(rb.y), bf_hi(rb.y)}; }
          f32x4 v;
          v.x = r.x + scale * acc[nb][tb][4 * i + 0];
          v.y = r.y + scale * acc[nb][tb][4 * i + 1];
          v.z = r.z + scale * acc[nb][tb][4 * i + 2];
          v.w = r.w + scale * acc[nb][tb][4 * i + 3];
          sq += v.x * v.x + v.y * v.y + v.z * v.z + v.w * v.w;
          if (MODE == 2) *(f32x4*)(hp + n) = v;
          else *(u32x2*)(hb + n) = (u32x2){pk_bf16(v.x, v.y), pk_bf16(v.z, v.w)};
        }
    }
    sq += __shfl_xor(sq, 32);
    if (valid && h == 0) atomicAdd(ssout + tok, sq);
  }
}

__device__ void phase_mix(CP& p, const Grp& G) {
  const int total = G.M * 432;
#pragma unroll 2
  for (int idx = blockIdx.x * 256 + ltid(); idx < total; idx += gridDim.x * 256) {
    const int row = idx / 432, ch = idx - row * 432;
    int s, t;
    if (row < G.Mx) { s = row >> G.lgS; t = 16 + (row & (G.S - 1)); } else { s = (row - G.Mx) >> 4; t = (row - G.Mx) & 15; }
    const int col = ch * 8;
    const u16* pc = p.P + (size_t)row * NIN + 3072 + col;
    const u32x4 c = *(const u32x4*)pc;
    u32x4 pv = {0, 0, 0, 0}, nx = {0, 0, 0, 0};
    if (t > 0) pv = *(const u32x4*)(p.P + (size_t)rowof(G, s, t - 1) * NIN + 3072 + col);
    if (t < G.L - 1) nx = *(const u32x4*)(p.P + (size_t)rowof(G, s, t + 1) * NIN + 3072 + col);
    const f32x4 mp0 = *(const f32x4*)(p.mu_prev + col), mp1 = *(const f32x4*)(p.mu_prev + col + 4);
    const f32x4 mn0 = *(const f32x4*)(p.mu_next + col), mn1 = *(const f32x4*)(p.mu_next + col + 4);
    float o[8];
#pragma unroll
    for (int e = 0; e < 4; ++e) {
      const float c0 = bf_lo(c[e]), c1 = bf_hi(c[e]);
      const float mpa = e < 2 ? mp0[2 * e] : mp1[2 * e - 4], mpb = e < 2 ? mp0[2 * e + 1] : mp1[2 * e - 3];
      const float mna = e < 2 ? mn0[2 * e] : mn1[2 * e - 4], mnb = e < 2 ? mn0[2 * e + 1] : mn1[2 * e - 3];
      o[2 * e] = c0 + mpa * (bf_lo(pv[e]) - c0) + mna * (bf_lo(nx[e]) - c0);
      o[2 * e + 1] = c1 + mpb * (bf_hi(pv[e]) - c1) + mnb * (bf_hi(nx[e]) - c1);
    }
    if (col < 3072) {
      const int sec = col >> 10, ci = col & 1023, head = ci >> 6, c0 = ci & 63;
      const size_t ro = ((size_t)row * 16 + head) * 192 + sec * 64 + c0;
      const u32x4 pk = (u32x4){pk_f16(o[0], o[1]), pk_f16(o[2], o[3]), pk_f16(o[4], o[5]), pk_f16(o[6], o[7])};
      *(u32x4*)(p.RKV + ro) = pk;
      if (sec == 1) { *(u32x4*)(p.DIR0 + ro) = pk; *(u32x4*)(p.DIR1 + ro) = pk; }
    } else {
      const int fc = col - 3072;
      if (fc < 128) {
#pragma unroll
        for (int e = 0; e < 8; ++e) o[e] = 1.f - 2.f / (1.f + __expf(2.f * o[e]));
      } else if (fc >= 256) {
#pragma unroll
        for (int e = 0; e < 8; ++e) o[e] = sigm(o[e]);
      }
      *(u32x4*)(p.F + (size_t)row * 384 + fc) = (u32x4){pk_bf16(o[0], o[1]), pk_bf16(o[2], o[3]), pk_bf16(o[4], o[5]), pk_bf16(o[6], o[7])};
    }
  }
}

__device__ __forceinline__ void epi_decay(const f32x16 (&acc)[2][2], int nbase, int tbase, int M, const float* w0, u16* DIR) {
  const int lane = ltid() & 63, l32 = lane & 31, h = lane >> 5;
  const int head = nbase >> 6;
#pragma unroll
  for (int tb = 0; tb < 2; ++tb) {
    const int tok = tbase + tb * 32 + l32;
    if (tok < M) {
      u16* dst = DIR + ((size_t)tok * 16 + head) * 192;
#pragma unroll
      for (int nb = 0; nb < 2; ++nb)
#pragma unroll
        for (int i = 0; i < 4; ++i) {
          const int c = nb * 32 + 8 * i + 4 * h;
          const f32x4 w = *(const f32x4*)(w0 + nbase + c);
          float o[4];
#pragma unroll
          for (int j = 0; j < 4; ++j) o[j] = 0.6065306597126334f * sigm(w[j] + acc[nb][tb][4 * i + j]);
          *(u32x2*)(dst + c) = (u32x2){pk_f16(o[0], o[1]), pk_f16(o[2], o[3])};
        }
    }
  }
}

__device__ __forceinline__ void epi_adir(const f32x16 (&acc)[2][2], int nbase, int tbase, int M, CP& p, int dir) {
  const int lane = ltid() & 63, l32 = lane & 31, h = lane >> 5;
  const int head = nbase >> 6;
  u16* DIR = dir ? p.DIR1 : p.DIR0;
  const float* a0 = p.rw_a0 + dir * 1024;
#pragma unroll
  for (int tb = 0; tb < 2; ++tb) {
    const int tok = tbase + tb * 32 + l32;
    const bool valid = tok < M;
    const int tk = valid ? tok : M - 1;
    const size_t rec = ((size_t)tk * 16 + head) * 192;
    float nsq = 0.f;
#pragma unroll
    for (int nb = 0; nb < 2; ++nb)
#pragma unroll
      for (int i = 0; i < 4; ++i) {
        const int c = nb * 32 + 8 * i + 4 * h;
        const u32x2 kr = *(const u32x2*)(DIR + rec + 64 + c);
        const f32x4 kkw = *(const f32x4*)(p.k_k + nbase + c);
        const float q0 = h_lo(kr.x) * kkw[0], q1 = h_hi(kr.x) * kkw[1], q2 = h_lo(kr.y) * kkw[2], q3 = h_hi(kr.y) * kkw[3];
        nsq += q0 * q0 + q1 * q1 + q2 * q2 + q3 * q3;
      }
    nsq += __shfl_xor(nsq, 32);
    const float inv = 1.f / fmaxf(sqrtf(nsq), 1e-12f);
    if (valid) {
#pragma unroll
      for (int nb = 0; nb < 2; ++nb)
#pragma unroll
        for (int i = 0; i < 4; ++i) {
          const int c = nb * 32 + 8 * i + 4 * h;
          const u32x2 kr = *(const u32x2*)(DIR + rec + 64 + c);
          const float kv[4] = {h_lo(kr.x), h_hi(kr.x), h_lo(kr.y), h_hi(kr.y)};
          const f32x4 kkw = *(const f32x4*)(p.k_k + nbase + c);
          const f32x4 kaw = *(const f32x4*)(p.k_a + nbase + c);
          const f32x4 a0v = *(const f32x4*)(a0 + nbase + c);
          float kk[4], kd[4], bp[4];
#pragma unroll
          for (int j = 0; j < 4; ++j) {
            const float k = kv[j];
            kk[j] = k * kkw[j] * inv;
            const float aa = sigm(a0v[j] + acc[nb][tb][4 * i + j]);
            kd[j] = k * (1.f + (aa - 1.f) * kaw[j]);
            bp[j] = -kk[j] * aa;
          }
          if (dir == 0) *(u32x2*)(p.RKV + rec + 64 + c) = (u32x2){pk_f16(kk[0], kk[1]), pk_f16(kk[2], kk[3])};
          *(u32x2*)(DIR + rec + 64 + c) = (u32x2){pk_f16(kd[0], kd[1]), pk_f16(kd[2], kd[3])};
          *(u32x2*)(DIR + rec + 128 + c) = (u32x2){pk_f16(bp[0], bp[1]), pk_f16(bp[2], bp[3])};
        }
    }
  }
}

template <int LPR>
__device__ void scan_task(CP& p, const Grp& G, int task, char* lds) {
  constexpr int KPL = 64 / LPR, RPB = 256 / LPR, NSPLIT = 64 / RPB;
  const int part = task % NSPLIT, t1 = task / NSPLIT;
  const int dir = t1 & 1, head = (t1 >> 1) & 15, s = t1 >> 5;
  float* buf = (float*)lds;
  const u16* rkv = p.RKV;
  const u16* dr = dir ? p.DIR1 : p.DIR0;
  u16* Y = dir ? p.Y1 : p.Y0;
  const int tid = ltid();
  const int row = part * RPB + tid / LPR, kc = tid % LPR;
  const int L = G.L, nch = L >> 4;
  u32x4 pre[3];
  auto issue = [&](int c) {
#pragma unroll
    for (int i = 0; i < 3; ++i) {
      const int id = tid + 256 * i, st = id / 48, ci = id - st * 48;
      const int n = c * 16 + st, t = dir ? L - 1 - n : n;
      const size_t rec = ((size_t)rowof(G, s, t) * 16 + head) * 192;
      const u16* src = ci < 24 ? rkv + rec + ci * 8 : dr + rec + (ci - 24) * 8;
      pre[i] = *(const u32x4*)src;
    }
  };
  auto commit = [&](int b) {
#pragma unroll
    for (int i = 0; i < 3; ++i) {
      const int id = tid + 256 * i, st = id / 48, ci = id - st * 48;
      const int sec = ci >> 3;
      const int base = sec >= 3 ? (sec - 1) * 64 : (sec == 0 ? 64 : (sec == 1 ? 0 : 320));
      float f[8];
#pragma unroll
      for (int e = 0; e < 4; ++e) { f[2 * e] = h_lo(pre[i][e]); f[2 * e + 1] = h_hi(pre[i][e]); }
      if (sec == 3) {
#pragma unroll
        for (int e = 0; e < 8; ++e) f[e] = __expf(-f[e]);
      }
      float* d = buf + b * 6144 + st * 384 + base + (ci & 7) * 8;
      *(f32x4*)d = (f32x4){f[0], f[1], f[2], f[3]};
      *(f32x4*)(d + 4) = (f32x4){f[4], f[5], f[6], f[7]};
    }
  };
  float S[KPL];
#pragma unroll
  for (int i = 0; i < KPL; ++i) S[i] = 0.f;
  __syncthreads();
  issue(0);
  commit(0);
  __syncthreads();
  __builtin_amdgcn_s_setprio(3);
  for (int c = 0; c < nch; ++c) {
    if (c + 1 < nch) issue(c + 1);
    const float* b = buf + (c & 1) * 6144;
#pragma unroll 1
    for (int g0 = 0; g0 < 16; g0 += LPR) {
      float ykeep = 0.f;
#pragma unroll 2
      for (int j = 0; j < LPR; ++j) {
        const int st = g0 + j;
        const float* q = b + st * 384 + kc * KPL;
        f32x4 kk[KPL / 4], rr[KPL / 4], ww[KPL / 4], dd[KPL / 4], bb[KPL / 4];
#pragma unroll
        for (int jj = 0; jj < KPL / 4; ++jj) {
          kk[jj] = *(const f32x4*)(q + 4 * jj);
          rr[jj] = *(const f32x4*)(q + 64 + 4 * jj);
          ww[jj] = *(const f32x4*)(q + 128 + 4 * jj);
          dd[jj] = *(const f32x4*)(q + 192 + 4 * jj);
          bb[jj] = *(const f32x4*)(q + 256 + 4 * jj);
        }
        const float vv = b[st * 384 + 320 + row];
        float sa0 = 0.f, sa1 = 0.f;
#pragma unroll
        for (int jj = 0; jj < KPL / 4; ++jj) {
          sa0 += S[4 * jj] * kk[jj][0]; sa1 += S[4 * jj + 1] * kk[jj][1];
          sa0 += S[4 * jj + 2] * kk[jj][2]; sa1 += S[4 * jj + 3] * kk[jj][3];
        }
        float sa = sa0 + sa1;
        sa = LPR == 8 ? reduce8(sa) : reduce4(sa);
        float y0 = 0.f, y1 = 0.f;
#pragma unroll
        for (int jj = 0; jj < KPL / 4; ++jj)
#pragma unroll
          for (int e = 0; e < 4; ++e) {
            const float sn = S[4 * jj + e] * ww[jj][e] + (sa * bb[jj][e] + vv * dd[jj][e]);
            S[4 * jj + e] = sn;
            if (e & 1) y1 += sn * rr[jj][e]; else y0 += sn * rr[jj][e];
          }
        float y = y0 + y1;
        y = LPR == 8 ? reduce8(y) : reduce4(y);
        ykeep = (kc == j) ? y : ykeep;
      }
      const int n = c * 16 + g0 + kc, t = dir ? L - 1 - n : n;
      Y[(size_t)rowof(G, s, t) * 1024 + head * 64 + row] = bf16_1(ykeep);
    }
    if (c + 1 < nch) commit((c + 1) & 1);
    __syncthreads();
  }
  __builtin_amdgcn_s_setprio(0);
}

__device__ void attn_tile(CP& p, const Grp& G, int s, int hd, int qb, char* lds, float lam) {
  const int tid = ltid(), lane = tid & 63, wave = tid >> 6, l32 = lane & 31, h = lane >> 5;
  const int L = G.L, Lp = (G.L + 63) & ~63;
  const u16* Pb = p.P;
  float* lutl = (float*)(lds + 49152);
  __syncthreads();
  for (int i = tid; i < 511; i += 256) lutl[i] = p.lut[hd * 512 + i];
  const int q = 16 + qb * 128 + wave * 32 + l32;
  const int qc = s * G.S + (q - 16);
  const int qw0 = 16 + qb * 128 + wave * 32;
  u16* odst = p.O + (size_t)qc * 1024 + hd * 128;
  int kkey[2], kchn[2];
#pragma unroll
  for (int i = 0; i < 2; ++i) { const int c = tid + 256 * i; kkey[i] = c >> 3; kchn[i] = (c & 7) ^ ((kkey[i] >> 1) & 7); }
  const u16* vsrc[4];
#pragma unroll
  for (int i = 0; i < 4; ++i) {
    const int c = tid + 256 * i, dv = c >> 3, c8 = (c & 7) ^ ((dv >> 1) & 7);
    vsrc[i] = p.VT + ((size_t)(s * 1024 + hd * 128 + dv) * Lp) + c8 * 8;
  }
  const unsigned lds0 = __builtin_amdgcn_readfirstlane((unsigned)(uintptr_t)(LAS char*)lds + wave * 1024);
  const int n64 = (L + 63) >> 6;
#pragma unroll 1
  for (int br = 0; br < 2; ++br) {
    bf16x8 qv[4];
#pragma unroll
    for (int ks = 0; ks < 4; ++ks) {
      const u32x4 raw = *(const u32x4*)(Pb + (size_t)qc * NIN + hd * 128 + br * 64 + ks * 16 + h * 8);
      u32x4 sc;
#pragma unroll
      for (int e = 0; e < 4; ++e) sc[e] = pk_bf16(bf_lo(raw[e]) * 0.125f, bf_hi(raw[e]) * 0.125f);
      qv[ks] = __builtin_bit_cast(bf16x8, sc);
    }
    const u16* kp = Pb + 1024 + hd * 128 + br * 64;
    auto stage = [&](int kt) {
      const int k0 = kt * 64;
      const unsigned sb = lds0 + (kt & 1) * 24576;
#pragma unroll
      for (int i = 0; i < 2; ++i) {
        int kr = k0 + kkey[i]; kr = kr < L ? kr : L - 1;
        glds16(kp + (size_t)rowof(G, s, kr) * NIN + kchn[i] * 8, sb + i * 4096);
      }
#pragma unroll
      for (int i = 0; i < 4; ++i) glds16(vsrc[i] + k0, sb + 8192 + i * 4096);
    };
    f32x16 O[4];
#pragma unroll
    for (int mb = 0; mb < 4; ++mb)
#pragma unroll
      for (int r = 0; r < 16; ++r) O[mb][r] = 0.f;
    float mrun = -1e30f, lrun = 0.f;
    asm volatile("s_waitcnt vmcnt(0) lgkmcnt(0)" ::: "memory");
    __builtin_amdgcn_s_barrier();
    stage(0);
    const float cneg = lutl[0], cpos = lutl[510];
    for (int kt = 0; kt < n64; ++kt) {
      asm volatile("s_waitcnt vmcnt(0)" ::: "memory");
      __builtin_amdgcn_s_barrier();
      if (kt + 1 < n64) stage(kt + 1);
      const char* st64 = lds + (kt & 1) * 24576;
#pragma unroll 1
      for (int hf = 0; hf < 2; ++hf) {
      const int kt0 = kt * 64 + hf * 32;
      if (kt0 >= L) break;
      const char* st = st64 + hf * 4096;
      f32x16 sacc;
#pragma unroll
      for (int r = 0; r < 16; ++r) sacc[r] = 0.f;
      bf16x8 kf[4], vf[4][2];
#pragma unroll
      for (int ks = 0; ks < 4; ++ks) kf[ks] = *(const bf16x8*)(st + l32 * 128 + (((ks * 2 + h) ^ ((l32 >> 1) & 7)) << 4));
#pragma unroll
      for (int mb = 0; mb < 4; ++mb)
#pragma unroll
        for (int s2 = 0; s2 < 2; ++s2) {
          const int vr = mb * 32 + l32;
          vf[mb][s2] = *(const bf16x8*)(st64 + 8192 + vr * 128 + (((hf * 4 + 2 * s2 + h) ^ ((vr >> 1) & 7)) << 4));
        }
      __builtin_amdgcn_sched_barrier(0);
#pragma unroll
      for (int ks = 0; ks < 4; ++ks) sacc = __builtin_amdgcn_mfma_f32_32x32x16_bf16(kf[ks], qv[ks], sacc, 0, 0, 0);
      const bool farneg = (kt0 + 31) <= (qw0 - 128);
      const bool farpos = kt0 >= (qw0 + 31 + 128);
      float ps = 0.f, alpha;
      if ((farneg || farpos) && (kt0 + 32 <= L)) {
        const float cv = farneg ? cneg : cpos;
        float mx = fmaxf(fmaxf(sacc[0], sacc[1]), sacc[2]);
#pragma unroll
        for (int r = 3; r < 15; r += 2) mx = fmaxf(fmaxf(mx, sacc[r]), sacc[r + 1]);
        mx = fmaxf(mx, sacc[15]);
        mx = xmax32(mx);
        const float mnew = fmaxf(mrun, mx * LOG2E + cv);
        alpha = __builtin_amdgcn_exp2f(mrun - mnew);
        mrun = mnew;
        const float sh = cv - mnew;
#pragma unroll
        for (int r = 0; r < 16; ++r) { sacc[r] = __builtin_amdgcn_exp2f(sacc[r] * LOG2E + sh); ps += sacc[r]; }
      } else {
        float mx = -1e30f;
        if (farneg || farpos) {
          const float cv = farneg ? cneg : cpos;
#pragma unroll
          for (int r = 0; r < 16; ++r) { sacc[r] = sacc[r] * LOG2E + cv; }
        } else {
#pragma unroll
          for (int r = 0; r < 16; ++r) {
            const int key = kt0 + 8 * (r >> 2) + 4 * h + (r & 3);
            int d = key - q + 255;
            d = d < 0 ? 0 : (d > 510 ? 510 : d);
            sacc[r] = sacc[r] * LOG2E + lutl[d];
          }
        }
        if (kt0 + 32 > L) {
#pragma unroll
          for (int r = 0; r < 16; ++r) {
            const int key = kt0 + 8 * (r >> 2) + 4 * h + (r & 3);
            if (key >= L) sacc[r] = -INFINITY;
          }
        }
#pragma unroll
        for (int r = 0; r < 16; ++r) mx = fmaxf(mx, sacc[r]);
        mx = xmax32(mx);
        const float mnew = fmaxf(mrun, mx);
        alpha = __builtin_amdgcn_exp2f(mrun - mnew);
        mrun = mnew;
#pragma unroll
        for (int r = 0; r < 16; ++r) { sacc[r] = __builtin_amdgcn_exp2f(sacc[r] - mnew); ps += sacc[r]; }
      }
      lrun = lrun * alpha + ps;
      if (__any(alpha != 1.f)) {
#pragma unroll
        for (int mb = 0; mb < 4; ++mb)
#pragma unroll
          for (int r = 0; r < 16; ++r) O[mb][r] *= alpha;
      }
      bf16x8 pf[2];
#pragma unroll
      for (int s2 = 0; s2 < 2; ++s2) {
        u32x4 w;
#pragma unroll
        for (int e = 0; e < 4; ++e) w[e] = pk_bf16(sacc[8 * s2 + 2 * e], sacc[8 * s2 + 2 * e + 1]);
        pf[s2] = __builtin_bit_cast(bf16x8, w);
      }
      __builtin_amdgcn_sched_barrier(0);
#pragma unroll
      for (int s2 = 0; s2 < 2; ++s2)
#pragma unroll
        for (int mb = 0; mb < 4; ++mb)
          O[mb] = __builtin_amdgcn_mfma_f32_32x32x16_bf16(vf[mb][s2], pf[s2], O[mb], 0, 0, 0);
      }
    }
    const float lt = lrun + __shfl_xor(lrun, 32);
    if (br == 0) {
      const float i1 = 1.f / lt;
#pragma unroll
      for (int mb = 0; mb < 4; ++mb)
#pragma unroll
        for (int i = 0; i < 4; ++i)
          if (q < L) *(u32x2*)(odst + mb * 32 + 8 * i + 4 * h) = (u32x2){pk_bf16(O[mb][4 * i] * i1, O[mb][4 * i + 1] * i1), pk_bf16(O[mb][4 * i + 2] * i1, O[mb][4 * i + 3] * i1)};
    } else {
      const float i2 = lam / lt;
      float ssq = 0.f;
#pragma unroll
      for (int mb = 0; mb < 4; ++mb)
#pragma unroll
        for (int i = 0; i < 4; ++i) {
          u32x2 w = {0, 0};
          if (q < L) w = *(const u32x2*)(odst + mb * 32 + 8 * i + 4 * h);
          const float o0 = bf_lo(w.x) - O[mb][4 * i] * i2, o1v = bf_hi(w.x) - O[mb][4 * i + 1] * i2, o2 = bf_lo(w.y) - O[mb][4 * i + 2] * i2, o3 = bf_hi(w.y) - O[mb][4 * i + 3] * i2;
          O[mb][4 * i] = o0; O[mb][4 * i + 1] = o1v; O[mb][4 * i + 2] = o2; O[mb][4 * i + 3] = o3;
          ssq += o0 * o0 + o1v * o1v + o2 * o2 + o3 * o3;
        }
      ssq += __shfl_xor(ssq, 32);
      const float rn = rsqrtf(ssq * (1.f / 128.f) + EPSN) * 0.8f;
      if (q < L) {
#pragma unroll
        for (int mb = 0; mb < 4; ++mb)
#pragma unroll
          for (int i = 0; i < 4; ++i) {
            const int dv = mb * 32 + 8 * i + 4 * h;
            const f32x4 g = *(const f32x4*)(p.subln + dv);
            *(u32x2*)(odst + dv) = (u32x2){pk_bf16(O[mb][4 * i] * rn * g.x, O[mb][4 * i + 1] * rn * g.y),
                                           pk_bf16(O[mb][4 * i + 2] * rn * g.z, O[mb][4 * i + 3] * rn * g.w)};
          }
      }
    }
  }
}

__device__ void phase_mixer(CP& p, const Grp& G, int g, char* lds) {
  if (G.nseq == 4) { for (int t = blockIdx.x; t < 256; t += gridDim.x) scan_task<8>(p, G, t, lds); }
  else { for (int t = blockIdx.x; t < 256; t += gridDim.x) scan_task<4>(p, G, t, lds); }
  const int nqb = G.S >> 7;
  const int nper = G.nseq * nqb;
  const float lam = p.lam[0];
  int* shw = (int*)(lds + 65536 - 16);
  const int myx = (int)xb_xcc_id() & 7;
  for (int dx = 0; dx < 8; ++dx) {
    const int hd = (myx + dx) & 7;
    while (true) {
      __syncthreads();
      if (ltid() == 0) *shw = atomicAdd(p.cnt + g * 8 + hd, 1);
      __syncthreads();
      const int t = *shw;
      if (t >= nper) break;
      const int qb = t % nqb, s = t / nqb;
      attn_tile(p, G, s, hd, qb, lds, lam);
    }
  }
}

__device__ void phase_post(CP& p, const Grp& G) {
  const int lane = ltid() & 63;
  const int nw = gridDim.x * 4;
  const int c0 = lane * 16, head = lane >> 2, hc = (lane & 3) * 16;
  for (int row = blockIdx.x * 4 + (ltid() >> 6); row < G.Mx; row += nw) {
    float y[16];
    {
      const u32x4 a0 = *(const u32x4*)(p.Y0 + (size_t)row * 1024 + c0), a1 = *(const u32x4*)(p.Y0 + (size_t)row * 1024 + c0 + 8);
      const u32x4 b0 = *(const u32x4*)(p.Y1 + (size_t)row * 1024 + c0), b1 = *(const u32x4*)(p.Y1 + (size_t)row * 1024 + c0 + 8);
#pragma unroll
      for (int e = 0; e < 4; ++e) {
        y[2 * e] = bf_lo(a0[e]) + bf_lo(b0[e]); y[2 * e + 1] = bf_hi(a0[e]) + bf_hi(b0[e]);
        y[8 + 2 * e] = bf_lo(a1[e]) + bf_lo(b1[e]); y[8 + 2 * e + 1] = bf_hi(a1[e]) + bf_hi(b1[e]);
      }
    }
    float s1 = 0.f;
#pragma unroll
    for (int e = 0; e < 16; ++e) s1 += y[e];
    s1 = reduce4(s1);
    const float mu = s1 * (1.f / 64.f);
    float s2 = 0.f;
#pragma unroll
    for (int e = 0; e < 16; ++e) { const float d = y[e] - mu; s2 += d * d; }
    s2 = reduce4(s2);
    const float rstd = rsqrtf(s2 * (1.f / 64.f) + 64e-5f);
    const size_t rec = ((size_t)row * 16 + head) * 192 + hc;
    float rr[16], vv[16], kd[16];
    {
      const u32x4 r0 = *(const u32x4*)(p.RKV + rec), r1 = *(const u32x4*)(p.RKV + rec + 8);
      const u32x4 v0 = *(const u32x4*)(p.RKV + rec + 128), v1 = *(const u32x4*)(p.RKV + rec + 136);
      const u32x4 f0 = *(const u32x4*)(p.DIR0 + rec + 64), f1 = *(const u32x4*)(p.DIR0 + rec + 72);
      const u32x4 g0 = *(const u32x4*)(p.DIR1 + rec + 64), g1 = *(const u32x4*)(p.DIR1 + rec + 72);
#pragma unroll
      for (int e = 0; e < 4; ++e) {
        rr[2 * e] = h_lo(r0[e]); rr[2 * e + 1] = h_hi(r0[e]); rr[8 + 2 * e] = h_lo(r1[e]); rr[8 + 2 * e + 1] = h_hi(r1[e]);
        vv[2 * e] = h_lo(v0[e]); vv[2 * e + 1] = h_hi(v0[e]); vv[8 + 2 * e] = h_lo(v1[e]); vv[8 + 2 * e + 1] = h_hi(v1[e]);
        kd[2 * e] = h_lo(f0[e]) + h_lo(g0[e]); kd[2 * e + 1] = h_hi(f0[e]) + h_hi(g0[e]);
        kd[8 + 2 * e] = h_lo(f1[e]) + h_lo(g1[e]); kd[8 + 2 * e + 1] = h_hi(f1[e]) + h_hi(g1[e]);
      }
    }
    float bs = 0.f;
#pragma unroll
    for (int e = 0; e < 16; ++e) bs += rr[e] * kd[e] * p.r_k[c0 + e];
    bs = reduce4(bs);
    const u32x4 g0 = *(const u32x4*)(p.G + (size_t)row * 1024 + c0), g1 = *(const u32x4*)(p.G + (size_t)row * 1024 + c0 + 8);
    float o[16];
#pragma unroll
    for (int e = 0; e < 16; ++e) {
      const unsigned gw = e < 8 ? g0[e >> 1] : g1[(e - 8) >> 1];
      const float gg = (e & 1) ? bf_hi(gw) : bf_lo(gw);
      o[e] = ((y[e] - mu) * rstd * p.lnx_w[c0 + e] + p.lnx_b[c0 + e] + bs * vv[e]) * gg;
    }
    u16* dst = (u16*)p.H + (size_t)row * 1024 + c0;
    *(u32x4*)dst = (u32x4){pk_bf16(o[0], o[1]), pk_bf16(o[2], o[3]), pk_bf16(o[4], o[5]), pk_bf16(o[6], o[7])};
    *(u32x4*)(dst + 8) = (u32x4){pk_bf16(o[8], o[9]), pk_bf16(o[10], o[11]), pk_bf16(o[12], o[13]), pk_bf16(o[14], o[15])};
  }
}

__device__ void phase_final(CP& p, const Grp& G) {
  const int lane = ltid() & 63;
  const int nw = gridDim.x * 4;
#pragma unroll 2
  for (int row = blockIdx.x * 4 + (ltid() >> 6); row < G.Mx; row += nw) {
    const float rs = rsqrtf(p.ss3[row] * (1.f / 1024.f) + EPSN);
    const float* hp = p.H + (size_t)row * 1024;
    float* op = G.out + (size_t)row * 1024;
#pragma unroll
    for (int i = 0; i < 4; ++i) {
      const f32x4 v = *(const f32x4*)(hp + i * 256 + lane * 4);
      const f32x4 g = *(const f32x4*)(p.final_norm + i * 256 + lane * 4);
      *(f32x4*)(op + i * 256 + lane * 4) = (f32x4){v.x * rs * g.x, v.y * rs * g.y, v.z * rs * g.z, v.w * rs * g.w};
    }
  }
}

__device__ void run_phase(CP& p, int ph, char* lds) {
  int* gctr = p.cnt + 64 + ph * 64;
  if (ph == 0) { phase_prep(p, lds); return; }
  int g, k;
  if (ph <= NMETA_PH) { g = -1; k = ph - 1; }
  else { g = (ph - 1 - NMETA_PH) / PH_PER_G; k = (ph - 1 - NMETA_PH) - g * PH_PER_G; }
  const Grp G = get_grp(p, g);
  const int Mall = G.M;
  const int M = G.Mx;
  u16* Pout = G.meta ? p.PM : p.P;
  switch (k) {
    case 0: phase_rows(p, G); break;
    case 1:
      gemm_phase_w(p.HB, 1024, M, p.W1A, 1024, 2 * FFD, lds, gctr, [&](const f32x16 (&acc)[2][2], int nb, int tb) { epi_swiglu(acc, nb, tb, M, p.ss0, p.ACT); });
      break;
    case 2:
      gemm_phase_w(p.ACT, FFD, M, p.WD1, FFD, 1024, lds, gctr, [&](const f32x16 (&acc)[2][2], int nb, int tb) { epi_resid<0>(acc, nb, tb, p, G); });
      break;
    case 3:
      gemm_phase_w(p.HB, 1024, M, p.WIN, 1024, NIN, lds, gctr, [&](const f32x16 (&acc)[2][2], int nbase, int tbase) {
        const int lane = ltid() & 63, l32 = lane & 31, h = lane >> 5;
#pragma unroll
        for (int tb = 0; tb < 2; ++tb) {
          const int tok = tbase + tb * 32 + l32;
          if (tok < M) {
            const float rs = rsqrtf(p.ss1[tok] * (1.f / 1024.f) + EPSN);
            if (!G.meta && nbase >= 2048 && nbase < 3072) {
              const int s = tok >> G.lgS, t = 16 + (tok & (G.S - 1));
              const int Lp = (G.L + 63) & ~63;
              const int pos = (t & ~12) | ((t & 4) << 1) | ((t & 8) >> 1);
              u16* vt = p.VT + ((size_t)(s * 1024 + (nbase - 2048)) * Lp) + pos;
#pragma unroll
              for (int nb = 0; nb < 2; ++nb)
#pragma unroll
                for (int r = 0; r < 16; ++r) {
                  const int dvl = nb * 32 + 8 * (r >> 2) + 4 * h + (r & 3);
                  vt[(size_t)dvl * Lp] = bf16_1(acc[nb][tb][r] * rs);
                }
            } else {
              u16* dst = Pout + (size_t)tok * NIN + nbase + 4 * h;
#pragma unroll
              for (int nb = 0; nb < 2; ++nb)
#pragma unroll
                for (int i = 0; i < 4; ++i)
                  *(u32x2*)(dst + nb * 32 + 8 * i) = (u32x2){pk_bf16(acc[nb][tb][4 * i] * rs, acc[nb][tb][4 * i + 1] * rs),
                                                             pk_bf16(acc[nb][tb][4 * i + 2] * rs, acc[nb][tb][4 * i + 3] * rs)};
            }
          }
        }
      });
      break;
    case 4: phase_mix(p, G); break;
    case 5:
      gemm_phase(p.F, 384, Mall, p.W2F, 64, 1024, lds, gctr, [&](const f32x16 (&acc)[2][2], int nb, int tb) { epi_decay(acc, nb, tb, Mall, p.rw_w0, p.DIR0); });
      gemm_phase(p.F + 64, 384, Mall, p.W2B, 64, 1024, lds, gctr + 8, [&](const f32x16 (&acc)[2][2], int nb, int tb) { epi_decay(acc, nb, tb, Mall, p.rw_w0 + 1024, p.DIR1); });
      gemm_phase(p.F + 128, 384, Mall, p.A2F, 64, 1024, lds, gctr + 16, [&](const f32x16 (&acc)[2][2], int nb, int tb) { epi_adir(acc, nb, tb, Mall, p, 0); });
      gemm_phase(p.F + 192, 384, Mall, p.A2B, 64, 1024, lds, gctr + 24, [&](const f32x16 (&acc)[2][2], int nb, int tb) { epi_adir(acc, nb, tb, Mall, p, 1); });
      gemm_phase(p.F + 256, 384, Mall, p.G2T, 128, 1024, lds, gctr + 32, [&](const f32x16 (&acc)[2][2], int nbase, int tbase) {
        const int lane = ltid() & 63, l32 = lane & 31, h = lane >> 5;
#pragma unroll
        for (int tb = 0; tb < 2; ++tb) {
          const int tok = tbase + tb * 32 + l32;
          if (tok < Mall) {
            u16* dst = p.G + (size_t)tok * 1024 + nbase + 4 * h;
#pragma unroll
            for (int nb = 0; nb < 2; ++nb)
#pragma unroll
              for (int i = 0; i < 4; ++i)
                *(u32x2*)(dst + nb * 32 + 8 * i) = (u32x2){pk_bf16(acc[nb][tb][4 * i], acc[nb][tb][4 * i + 1]), pk_bf16(acc[nb][tb][4 * i + 2], acc[nb][tb][4 * i + 3])};
          }
        }
      });
      break;
    case 6: phase_mixer(p, G, g, lds); break;
    case 7: phase_post(p, G); break;
    case 8: {
      const int nN = 8, nM = (M + 255) >> 8, nt = nN * nM;
      const int wave = ltid() >> 6;
      const int lane = ltid() & 63, l32 = lane & 31, h = lane >> 5;
      const int xcd = blockIdx.x & 7, g8 = gridDim.x >> 3;
      const int tq = nt >> 3, trm = nt & 7;
      const int tstart = xcd < trm ? xcd * (tq + 1) : trm * (tq + 1) + (xcd - trm) * tq;
      const int tcnt = tq + (xcd < trm ? 1 : 0);
      WideCtx c;
      h_init(c, lds);
      for (int off = blockIdx.x >> 3; off < tcnt; off += g8) {
        const int id = tstart + off, nig = 4 * nN, grp = id / nig, fm = grp * 4;
        const int gsz = (nM - fm) < 4 ? (nM - fm) : 4, idl = id - grp * nig;
        const int tm = fm + idl % gsz, tn = idl / gsz;
        const int nbase = tn * 128 + (wave & 1) * 64;
#pragma unroll 1
        for (int pass = 0; pass < 2; ++pass) {
          f32x16 acc0[2][2], acc1[2][2];
          zero_acc(acc0);
          zero_acc(acc1);
          h_tile(c, pass ? (const u16*)p.H : p.O, 1024, M, tm * 256, pass ? p.WRW : p.WATT, 1024, tn * 128);
          asm volatile("s_waitcnt vmcnt(0) lgkmcnt(0)" ::: "memory");
          __builtin_amdgcn_s_barrier();
          h_stage(c, 0);
          h_main(acc0, acc1, c, 32, lds);
          auto epi = [&](const f32x16 (&acc)[2][2], int tbase) {
#pragma unroll
            for (int tb = 0; tb < 2; ++tb) {
              const int tok = tbase + tb * 32 + l32;
              if (tok < M) {
                const u16* gp = p.P + (size_t)tok * NIN + 6528 + pass * 1024 + nbase + 4 * h;
                u16* dst = p.MERGED + (size_t)tok * 1024 + nbase + 4 * h;
#pragma unroll
                for (int nb = 0; nb < 2; ++nb)
#pragma unroll
                  for (int i = 0; i < 4; ++i) {
                    const u32x2 ga = *(const u32x2*)(gp + nb * 32 + 8 * i);
                    float o0 = sigm(bf_lo(ga.x)) * acc[nb][tb][4 * i];
                    float o1 = sigm(bf_hi(ga.x)) * acc[nb][tb][4 * i + 1];
                    float o2 = sigm(bf_lo(ga.y)) * acc[nb][tb][4 * i + 2];
                    float o3 = sigm(bf_hi(ga.y)) * acc[nb][tb][4 * i + 3];
                    if (pass) {
                      const u32x2 pv = *(const u32x2*)(dst + nb * 32 + 8 * i);
                      o0 += bf_lo(pv.x); o1 += bf_hi(pv.x); o2 += bf_lo(pv.y); o3 += bf_hi(pv.y);
                    }
                    *(u32x2*)(dst + nb * 32 + 8 * i) = (u32x2){pk_bf16(o0, o1), pk_bf16(o2, o3)};
                  }
              }
            }
          };
          epi(acc0, tm * 256 + (wave >> 1) * 64);
          epi(acc1, tm * 256 + 128 + (wave >> 1) * 64);
        }
      }
    } break;
    case 9:
      gemm_phase_w(p.MERGED, 1024, M, p.WOUT, 1024, 1024, lds, gctr, [&](const f32x16 (&acc)[2][2], int nb, int tb) { epi_resid<1>(acc, nb, tb, p, G); });
      break;
    case 10:
      gemm_phase_w(p.HB, 1024, M, p.W2A, 1024, 2 * FFD, lds, gctr, [&](const f32x16 (&acc)[2][2], int nb, int tb) { epi_swiglu(acc, nb, tb, M, p.ss2, p.ACT); });
      break;
    case 11:
      gemm_phase_w(p.ACT, FFD, M, p.WD2, FFD, 1024, lds, gctr, [&](const f32x16 (&acc)[2][2], int nb, int tb) { epi_resid<2>(acc, nb, tb, p, G); });
      break;
    case 12: phase_final(p, G); break;
  }
}

__global__ void __launch_bounds__(256, 2) mega(Params p, int ph_lo, int ph_hi, int coop) {
  __shared__ __attribute__((aligned(16))) char lds[65536 + 16];
  uint4& xb_words = *(uint4*)(lds + 65536);
  CP* pp = (CP*)__builtin_amdgcn_kernarg_segment_ptr();
  asm volatile("" : "+s"(pp));
  if (threadIdx.x == 0) xb_words = make_uint4(0u, 0u, 0u, 0u);
  __syncthreads();
  const XcdBarrier xb = xcd_barrier_post(pp->bar, (volatile LAS unsigned*)&xb_words);
  for (int ph = ph_lo; ph < ph_hi; ++ph) {
    run_phase(*pp, ph, lds);
    if (coop && ph + 1 < ph_hi) {
      if (ph == 0) cg::this_grid().sync();
      else xcd_barrier(xb);
    }
  }
}

extern "C" void kernel_launch(void* const* d_in, const int* in_sizes, int n_in, void* d_out, int out_size, void* d_ws,
                              size_t ws_size, hipStream_t stream) {
  Params p;
  memset(&p, 0, sizeof(p));
  const float** f = (const float**)&p;
  for (int i = 0; i < 35; ++i) f[i] = (const float*)d_in[i];
  p.out = (float*)d_out;
  char* w = (char*)d_ws;
  size_t off = 0;
  auto alloc = [&](size_t bytes) { char* r = w + off; off += (bytes + 255) & ~(size_t)255; return r; };
  p.W1A = (u16*)alloc((size_t)2 * FFD * 1024 * 2);
  p.WD1 = (u16*)alloc((size_t)1024 * FFD * 2);
  p.WIN = (u16*)alloc((size_t)NIN * 1024 * 2);
  p.WATT = (u16*)alloc((size_t)1024 * 1024 * 2);
  p.WRW = (u16*)alloc((size_t)1024 * 1024 * 2);
  p.WOUT = (u16*)alloc((size_t)1024 * 1024 * 2);
  p.W2A = (u16*)alloc((size_t)2 * FFD * 1024 * 2);
  p.WD2 = (u16*)alloc((size_t)1024 * FFD * 2);
  p.W2F = (u16*)alloc((size_t)1024 * 64 * 2);
  p.W2B = (u16*)alloc((size_t)1024 * 64 * 2);
  p.A2F = (u16*)alloc((size_t)1024 * 64 * 2);
  p.A2B = (u16*)alloc((size_t)1024 * 64 * 2);
  p.G2T = (u16*)alloc((size_t)1024 * 128 * 2);
  p.lut = (float*)alloc(8 * 512 * 4);
  p.cnt = (int*)alloc((64 + NPHASES * 64) * 4);
  p.lam = (float*)alloc(256);
  p.bar = (unsigned*)alloc(XCD_BAR_WORDS * 4);
  const size_t R = MAXROWS;
  p.H = (float*)alloc(R * 1024 * 4);
  p.HB = (u16*)alloc(R * 1024 * 2);
  p.ACT = (u16*)alloc(R * FFD * 2);
  p.Y0 = p.ACT;
  p.Y1 = p.ACT + R * 1024;
  p.F = p.ACT + R * 2048;
  p.P = (u16*)alloc(R * NIN * 2);
  p.RKV = (u16*)alloc(R * 16 * 192 * 2);
  p.DIR0 = (u16*)alloc(R * 16 * 192 * 2);
  p.DIR1 = (u16*)alloc(R * 16 * 192 * 2);
  p.G = (u16*)alloc(R * 1024 * 2);
  p.O = (u16*)alloc(R * 1024 * 2);
  p.MERGED = (u16*)alloc(R * 1024 * 2);
  p.VT = (u16*)alloc((size_t)8 * 8 * 128 * 2112 * 2);
  p.PM = (u16*)alloc((size_t)16 * NIN * 2);
  p.ss0 = (float*)alloc(R * 4);
  p.ss1 = (float*)alloc(R * 4);
  p.ss2 = (float*)alloc(R * 4);
  p.ss3 = (float*)alloc(R * 4);
  if (off > ws_size) { fprintf(stderr, "workspace too small: need %zu have %zu\n", off, ws_size); return; }
  static int grid_blocks = 0;
  if (!grid_blocks) {
    int dev = 0, cus = 0, per_cu = 0;
    hipGetDevice(&dev);
    hipDeviceGetAttribute(&cus, hipDeviceAttributeMultiprocessorCount, dev);
    hipOccupancyMaxActiveBlocksPerMultiprocessor(&per_cu, mega, 256, 0);
    per_cu = 2;
    grid_blocks = cus * per_cu;
  }
  hipMemsetAsync(p.bar, 0, XCD_BAR_WORDS * 4, stream);
  hipMemsetAsync(p.cnt, 0, (64 + NPHASES * 64) * 4, stream);
  int ph_lo = 0, ph_hi = NPHASES, coop = 1;
  void* args[] = {&p, &ph_lo, &ph_hi, &coop};
  hipError_t e = hipLaunchCooperativeKernel((void*)mega, dim3(grid_blocks), dim3(256), args, 0, stream);
  if (e != hipSuccess) fprintf(stderr, "cooperative launch failed: %s (grid %d)\n", hipGetErrorString(e), grid_blocks);
}
```

```cpp
#include <hip/hip_runtime.h>
#include <hip/hip_cooperative_groups.h>
#include <stdint.h>
#include <string.h>
#include <stdio.h>
namespace cg = cooperative_groups;

typedef unsigned short u16;
typedef short bf16x8 __attribute__((ext_vector_type(8)));
typedef float f32x16 __attribute__((ext_vector_type(16)));
typedef float f32x4 __attribute__((ext_vector_type(4)));
typedef float f32x2 __attribute__((ext_vector_type(2)));
typedef unsigned u32x4 __attribute__((ext_vector_type(4)));
typedef unsigned u32x2 __attribute__((ext_vector_type(2)));
typedef __bf16 bf16x2_t __attribute__((ext_vector_type(2)));
typedef _Float16 f16x2_t __attribute__((ext_vector_type(2)));

#define NIN 8576
#define FFD 2816
#define EPSN 1e-6f
#define LOG2E 1.4426950408889634f
#define NGROUPS 6
#define PH_PER_G 13
#define NMETA_PH 4
#define NPHASES (1 + NMETA_PH + NGROUPS * PH_PER_G)
#define MAXROWS 16512

struct Params {
  const float *x_prompt, *x_sample, *meta, *rel_bias, *ffn1_norm, *ffn1_wg, *ffn1_wu, *ffn1_wd, *mix_norm, *w_in;
  const float *lq1, *lk1, *lq2, *lk2, *subln, *w_attn, *mu_prev, *mu_next, *rw_w0, *rw_w2, *rw_a0, *rw_a2, *rw_g2;
  const float *k_k, *k_a, *r_k, *lnx_w, *lnx_b, *w_rw, *w_out, *ffn2_norm, *ffn2_wg, *ffn2_wu, *ffn2_wd, *final_norm;
  float* out;
  u16 *W1A, *WD1, *WIN, *WATT, *WRW, *WOUT, *W2A, *WD2, *W2F, *W2B, *A2F, *A2B, *G2T;
  float* lut; int* cnt; float* lam; unsigned* bar; u16* VT; u16* PM;
  float* H; u16 *HB, *ACT, *P, *RKV, *DIR0, *DIR1, *G, *O, *MERGED, *Y0, *Y1, *F;
  float *ss0, *ss1, *ss2, *ss3;
};

typedef const Params __attribute__((address_space(4))) CP;
struct Grp { int nseq, L, S, lgS, M, Mx, meta; const float* x; float* out; };
__device__ __forceinline__ int rowof(const Grp& G, int s, int t) { return t < 16 ? G.Mx + s * 16 + t : s * G.S + (t - 16); }

__device__ __forceinline__ Grp get_grp(CP& p, int g) {
  Grp r;
  r.meta = 0;
  if (g < 0) {
    r.nseq = 1; r.L = 16; r.S = 16; r.lgS = 4; r.x = p.meta; r.out = nullptr; r.M = 16; r.Mx = 16; r.meta = 1;
    return r;
  }
  if (g < 4) { r.nseq = 4; r.L = 4112; r.S = 4096; r.lgS = 12; r.x = p.x_prompt + (size_t)g * 4 * 4096 * 1024; r.out = p.out + (size_t)g * 4 * 4096 * 1024; }
  else { r.nseq = 8; r.L = 2064; r.S = 2048; r.lgS = 11; r.x = p.x_sample + (size_t)(g - 4) * 8 * 2048 * 1024; r.out = p.out + (size_t)16 * 4096 * 1024 + (size_t)(g - 4) * 8 * 2048 * 1024; }
  r.M = r.nseq * r.L;
  r.Mx = r.nseq * r.S;
  return r;
}

__device__ __forceinline__ int ltid() { int t = threadIdx.x; asm volatile("" : "+v"(t)); return t; }
__device__ __forceinline__ unsigned pk_bf16(float a, float b) {
  f32x2 v = {a, b};
  bf16x2_t r = __builtin_convertvector(v, bf16x2_t);
  return __builtin_bit_cast(unsigned, r);
}
__device__ __forceinline__ float bf_lo(unsigned u) { return __uint_as_float(u << 16); }
__device__ __forceinline__ float bf_hi(unsigned u) { return __uint_as_float(u & 0xffff0000u); }
__device__ __forceinline__ unsigned pk_f16(float a, float b) {
  f32x2 v = {a, b};
  f16x2_t r = __builtin_convertvector(v, f16x2_t);
  return __builtin_bit_cast(unsigned, r);
}
__device__ __forceinline__ float h_lo(unsigned u) { f16x2_t r = __builtin_bit_cast(f16x2_t, u); return (float)r.x; }
__device__ __forceinline__ float h_hi(unsigned u) { f16x2_t r = __builtin_bit_cast(f16x2_t, u); return (float)r.y; }
__device__ __forceinline__ u16 bf16_1(float a) { return (u16)(pk_bf16(a, 0.f) & 0xffffu); }
__device__ __forceinline__ float sigm(float x) { return __builtin_amdgcn_rcpf(1.f + __builtin_amdgcn_exp2f(-LOG2E * x)); }
__device__ __forceinline__ float wave_sum(float v) {
#pragma unroll
  for (int o = 32; o > 0; o >>= 1) v += __shfl_xor(v, o);
  return v;
}
template <int CTRL> __device__ __forceinline__ float dppf(float x) {
  return __int_as_float(__builtin_amdgcn_update_dpp(0, __float_as_int(x), CTRL, 0xf, 0xf, true));
}
__device__ __forceinline__ float xmax32(float x) {
  const auto r = __builtin_amdgcn_permlane32_swap(__float_as_uint(x), __float_as_uint(x), false, false);
  return fmaxf(__uint_as_float(r[0]), __uint_as_float(r[1]));
}
__device__ __forceinline__ float reduce8(float x) {
  x += dppf<0xB1>(x);
  x += dppf<0x4E>(x);
  x += dppf<0x141>(x);
  return x;
}
__device__ __forceinline__ float reduce4(float x) {
  x += dppf<0xB1>(x);
  x += dppf<0x4E>(x);
  return x;
}

__device__ void prep_transpose(const float* __restrict__ src, int K, int N, u16* __restrict__ dst,
                               const float* __restrict__ gain, int mode, char* lds) {
  float* tile = (float*)lds;
  const int tn = N / 64, nt = (K / 64) * tn;
  const int tid = ltid();
  for (int t = blockIdx.x; t < nt; t += gridDim.x) {
    const int k0 = (t / tn) * 64, n0 = (t % tn) * 64;
    const int nl = tid & 63, kq = tid >> 6;
#pragma unroll
    for (int i = 0; i < 16; ++i) {
      const int k = i * 4 + kq;
      float v = src[(size_t)(k0 + k) * N + n0 + nl];
      if (gain) v *= gain[k0 + k];
      tile[k * 65 + nl] = v;
    }
    __syncthreads();
    const int n = tid >> 2, kk = (tid & 3) * 16;
    unsigned w[8];
#pragma unroll
    for (int i = 0; i < 8; ++i) w[i] = pk_bf16(tile[(kk + 2 * i) * 65 + n], tile[(kk + 2 * i + 1) * 65 + n]);
    const int ng = n0 + n;
    const int row = mode == 0 ? ng : ((ng >> 5) * 64 + (ng & 31) + (mode == 2 ? 32 : 0));
    u32x4* d = (u32x4*)(dst + (size_t)row * K + k0 + kk);
    d[0] = (u32x4){w[0], w[1], w[2], w[3]};
    d[1] = (u32x4){w[4], w[5], w[6], w[7]};
    __syncthreads();
  }
}

__device__ void phase_prep(CP& p, char* lds) {
  if (blockIdx.x == 0) {
    const int tid = ltid();
    for (int idx = tid; idx < 8 * 511; idx += 256) {
      const int hd = idx / 511, di = idx - hd * 511, d = di - 255;
      const int n = d < 0 ? -d : d;
      int bk;
      if (n < 8) bk = n;
      else {
        const float nf = (float)n;
        int large = 8 + (int)(logf(nf / 8.0f) / 2.772588722239781f * 8.0f);
        bk = large < 15 ? large : 15;
      }
      const int bucket = (d > 0 ? 16 : 0) + bk;
      p.lut[hd * 512 + di] = p.rel_bias[bucket * 8 + hd] * LOG2E;
    }
    if (tid == 0) {
      float s1 = 0.f, s2 = 0.f;
      for (int i = 0; i < 64; ++i) { s1 += p.lq1[i] * p.lk1[i]; s2 += p.lq2[i] * p.lk2[i]; }
      p.lam[0] = expf(s1) - expf(s2) + 0.2f;
    }
  }
  prep_transpose(p.ffn1_wg, 1024, FFD, p.W1A, p.ffn1_norm, 1, lds);
  prep_transpose(p.ffn1_wu, 1024, FFD, p.W1A, p.ffn1_norm, 2, lds);
  prep_transpose(p.ffn1_wd, FFD, 1024, p.WD1, nullptr, 0, lds);
  prep_transpose(p.w_in, 1024, NIN, p.WIN, p.mix_norm, 0, lds);
  prep_transpose(p.w_attn, 1024, 1024, p.WATT, nullptr, 0, lds);
  prep_transpose(p.w_rw, 1024, 1024, p.WRW, nullptr, 0, lds);
  prep_transpose(p.w_out, 1024, 1024, p.WOUT, nullptr, 0, lds);
  prep_transpose(p.ffn2_wg, 1024, FFD, p.W2A, p.ffn2_norm, 1, lds);
  prep_transpose(p.ffn2_wu, 1024, FFD, p.W2A, p.ffn2_norm, 2, lds);
  prep_transpose(p.ffn2_wd, FFD, 1024, p.WD2, nullptr, 0, lds);
  prep_transpose(p.rw_w2, 64, 1024, p.W2F, nullptr, 0, lds);
  prep_transpose(p.rw_w2 + 64 * 1024, 64, 1024, p.W2B, nullptr, 0, lds);
  prep_transpose(p.rw_a2, 64, 1024, p.A2F, nullptr, 0, lds);
  prep_transpose(p.rw_a2 + 64 * 1024, 64, 1024, p.A2B, nullptr, 0, lds);
  prep_transpose(p.rw_g2, 128, 1024, p.G2T, nullptr, 0, lds);
}

__device__ void phase_rows(CP& p, const Grp& G) {
  const int lane = ltid() & 63;
  const int nw = gridDim.x * 4;
  const int gw = blockIdx.x * 4 + (ltid() >> 6);
#pragma unroll 2
  for (int row = gw; row < G.Mx; row += nw) {
    const float* src = G.x + (size_t)row * 1024;
    float ss = 0.f;
#pragma unroll
    for (int i = 0; i < 4; ++i) {
      const f32x4 v = *(const f32x4*)(src + i * 256 + lane * 4);
      ss += v.x * v.x + v.y * v.y + v.z * v.z + v.w * v.w;
      u32x2 o = {pk_bf16(v.x, v.y), pk_bf16(v.z, v.w)};
      *(u32x2*)(p.HB + (size_t)row * 1024 + i * 256 + lane * 4) = o;
    }
    ss = wave_sum(ss);
    if (lane == 0) { p.ss0[row] = ss; p.ss1[row] = 0.f; p.ss2[row] = 0.f; p.ss3[row] = 0.f; }
  }
  if (G.meta) return;
  const int Lp = (G.L + 63) & ~63;
  for (int r = gw; r < G.nseq * 16; r += nw) {
    const int s = r >> 4, t = r & 15;
    const u16* srcp = p.PM + (size_t)t * NIN;
    u16* dstp = p.P + (size_t)(G.Mx + r) * NIN;
    for (int c = lane * 8; c < NIN; c += 512)
      if (c < 2048 || c >= 3072) *(u32x4*)(dstp + c) = *(const u32x4*)(srcp + c);
    const int pos = (t & ~12) | ((t & 4) << 1) | ((t & 8) >> 1);
    for (int c = lane; c < 1024; c += 64) p.VT[(size_t)(s * 1024 + c) * Lp + pos] = srcp[2048 + c];
  }
}

#define LAS __attribute__((address_space(3)))
#define XB_TMO      128
#define XB_XCNT(j)  (256  + 64 * (j))
#define XB_XSUB(j)  (1280 + 64 * (j))
#define XB_XGEN(j)  (2304 + 64 * (j))
#define XB_TOP      3328
#define XB_TOPGEN   3392
#define XCD_BAR_WORDS 3456
#define XB_SPIN_CAP (1u << 18)
__device__ __forceinline__ unsigned xb_ld(unsigned* p) { return __hip_atomic_load(p, __ATOMIC_RELAXED, __HIP_MEMORY_SCOPE_AGENT); }
__device__ __forceinline__ unsigned xb_add(unsigned* p, unsigned v) { return __hip_atomic_fetch_add(p, v, __ATOMIC_RELAXED, __HIP_MEMORY_SCOPE_AGENT); }
__device__ __forceinline__ unsigned xb_xcc_id() { return (unsigned)__builtin_amdgcn_s_getreg((3 << 11) | 20) & 0xFu; }
#define XB_SPIN(cond, bar) do { unsigned _sp = 0; while (cond) { __builtin_amdgcn_s_sleep(1); \
    if ((++_sp & 255u) == 0u) { if (xb_ld(&(bar)[XB_TMO])) break; if (_sp > XB_SPIN_CAP) { atomicAdd(&(bar)[XB_TMO], 1u); break; } } } } while (0)
struct XcdBarrier { unsigned* bar; unsigned x; volatile LAS unsigned* st; };
__device__ __forceinline__ XcdBarrier xcd_barrier_post(unsigned* bar, volatile LAS unsigned* st) {
  XcdBarrier b; b.bar = bar; b.x = xb_xcc_id(); b.st = st;
  if (threadIdx.x == 0) (void)xb_add(&bar[XB_XCNT(b.x)], 1u);
  return b;
}
__device__ __forceinline__ void xcd_barrier_complete(unsigned* bar, unsigned x, unsigned& nloc, unsigned& nx) {
  const unsigned G = gridDim.x * gridDim.y * gridDim.z;
  unsigned sum, cnt, mine, sp = 0u;
  for (;;) {
    sum = 0u; cnt = 0u; mine = 0u;
#pragma unroll
    for (unsigned j = 0; j < 16; ++j) { const unsigned c = xb_ld(&bar[XB_XCNT(j)]); sum += c; cnt += (c > 0u) ? 1u : 0u; mine = (j == x) ? c : mine; }
    if (sum == G) break;
    __builtin_amdgcn_s_sleep(1);
    if ((++sp & 255u) == 0u) { if (xb_ld(&bar[XB_TMO])) break; if (sp > XB_SPIN_CAP) { atomicAdd(&bar[XB_TMO], 1u); break; } }
  }
  nloc = mine > 0u ? mine : 1u; nx = cnt > 0u ? cnt : 1u;
}
__device__ __forceinline__ void xcd_barrier(const XcdBarrier& b) {
  asm volatile("s_waitcnt vmcnt(0)" ::: "memory");
  __syncthreads();
  if (threadIdx.x == 0) {
    unsigned* bar = b.bar;
    __builtin_amdgcn_s_waitcnt(0);
    unsigned nloc = b.st[0], nx = b.st[1];
    if (nloc == 0u) { xcd_barrier_complete(bar, b.x, nloc, nx); b.st[0] = nloc; b.st[1] = nx; }
    const unsigned old = xb_add(&bar[XB_XSUB(b.x)], 1u);
    const unsigned gen = old / nloc;
    if (old + 1u == (gen + 1u) * nloc) {
      __builtin_amdgcn_fence(__ATOMIC_RELEASE, "agent");
      asm volatile("s_waitcnt vmcnt(0)" ::: "memory");
      const unsigned og = xb_add(&bar[XB_TOP], 1u);
      const unsigned tg = og / nx;
      if (og + 1u == (tg + 1u) * nx) xb_add(&bar[XB_TOPGEN], 1u);
      else XB_SPIN(xb_ld(&bar[XB_TOPGEN]) == tg, bar);
      __builtin_amdgcn_fence(__ATOMIC_ACQUIRE, "agent");
      xb_add(&bar[XB_XGEN(b.x)], 1u);
      asm volatile("s_waitcnt vmcnt(0)" ::: "memory");
    } else {
      XB_SPIN(xb_ld(&bar[XB_XGEN(b.x)]) == gen, bar);
      __builtin_amdgcn_fence(__ATOMIC_ACQUIRE, "agent");
      asm volatile("s_waitcnt vmcnt(0)" ::: "memory");
    }
  }
  __syncthreads();
}

#define LAS __attribute__((address_space(3)))
#define LAS __attribute__((address_space(3)))
#define LAS __attribute__((address_space(3)))
__device__ __forceinline__ void glds16(const void* gsrc, unsigned lds_dst) {
  unsigned keep;
  asm volatile("s_mov_b32 %0, m0\n\ts_mov_b32 m0, %2\n\ts_nop 0\n\tglobal_load_lds_dwordx4 %1, off\n\ts_mov_b32 m0, %0" : "=&s"(keep) : "v"(gsrc), "s"(lds_dst) : "memory");
}
struct GemmCtx {
  const u16* ap[2];
  const u16* wp[2];
  int wro[2], wsw[2], aro[2], asw[2];
  unsigned lds0;
  int tid, h;
};
__device__ __forceinline__ void g_init(GemmCtx& c, char* lds) {
  const int tid = ltid(), lane = tid & 63, wave = tid >> 6;
  const int wn = wave & 1, wt = wave >> 1, l32 = lane & 31;
  c.tid = tid; c.h = lane >> 5;
#pragma unroll
  for (int b = 0; b < 2; ++b) {
    const int wr = wn * 64 + b * 32 + l32, ar = wt * 64 + b * 32 + l32;
    c.wro[b] = wr * 64; c.wsw[b] = (wr >> 2) & 3;
    c.aro[b] = 8192 + ar * 64; c.asw[b] = (ar >> 2) & 3;
  }
  c.lds0 = __builtin_amdgcn_readfirstlane((unsigned)(uintptr_t)(LAS char*)lds + wave * 1024);
}
__device__ __forceinline__ void g_tile(GemmCtx& c, const u16* __restrict__ A, int lda, int M, int m0, const u16* __restrict__ W, int ldw, int n0) {
#pragma unroll
  for (int i = 0; i < 2; ++i) {
    const int q = c.tid + 256 * i, row = q >> 2, ch = (q & 3) ^ ((row >> 2) & 3);
    int ar = m0 + row; ar = ar < M ? ar : M - 1;
    c.ap[i] = A + (size_t)ar * lda + ch * 8;
    c.wp[i] = W + (size_t)(n0 + row) * ldw + ch * 8;
  }
}
__device__ __forceinline__ void g_stage(const GemmCtx& c, int kt) {
  const unsigned sb = c.lds0 + (kt & 3) * 16384;
#pragma unroll
  for (int i = 0; i < 2; ++i) {
    glds16(c.wp[i] + kt * 32, sb + i * 4096);
    glds16(c.ap[i] + kt * 32, sb + 8192 + i * 4096);
  }
}
__device__ __forceinline__ void g_prologue(const GemmCtx& c, int nk) {
#pragma unroll
  for (int s = 0; s < 3; ++s)
    if (s < nk) g_stage(c, s);
}
struct Frags { bf16x8 w[2][2], a[2][2]; };
__device__ __forceinline__ void g_read(Frags& f, const GemmCtx& c, int kt, const char* lds) {
  const char* st = lds + (kt & 3) * 16384;
#pragma unroll
  for (int ks = 0; ks < 2; ++ks)
#pragma unroll
    for (int b = 0; b < 2; ++b) {
      f.w[ks][b] = *(const bf16x8*)(st + c.wro[b] + (((ks * 2 + c.h) ^ c.wsw[b]) << 4));
      f.a[ks][b] = *(const bf16x8*)(st + c.aro[b] + (((ks * 2 + c.h) ^ c.asw[b]) << 4));
    }
}
__device__ __forceinline__ void g_mma(f32x16 (&acc)[2][2], const Frags& f) {
#pragma unroll
  for (int ks = 0; ks < 2; ++ks)
#pragma unroll
    for (int nb = 0; nb < 2; ++nb)
#pragma unroll
      for (int tb = 0; tb < 2; ++tb)
        acc[nb][tb] = __builtin_amdgcn_mfma_f32_32x32x16_bf16(f.w[ks][nb], f.a[ks][tb], acc[nb][tb], 0, 0, 0);
}
__device__ __forceinline__ void g_wait(int ks_needed, int issued_hi, bool drain_all) {
  const int allowed = issued_hi - ks_needed;
  if (drain_all || allowed <= 0) asm volatile("s_waitcnt vmcnt(0) lgkmcnt(0)" ::: "memory");
  else if (allowed == 1) asm volatile("s_waitcnt vmcnt(4) lgkmcnt(0)" ::: "memory");
  else asm volatile("s_waitcnt vmcnt(8) lgkmcnt(0)" ::: "memory");
  __builtin_amdgcn_s_barrier();
}
__device__ __forceinline__ void g_main(f32x16 (&acc)[2][2], const GemmCtx& c, int nk, char* lds) {
  Frags f0, f1;
  g_wait(0, nk - 1 < 2 ? nk - 1 : 2, true);
  if (3 < nk) g_stage(c, 3);
  g_read(f0, c, 0, lds);
  for (int kt = 0; kt < nk; kt += 2) {
    {
      const int hi = (kt + 3 < nk - 1) ? kt + 3 : nk - 1;
      g_wait(kt + 1, hi, false);
      if (kt + 4 < nk) g_stage(c, kt + 4);
      g_read(f1, c, kt + 1, lds);
      g_mma(acc, f0);
    }
    if (kt + 2 < nk) {
      const int hi = (kt + 4 < nk - 1) ? kt + 4 : nk - 1;
      g_wait(kt + 2, hi, false);
      if (kt + 5 < nk) g_stage(c, kt + 5);
      g_read(f0, c, kt + 2, lds);
    }
    g_mma(acc, f1);
  }
}
__device__ __forceinline__ void gemm_kloop(f32x16 (&acc)[2][2], const u16* __restrict__ A, int lda, int M, int m0,
                                           const u16* __restrict__ W, int ldw, int n0, int K, char* lds) {
  GemmCtx c;
  g_init(c, lds);
  g_tile(c, A, lda, M, m0, W, ldw, n0);
  asm volatile("s_waitcnt vmcnt(0)" ::: "memory");
  __builtin_amdgcn_s_barrier();
  g_prologue(c, K >> 5);
  g_main(acc, c, K >> 5, lds);
}

__device__ __forceinline__ void zero_acc(f32x16 (&acc)[2][2]) {
#pragma unroll
  for (int a = 0; a < 2; ++a)
#pragma unroll
    for (int b = 0; b < 2; ++b)
#pragma unroll
      for (int r = 0; r < 16; ++r) acc[a][b][r] = 0.f;
}

template <class F>
__device__ __forceinline__ void gemm_phase(const u16* A, int lda, int M, const u16* W, int K, int N, char* lds, int* ctr, F&& epi) {
  const int nN = N >> 7, nM = (M + 127) >> 7, nt = nN * nM, nk = K >> 5;
  const int xcd = (int)xb_xcc_id() & 7;
  const int tq = nt >> 3, trm = nt & 7;
  const int tstart = xcd < trm ? xcd * (tq + 1) : trm * (tq + 1) + (xcd - trm) * tq;
  const int tcnt = tq + (xcd < trm ? 1 : 0);
  auto decode = [&](int off, int& tm, int& tn) {
    const int id = tstart + off, nig = 8 * nN, grp = id / nig, fm = grp * 8;
    const int gsz = (nM - fm) < 8 ? (nM - fm) : 8, idl = id - grp * nig;
    tm = fm + idl % gsz; tn = idl / gsz;
  };
  GemmCtx c;
  g_init(c, lds);
  const int wave = c.tid >> 6;
  volatile int* bw = (volatile int*)(lds + 65536);
  int* myctr = ctr + xcd;
  int par = 0;
  if (c.tid == 0) bw[2] = atomicAdd(myctr, 1);
  asm volatile("s_waitcnt vmcnt(0) lgkmcnt(0)" ::: "memory");
  __builtin_amdgcn_s_barrier();
  int off = bw[2];
  int tm = 0, tn = 0;
  if (off < tcnt) { decode(off, tm, tn); g_tile(c, A, lda, M, tm * 128, W, K, tn * 128); g_prologue(c, nk); }
  while (off < tcnt) {
    f32x16 acc[2][2];
    zero_acc(acc);
    g_main(acc, c, nk, lds);
    const int ctm = tm, ctn = tn;
    par ^= 1;
    if (c.tid == 0) bw[2 + par] = atomicAdd(myctr, 1);
    asm volatile("s_waitcnt lgkmcnt(0)" ::: "memory");
    __builtin_amdgcn_s_barrier();
    off = bw[2 + par];
    if (off < tcnt) { decode(off, tm, tn); g_tile(c, A, lda, M, tm * 128, W, K, tn * 128); g_prologue(c, nk); }
    epi(acc, ctn * 128 + (wave & 1) * 64, ctm * 128 + (wave >> 1) * 64);
  }
}

struct WideCtx {
  const u16* ap[4];
  const u16* wp[2];
  int wro[2], wsw[2], aro[2][2], asw[2][2];
  unsigned lds0;
  int tid, h;
};
__device__ __forceinline__ void h_init(WideCtx& c, char* lds) {
  const int tid = ltid(), lane = tid & 63, wave = tid >> 6;
  const int wn = wave & 1, wt = wave >> 1, l32 = lane & 31;
  c.tid = tid; c.h = lane >> 5;
#pragma unroll
  for (int b = 0; b < 2; ++b) {
    const int wr = wn * 64 + b * 32 + l32;
    c.wro[b] = wr * 64; c.wsw[b] = (wr >> 2) & 3;
#pragma unroll
    for (int j = 0; j < 2; ++j) {
      const int ar = j * 128 + wt * 64 + b * 32 + l32;
      c.aro[j][b] = 8192 + ar * 64; c.asw[j][b] = (ar >> 2) & 3;
    }
  }
  c.lds0 = __builtin_amdgcn_readfirstlane((unsigned)(uintptr_t)(LAS char*)lds + wave * 1024);
}
__device__ __forceinline__ void h_tile(WideCtx& c, const u16* __restrict__ A, int lda, int M, int m0, const u16* __restrict__ W, int ldw, int n0) {
#pragma unroll
  for (int i = 0; i < 2; ++i) {
    const int q = c.tid + 256 * i, row = q >> 2, ch = (q & 3) ^ ((row >> 2) & 3);
    c.wp[i] = W + (size_t)(n0 + row) * ldw + ch * 8;
  }
#pragma unroll
  for (int i = 0; i < 4; ++i) {
    const int q = c.tid + 256 * i, row = q >> 2, ch = (q & 3) ^ ((row >> 2) & 3);
    int ar = m0 + row; ar = ar < M ? ar : M - 1;
    c.ap[i] = A + (size_t)ar * lda + ch * 8;
  }
}
__device__ __forceinline__ void h_stage(const WideCtx& c, int kt) {
  const unsigned sb = c.lds0 + (kt & 1) * 24576;
#pragma unroll
  for (int i = 0; i < 2; ++i) glds16(c.wp[i] + kt * 32, sb + i * 4096);
#pragma unroll
  for (int i = 0; i < 4; ++i) glds16(c.ap[i] + kt * 32, sb + 8192 + i * 4096);
}
__device__ __forceinline__ void h_main(f32x16 (&acc0)[2][2], f32x16 (&acc1)[2][2], const WideCtx& c, int nk, char* lds) {
  const int h = c.h;
  for (int kt = 0; kt < nk; ++kt) {
    asm volatile("s_waitcnt vmcnt(0)" ::: "memory");
    __builtin_amdgcn_s_barrier();
    if (kt + 1 < nk) h_stage(c, kt + 1);
    const char* st = lds + (kt & 1) * 24576;
#pragma unroll
    for (int ks = 0; ks < 2; ++ks) {
      bf16x8 wf[2], a0[2], a1[2];
#pragma unroll
      for (int b = 0; b < 2; ++b) {
        wf[b] = *(const bf16x8*)(st + c.wro[b] + (((ks * 2 + h) ^ c.wsw[b]) << 4));
        a0[b] = *(const bf16x8*)(st + c.aro[0][b] + (((ks * 2 + h) ^ c.asw[0][b]) << 4));
        a1[b] = *(const bf16x8*)(st + c.aro[1][b] + (((ks * 2 + h) ^ c.asw[1][b]) << 4));
      }
#pragma unroll
      for (int nb = 0; nb < 2; ++nb)
#pragma unroll
        for (int tb = 0; tb < 2; ++tb) {
          acc0[nb][tb] = __builtin_amdgcn_mfma_f32_32x32x16_bf16(wf[nb], a0[tb], acc0[nb][tb], 0, 0, 0);
          acc1[nb][tb] = __builtin_amdgcn_mfma_f32_32x32x16_bf16(wf[nb], a1[tb], acc1[nb][tb], 0, 0, 0);
        }
    }
  }
}
template <class F>
__device__ __forceinline__ void gemm_phase_w(const u16* A, int lda, int M, const u16* W, int K, int N, char* lds, int* ctr, F&& epi) {
  const int nN = N >> 7, nM = (M + 255) >> 8, nt = nN * nM, nk = K >> 5;
  const int xcd = (int)xb_xcc_id() & 7;
  const int tq = nt >> 3, trm = nt & 7;
  const int tstart = xcd < trm ? xcd * (tq + 1) : trm * (tq + 1) + (xcd - trm) * tq;
  const int tcnt = tq + (xcd < trm ? 1 : 0);
  auto decode = [&](int off, int& tm, int& tn) {
    const int id = tstart + off, nig = 4 * nN, grp = id / nig, fm = grp * 4;
    const int gsz = (nM - fm) < 4 ? (nM - fm) : 4, idl = id - grp * nig;
    tm = fm + idl % gsz; tn = idl / gsz;
  };
  WideCtx c;
  h_init(c, lds);
  const int wave = c.tid >> 6;
  volatile int* bw = (volatile int*)(lds + 65536);
  int* myctr = ctr + xcd;
  int par = 0;
  if (c.tid == 0) bw[2] = atomicAdd(myctr, 1);
  asm volatile("s_waitcnt vmcnt(0) lgkmcnt(0)" ::: "memory");
  __builtin_amdgcn_s_barrier();
  int off = bw[2];
  int tm = 0, tn = 0;
  if (off < tcnt) { decode(off, tm, tn); h_tile(c, A, lda, M, tm * 256, W, K, tn * 128); h_stage(c, 0); }
  while (off < tcnt) {
    f32x16 acc0[2][2], acc1[2][2];
    zero_acc(acc0);
    zero_acc(acc1);
    h_main(acc0, acc1, c, nk, lds);
    const int ctm = tm, ctn = tn;
    par ^= 1;
    if (c.tid == 0) bw[2 + par] = atomicAdd(myctr, 1);
    asm volatile("s_waitcnt lgkmcnt(0)" ::: "memory");
    __builtin_amdgcn_s_barrier();
    off = bw[2 + par];
    if (off < tcnt) { decode(off, tm, tn); h_tile(c, A, lda, M, tm * 256, W, K, tn * 128); h_stage(c, 0); }
    epi(acc0, ctn * 128 + (wave & 1) * 64, ctm * 256 + (wave >> 1) * 64);
    epi(acc1, ctn * 128 + (wave & 1) * 64, ctm * 256 + 128 + (wave >> 1) * 64);
  }
}


__device__ __forceinline__ void epi_swiglu(const f32x16 (&acc)[2][2], int nbase, int tbase, int M, const float* ss, u16* ACT) {
  const int lane = ltid() & 63, l32 = lane & 31, h = lane >> 5;
  const int cb = (nbase >> 6) * 32;
#pragma unroll
  for (int tb = 0; tb < 2; ++tb) {
    const int tok = tbase + tb * 32 + l32;
    if (tok < M) {
      const float rs = rsqrtf(ss[tok] * (1.f / 1024.f) + EPSN);
      u16* dst = ACT + (size_t)tok * FFD + cb + 4 * h;
#pragma unroll
      for (int i = 0; i < 4; ++i) {
        float o[4];
#pragma unroll
        for (int j = 0; j < 4; ++j) {
          const float g = acc[0][tb][4 * i + j] * rs, u = acc[1][tb][4 * i + j] * rs;
          o[j] = g * sigm(g) * u;
        }
        *(u32x2*)(dst + 8 * i) = (u32x2){pk_bf16(o[0], o[1]), pk_bf16(o[2], o[3])};
      }
    }
  }
}

template <int MODE>
__device__ __forceinline__ void epi_resid(const f32x16 (&acc)[2][2], int nbase, int tbase, CP& p, const Grp& G) {
  const int lane = ltid() & 63, l32 = lane & 31, h = lane >> 5;
  const float scale = MODE == 1 ? 1.f : 0.5f;
  float* ssout = MODE == 0 ? p.ss1 : (MODE == 1 ? p.ss2 : p.ss3);
#pragma unroll
  for (int tb = 0; tb < 2; ++tb) {
    const int tok = tbase + tb * 32 + l32;
    const bool valid = tok < G.Mx;
    float sq = 0.f;
    if (valid) {
      float* hp = p.H + (size_t)tok * 1024;
      u16* hb = p.HB + (size_t)tok * 1024;
      const float* rp = G.x + (size_t)tok * 1024;
#pragma unroll
      for (int nb = 0; nb < 2; ++nb)
#pragma unroll
        for (int i = 0; i < 4; ++i) {
          const int n = nbase + nb * 32 + 8 * i + 4 * h;
          f32x4 r;
          if (MODE == 0) r = *(const f32x4*)(rp + n);
          else { const u32x2 rb = *(const u32x2*)(hb + n); r = (f32x4){bf_lo(rb.x), bf_hi(rb.x), bf_lo(rb.y), bf_hi(rb.y)}; }
          f32x4 v;
          v.x = r.x + scale * acc[nb][tb][4 * i + 0];
          v.y = r.y + scale * acc[nb][tb][4 * i + 1];
          v.z = r.z + scale * acc[nb][tb][4 * i + 2];
          v.w = r.w + scale * acc[nb][tb][4 * i + 3];
          sq += v.x * v.x + v.y * v.y + v.z * v.z + v.w * v.w;
          if (MODE == 2) *(f32x4*)(hp + n) = v;
          else *(u32x2*)(hb + n) = (u32x2){pk_bf16(v.x, v.y), pk_bf16(v.z, v.w)};
        }
    }
    sq += __shfl_xor(sq, 32);
    if (valid && h == 0) atomicAdd(ssout + tok, sq);
  }
}

__device__ void phase_mix(CP& p, const Grp& G) {
  const int total = G.M * 432;
#pragma unroll 2
  for (int idx = blockIdx.x * 256 + ltid(); idx < total; idx += gridDim.x * 256) {
    const int row = idx / 432, ch = idx - row * 432;
    int s, t;
    if (row < G.Mx) { s = row >> G.lgS; t = 16 + (row & (G.S - 1)); } else { s = (row - G.Mx) >> 4; t = (row - G.Mx) & 15; }
    const int col = ch * 8;
    const u16* pc = p.P + (size_t)row * NIN + 3072 + col;
    const u32x4 c = *(const u32x4*)pc;
    u32x4 pv = {0, 0, 0, 0}, nx = {0, 0, 0, 0};
    if (t > 0) pv = *(const u32x4*)(p.P + (size_t)rowof(G, s, t - 1) * NIN + 3072 + col);
    if (t < G.L - 1) nx = *(const u32x4*)(p.P + (size_t)rowof(G, s, t + 1) * NIN + 3072 + col);
    const f32x4 mp0 = *(const f32x4*)(p.mu_prev + col), mp1 = *(const f32x4*)(p.mu_prev + col + 4);
    const f32x4 mn0 = *(const f32x4*)(p.mu_next + col), mn1 = *(const f32x4*)(p.mu_next + col + 4);
    float o[8];
#pragma unroll
    for (int e = 0; e < 4; ++e) {
      const float c0 = bf_lo(c[e]), c1 = bf_hi(c[e]);
      const float mpa = e < 2 ? mp0[2 * e] : mp1[2 * e - 4], mpb = e < 2 ? mp0[2 * e + 1] : mp1[2 * e - 3];
      const float mna = e < 2 ? mn0[2 * e] : mn1[2 * e - 4], mnb = e < 2 ? mn0[2 * e + 1] : mn1[2 * e - 3];
      o[2 * e] = c0 + mpa * (bf_lo(pv[e]) - c0) + mna * (bf_lo(nx[e]) - c0);
      o[2 * e + 1] = c1 + mpb * (bf_hi(pv[e]) - c1) + mnb * (bf_hi(nx[e]) - c1);
    }
    if (col < 3072) {
      const int sec = col >> 10, ci = col & 1023, head = ci >> 6, c0 = ci & 63;
      const size_t ro = ((size_t)row * 16 + head) * 192 + sec * 64 + c0;
      const u32x4 pk = (u32x4){pk_f16(o[0], o[1]), pk_f16(o[2], o[3]), pk_f16(o[4], o[5]), pk_f16(o[6], o[7])};
      *(u32x4*)(p.RKV + ro) = pk;
      if (sec == 1) { *(u32x4*)(p.DIR0 + ro) = pk; *(u32x4*)(p.DIR1 + ro) = pk; }
    } else {
      const int fc = col - 3072;
      if (fc < 128) {
#pragma unroll
        for (int e = 0; e < 8; ++e) o[e] = 1.f - 2.f / (1.f + __expf(2.f * o[e]));
      } else if (fc >= 256) {
#pragma unroll
        for (int e = 0; e < 8; ++e) o[e] = sigm(o[e]);
      }
      *(u32x4*)(p.F + (size_t)row * 384 + fc) = (u32x4){pk_bf16(o[0], o[1]), pk_bf16(o[2], o[3]), pk_bf16(o[4], o[5]), pk_bf16(o[6], o[7])};
    }
  }
}

__device__ __forceinline__ void epi_decay(const f32x16 (&acc)[2][2], int nbase, int tbase, int M, const float* w0, u16* DIR) {
  const int lane = ltid() & 63, l32 = lane & 31, h = lane >> 5;
  const int head = nbase >> 6;
#pragma unroll
  for (int tb = 0; tb < 2; ++tb) {
    const int tok = tbase + tb * 32 + l32;
    if (tok < M) {
      u16* dst = DIR + ((size_t)tok * 16 + head) * 192;
#pragma unroll
      for (int nb = 0; nb < 2; ++nb)
#pragma unroll
        for (int i = 0; i < 4; ++i) {
          const int c = nb * 32 + 8 * i + 4 * h;
          const f32x4 w = *(const f32x4*)(w0 + nbase + c);
          float o[4];
#pragma unroll
          for (int j = 0; j < 4; ++j) o[j] = 0.6065306597126334f * sigm(w[j] + acc[nb][tb][4 * i + j]);
          *(u32x2*)(dst + c) = (u32x2){pk_f16(o[0], o[1]), pk_f16(o[2], o[3])};
        }
    }
  }
}

__device__ __forceinline__ void epi_adir(const f32x16 (&acc)[2][2], int nbase, int tbase, int M, CP& p, int dir) {
  const int lane = ltid() & 63, l32 = lane & 31, h = lane >> 5;
  const int head = nbase >> 6;
  u16* DIR = dir ? p.DIR1 : p.DIR0;
  const float* a0 = p.rw_a0 + dir * 1024;
#pragma unroll
  for (int tb = 0; tb < 2; ++tb) {
    const int tok = tbase + tb * 32 + l32;
    const bool valid = tok < M;
    const int tk = valid ? tok : M - 1;
    const size_t rec = ((size_t)tk * 16 + head) * 192;
    float nsq = 0.f;
#pragma unroll
    for (int nb = 0; nb < 2; ++nb)
#pragma unroll
      for (int i = 0; i < 4; ++i) {
        const int c = nb * 32 + 8 * i + 4 * h;
        const u32x2 kr = *(const u32x2*)(DIR + rec + 64 + c);
        const f32x4 kkw = *(const f32x4*)(p.k_k + nbase + c);
        const float q0 = h_lo(kr.x) * kkw[0], q1 = h_hi(kr.x) * kkw[1], q2 = h_lo(kr.y) * kkw[2], q3 = h_hi(kr.y) * kkw[3];
        nsq += q0 * q0 + q1 * q1 + q2 * q2 + q3 * q3;
      }
    nsq += __shfl_xor(nsq, 32);
    const float inv = 1.f / fmaxf(sqrtf(nsq), 1e-12f);
    if (valid) {
#pragma unroll
      for (int nb = 0; nb < 2; ++nb)
#pragma unroll
        for (int i = 0; i < 4; ++i) {
          const int c = nb * 32 + 8 * i + 4 * h;
          const u32x2 kr = *(const u32x2*)(DIR + rec + 64 + c);
          const float kv[4] = {h_lo(kr.x), h_hi(kr.x), h_lo(kr.y), h_hi(kr.y)};
          const f32x4 kkw = *(const f32x4*)(p.k_k + nbase + c);
          const f32x4 kaw = *(const f32x4*)(p.k_a + nbase + c);
          const f32x4 a0v = *(const f32x4*)(a0 + nbase + c);
          float kk[4], kd[4], bp[4];
#pragma unroll
          for (int j = 0; j < 4; ++j) {
            const float k = kv[j];
            kk[j] = k * kkw[j] * inv;
            const float aa = sigm(a0v[j] + acc[nb][tb][4 * i + j]);
            kd[j] = k * (1.f + (aa - 1.f) * kaw[j]);
            bp[j] = -kk[j] * aa;
          }
          if (dir == 0) *(u32x2*)(p.RKV + rec + 64 + c) = (u32x2){pk_f16(kk[0], kk[1]), pk_f16(kk[2], kk[3])};
          *(u32x2*)(DIR + rec + 64 + c) = (u32x2){pk_f16(kd[0], kd[1]), pk_f16(kd[2], kd[3])};
          *(u32x2*)(DIR + rec + 128 + c) = (u32x2){pk_f16(bp[0], bp[1]), pk_f16(bp[2], bp[3])};
        }
    }
  }
}

template <int LPR>
__device__ void scan_task(CP& p, const Grp& G, int task, char* lds) {
  constexpr int KPL = 64 / LPR, RPB = 256 / LPR, NSPLIT = 64 / RPB;
  const int part = task % NSPLIT, t1 = task / NSPLIT;
  const int dir = t1 & 1, head = (t1 >> 1) & 15, s = t1 >> 5;
  float* buf = (float*)lds;
  const u16* rkv = p.RKV;
  const u16* dr = dir ? p.DIR1 : p.DIR0;
  u16* Y = dir ? p.Y1 : p.Y0;
  const int tid = ltid();
  const int row = part * RPB + tid / LPR, kc = tid % LPR;
  const int L = G.L, nch = L >> 4;
  u32x4 pre[3];
  auto issue = [&](int c) {
#pragma unroll
    for (int i = 0; i < 3; ++i) {
      const int id = tid + 256 * i, st = id / 48, ci = id - st * 48;
      const int n = c * 16 + st, t = dir ? L - 1 - n : n;
      const size_t rec = ((size_t)rowof(G, s, t) * 16 + head) * 192;
      const u16* src = ci < 24 ? rkv + rec + ci * 8 : dr + rec + (ci - 24) * 8;
      pre[i] = *(const u32x4*)src;
    }
  };
  auto commit = [&](int b) {
#pragma unroll
    for (int i = 0; i < 3; ++i) {
      const int id = tid + 256 * i, st = id / 48, ci = id - st * 48;
      const int sec = ci >> 3;
      const int base = sec >= 3 ? (sec - 1) * 64 : (sec == 0 ? 64 : (sec == 1 ? 0 : 320));
      float f[8];
#pragma unroll
      for (int e = 0; e < 4; ++e) { f[2 * e] = h_lo(pre[i][e]); f[2 * e + 1] = h_hi(pre[i][e]); }
      if (sec == 3) {
#pragma unroll
        for (int e = 0; e < 8; ++e) f[e] = __expf(-f[e]);
      }
      float* d = buf + b * 6144 + st * 384 + base + (ci & 7) * 8;
      *(f32x4*)d = (f32x4){f[0], f[1], f[2], f[3]};
      *(f32x4*)(d + 4) = (f32x4){f[4], f[5], f[6], f[7]};
    }
  };
  float S[KPL];
#pragma unroll
  for (int i = 0; i < KPL; ++i) S[i] = 0.f;
  __syncthreads();
  issue(0);
  commit(0);
  __syncthreads();
  __builtin_amdgcn_s_setprio(3);
  for (int c = 0; c < nch; ++c) {
    if (c + 1 < nch) issue(c + 1);
    const float* b = buf + (c & 1) * 6144;
#pragma unroll 1
    for (int g0 = 0; g0 < 16; g0 += LPR) {
      float ykeep = 0.f;
#pragma unroll 2
      for (int j = 0; j < LPR; ++j) {
        const int st = g0 + j;
        const float* q = b + st * 384 + kc * KPL;
        f32x4 kk[KPL / 4], rr[KPL / 4], ww[KPL / 4], dd[KPL / 4], bb[KPL / 4];
#pragma unroll
        for (int jj = 0; jj < KPL / 4; ++jj) {
          kk[jj] = *(const f32x4*)(q + 4 * jj);
          rr[jj] = *(const f32x4*)(q + 64 + 4 * jj);
          ww[jj] = *(const f32x4*)(q + 128 + 4 * jj);
          dd[jj] = *(const f32x4*)(q + 192 + 4 * jj);
          bb[jj] = *(const f32x4*)(q + 256 + 4 * jj);
        }
        const float vv = b[st * 384 + 320 + row];
        float sa0 = 0.f, sa1 = 0.f;
#pragma unroll
        for (int jj = 0; jj < KPL / 4; ++jj) {
          sa0 += S[4 * jj] * kk[jj][0]; sa1 += S[4 * jj + 1] * kk[jj][1];
          sa0 += S[4 * jj + 2] * kk[jj][2]; sa1 += S[4 * jj + 3] * kk[jj][3];
        }
        float sa = sa0 + sa1;
        sa = LPR == 8 ? reduce8(sa) : reduce4(sa);
        float y0 = 0.f, y1 = 0.f;
#pragma unroll
        for (int jj = 0; jj < KPL / 4; ++jj)
#pragma unroll
          for (int e = 0; e < 4; ++e) {
            const float sn = S[4 * jj + e] * ww[jj][e] + (sa * bb[jj][e] + vv * dd[jj][e]);
            S[4 * jj + e] = sn;
            if (e & 1) y1 += sn * rr[jj][e]; else y0 += sn * rr[jj][e];
          }
        float y = y0 + y1;
        y = LPR == 8 ? reduce8(y) : reduce4(y);
        ykeep = (kc == j) ? y : ykeep;
      }
      const int n = c * 16 + g0 + kc, t = dir ? L - 1 - n : n;
      Y[(size_t)rowof(G, s, t) * 1024 + head * 64 + row] = bf16_1(ykeep);
    }
    if (c + 1 < nch) commit((c + 1) & 1);
    __syncthreads();
  }
  __builtin_amdgcn_s_setprio(0);
}

__device__ void attn_tile(CP& p, const Grp& G, int s, int hd, int qb, char* lds, float lam) {
  const int tid = ltid(), lane = tid & 63, wave = tid >> 6, l32 = lane & 31, h = lane >> 5;
  const int L = G.L, Lp = (G.L + 63) & ~63;
  const u16* Pb = p.P;
  float* lutl = (float*)(lds + 49152);
  __syncthreads();
  for (int i = tid; i < 511; i += 256) lutl[i] = p.lut[hd * 512 + i];
  const int q = 16 + qb * 128 + wave * 32 + l32;
  const int qc = s * G.S + (q - 16);
  const int qw0 = 16 + qb * 128 + wave * 32;
  u16* odst = p.O + (size_t)qc * 1024 + hd * 128;
  int kkey[2], kchn[2];
#pragma unroll
  for (int i = 0; i < 2; ++i) { const int c = tid + 256 * i; kkey[i] = c >> 3; kchn[i] = (c & 7) ^ ((kkey[i] >> 1) & 7); }
  const u16* vsrc[4];
#pragma unroll
  for (int i = 0; i < 4; ++i) {
    const int c = tid + 256 * i, dv = c >> 3, c8 = (c & 7) ^ ((dv >> 1) & 7);
    vsrc[i] = p.VT + ((size_t)(s * 1024 + hd * 128 + dv) * Lp) + c8 * 8;
  }
  const unsigned lds0 = __builtin_amdgcn_readfirstlane((unsigned)(uintptr_t)(LAS char*)lds + wave * 1024);
  const int n64 = (L + 63) >> 6;
#pragma unroll 1
  for (int br = 0; br < 2; ++br) {
    bf16x8 qv[4];
#pragma unroll
    for (int ks = 0; ks < 4; ++ks) {
      const u32x4 raw = *(const u32x4*)(Pb + (size_t)qc * NIN + hd * 128 + br * 64 + ks * 16 + h * 8);
      u32x4 sc;
#pragma unroll
      for (int e = 0; e < 4; ++e) sc[e] = pk_bf16(bf_lo(raw[e]) * 0.125f, bf_hi(raw[e]) * 0.125f);
      qv[ks] = __builtin_bit_cast(bf16x8, sc);
    }
    const u16* kp = Pb + 1024 + hd * 128 + br * 64;
    auto stage = [&](int kt) {
      const int k0 = kt * 64;
      const unsigned sb = lds0 + (kt & 1) * 24576;
#pragma unroll
      for (int i = 0; i < 2; ++i) {
        int kr = k0 + kkey[i]; kr = kr < L ? kr : L - 1;
        glds16(kp + (size_t)rowof(G, s, kr) * NIN + kchn[i] * 8, sb + i * 4096);
      }
#pragma unroll
      for (int i = 0; i < 4; ++i) glds16(vsrc[i] + k0, sb + 8192 + i * 4096);
    };
    f32x16 O[4];
#pragma unroll
    for (int mb = 0; mb < 4; ++mb)
#pragma unroll
      for (int r = 0; r < 16; ++r) O[mb][r] = 0.f;
    float mrun = -1e30f, lrun = 0.f;
    asm volatile("s_waitcnt vmcnt(0) lgkmcnt(0)" ::: "memory");
    __builtin_amdgcn_s_barrier();
    stage(0);
    const float cneg = lutl[0], cpos = lutl[510];
    for (int kt = 0; kt < n64; ++kt) {
      asm volatile("s_waitcnt vmcnt(0)" ::: "memory");
      __builtin_amdgcn_s_barrier();
      if (kt + 1 < n64) stage(kt + 1);
      const char* st64 = lds + (kt & 1) * 24576;
#pragma unroll
      for (int hf = 0; hf < 2; ++hf) {
      const int kt0 = kt * 64 + hf * 32;
      if (kt0 >= L) break;
      const char* st = st64 + hf * 4096;
      f32x16 sacc;
#pragma unroll
      for (int r = 0; r < 16; ++r) sacc[r] = 0.f;
      bf16x8 kf[4], vf[4][2];
#pragma unroll
      for (int ks = 0; ks < 4; ++ks) kf[ks] = *(const bf16x8*)(st + l32 * 128 + (((ks * 2 + h) ^ ((l32 >> 1) & 7)) << 4));
#pragma unroll
      for (int mb = 0; mb < 4; ++mb)
#pragma unroll
        for (int s2 = 0; s2 < 2; ++s2) {
          const int vr = mb * 32 + l32;
          vf[mb][s2] = *(const bf16x8*)(st64 + 8192 + vr * 128 + (((hf * 4 + 2 * s2 + h) ^ ((vr >> 1) & 7)) << 4));
        }
      __builtin_amdgcn_sched_barrier(0);
#pragma unroll
      for (int ks = 0; ks < 4; ++ks) sacc = __builtin_amdgcn_mfma_f32_32x32x16_bf16(kf[ks], qv[ks], sacc, 0, 0, 0);
      const bool farneg = (kt0 + 31) <= (qw0 - 128);
      const bool farpos = kt0 >= (qw0 + 31 + 128);
      float ps = 0.f, alpha;
      if ((farneg || farpos) && (kt0 + 32 <= L)) {
        const float cv = farneg ? cneg : cpos;
        float mx = fmaxf(fmaxf(sacc[0], sacc[1]), sacc[2]);
#pragma unroll
        for (int r = 3; r < 15; r += 2) mx = fmaxf(fmaxf(mx, sacc[r]), sacc[r + 1]);
        mx = fmaxf(mx, sacc[15]);
        mx = xmax32(mx);
        const float mnew = fmaxf(mrun, mx * LOG2E + cv);
        alpha = __builtin_amdgcn_exp2f(mrun - mnew);
        mrun = mnew;
        const float sh = cv - mnew;
#pragma unroll
        for (int r = 0; r < 16; ++r) { sacc[r] = __builtin_amdgcn_exp2f(sacc[r] * LOG2E + sh); ps += sacc[r]; }
      } else {
        float mx = -1e30f;
        if (farneg || farpos) {
          const float cv = farneg ? cneg : cpos;
#pragma unroll
          for (int r = 0; r < 16; ++r) { sacc[r] = sacc[r] * LOG2E + cv; }
        } else {
#pragma unroll
          for (int r = 0; r < 16; ++r) {
            const int key = kt0 + 8 * (r >> 2) + 4 * h + (r & 3);
            int d = key - q + 255;
            d = d < 0 ? 0 : (d > 510 ? 510 : d);
            sacc[r] = sacc[r] * LOG2E + lutl[d];
          }
        }
        if (kt0 + 32 > L) {
#pragma unroll
          for (int r = 0; r < 16; ++r) {
            const int key = kt0 + 8 * (r >> 2) + 4 * h + (r & 3);
            if (key >= L) sacc[r] = -INFINITY;
          }
        }
#pragma unroll
        for (int r = 0; r < 16; ++r) mx = fmaxf(mx, sacc[r]);
        mx = xmax32(mx);
        const float mnew = fmaxf(mrun, mx);
        alpha = __builtin_amdgcn_exp2f(mrun - mnew);
        mrun = mnew;
#pragma unroll
        for (int r = 0; r < 16; ++r) { sacc[r] = __builtin_amdgcn_exp2f(sacc[r] - mnew); ps += sacc[r]; }
      }
      lrun = lrun * alpha + ps;
      if (__any(alpha != 1.f)) {
#pragma unroll
        for (int mb = 0; mb < 4; ++mb)
#pragma unroll
          for (int r = 0; r < 16; ++r) O[mb][r] *= alpha;
      }
      bf16x8 pf[2];
#pragma unroll
      for (int s2 = 0; s2 < 2; ++s2) {
        u32x4 w;
#pragma unroll
        for (int e = 0; e < 4; ++e) w[e] = pk_bf16(sacc[8 * s2 + 2 * e], sacc[8 * s2 + 2 * e + 1]);
        pf[s2] = __builtin_bit_cast(bf16x8, w);
      }
      __builtin_amdgcn_sched_barrier(0);
#pragma unroll
      for (int s2 = 0; s2 < 2; ++s2)
#pragma unroll
        for (int mb = 0; mb < 4; ++mb)
          O[mb] = __builtin_amdgcn_mfma_f32_32x32x16_bf16(vf[mb][s2], pf[s2], O[mb], 0, 0, 0);
      }
    }
    const float lt = lrun + __shfl_xor(lrun, 32);
    if (br == 0) {
      const float i1 = 1.f / lt;
#pragma unroll
      for (int mb = 0; mb < 4; ++mb)
#pragma unroll
        for (int i = 0; i < 4; ++i)
          if (q < L) *(u32x2*)(odst + mb * 32 + 8 * i + 4 * h) = (u32x2){pk_bf16(O[mb][4 * i] * i1, O[mb][4 * i + 1] * i1), pk_bf16(O[mb][4 * i + 2] * i1, O[mb][4 * i + 3] * i1)};
    } else {
      const float i2 = lam / lt;
      float ssq = 0.f;
#pragma unroll
      for (int mb = 0; mb < 4; ++mb)
#pragma unroll
        for (int i = 0; i < 4; ++i) {
          u32x2 w = {0, 0};
          if (q < L) w = *(const u32x2*)(odst + mb * 32 + 8 * i + 4 * h);
          const float o0 = bf_lo(w.x) - O[mb][4 * i] * i2, o1v = bf_hi(w.x) - O[mb][4 * i + 1] * i2, o2 = bf_lo(w.y) - O[mb][4 * i + 2] * i2, o3 = bf_hi(w.y) - O[mb][4 * i + 3] * i2;
          O[mb][4 * i] = o0; O[mb][4 * i + 1] = o1v; O[mb][4 * i + 2] = o2; O[mb][4 * i + 3] = o3;
          ssq += o0 * o0 + o1v * o1v + o2 * o2 + o3 * o3;
        }
      ssq += __shfl_xor(ssq, 32);
      const float rn = rsqrtf(ssq * (1.f / 128.f) + EPSN) * 0.8f;
      if (q < L) {
#pragma unroll
        for (int mb = 0; mb < 4; ++mb)
#pragma unroll
          for (int i = 0; i < 4; ++i) {
            const int dv = mb * 32 + 8 * i + 4 * h;
            const f32x4 g = *(const f32x4*)(p.subln + dv);
            *(u32x2*)(odst + dv) = (u32x2){pk_bf16(O[mb][4 * i] * rn * g.x, O[mb][4 * i + 1] * rn * g.y),
                                           pk_bf16(O[mb][4 * i + 2] * rn * g.z, O[mb][4 * i + 3] * rn * g.w)};
          }
      }
    }
  }
}

__device__ void phase_mixer(CP& p, const Grp& G, int g, char* lds) {
  if (G.nseq == 4) { for (int t = blockIdx.x; t < 256; t += gridDim.x) scan_task<8>(p, G, t, lds); }
  else { for (int t = blockIdx.x; t < 256; t += gridDim.x) scan_task<4>(p, G, t, lds); }
  const int nqb = G.S >> 7;
  const int nper = G.nseq * nqb;
  const float lam = p.lam[0];
  int* shw = (int*)(lds + 65536 - 16);
  const int myx = (int)xb_xcc_id() & 7;
  for (int dx = 0; dx < 8; ++dx) {
    const int hd = (myx + dx) & 7;
    while (true) {
      __syncthreads();
      if (ltid() == 0) *shw = atomicAdd(p.cnt + g * 8 + hd, 1);
      __syncthreads();
      const int t = *shw;
      if (t >= nper) break;
      const int qb = t % nqb, s = t / nqb;
      attn_tile(p, G, s, hd, qb, lds, lam);
    }
  }
}

__device__ void phase_post(CP& p, const Grp& G) {
  const int lane = ltid() & 63;
  const int nw = gridDim.x * 4;
  const int c0 = lane * 16, head = lane >> 2, hc = (lane & 3) * 16;
  for (int row = blockIdx.x * 4 + (ltid() >> 6); row < G.Mx; row += nw) {
    float y[16];
    {
      const u32x4 a0 = *(const u32x4*)(p.Y0 + (size_t)row * 1024 + c0), a1 = *(const u32x4*)(p.Y0 + (size_t)row * 1024 + c0 + 8);
      const u32x4 b0 = *(const u32x4*)(p.Y1 + (size_t)row * 1024 + c0), b1 = *(const u32x4*)(p.Y1 + (size_t)row * 1024 + c0 + 8);
#pragma unroll
      for (int e = 0; e < 4; ++e) {
        y[2 * e] = bf_lo(a0[e]) + bf_lo(b0[e]); y[2 * e + 1] = bf_hi(a0[e]) + bf_hi(b0[e]);
        y[8 + 2 * e] = bf_lo(a1[e]) + bf_lo(b1[e]); y[8 + 2 * e + 1] = bf_hi(a1[e]) + bf_hi(b1[e]);
      }
    }
    float s1 = 0.f;
#pragma unroll
    for (int e = 0; e < 16; ++e) s1 += y[e];
    s1 = reduce4(s1);
    const float mu = s1 * (1.f / 64.f);
    float s2 = 0.f;
#pragma unroll
    for (int e = 0; e < 16; ++e) { const float d = y[e] - mu; s2 += d * d; }
    s2 = reduce4(s2);
    const float rstd = rsqrtf(s2 * (1.f / 64.f) + 64e-5f);
    const size_t rec = ((size_t)row * 16 + head) * 192 + hc;
    float rr[16], vv[16], kd[16];
    {
      const u32x4 r0 = *(const u32x4*)(p.RKV + rec), r1 = *(const u32x4*)(p.RKV + rec + 8);
      const u32x4 v0 = *(const u32x4*)(p.RKV + rec + 128), v1 = *(const u32x4*)(p.RKV + rec + 136);
      const u32x4 f0 = *(const u32x4*)(p.DIR0 + rec + 64), f1 = *(const u32x4*)(p.DIR0 + rec + 72);
      const u32x4 g0 = *(const u32x4*)(p.DIR1 + rec + 64), g1 = *(const u32x4*)(p.DIR1 + rec + 72);
#pragma unroll
      for (int e = 0; e < 4; ++e) {
        rr[2 * e] = h_lo(r0[e]); rr[2 * e + 1] = h_hi(r0[e]); rr[8 + 2 * e] = h_lo(r1[e]); rr[8 + 2 * e + 1] = h_hi(r1[e]);
        vv[2 * e] = h_lo(v0[e]); vv[2 * e + 1] = h_hi(v0[e]); vv[8 + 2 * e] = h_lo(v1[e]); vv[8 + 2 * e + 1] = h_hi(v1[e]);
        kd[2 * e] = h_lo(f0[e]) + h_lo(g0[e]); kd[2 * e + 1] = h_hi(f0[e]) + h_hi(g0[e]);
        kd[8 + 2 * e] = h_lo(f1[e]) + h_lo(g1[e]); kd[8 + 2 * e + 1] = h_hi(f1[e]) + h_hi(g1[e]);
      }
    }
    float bs = 0.f;
#pragma unroll
    for (int e = 0; e < 16; ++e) bs += rr[e] * kd[e] * p.r_k[c0 + e];
    bs = reduce4(bs);
    const u32x4 g0 = *(const u32x4*)(p.G + (size_t)row * 1024 + c0), g1 = *(const u32x4*)(p.G + (size_t)row * 1024 + c0 + 8);
    float o[16];
#pragma unroll
    for (int e = 0; e < 16; ++e) {
      const unsigned gw = e < 8 ? g0[e >> 1] : g1[(e - 8) >> 1];
      const float gg = (e & 1) ? bf_hi(gw) : bf_lo(gw);
      o[e] = ((y[e] - mu) * rstd * p.lnx_w[c0 + e] + p.lnx_b[c0 + e] + bs * vv[e]) * gg;
    }
    u16* dst = (u16*)p.H + (size_t)row * 1024 + c0;
    *(u32x4*)dst = (u32x4){pk_bf16(o[0], o[1]), pk_bf16(o[2], o[3]), pk_bf16(o[4], o[5]), pk_bf16(o[6], o[7])};
    *(u32x4*)(dst + 8) = (u32x4){pk_bf16(o[8], o[9]), pk_bf16(o[10], o[11]), pk_bf16(o[12], o[13]), pk_bf16(o[14], o[15])};
  }
}

__device__ void phase_final(CP& p, const Grp& G) {
  const int lane = ltid() & 63;
  const int nw = gridDim.x * 4;
#pragma unroll 2
  for (int row = blockIdx.x * 4 + (ltid() >> 6); row < G.Mx; row += nw) {
    const float rs = rsqrtf(p.ss3[row] * (1.f / 1024.f) + EPSN);
    const float* hp = p.H + (size_t)row * 1024;
    float* op = G.out + (size_t)row * 1024;
#pragma unroll
    for (int i = 0; i < 4; ++i) {
      const f32x4 v = *(const f32x4*)(hp + i * 256 + lane * 4);
      const f32x4 g = *(const f32x4*)(p.final_norm + i * 256 + lane * 4);
      *(f32x4*)(op + i * 256 + lane * 4) = (f32x4){v.x * rs * g.x, v.y * rs * g.y, v.z * rs * g.z, v.w * rs * g.w};
    }
  }
}

__device__ void run_phase(CP& p, int ph, char* lds) {
  int* gctr = p.cnt + 64 + ph * 64;
  if (ph == 0) { phase_prep(p, lds); return; }
  int g, k;
  if (ph <= NMETA_PH) { g = -1; k = ph - 1; }
  else { g = (ph - 1 - NMETA_PH) / PH_PER_G; k = (ph - 1 - NMETA_PH) - g * PH_PER_G; }
  const Grp G = get_grp(p, g);
  const int Mall = G.M;
  const int M = G.Mx;
  u16* Pout = G.meta ? p.PM : p.P;
  switch (k) {
    case 0: phase_rows(p, G); break;
    case 1:
      gemm_phase_w(p.HB, 1024, M, p.W1A, 1024, 2 * FFD, lds, gctr, [&](const f32x16 (&acc)[2][2], int nb, int tb) { epi_swiglu(acc, nb, tb, M, p.ss0, p.ACT); });
      break;
    case 2:
      gemm_phase_w(p.ACT, FFD, M, p.WD1, FFD, 1024, lds, gctr, [&](const f32x16 (&acc)[2][2], int nb, int tb) { epi_resid<0>(acc, nb, tb, p, G); });
      break;
    case 3:
      gemm_phase_w(p.HB, 1024, M, p.WIN, 1024, NIN, lds, gctr, [&](const f32x16 (&acc)[2][2], int nbase, int tbase) {
        const int lane = ltid() & 63, l32 = lane & 31, h = lane >> 5;
#pragma unroll
        for (int tb = 0; tb < 2; ++tb) {
          const int tok = tbase + tb * 32 + l32;
          if (tok < M) {
            const float rs = rsqrtf(p.ss1[tok] * (1.f / 1024.f) + EPSN);
            if (!G.meta && nbase >= 2048 && nbase < 3072) {
              const int s = tok >> G.lgS, t = 16 + (tok & (G.S - 1));
              const int Lp = (G.L + 63) & ~63;
              const int pos = (t & ~12) | ((t & 4) << 1) | ((t & 8) >> 1);
              u16* vt = p.VT + ((size_t)(s * 1024 + (nbase - 2048)) * Lp) + pos;
#pragma unroll
              for (int nb = 0; nb < 2; ++nb)
#pragma unroll
                for (int r = 0; r < 16; ++r) {
                  const int dvl = nb * 32 + 8 * (r >> 2) + 4 * h + (r & 3);
                  vt[(size_t)dvl * Lp] = bf16_1(acc[nb][tb][r] * rs);
                }
            } else {
              u16* dst = Pout + (size_t)tok * NIN + nbase + 4 * h;
#pragma unroll
              for (int nb = 0; nb < 2; ++nb)
#pragma unroll
                for (int i = 0; i < 4; ++i)
                  *(u32x2*)(dst + nb * 32 + 8 * i) = (u32x2){pk_bf16(acc[nb][tb][4 * i] * rs, acc[nb][tb][4 * i + 1] * rs),
                                                             pk_bf16(acc[nb][tb][4 * i + 2] * rs, acc[nb][tb][4 * i + 3] * rs)};
            }
          }
        }
      });
      break;
    case 4: phase_mix(p, G); break;
    case 5:
      gemm_phase(p.F, 384, Mall, p.W2F, 64, 1024, lds, gctr, [&](const f32x16 (&acc)[2][2], int nb, int tb) { epi_decay(acc, nb, tb, Mall, p.rw_w0, p.DIR0); });
      gemm_phase(p.F + 64, 384, Mall, p.W2B, 64, 1024, lds, gctr + 8, [&](const f32x16 (&acc)[2][2], int nb, int tb) { epi_decay(acc, nb, tb, Mall, p.rw_w0 + 1024, p.DIR1); });
      gemm_phase(p.F + 128, 384, Mall, p.A2F, 64, 1024, lds, gctr + 16, [&](const f32x16 (&acc)[2][2], int nb, int tb) { epi_adir(acc, nb, tb, Mall, p, 0); });
      gemm_phase(p.F + 192, 384, Mall, p.A2B, 64, 1024, lds, gctr + 24, [&](const f32x16 (&acc)[2][2], int nb, int tb) { epi_adir(acc, nb, tb, Mall, p, 1); });
      gemm_phase(p.F + 256, 384, Mall, p.G2T, 128, 1024, lds, gctr + 32, [&](const f32x16 (&acc)[2][2], int nbase, int tbase) {
        const int lane = ltid() & 63, l32 = lane & 31, h = lane >> 5;
#pragma unroll
        for (int tb = 0; tb < 2; ++tb) {
          const int tok = tbase + tb * 32 + l32;
          if (tok < Mall) {
            u16* dst = p.G + (size_t)tok * 1024 + nbase + 4 * h;
#pragma unroll
            for (int nb = 0; nb < 2; ++nb)
#pragma unroll
              for (int i = 0; i < 4; ++i)
                *(u32x2*)(dst + nb * 32 + 8 * i) = (u32x2){pk_bf16(acc[nb][tb][4 * i], acc[nb][tb][4 * i + 1]), pk_bf16(acc[nb][tb][4 * i + 2], acc[nb][tb][4 * i + 3])};
          }
        }
      });
      break;
    case 6: phase_mixer(p, G, g, lds); break;
    case 7: phase_post(p, G); break;
    case 8: {
      const int nN = 8, nM = (M + 255) >> 8, nt = nN * nM;
      const int wave = ltid() >> 6;
      const int lane = ltid() & 63, l32 = lane & 31, h = lane >> 5;
      const int xcd = blockIdx.x & 7, g8 = gridDim.x >> 3;
      const int tq = nt >> 3, trm = nt & 7;
      const int tstart = xcd < trm ? xcd * (tq + 1) : trm * (tq + 1) + (xcd - trm) * tq;
      const int tcnt = tq + (xcd < trm ? 1 : 0);
      WideCtx c;
      h_init(c, lds);
      for (int off = blockIdx.x >> 3; off < tcnt; off += g8) {
        const int id = tstart + off, nig = 4 * nN, grp = id / nig, fm = grp * 4;
        const int gsz = (nM - fm) < 4 ? (nM - fm) : 4, idl = id - grp * nig;
        const int tm = fm + idl % gsz, tn = idl / gsz;
        const int nbase = tn * 128 + (wave & 1) * 64;
#pragma unroll 1
        for (int pass = 0; pass < 2; ++pass) {
          f32x16 acc0[2][2], acc1[2][2];
          zero_acc(acc0);
          zero_acc(acc1);
          h_tile(c, pass ? (const u16*)p.H : p.O, 1024, M, tm * 256, pass ? p.WRW : p.WATT, 1024, tn * 128);
          asm volatile("s_waitcnt vmcnt(0) lgkmcnt(0)" ::: "memory");
          __builtin_amdgcn_s_barrier();
          h_stage(c, 0);
          h_main(acc0, acc1, c, 32, lds);
          auto epi = [&](const f32x16 (&acc)[2][2], int tbase) {
#pragma unroll
            for (int tb = 0; tb < 2; ++tb) {
              const int tok = tbase + tb * 32 + l32;
              if (tok < M) {
                const u16* gp = p.P + (size_t)tok * NIN + 6528 + pass * 1024 + nbase + 4 * h;
                u16* dst = p.MERGED + (size_t)tok * 1024 + nbase + 4 * h;
#pragma unroll
                for (int nb = 0; nb < 2; ++nb)
#pragma unroll
                  for (int i = 0; i < 4; ++i) {
                    const u32x2 ga = *(const u32x2*)(gp + nb * 32 + 8 * i);
                    float o0 = sigm(bf_lo(ga.x)) * acc[nb][tb][4 * i];
                    float o1 = sigm(bf_hi(ga.x)) * acc[nb][tb][4 * i + 1];
                    float o2 = sigm(bf_lo(ga.y)) * acc[nb][tb][4 * i + 2];
                    float o3 = sigm(bf_hi(ga.y)) * acc[nb][tb][4 * i + 3];
                    if (pass) {
                      const u32x2 pv = *(const u32x2*)(dst + nb * 32 + 8 * i);
                      o0 += bf_lo(pv.x); o1 += bf_hi(pv.x); o2 += bf_lo(pv.y); o3 += bf_hi(pv.y);
                    }
                    *(u32x2*)(dst + nb * 32 + 8 * i) = (u32x2){pk_bf16(o0, o1), pk_bf16(o2, o3)};
                  }
              }
            }
          };
          epi(acc0, tm * 256 + (wave >> 1) * 64);
          epi(acc1, tm * 256 + 128 + (wave >> 1) * 64);
        }
      }
    } break;
    case 9:
      gemm_phase_w(p.MERGED, 1024, M, p.WOUT, 1024, 1024, lds, gctr, [&](const f32x16 (&acc)[2][2], int nb, int tb) { epi_resid<1>(acc, nb, tb, p, G); });
      break;
    case 10:
      gemm_phase_w(p.HB, 1024, M, p.W2A, 1024, 2 * FFD, lds, gctr, [&](const f32x16 (&acc)[2][2], int nb, int tb) { epi_swiglu(acc, nb, tb, M, p.ss2, p.ACT); });
      break;
    case 11:
      gemm_phase_w(p.ACT, FFD, M, p.WD2, FFD, 1024, lds, gctr, [&](const f32x16 (&acc)[2][2], int nb, int tb) { epi_resid<2>(acc, nb, tb, p, G); });
      break;
    case 12: phase_final(p, G); break;
  }
}

__global__ void __launch_bounds__(256, 2) mega(Params p, int ph_lo, int ph_hi, int coop) {
  __shared__ __attribute__((aligned(16))) char lds[65536 + 16];
  uint4& xb_words = *(uint4*)(lds + 65536);
  CP* pp = (CP*)__builtin_amdgcn_kernarg_segment_ptr();
  asm volatile("" : "+s"(pp));
  if (threadIdx.x == 0) xb_words = make_uint4(0u, 0u, 0u, 0u);
  __syncthreads();
  const XcdBarrier xb = xcd_barrier_post(pp->bar, (volatile LAS unsigned*)&xb_words);
  for (int ph = ph_lo; ph < ph_hi; ++ph) {
    run_phase(*pp, ph, lds);
    if (coop && ph + 1 < ph_hi) {
      if (ph == 0) cg::this_grid().sync();
      else xcd_barrier(xb);
    }
  }
}

extern "C" void kernel_launch(void* const* d_in, const int* in_sizes, int n_in, void* d_out, int out_size, void* d_ws,
                              size_t ws_size, hipStream_t stream) {
  Params p;
  memset(&p, 0, sizeof(p));
  const float** f = (const float**)&p;
  for (int i = 0; i < 35; ++i) f[i] = (const float*)d_in[i];
  p.out = (float*)d_out;
  char* w = (char*)d_ws;
  size_t off = 0;
  auto alloc = [&](size_t bytes) { char* r = w + off; off += (bytes + 255) & ~(size_t)255; return r; };
  p.W1A = (u16*)alloc((size_t)2 * FFD * 1024 * 2);
  p.WD1 = (u16*)alloc((size_t)1024 * FFD * 2);
  p.WIN = (u16*)alloc((size_t)NIN * 1024 * 2);
  p.WATT = (u16*)alloc((size_t)1024 * 1024 * 2);
  p.WRW = (u16*)alloc((size_t)1024 * 1024 * 2);
  p.WOUT = (u16*)alloc((size_t)1024 * 1024 * 2);
  p.W2A = (u16*)alloc((size_t)2 * FFD * 1024 * 2);
  p.WD2 = (u16*)alloc((size_t)1024 * FFD * 2);
  p.W2F = (u16*)alloc((size_t)1024 * 64 * 2);
  p.W2B = (u16*)alloc((size_t)1024 * 64 * 2);
  p.A2F = (u16*)alloc((size_t)1024 * 64 * 2);
  p.A2B = (u16*)alloc((size_t)1024 * 64 * 2);
  p.G2T = (u16*)alloc((size_t)1024 * 128 * 2);
  p.lut = (float*)alloc(8 * 512 * 4);
  p.cnt = (int*)alloc((64 + NPHASES * 64) * 4);
  p.lam = (float*)alloc(256);
  p.bar = (unsigned*)alloc(XCD_BAR_WORDS * 4);
  const size_t R = MAXROWS;
  p.H = (float*)alloc(R * 1024 * 4);
  p.HB = (u16*)alloc(R * 1024 * 2);
  p.ACT = (u16*)alloc(R * FFD * 2);
  p.Y0 = p.ACT;
  p.Y1 = p.ACT + R * 1024;
  p.F = p.ACT + R * 2048;
  p.P = (u16*)alloc(R * NIN * 2);
  p.RKV = (u16*)alloc(R * 16 * 192 * 2);
  p.DIR0 = (u16*)alloc(R * 16 * 192 * 2);
  p.DIR1 = (u16*)alloc(R * 16 * 192 * 2);
  p.G = (u16*)alloc(R * 1024 * 2);
  p.O = (u16*)alloc(R * 1024 * 2);
  p.MERGED = (u16*)alloc(R * 1024 * 2);
  p.VT = (u16*)alloc((size_t)8 * 8 * 128 * 2112 * 2);
  p.PM = (u16*)alloc((size_t)16 * NIN * 2);
  p.ss0 = (float*)alloc(R * 4);
  p.ss1 = (float*)alloc(R * 4);
  p.ss2 = (float*)alloc(R * 4);
  p.ss3 = (float*)alloc(R * 4);
  if (off > ws_size) { fprintf(stderr, "workspace too small: need %zu have %zu\n", off, ws_size); return; }
  static int grid_blocks = 0;
  if (!grid_blocks) {
    int dev = 0, cus = 0, per_cu = 0;
    hipGetDevice(&dev);
    hipDeviceGetAttribute(&cus, hipDeviceAttributeMultiprocessorCount, dev);
    hipOccupancyMaxActiveBlocksPerMultiprocessor(&per_cu, mega, 256, 0);
    per_cu = 2;
    grid_blocks = cus * per_cu;
  }
  hipMemsetAsync(p.bar, 0, XCD_BAR_WORDS * 4, stream);
  hipMemsetAsync(p.cnt, 0, (64 + NPHASES * 64) * 4, stream);
  int ph_lo = 0, ph_hi = NPHASES, coop = 1;
  void* args[] = {&p, &ph_lo, &ph_hi, &coop};
  hipError_t e = hipLaunchCooperativeKernel((void*)mega, dim3(grid_blocks), dim3(256), args, 0, stream);
  if (e != hipSuccess) fprintf(stderr, "cooperative launch failed: %s (grid %d)\n", hipGetErrorString(e), grid_blocks);
}
```
